# Optimizing an MI355X kernel written in HIP

```python
import math
import jax
import jax.numpy as jnp
from jax import lax
import numpy as np

D_MODEL = 1024
BATCH = 4
SEQ = 4096
DEPTH = 1
DEC_BATCH = 8
DEC_SEQ = 32
PAST_LEN = 4096

CHUNK = 64
D_MIX = D_MODEL
D_S5 = D_MIX // 2
S5_GROUP = 16
S5_GROUPS = D_S5 // S5_GROUP
S5_STATE = 64
D_FOX = D_MIX - D_S5
FOX_HEAD_DIM = 64
FOX_HEADS = D_FOX // FOX_HEAD_DIM
D_IN = D_S5 + 3 * D_FOX + FOX_HEADS
SPLITS = (D_S5, D_S5 + D_FOX, D_S5 + 2 * D_FOX, D_S5 + 3 * D_FOX)
D_FF = 2816
N_MOD = 9
Q_BLOCK = 128
ATTN_SCALE = FOX_HEAD_DIM ** -0.5
NEG_INF = -1e30
EPS = 1e-6
FORGET_BIAS_INIT = 4.0
DT_MIN = 0.001
DT_MAX = 0.1

kernel_name = 'hymba_s5_fox_macaron_adaln_stream_step'


def rmsnorm(x, g):
    x32 = x.astype(jnp.float32)
    y = x32 * lax.rsqrt(jnp.mean(x32 * x32, axis=-1, keepdims=True) + EPS)
    return (y * g.astype(jnp.float32)).astype(x.dtype)


def modulate(h, shift, scale):
    return h * (1 + scale) + shift


def swiglu(h, w_up, w_down):
    gu = jnp.einsum('bld,df->blf', h, w_up)
    g, u = jnp.split(gu, 2, axis=-1)
    return jnp.einsum('blf,fd->bld', jax.nn.silu(g) * u, w_down)


def _ssm_combine(e1, e2):
    a1, b1 = e1
    a2, b2 = e2
    return a1 * a2, a2 * b1 + b2


def s5_branch(u, h0, p):
    f32 = jnp.float32
    bsz, L, _ = u.shape
    lam = lax.complex(p['lam_re'].astype(f32), p['lam_im'].astype(f32))
    dt = jnp.exp(p['log_dt'].astype(f32))[:, None]
    a_bar = jnp.exp(lam * dt)
    b_mat = lax.complex(p['s5_b_re'].astype(f32), p['s5_b_im'].astype(f32))
    b_bar = ((a_bar - 1.0) / lam)[..., None] * b_mat
    c_mat = lax.complex(p['s5_c_re'].astype(f32), p['s5_c_im'].astype(f32))
    u32 = u.astype(f32)
    bu = jnp.einsum('blgc,gpc->blgp', u32.reshape(bsz, L, S5_GROUPS, S5_GROUP), b_bar)
    a_seq = jnp.broadcast_to(a_bar, bu.shape)
    a_cum, states = lax.associative_scan(_ssm_combine, (a_seq, bu), axis=1)
    states = states + a_cum * h0[:, None]
    y = jnp.real(jnp.einsum('blgp,gcp->blgc', states, c_mat)).reshape(bsz, L, D_S5)
    y = y + p['s5_d'].astype(f32) * u32
    y = jax.nn.gelu(y)
    y = y * jax.nn.sigmoid(jnp.einsum('ble,ef->blf', y, p['w_glu'].astype(f32)) + p['b_glu'].astype(f32))
    last = states[:, -1]
    return y.astype(u.dtype), jnp.real(last), jnp.imag(last)


def fox_attention(q, k, v, Fq, Fk, q_pos, k_pos):
    f32 = jnp.float32
    s = jnp.einsum('bqhd,bkhd->bhqk', q.astype(f32), k.astype(f32)) * ATTN_SCALE
    s = s + jnp.transpose(Fq, (0, 2, 1))[..., :, None] - jnp.transpose(Fk, (0, 2, 1))[..., None, :]
    mask = k_pos[None, :] <= q_pos[:, None]
    s = jnp.where(mask, s, NEG_INF)
    pr = jax.nn.softmax(s, axis=-1)
    return jnp.einsum('bhqk,bkhd->bqhd', pr, v.astype(f32))


def hybrid_mixer(h, p, cache):
    f32 = jnp.float32
    bsz, L, _ = h.shape
    proj = jnp.einsum('bld,de->ble', h, p['w_in'])
    u, q, k, v, fl = jnp.split(proj, SPLITS, axis=-1)
    q = q.reshape(bsz, L, FOX_HEADS, FOX_HEAD_DIM)
    k = k.reshape(bsz, L, FOX_HEADS, FOX_HEAD_DIM)
    v = v.reshape(bsz, L, FOX_HEADS, FOX_HEAD_DIM)
    logf = jax.nn.log_sigmoid(fl.astype(f32) + p['b_fgate'].astype(f32))
    if cache is None:
        h0 = jnp.zeros((bsz, S5_GROUPS, S5_STATE), jnp.complex64)
        F = jnp.cumsum(logf, axis=1)
        pos = jnp.arange(L)
        nb = L // Q_BLOCK

        def attend(blk):
            qb, Fqb, pb = blk
            return fox_attention(qb, k, v, Fqb, F, pb, pos)

        o = lax.map(attend, (q.reshape(bsz, nb, Q_BLOCK, FOX_HEADS, FOX_HEAD_DIM).swapaxes(0, 1),
                             F.reshape(bsz, nb, Q_BLOCK, FOX_HEADS).swapaxes(0, 1),
                             pos.reshape(nb, Q_BLOCK)))
        o = o.swapaxes(0, 1).reshape(bsz, L, D_FOX)
    else:
        cache_k, cache_v, cache_logf, s_re, s_im = cache
        past = cache_k.shape[1]
        h0 = lax.complex(s_re.astype(f32), s_im.astype(f32))
        k_all = jnp.concatenate([cache_k.astype(k.dtype), k], axis=1)
        v_all = jnp.concatenate([cache_v.astype(v.dtype), v], axis=1)
        F_all = jnp.cumsum(jnp.concatenate([cache_logf.astype(f32), logf], axis=1), axis=1)
        o = fox_attention(q, k_all, v_all, F_all[:, past:], F_all,
                          past + jnp.arange(L), jnp.arange(past + L))
        o = o.reshape(bsz, L, D_FOX)
    y_s5, s_re_new, s_im_new = s5_branch(u, h0, p)
    mixed = jnp.concatenate([rmsnorm(y_s5, p['g_s5_out']),
                             rmsnorm(o.astype(h.dtype), p['g_fox_out'])], axis=-1)
    out = jnp.einsum('ble,ed->bld', mixed, p['w_out'])
    return out, (k, v, logf, s_re_new, s_im_new)


def trunk_layer(x, c, p, cache):
    mod = jnp.einsum('bd,de->be', jax.nn.silu(c), p['w_ada']) + p['b_ada']
    sh1, sc1, g1, sh2, sc2, g2, sh3, sc3, g3 = [m[:, None, :] for m in jnp.split(mod, N_MOD, axis=-1)]
    h = modulate(rmsnorm(x, p['g_ffn1']), sh1, sc1)
    x = x + 0.5 * (1 + g1) * swiglu(h, p['w_up1'], p['w_down1'])
    h = modulate(rmsnorm(x, p['g_mix']), sh2, sc2)
    y, new_state = hybrid_mixer(h, p, cache)
    x = x + (1 + g2) * y
    h = modulate(rmsnorm(x, p['g_ffn2']), sh3, sc3)
    x = x + 0.5 * (1 + g3) * swiglu(h, p['w_up2'], p['w_down2'])
    return x, new_state


def setup_inputs(seed: int = 0) -> dict:
    key = jax.random.key(seed)
    ks = jax.random.split(key, 36)
    f32 = jnp.float32

    def nrm(k, shape, scale=1.0):
        return jax.random.normal(k, shape, f32) * scale

    n = jnp.arange(S5_STATE, dtype=f32)
    return {
        'x_prompt': nrm(ks[0], (BATCH, SEQ, D_MODEL)),
        'x_sample': nrm(ks[1], (DEC_BATCH, DEC_SEQ, D_MODEL)),
        'c_prompt': nrm(ks[2], (BATCH, D_MODEL)),
        'c_sample': nrm(ks[3], (DEC_BATCH, D_MODEL)),
        'cache_fox_k': nrm(ks[4], (DEPTH, DEC_BATCH, PAST_LEN, FOX_HEADS, FOX_HEAD_DIM)),
        'cache_fox_v': nrm(ks[5], (DEPTH, DEC_BATCH, PAST_LEN, FOX_HEADS, FOX_HEAD_DIM)),
        'cache_fox_logf': jax.nn.log_sigmoid(FORGET_BIAS_INIT + nrm(ks[6], (DEPTH, DEC_BATCH, PAST_LEN, FOX_HEADS))),
        'state_s5_re': nrm(ks[7], (DEPTH, DEC_BATCH, S5_GROUPS, S5_STATE), 0.1),
        'state_s5_im': nrm(ks[8], (DEPTH, DEC_BATCH, S5_GROUPS, S5_STATE), 0.1),
        'w_ada': nrm(ks[9], (DEPTH, D_MODEL, N_MOD * D_MODEL), 0.1 * D_MODEL ** -0.5),
        'b_ada': nrm(ks[10], (DEPTH, N_MOD * D_MODEL), 0.01),
        'g_ffn1': 1.0 + nrm(ks[11], (DEPTH, D_MODEL), 0.01),
        'w_up1': nrm(ks[12], (DEPTH, D_MODEL, 2 * D_FF), D_MODEL ** -0.5),
        'w_down1': nrm(ks[13], (DEPTH, D_FF, D_MODEL), D_FF ** -0.5),
        'g_mix': 1.0 + nrm(ks[14], (DEPTH, D_MODEL), 0.01),
        'w_in': nrm(ks[15], (DEPTH, D_MODEL, D_IN), D_MODEL ** -0.5),
        'b_fgate': FORGET_BIAS_INIT + nrm(ks[16], (DEPTH, FOX_HEADS), 0.1),
        'lam_re': -0.5 + nrm(ks[17], (DEPTH, S5_GROUPS, S5_STATE), 0.01),
        'lam_im': math.pi * n + nrm(ks[18], (DEPTH, S5_GROUPS, S5_STATE), 0.01),
        'log_dt': jax.random.uniform(ks[19], (DEPTH, S5_GROUPS), f32, math.log(DT_MIN), math.log(DT_MAX)),
        's5_b_re': nrm(ks[20], (DEPTH, S5_GROUPS, S5_STATE, S5_GROUP), (2 * S5_GROUP) ** -0.5),
        's5_b_im': nrm(ks[21], (DEPTH, S5_GROUPS, S5_STATE, S5_GROUP), (2 * S5_GROUP) ** -0.5),
        's5_c_re': nrm(ks[22], (DEPTH, S5_GROUPS, S5_GROUP, S5_STATE), (2 * S5_STATE) ** -0.5),
        's5_c_im': nrm(ks[23], (DEPTH, S5_GROUPS, S5_GROUP, S5_STATE), (2 * S5_STATE) ** -0.5),
        's5_d': nrm(ks[24], (DEPTH, D_S5), 0.3),
        'w_glu': nrm(ks[25], (DEPTH, D_S5, D_S5), D_S5 ** -0.5),
        'b_glu': nrm(ks[26], (DEPTH, D_S5), 0.01),
        'g_s5_out': 1.0 + nrm(ks[27], (DEPTH, D_S5), 0.01),
        'g_fox_out': 1.0 + nrm(ks[28], (DEPTH, D_FOX), 0.01),
        'w_out': nrm(ks[29], (DEPTH, D_MIX, D_MODEL), D_MIX ** -0.5),
        'g_ffn2': 1.0 + nrm(ks[30], (DEPTH, D_MODEL), 0.01),
        'w_up2': nrm(ks[31], (DEPTH, D_MODEL, 2 * D_FF), D_MODEL ** -0.5),
        'w_down2': nrm(ks[32], (DEPTH, D_FF, D_MODEL), D_FF ** -0.5),
        'g_final': 1.0 + nrm(ks[33], (D_MODEL,), 0.01),
    }


def reference(x_prompt, x_sample, c_prompt, c_sample, cache_fox_k, cache_fox_v, cache_fox_logf,
              state_s5_re, state_s5_im, w_ada, b_ada, g_ffn1, w_up1, w_down1, g_mix, w_in, b_fgate,
              lam_re, lam_im, log_dt, s5_b_re, s5_b_im, s5_c_re, s5_c_im, s5_d, w_glu, b_glu,
              g_s5_out, g_fox_out, w_out, g_ffn2, w_up2, w_down2, g_final):
    xp, xs = x_prompt, x_sample
    new_p, new_s = [], []
    for l in range(DEPTH):
        p = dict(w_ada=w_ada[l], b_ada=b_ada[l], g_ffn1=g_ffn1[l], w_up1=w_up1[l], w_down1=w_down1[l],
                 g_mix=g_mix[l], w_in=w_in[l], b_fgate=b_fgate[l], lam_re=lam_re[l], lam_im=lam_im[l],
                 log_dt=log_dt[l], s5_b_re=s5_b_re[l], s5_b_im=s5_b_im[l], s5_c_re=s5_c_re[l],
                 s5_c_im=s5_c_im[l], s5_d=s5_d[l], w_glu=w_glu[l], b_glu=b_glu[l],
                 g_s5_out=g_s5_out[l], g_fox_out=g_fox_out[l], w_out=w_out[l], g_ffn2=g_ffn2[l],
                 w_up2=w_up2[l], w_down2=w_down2[l])
        xp, st_p = trunk_layer(xp, c_prompt, p, None)
        xs, st_s = trunk_layer(xs, c_sample, p, (cache_fox_k[l], cache_fox_v[l], cache_fox_logf[l],
                                                 state_s5_re[l], state_s5_im[l]))
        new_p.append(st_p)
        new_s.append(st_s)
    y_prompt = rmsnorm(xp, g_final)
    y_sample = rmsnorm(xs, g_final)
    k_p = jnp.stack([s[0] for s in new_p])
    v_p = jnp.stack([s[1] for s in new_p])
    logf_p = jnp.stack([s[2] for s in new_p])
    s5re_p = jnp.stack([s[3] for s in new_p])
    s5im_p = jnp.stack([s[4] for s in new_p])
    k_s = jnp.stack([s[0] for s in new_s])
    v_s = jnp.stack([s[1] for s in new_s])
    logf_s = jnp.stack([s[2] for s in new_s])
    s5re_s = jnp.stack([s[3] for s in new_s])
    s5im_s = jnp.stack([s[4] for s in new_s])
    return (y_prompt, y_sample, k_p, v_p, logf_p, s5re_p, s5im_p, k_s, v_s, logf_s, s5re_s, s5im_s)
```

```cpp
#include <hip/hip_runtime.h>
#include <hip/hip_cooperative_groups.h>
#include <cstdio>
#include <cstdint>
namespace cg = cooperative_groups;
namespace pg8 {
#define PG8_LAS __attribute__((address_space(3)))
typedef unsigned short bf16_t;
typedef short bf16x8 __attribute__((ext_vector_type(8)));
typedef float f32x4 __attribute__((ext_vector_type(4)));
typedef unsigned u32x4 __attribute__((ext_vector_type(4)));
constexpr int BM = 256, BK = 64, HALF = 128, HTB = HALF * BK * 2  , STAGE_BYTES = 8 * HTB, NXCD = 8, WGM = 8;

__host__ __device__ __forceinline__ int lds_byte(int r, int c) { const int st = (r >> 4) * 2 + (c >> 5), rr = r & 15, cc = c & 31, ob = rr * 64 + cc * 2; return st * 1024 + (ob ^ (((ob >> 9) & 1) << 5)); }
__host__ __device__ __forceinline__ void stage_rc(int b, int& R, int& C) { const int st = b / 1024, sb = b % 1024, swz = sb ^ (((sb >> 9) & 1) << 5); R = (st >> 1) * 16 + swz / 64; C = (st & 1) * 32 + (swz % 64) / 2; }
__host__ __device__ __forceinline__ int perm32(int rho) { const int n = rho >> 4, i = rho & 15; return 8 * (i >> 2) + 4 * n + (i & 3); }

struct Unit { int pm, pn; };
struct Gemm { const bf16_t* A; const bf16_t* Bt; int M, N, K; };

struct StaticOrder {
    int nM, nN, nwg, G, c;
    __host__ __device__ void init(int M, int N, int G_, int c_) { nM = M / BM; nN = N / BM; nwg = nM * nN; G = G_; c = c_; }
    __host__ __device__ bool next(int i, Unit& u) const {
        const long L = (long)i * G + c; if (L >= nwg) return false;
        int wgid = (int)L; { const int q = nwg / NXCD, r = nwg % NXCD, xcd = wgid % NXCD, off = wgid / NXCD; wgid = (xcd < r ? xcd * (q + 1) : r * (q + 1) + (xcd - r) * q) + off; }
        const int nig = WGM * nN, gid = wgid / nig, fm = gid * WGM, gsz = (nM - fm) < WGM ? (nM - fm) : WGM;
        u.pm = fm + ((wgid % nig) % gsz); u.pn = (wgid % nig) / gsz; return true;
    }
    __device__ __forceinline__ void a_ready(const Unit&) const {}
    __device__ __forceinline__ void done(const Unit&) const {}
};

__device__ __forceinline__ unsigned cvt_pk_bf16(float lo, float hi) { unsigned r; asm volatile("v_cvt_pk_bf16_f32 %0, %1, %2" : "=v"(r) : "v"(lo), "v"(hi)); return r; }
typedef float f32x2 __attribute__((ext_vector_type(2)));
__device__ __forceinline__ f32x2 gelu_pk(f32x2 v) {
    const f32x2 av = __builtin_elementwise_abs(v), d = av * 0.2316418882f + 1.0f;
    f32x2 t; t.x = __builtin_amdgcn_rcpf(d.x); t.y = __builtin_amdgcn_rcpf(d.y);
    f32x2 q = t * 0.5307027145f + (-0.7265760135f); q = q * t + 0.7107068705f; q = q * t + (-0.142248368f); q = q * t + 0.127414796f; q = q * t;
    const f32x2 s = (v * v) * (-0.72134752044f);
    f32x2 e; e.x = __builtin_amdgcn_exp2f(s.x); e.y = __builtin_amdgcn_exp2f(s.y);
    const f32x2 m = v * (q * e), r = v - m;
    f32x2 o; o.x = v.x < 0.f ? m.x : r.x; o.y = v.y < 0.f ? m.y : r.y; return o;
}

template <int ACT  > struct EpiBf16 {
    static constexpr bool PERM = true, AFTER_DRAIN = false; static_assert(ACT == 0 || ACT == 1, "EpiBf16: ACT is 0 (none) or 1 (gelu_pk)");
    bf16_t* O; int ldc; const float* bias; int split_cols; size_t split_stride; float scale0;
    __device__ __forceinline__ void operator()(const f32x4 (&acc)[2][2][4][2], const Unit& u, int wr, int wc, int fr, int fq) const {
        const int row0 = u.pm * BM + wr * 64 + fr; int colt = u.pn * BM; bf16_t* base = O;
        float sc = 1.f; if (split_cols) { const int t = colt / split_cols; base += (size_t)t * split_stride; colt -= t * split_cols; if (t == 0) sc = scale0; }
        const int col0 = colt + wc * 32 + 8 * fq, bcol0 = u.pn * BM + wc * 32 + 8 * fq;
        f32x4 bv[2][2];
#pragma unroll
        for (int bj = 0; bj < 2; ++bj)
#pragma unroll
            for (int n = 0; n < 2; ++n) bv[bj][n] = bias ? *(const f32x4*)(bias + bcol0 + bj * HALF + 4 * n) : (f32x4){0.f, 0.f, 0.f, 0.f};
#pragma unroll
        for (int ai = 0; ai < 2; ++ai)
#pragma unroll
            for (int m = 0; m < 4; ++m) { bf16_t* rowp = base + (size_t)(row0 + ai * HALF + m * 16) * ldc + col0;
#pragma unroll
                for (int bj = 0; bj < 2; ++bj) { f32x4 v0 = acc[ai][bj][m][0] + bv[bj][0], v1 = acc[ai][bj][m][1] + bv[bj][1];
                    if (ACT == 1) { f32x2 a = gelu_pk((f32x2){v0[0], v0[1]}), b = gelu_pk((f32x2){v0[2], v0[3]}), c = gelu_pk((f32x2){v1[0], v1[1]}), d = gelu_pk((f32x2){v1[2], v1[3]});
                        v0 = (f32x4){a.x, a.y, b.x, b.y}; v1 = (f32x4){c.x, c.y, d.x, d.y}; }
                    v0 = v0 * sc; v1 = v1 * sc; u32x4 w; w.x = cvt_pk_bf16(v0[0], v0[1]); w.y = cvt_pk_bf16(v0[2], v0[3]); w.z = cvt_pk_bf16(v1[0], v1[1]); w.w = cvt_pk_bf16(v1[2], v1[3]);
                    *(u32x4*)(rowp + bj * HALF) = w; } }
    }
};


template <class Epi, class Sched, bool ALIGN_EPI = false, bool SP2 = false>
__device__ __forceinline__ void gemm_phase(PG8_LAS unsigned char* lds, const Gemm g, const Sched& S, const Epi& E) {
    const int tid = threadIdx.x, wid = __builtin_amdgcn_readfirstlane(tid >> 6), lane = tid & 63, wr = wid >> 2, wc = wid & 3, fr = lane & 15, fq = lane >> 4;
    const int K = g.K, nt = K / BK;
    unsigned voffA[2], voffB[2];
#pragma unroll
    for (int i = 0; i < 2; ++i) { int R, C; stage_rc(tid * 16 + i * 8192, R, C); const int Rb = Epi::PERM ? ((R & ~31) + perm32(R & 31)) : R;
        voffA[i] = (unsigned)(R * K + C) * 2u; voffB[i] = (unsigned)(Rb * K + C) * 2u; }
    const size_t kstep = (size_t)(BK * 2);
    const size_t hstep = (size_t)HALF * K * 2;
    const size_t tstep = 2 * hstep;
    const unsigned ldsw = (unsigned)wid * 1024u;
    const int aoff = lds_byte(wr * 64 + fr, fq * 8), boff = lds_byte(wc * 32 + fr, fq * 8);
#define PG8_SA(b, h) (((b) * 2 + (h)) * HTB)
#define PG8_SB(b, h) ((4 + (b) * 2 + (h)) * HTB)
#define PG8_STAGE(bufoff, gbase, voff) do { _Pragma("unroll") for (int _i = 0; _i < 2; ++_i) \
        __builtin_amdgcn_global_load_lds((const unsigned*)((const char*)(gbase) + (voff)[_i]), (PG8_LAS unsigned*)(lds + (bufoff) + ldsw + _i * 8192), 16, 0, 0); } while (0)
#define PG8_LDA(dst, b, h) do { _Pragma("unroll") for (int m = 0; m < 4; ++m) _Pragma("unroll") for (int k = 0; k < 2; ++k) dst[m][k] = *(const PG8_LAS bf16x8*)(lds + PG8_SA(b, h) + aoff + m * 2048 + k * 1024); } while (0)
#define PG8_LDB(dst, b, h) do { _Pragma("unroll") for (int n = 0; n < 2; ++n) _Pragma("unroll") for (int k = 0; k < 2; ++k) dst[n][k] = *(const PG8_LAS bf16x8*)(lds + PG8_SB(b, h) + boff + n * 2048 + k * 1024); } while (0)
#define PG8_MMA(ai, bj, At, Bt) do { __builtin_amdgcn_s_setprio(1); _Pragma("unroll") for (int m = 0; m < 4; ++m) _Pragma("unroll") for (int n = 0; n < 2; ++n) _Pragma("unroll") for (int k = 0; k < 2; ++k) \
        acc[ai][bj][m][n] = __builtin_amdgcn_mfma_f32_16x16x32_bf16(Bt[n][k], At[m][k], acc[ai][bj][m][n], 0, 0, 0); __builtin_amdgcn_s_setprio(0); } while (0)
#define PG8_WAIT_V(n) asm volatile("s_waitcnt vmcnt(" #n ")" ::: "memory")
#define PG8_WAIT_L(n) asm volatile("s_waitcnt lgkmcnt(" #n ")" ::: "memory")
#define PG8_BAR __builtin_amdgcn_s_barrier()
#define PG8_SCHED __builtin_amdgcn_sched_barrier(0)
    Unit cur, nxt; int ui = 0;
    if (!S.next(0, cur)) return;
    f32x4 acc[2][2][4][2];
#pragma unroll
    for (int a = 0; a < 2; ++a)
#pragma unroll
        for (int b = 0; b < 2; ++b)
#pragma unroll
            for (int m = 0; m < 4; ++m)
#pragma unroll
                for (int n = 0; n < 2; ++n) acc[a][b][m][n] = (f32x4){0.f, 0.f, 0.f, 0.f};
    bf16x8 At[4][2], B0[2][2], B1[2][2];
    const char* cA = (const char*)g.A + (size_t)cur.pm * tstep; const char* cB = (const char*)g.Bt + (size_t)cur.pn * tstep;
    S.a_ready(cur);
    if constexpr (SP2) {
        PG8_STAGE(PG8_SB(0, 0), cB, voffB); PG8_STAGE(PG8_SB(0, 1), cB + hstep, voffB); PG8_STAGE(PG8_SA(0, 0), cA, voffA); PG8_STAGE(PG8_SA(0, 1), cA + hstep, voffA);
        if (wr == 1) PG8_BAR;
        PG8_WAIT_V(2); PG8_BAR;
        PG8_STAGE(PG8_SB(1, 0), cB + kstep, voffB); PG8_STAGE(PG8_SA(1, 0), cA + kstep, voffA); PG8_STAGE(PG8_SB(1, 1), cB + hstep + kstep, voffB);
        PG8_WAIT_V(6); PG8_BAR;
    } else {
        PG8_STAGE(PG8_SB(0, 0), cB, voffB); PG8_STAGE(PG8_SA(0, 0), cA, voffA); PG8_STAGE(PG8_SB(0, 1), cB + hstep, voffB); PG8_STAGE(PG8_SA(0, 1), cA + hstep, voffA);
        if (wr == 1) PG8_BAR;
        PG8_WAIT_V(4); PG8_BAR;
        PG8_STAGE(PG8_SB(1, 0), cB + kstep, voffB); PG8_STAGE(PG8_SA(1, 0), cA + kstep, voffA); PG8_STAGE(PG8_SB(1, 1), cB + hstep + kstep, voffB);
        PG8_WAIT_V(6); PG8_BAR;
    }
    for (;;) {
        const bool has_next = S.next(ui + 1, nxt);
        const char* nA = has_next ? (const char*)g.A + (size_t)nxt.pm * tstep : cA; const char* nB = has_next ? (const char*)g.Bt + (size_t)nxt.pn * tstep : cB;
        for (int t = 0; t < nt; t += 2) {
            const bool last = (t == nt - 2);
            const char* a1 = cA + (size_t)(t + 1) * kstep;
            const char* a2 = last ? nA : cA + (size_t)(t + 2) * kstep; const char* b2 = last ? nB : cB + (size_t)(t + 2) * kstep;
            const char* a3 = a2 + kstep; const char* b3 = b2 + kstep;
            if (last && has_next) S.a_ready(nxt);
            if constexpr (SP2) {
            PG8_LDB(B0, 0, 0); PG8_LDB(B1, 0, 1); PG8_SCHED; PG8_LDA(At, 0, 0); PG8_STAGE(PG8_SA(1, 1), a1 + hstep, voffA);
            PG8_WAIT_V(8); PG8_WAIT_L(0); PG8_BAR; PG8_MMA(0, 0, At, B0); PG8_MMA(0, 1, At, B1); PG8_BAR; PG8_SCHED;
            PG8_LDA(At, 0, 1); PG8_STAGE(PG8_SB(0, 0), b2, voffB); PG8_STAGE(PG8_SB(0, 1), b2 + hstep, voffB); PG8_STAGE(PG8_SA(0, 0), a2, voffA);
            PG8_WAIT_V(8); PG8_WAIT_L(0); PG8_BAR; PG8_MMA(1, 0, At, B0); PG8_MMA(1, 1, At, B1); PG8_BAR; PG8_SCHED;
            PG8_LDB(B0, 1, 0); PG8_LDB(B1, 1, 1); PG8_SCHED; PG8_LDA(At, 1, 0); PG8_STAGE(PG8_SA(0, 1), a2 + hstep, voffA);
            PG8_WAIT_V(8); PG8_WAIT_L(0); PG8_BAR; PG8_MMA(0, 0, At, B0); PG8_MMA(0, 1, At, B1); PG8_BAR; PG8_SCHED;
            PG8_LDA(At, 1, 1); PG8_STAGE(PG8_SB(1, 0), b3, voffB); PG8_STAGE(PG8_SB(1, 1), b3 + hstep, voffB); PG8_STAGE(PG8_SA(1, 0), a3, voffA);
            PG8_WAIT_V(8); PG8_WAIT_L(0); PG8_BAR; PG8_MMA(1, 0, At, B0); PG8_MMA(1, 1, At, B1); PG8_BAR; PG8_SCHED;
            } else {
            PG8_LDB(B0, 0, 0); PG8_SCHED; PG8_LDA(At, 0, 0); PG8_STAGE(PG8_SA(1, 1), a1 + hstep, voffA);
            PG8_WAIT_L(8); PG8_BAR; PG8_WAIT_L(0); PG8_MMA(0, 0, At, B0); PG8_BAR; PG8_SCHED;
            PG8_LDB(B1, 0, 1); PG8_STAGE(PG8_SB(0, 0), b2, voffB);
            PG8_BAR; PG8_WAIT_L(0); PG8_MMA(0, 1, At, B1); PG8_BAR;
            PG8_LDA(At, 0, 1); PG8_STAGE(PG8_SA(0, 0), a2, voffA);
            PG8_BAR; PG8_WAIT_L(0); PG8_MMA(1, 0, At, B0); PG8_BAR; PG8_SCHED;
            PG8_STAGE(PG8_SB(0, 1), b2 + hstep, voffB);
            PG8_WAIT_V(6); PG8_BAR; PG8_MMA(1, 1, At, B1); PG8_BAR;
            PG8_LDB(B0, 1, 0); PG8_SCHED; PG8_LDA(At, 1, 0); PG8_STAGE(PG8_SA(0, 1), a2 + hstep, voffA);
            PG8_WAIT_L(8); PG8_BAR; PG8_WAIT_L(0); PG8_MMA(0, 0, At, B0); PG8_BAR; PG8_SCHED;
            PG8_LDB(B1, 1, 1); PG8_STAGE(PG8_SB(1, 0), b3, voffB);
            PG8_BAR; PG8_WAIT_L(0); PG8_MMA(0, 1, At, B1); PG8_BAR;
            PG8_LDA(At, 1, 1); PG8_STAGE(PG8_SA(1, 0), a3, voffA);
            PG8_BAR; PG8_WAIT_L(0); PG8_MMA(1, 0, At, B0); PG8_BAR; PG8_SCHED;
            PG8_STAGE(PG8_SB(1, 1), b3 + hstep, voffB);
            PG8_WAIT_V(6); PG8_BAR; PG8_MMA(1, 1, At, B1); PG8_BAR;
            }
        }
        if constexpr (ALIGN_EPI) { if (wr == 0) PG8_BAR; }
        if constexpr (!Epi::AFTER_DRAIN) { E(acc, cur, wr, wc, fr, fq); S.done(cur); }
        if (!has_next) break;
#pragma unroll
        for (int a = 0; a < 2; ++a)
#pragma unroll
            for (int b = 0; b < 2; ++b)
#pragma unroll
                for (int m = 0; m < 4; ++m)
#pragma unroll
                    for (int n = 0; n < 2; ++n) acc[a][b][m][n] = (f32x4){0.f, 0.f, 0.f, 0.f};
        cur = nxt; cA = nA; cB = nB; ++ui;
        if constexpr (ALIGN_EPI) { if (wr == 1) PG8_BAR; }
    }
    PG8_WAIT_V(0);
    if constexpr (!ALIGN_EPI) { if (wr == 0) PG8_BAR; }
    PG8_BAR;
    if constexpr (Epi::AFTER_DRAIN) { E.fused(acc, cur, wr, wc, fr, fq, lds, wid, lane); S.done(cur); }
#undef PG8_SA
#undef PG8_SB
#undef PG8_STAGE
#undef PG8_LDA
#undef PG8_LDB
#undef PG8_MMA
#undef PG8_WAIT_V
#undef PG8_WAIT_L
#undef PG8_BAR
#undef PG8_SCHED
}
}

#ifndef PG8_SP2
#define PG8_SP2 true
#endif
#ifndef PG8_ALIGN
#define PG8_ALIGN true
#endif
#define LAS __attribute__((address_space(3)))
typedef unsigned short bf16;
typedef short bf16x8 __attribute__((ext_vector_type(8)));
typedef short s16x4 __attribute__((ext_vector_type(4)));
typedef float f32x4 __attribute__((ext_vector_type(4)));
typedef float f32x2 __attribute__((ext_vector_type(2)));
typedef float f32x16 __attribute__((ext_vector_type(16)));
typedef unsigned u32x4 __attribute__((ext_vector_type(4)));
typedef unsigned u32x2 __attribute__((ext_vector_type(2)));

constexpr int NP = 16384, NS = 256, MT = NP + NS, DM = 1024, FF = 2816, NUP = 5632, DH = 512, NMOD = 9216, DIN = 2056;
constexpr float EPS = 1e-6f, LOG2E = 1.4426950408889634f, QSCALE = 0.125f * 1.4426950408889634f;
constexpr size_t O_KP = 17039360, O_VP = 25427968, O_LFP = 33816576, O_SRP = 33947648, O_SIP = 33955840, O_KS = 33964032, O_VS = 34095104,
                 O_LFS = 34226176, O_SRS = 34228224, O_SIS = 34244608;
constexpr size_t MiB = 1u << 20;
constexpr size_t WS_MOD = 0, WS_S5C = 1 * MiB, WS_F2P = 2 * MiB, WS_F2S = 2 * MiB + 512 * 1024, WS_E = 4 * MiB, WS_WUP1 = 10 * MiB, WS_WDN1 = 21 * MiB,
                 WS_WIN = 27 * MiB, WS_WGLU = 31 * MiB, WS_WOUT = 32 * MiB, WS_WUP2 = 34 * MiB, WS_WDN2 = 45 * MiB, WS_HA = 52 * MiB, WS_HID = 86 * MiB;
constexpr size_t WS_U = WS_HID, WS_Q = WS_HID + 17 * MiB, WS_KB = WS_HID + 34 * MiB, WS_VB = WS_HID + 51 * MiB, WS_Z = WS_HID + 68 * MiB;
constexpr int S5_ITEMS_PER_G = 264, S5_ITEMS = 32 * 264;
constexpr int LDS_BYTES = 155648;
constexpr int NWAVES = 8;

struct Args { const float* in[34]; float* out; unsigned char* ws; int ph_lo, ph_hi; };

struct Frame {
    LAS unsigned char* lds;
    int tid, lane, wave, G, vcu, gw, NGW;
    const float* in[34];
    float* out;
    float* mod; f32x2* abar; f32x2* a64; f32x2* bbar; bf16* cmt; float* F2P; float* F2S; f32x2* E;
    bf16 *WUP1, *WDN1, *WIN, *WGLU, *WOUT, *WUP2, *WDN2, *HA, *HID, *U, *Q, *KB, *VB, *Z;
};

__device__ __forceinline__ unsigned f2bf(float f) { unsigned u = __builtin_bit_cast(unsigned, f); return (u + 0x7fffu + ((u >> 16) & 1u)) >> 16; }
__device__ __forceinline__ unsigned pk2(float lo, float hi) { return pg8::cvt_pk_bf16(lo, hi); }
__device__ __forceinline__ float bflo(unsigned w) { return __uint_as_float(w << 16); }
__device__ __forceinline__ float bfhi(unsigned w) { return __uint_as_float(w & 0xffff0000u); }
__device__ __forceinline__ float wave_sum(float v) {
#pragma unroll
    for (int o = 1; o < 64; o <<= 1) v += __shfl_xor(v, o);
    return v;
}
__device__ __forceinline__ float fsigmoid(float x) { return __builtin_amdgcn_rcpf(1.f + __builtin_amdgcn_exp2f(-x * LOG2E)); }
__device__ __forceinline__ int bidx(int row) { return row < NP ? (row >> 12) : 4 + ((row - NP) >> 5); }
#define LDS_WAIT() asm volatile("s_waitcnt lgkmcnt(0)" ::: "memory")

using pg8::Unit;
struct EpiSwiglu {
    static constexpr bool PERM = true, AFTER_DRAIN = false;
    bf16* H;
    __device__ __forceinline__ void operator()(const f32x4 (&acc)[2][2][4][2], const Unit& u, int wr, int wc, int fr, int fq) const {
        const int row0 = u.pm * 256 + wr * 64 + fr, col0 = u.pn * 128 + wc * 32 + 8 * fq;
#pragma unroll
        for (int ai = 0; ai < 2; ++ai)
#pragma unroll
            for (int m = 0; m < 4; ++m) {
                const int row = row0 + ai * 128 + m * 16;
                u32x4 w; unsigned ww[4];
#pragma unroll
                for (int n = 0; n < 2; ++n) {
                    const f32x4 g = acc[ai][0][m][n], up = acc[ai][1][m][n]; float r[4];
#pragma unroll
                    for (int i = 0; i < 4; ++i) r[i] = g[i] * fsigmoid(g[i]) * up[i];
                    ww[2 * n] = pk2(r[0], r[1]); ww[2 * n + 1] = pk2(r[2], r[3]);
                }
                w.x = ww[0]; w.y = ww[1]; w.z = ww[2]; w.w = ww[3];
                *(u32x4*)(H + (size_t)row * FF + col0) = w;
            }
    }
};
struct EpiResid {
    static constexpr bool PERM = true, AFTER_DRAIN = false;
    const float* xp; const float* xs; float* out; const float* mod; int gi; float gscale;
    __device__ __forceinline__ void operator()(const f32x4 (&acc)[2][2][4][2], const Unit& u, int wr, int wc, int fr, int fq) const {
        const int row0 = u.pm * 256 + wr * 64 + fr, col0 = u.pn * 256 + wc * 32 + 8 * fq;
#pragma unroll
        for (int ai = 0; ai < 2; ++ai)
#pragma unroll
            for (int m = 0; m < 4; ++m) {
                const int row = row0 + ai * 128 + m * 16;
                const float* xin = row < NP ? xp + (size_t)row * DM : xs + (size_t)(row - NP) * DM;
                const float* gate = mod + bidx(row) * NMOD + gi * DM;
                float* orow = out + (size_t)row * DM;
#pragma unroll
                for (int bj = 0; bj < 2; ++bj) {
                    const int col = col0 + bj * 128;
#pragma unroll
                    for (int n = 0; n < 2; ++n) {
                        const f32x4 g = *(const f32x4*)(gate + col + 4 * n), x = *(const f32x4*)(xin + col + 4 * n);
                        const f32x4 o = x + (g + 1.0f) * gscale * acc[ai][bj][m][n];
                        *(f32x4*)(orow + col + 4 * n) = o;
                    }
                }
            }
    }
};
struct EpiIn {
    static constexpr bool PERM = true, AFTER_DRAIN = false;
    bf16 *U, *Q, *KB, *VB; float* out;
    __device__ __forceinline__ void operator()(const f32x4 (&acc)[2][2][4][2], const Unit& u, int wr, int wc, int fr, int fq) const {
        const int t = u.pn >> 1;
        const int row0 = u.pm * 256 + wr * 64 + fr, col0 = (u.pn & 1) * 256 + wc * 32 + 8 * fq;
        bf16* dst = t == 0 ? U : t == 1 ? Q : t == 2 ? KB : VB;
        const float sc = t == 1 ? QSCALE : 1.0f;
#pragma unroll
        for (int ai = 0; ai < 2; ++ai)
#pragma unroll
            for (int m = 0; m < 4; ++m) {
                const int row = row0 + ai * 128 + m * 16;
                float* fo = row < NP ? out + (t == 2 ? O_KP : O_VP) + (size_t)row * DH : out + (t == 2 ? O_KS : O_VS) + (size_t)(row - NP) * DH;
#pragma unroll
                for (int bj = 0; bj < 2; ++bj) {
                    const int col = col0 + bj * 128;
                    const f32x4 v0 = acc[ai][bj][m][0], v1 = acc[ai][bj][m][1];
                    u32x4 w; w.x = pk2(v0[0] * sc, v0[1] * sc); w.y = pk2(v0[2] * sc, v0[3] * sc); w.z = pk2(v1[0] * sc, v1[1] * sc); w.w = pk2(v1[2] * sc, v1[3] * sc);
                    *(u32x4*)(dst + (size_t)row * DH + col) = w;
                    if (t >= 2) { *(f32x4*)(fo + col) = v0; *(f32x4*)(fo + col + 4) = v1; }
                }
            }
    }
};
struct EpiGlu {
    static constexpr bool PERM = true, AFTER_DRAIN = false;
    const bf16* Z; bf16* Y; const float* bglu;
    __device__ __forceinline__ void operator()(const f32x4 (&acc)[2][2][4][2], const Unit& u, int wr, int wc, int fr, int fq) const {
        const int row0 = u.pm * 256 + wr * 64 + fr, col0 = u.pn * 256 + wc * 32 + 8 * fq;
#pragma unroll
        for (int bj = 0; bj < 2; ++bj) {
            const int col = col0 + bj * 128;
            const f32x4 b0 = *(const f32x4*)(bglu + col), b1 = *(const f32x4*)(bglu + col + 4);
#pragma unroll
            for (int ai = 0; ai < 2; ++ai)
#pragma unroll
                for (int m = 0; m < 4; ++m) {
                    const int row = row0 + ai * 128 + m * 16;
                    const u32x4 z = *(const u32x4*)(Z + (size_t)row * DH + col);
                    const f32x4 a0 = acc[ai][bj][m][0] + b0, a1 = acc[ai][bj][m][1] + b1;
                    u32x4 w;
                    w.x = pk2(bflo(z.x) * fsigmoid(a0[0]), bfhi(z.x) * fsigmoid(a0[1]));
                    w.y = pk2(bflo(z.y) * fsigmoid(a0[2]), bfhi(z.y) * fsigmoid(a0[3]));
                    w.z = pk2(bflo(z.z) * fsigmoid(a1[0]), bfhi(z.z) * fsigmoid(a1[1]));
                    w.w = pk2(bflo(z.w) * fsigmoid(a1[2]), bfhi(z.w) * fsigmoid(a1[3]));
                    *(u32x4*)(Y + (size_t)row * DH + col) = w;
                }
        }
    }
};

__device__ __forceinline__ void phase_ada(Frame& F) {
    LAS float* sm = (LAS float*)F.lds;
    LAS float* red = sm + 12288;
    const float* cp = F.in[2]; const float* cs = F.in[3]; const float* wada = F.in[9]; const float* bada = F.in[10];
    for (int i = F.tid; i < 12288; i += 512) { const int d = i / 12, bi = i % 12; const float c = bi < 4 ? cp[bi * DM + d] : cs[(bi - 4) * DM + d]; sm[i] = c * fsigmoid(c); }
    __syncthreads();
    for (int cb = blockIdx.x; cb < 256; cb += F.G) {
        const int ks = F.tid / 36, cl = F.tid % 36;
        float acc[12];
#pragma unroll
        for (int i = 0; i < 12; ++i) acc[i] = 0.f;
        if (F.tid < 504) {
            for (int d = ks; d < DM; d += 14) {
                const float w = wada[(size_t)d * NMOD + cb * 36 + cl];
                const f32x4 s0 = *(const LAS f32x4*)(sm + d * 12), s1 = *(const LAS f32x4*)(sm + d * 12 + 4), s2 = *(const LAS f32x4*)(sm + d * 12 + 8);
                acc[0] += w * s0[0]; acc[1] += w * s0[1]; acc[2] += w * s0[2]; acc[3] += w * s0[3];
                acc[4] += w * s1[0]; acc[5] += w * s1[1]; acc[6] += w * s1[2]; acc[7] += w * s1[3];
                acc[8] += w * s2[0]; acc[9] += w * s2[1]; acc[10] += w * s2[2]; acc[11] += w * s2[3];
            }
#pragma unroll
            for (int i = 0; i < 12; ++i) red[(ks * 36 + cl) * 12 + i] = acc[i];
        }
        __syncthreads();
        if (F.tid < 432) {
            const int c2 = F.tid / 12, bi = F.tid % 12; float s = bada[cb * 36 + c2];
#pragma unroll
            for (int k = 0; k < 14; ++k) s += red[(k * 36 + c2) * 12 + bi];
            F.mod[bi * NMOD + cb * 36 + c2] = s;
        }
        __syncthreads();
    }
}
__device__ __forceinline__ void sincos_d(double x, double& s, double& c) {
    const double kf = __builtin_rint(x * 0.63661977236758134308);
    double r = __builtin_fma(-kf, 1.57079632679489655800e+00, x); r = __builtin_fma(-kf, 6.12323399573676603587e-17, r);
    const int k = ((int)kf) & 3; const double r2 = r * r;
    double sp = 1.0 / 6227020800.0; sp = __builtin_fma(sp, r2, -1.0 / 39916800.0); sp = __builtin_fma(sp, r2, 1.0 / 362880.0); sp = __builtin_fma(sp, r2, -1.0 / 5040.0);
    sp = __builtin_fma(sp, r2, 1.0 / 120.0); sp = __builtin_fma(sp, r2, -1.0 / 6.0); sp = __builtin_fma(sp, r2, 1.0); const double sr = sp * r;
    double cq = -1.0 / 87178291200.0; cq = __builtin_fma(cq, r2, 1.0 / 479001600.0); cq = __builtin_fma(cq, r2, -1.0 / 3628800.0); cq = __builtin_fma(cq, r2, 1.0 / 40320.0);
    cq = __builtin_fma(cq, r2, -1.0 / 720.0); cq = __builtin_fma(cq, r2, 1.0 / 24.0); cq = __builtin_fma(cq, r2, -0.5); const double cr = __builtin_fma(cq, r2, 1.0);
    s = (k == 0) ? sr : (k == 1) ? cr : (k == 2) ? -sr : -cr;
    c = (k == 0) ? cr : (k == 1) ? -sr : (k == 2) ? -cr : sr;
}
__device__ __forceinline__ double exp_d(double x) {
    const double n = __builtin_rint(x * 1.4426950408889634074);
    double r = __builtin_fma(-n, 6.93147180369123816490e-01, x); r = __builtin_fma(-n, 1.90821492927058770002e-10, r);
    double p = 1.0 / 6227020800.0;
    p = __builtin_fma(p, r, 1.0 / 479001600.0); p = __builtin_fma(p, r, 1.0 / 39916800.0); p = __builtin_fma(p, r, 1.0 / 3628800.0); p = __builtin_fma(p, r, 1.0 / 362880.0);
    p = __builtin_fma(p, r, 1.0 / 40320.0); p = __builtin_fma(p, r, 1.0 / 5040.0); p = __builtin_fma(p, r, 1.0 / 720.0); p = __builtin_fma(p, r, 1.0 / 120.0);
    p = __builtin_fma(p, r, 1.0 / 24.0); p = __builtin_fma(p, r, 1.0 / 6.0); p = __builtin_fma(p, r, 0.5); p = __builtin_fma(p, r, 1.0); p = __builtin_fma(p, r, 1.0);
    return __builtin_ldexp(p, (int)n);
}
__device__ __forceinline__ void phase_s5const(Frame& F) {
    const int id = blockIdx.x * 512 + F.tid;
    if (id >= 2048) return;
    const int g = id >> 6, p = id & 63;
    const double lre = (double)F.in[17][id], lim = (double)F.in[18][id], dt = exp_d((double)F.in[19][g]);
    const double mag = exp_d(lre * dt); double sn, cs; sincos_d(lim * dt, sn, cs);
    const double are = mag * cs, aim = mag * sn;
    F.abar[id] = (f32x2){(float)are, (float)aim};
    double pr = are, pi = aim;
#pragma unroll
    for (int i = 0; i < 6; ++i) { const double nr = pr * pr - pi * pi, ni = 2.0 * pr * pi; pr = nr; pi = ni; }
    F.a64[id] = (f32x2){(float)pr, (float)pi};
    const double xr = are - 1.0, xi = aim, den = lre * lre + lim * lim;
    const double cr = (xr * lre + xi * lim) / den, ci = (xi * lre - xr * lim) / den;
    const float* bre = F.in[20] + (size_t)id * 16; const float* bim = F.in[21] + (size_t)id * 16;
#pragma unroll
    for (int c = 0; c < 16; ++c) { const double br = bre[c], bi = bim[c]; F.bbar[(size_t)id * 16 + c] = (f32x2){(float)(cr * br - ci * bi), (float)(cr * bi + ci * br)}; }
    const float* cre = F.in[22]; const float* cim = F.in[23];
#pragma unroll
    for (int c = 0; c < 16; ++c) {
        F.cmt[(g * 16 + c) * 128 + p] = (bf16)f2bf(cre[(g * 16 + c) * 64 + p]);
        F.cmt[(g * 16 + c) * 128 + 64 + p] = (bf16)f2bf(-cim[(g * 16 + c) * 64 + p]);
    }
}
__device__ __forceinline__ void transpose_item(const float* W, int ldw, int k0, int n0, bf16* WT, int Kd, int drow0, LAS float* scr, int lane) {
#pragma unroll 8
    for (int i = 0; i < 32; ++i) { const int kk = 2 * i + (lane >> 5); scr[kk * 33 + (lane & 31)] = W[(size_t)(k0 + kk) * ldw + n0 + (lane & 31)]; }
    LDS_WAIT();
    const int c = lane & 7;
#pragma unroll
    for (int j = 0; j < 4; ++j) { const int n = (lane >> 3) + 8 * j; const LAS float* s = scr + (8 * c) * 33 + n;
        u32x4 o; o.x = pk2(s[0 * 33], s[1 * 33]); o.y = pk2(s[2 * 33], s[3 * 33]); o.z = pk2(s[4 * 33], s[5 * 33]); o.w = pk2(s[6 * 33], s[7 * 33]);
        *(u32x4*)(WT + (size_t)(drow0 + n) * Kd + k0 + 8 * c) = o; }
    LDS_WAIT();
}
__device__ __forceinline__ int up_drow(int n0) { return n0 < FF ? 256 * (n0 >> 7) + (n0 & 127) : 256 * ((n0 - FF) >> 7) + 128 + ((n0 - FF) & 127); }
__device__ __forceinline__ void phase_weights(Frame& F) {
    LAS float* scr = (LAS float*)(F.lds + 81920 + F.wave * 8704);
    constexpr int I_UP = 16 * 176, I_DN = 44 * 32, I_IN = 16 * 64, I_GLU = 8 * 16, I_OUT = 16 * 32;
    constexpr int NITEMS = 2 * I_UP + 2 * I_DN + I_IN + I_GLU + I_OUT;
    for (int it = F.gw; it < NITEMS; it += F.NGW) {
        int r = it;
        if (r < I_UP) { const int kb = r / 176, nb = r % 176; transpose_item(F.in[12], NUP, 64 * kb, 32 * nb, F.WUP1, DM, up_drow(32 * nb), scr, F.lane); continue; } r -= I_UP;
        if (r < I_UP) { const int kb = r / 176, nb = r % 176; transpose_item(F.in[31], NUP, 64 * kb, 32 * nb, F.WUP2, DM, up_drow(32 * nb), scr, F.lane); continue; } r -= I_UP;
        if (r < I_DN) { const int kb = r / 32, nb = r % 32; transpose_item(F.in[13], DM, 64 * kb, 32 * nb, F.WDN1, FF, 32 * nb, scr, F.lane); continue; } r -= I_DN;
        if (r < I_DN) { const int kb = r / 32, nb = r % 32; transpose_item(F.in[32], DM, 64 * kb, 32 * nb, F.WDN2, FF, 32 * nb, scr, F.lane); continue; } r -= I_DN;
        if (r < I_IN) { const int kb = r / 64, nb = r % 64; transpose_item(F.in[15], DIN, 64 * kb, 32 * nb, F.WIN, DM, 32 * nb, scr, F.lane); continue; } r -= I_IN;
        if (r < I_GLU) { const int kb = r / 16, nb = r % 16; transpose_item(F.in[25], DH, 64 * kb, 32 * nb, F.WGLU, DH, 32 * nb, scr, F.lane); continue; } r -= I_GLU;
        { const int kb = r / 32, nb = r % 32; transpose_item(F.in[29], DM, 64 * kb, 32 * nb, F.WOUT, DM, 32 * nb, scr, F.lane); }
    }
}

template <bool FG>
__device__ __forceinline__ void phase_norm(Frame& F, const float* xp, const float* xs, const float* gN, int si, int ci) {
    LAS float* wf = (LAS float*)F.lds;
    if (FG) {
        const float* win = F.in[15];
        for (int i = F.tid; i < 8192; i += 512) wf[i] = win[(size_t)(i >> 3) * DIN + 2048 + (i & 7)];
        __syncthreads();
    }
    const int lane = F.lane;
    for (int row = F.gw; row < MT; row += F.NGW) {
        const float* xr = row < NP ? xp + (size_t)row * DM : xs + (size_t)(row - NP) * DM;
        f32x4 v[4]; float ss = 0.f;
#pragma unroll
        for (int j = 0; j < 4; ++j) { v[j] = *(const f32x4*)(xr + 4 * lane + 256 * j); ss += (v[j][0] * v[j][0] + v[j][1] * v[j][1]) + (v[j][2] * v[j][2] + v[j][3] * v[j][3]); }
        const float rstd = 1.0f / sqrtf(wave_sum(ss) * (1.0f / DM) + EPS);
        const float* sh = F.mod + bidx(row) * NMOD + si * DM; const float* sc = F.mod + bidx(row) * NMOD + ci * DM;
        float f[8];
#pragma unroll
        for (int i = 0; i < 8; ++i) f[i] = 0.f;
#pragma unroll
        for (int j = 0; j < 4; ++j) {
            const int col = 4 * lane + 256 * j;
            const f32x4 g4 = *(const f32x4*)(gN + col), s4 = *(const f32x4*)(sc + col), h4 = *(const f32x4*)(sh + col);
            const f32x4 h = v[j] * rstd * g4 * (s4 + 1.0f) + h4;
            u32x2 w; w.x = pk2(h[0], h[1]); w.y = pk2(h[2], h[3]);
            *(u32x2*)(F.HA + (size_t)row * DM + col) = w;
            if (FG) {
#pragma unroll
                for (int e = 0; e < 4; ++e) {
                    const f32x4 w0 = *(const LAS f32x4*)(wf + (col + e) * 8), w1 = *(const LAS f32x4*)(wf + (col + e) * 8 + 4);
                    f[0] += h[e] * w0[0]; f[1] += h[e] * w0[1]; f[2] += h[e] * w0[2]; f[3] += h[e] * w0[3];
                    f[4] += h[e] * w1[0]; f[5] += h[e] * w1[1]; f[6] += h[e] * w1[2]; f[7] += h[e] * w1[3];
                }
            }
        }
        if (FG) {
#pragma unroll
            for (int i = 0; i < 8; ++i) f[i] = wave_sum(f[i]);
            float fv = f[0];
            fv = lane == 1 ? f[1] : fv; fv = lane == 2 ? f[2] : fv; fv = lane == 3 ? f[3] : fv; fv = lane == 4 ? f[4] : fv;
            fv = lane == 5 ? f[5] : fv; fv = lane == 6 ? f[6] : fv; fv = lane == 7 ? f[7] : fv;
            if (lane < 8) {
                const float x = fv + F.in[16][lane];
                const float lf = fminf(x, 0.f) - log1pf(expf(-fabsf(x)));
                float* o = row < NP ? F.out + O_LFP + (size_t)row * 8 : F.out + O_LFS + (size_t)(row - NP) * 8;
                o[lane] = lf;
            }
        }
    }
}
__device__ __forceinline__ void phase_mixnorm(Frame& F) {
    const int lane = F.lane; const float* gs = F.in[27]; const float* gf = F.in[28];
    for (int row = F.gw; row < MT; row += F.NGW) {
#pragma unroll
        for (int part = 0; part < 2; ++part) {
            const bf16* src = (part == 0 ? F.U : F.Q) + (size_t)row * DH + 8 * lane;
            const float* g = (part == 0 ? gs : gf) + 8 * lane;
            const u32x4 z = *(const u32x4*)src;
            float v[8] = {bflo(z.x), bfhi(z.x), bflo(z.y), bfhi(z.y), bflo(z.z), bfhi(z.z), bflo(z.w), bfhi(z.w)};
            float ss = 0.f;
#pragma unroll
            for (int i = 0; i < 8; ++i) ss += v[i] * v[i];
            const float rstd = 1.0f / sqrtf(wave_sum(ss) * (1.0f / DH) + EPS);
            const f32x4 g0 = *(const f32x4*)g, g1 = *(const f32x4*)(g + 4);
            u32x4 w; w.x = pk2(v[0] * rstd * g0[0], v[1] * rstd * g0[1]); w.y = pk2(v[2] * rstd * g0[2], v[3] * rstd * g0[3]);
            w.z = pk2(v[4] * rstd * g1[0], v[5] * rstd * g1[1]); w.w = pk2(v[6] * rstd * g1[2], v[7] * rstd * g1[3]);
            *(u32x4*)(F.HA + (size_t)row * DM + part * DH + 8 * lane) = w;
        }
    }
}
__device__ __forceinline__ void phase_finalnorm(Frame& F) {
    const int lane = F.lane; const float* gN = F.in[33];
    for (int row = F.gw; row < MT; row += F.NGW) {
        float* xr = F.out + (size_t)row * DM;
        f32x4 v[4]; float ss = 0.f;
#pragma unroll
        for (int j = 0; j < 4; ++j) { v[j] = *(const f32x4*)(xr + 4 * lane + 256 * j); ss += (v[j][0] * v[j][0] + v[j][1] * v[j][1]) + (v[j][2] * v[j][2] + v[j][3] * v[j][3]); }
        const float rstd = 1.0f / sqrtf(wave_sum(ss) * (1.0f / DM) + EPS);
#pragma unroll
        for (int j = 0; j < 4; ++j) { const f32x4 g4 = *(const f32x4*)(gN + 4 * lane + 256 * j); *(f32x4*)(xr + 4 * lane + 256 * j) = v[j] * rstd * g4; }
    }
}
__device__ __forceinline__ void phase_fcum(Frame& F) {
    LAS float* wt = (LAS float*)F.lds;
    const int tid = F.tid, lane = F.lane, wave = F.wave;
    for (int job = blockIdx.x; job < 96; job += F.G) {
        const float* src; float* dst; int b, h;
        if (job < 32) { b = job >> 3; h = job & 7; src = F.out + O_LFP + (size_t)b * 4096 * 8 + h; dst = F.F2P + (size_t)job * 4096; }
        else { const int j2 = job - 32; b = j2 >> 3; h = j2 & 7; src = F.in[6] + (size_t)b * 4096 * 8 + h; dst = F.F2S + (size_t)j2 * 4128; }
        float v[8]; float tsum = 0.f;
#pragma unroll
        for (int i = 0; i < 8; ++i) { v[i] = src[(size_t)(8 * tid + i) * 8]; tsum += v[i]; }
        float inc = tsum;
#pragma unroll
        for (int o = 1; o < 64; o <<= 1) { const float t = __shfl_up(inc, o); if (lane >= o) inc += t; }
        if (lane == 63) wt[wave] = inc;
        __syncthreads();
        float woff = 0.f, total = 0.f;
#pragma unroll
        for (int w = 0; w < 8; ++w) { const float x = wt[w]; if (w < wave) woff += x; total += x; }
        float run = woff + inc - tsum;
#pragma unroll
        for (int i = 0; i < 8; ++i) { run += v[i]; dst[8 * tid + i] = run * LOG2E; }
        if (job >= 32 && wave == 0) {
            float x = lane < 32 ? F.out[O_LFS + (size_t)(b * 32 + lane) * 8 + h] : 0.f;
#pragma unroll
            for (int o = 1; o < 64; o <<= 1) { const float t = __shfl_up(x, o); if (lane >= o) x += t; }
            if (lane < 32) dst[4096 + lane] = (total + x) * LOG2E;
        }
        __syncthreads();
    }
}

constexpr int KP = 72, VP = 68;
__device__ __forceinline__ void attn_tile(const LAS bf16* kL, const LAS bf16* vL, const LAS float* fL, LAS float* wsf, const bf16x8 (&qr)[4], f32x16 (&o)[2],
                                          float& m, float& l, bool domask, int lim, int r32, int hi) {
    f32x16 p0, p1;
#pragma unroll
    for (int r = 0; r < 16; ++r) { p0[r] = 0.f; p1[r] = 0.f; }
#pragma unroll
    for (int d0 = 0; d0 < 4; ++d0) {
        const bf16x8 a0 = *(const LAS bf16x8*)(kL + r32 * KP + d0 * 16 + hi * 8);
        const bf16x8 a1 = *(const LAS bf16x8*)(kL + (32 + r32) * KP + d0 * 16 + hi * 8);
        p0 = __builtin_amdgcn_mfma_f32_32x32x16_bf16(a0, qr[d0], p0, 0, 0, 0);
        p1 = __builtin_amdgcn_mfma_f32_32x32x16_bf16(a1, qr[d0], p1, 0, 0, 0);
    }
#pragma unroll
    for (int rg = 0; rg < 4; ++rg) {
        const f32x4 fa = *(const LAS f32x4*)(fL + 8 * rg + 4 * hi), fb = *(const LAS f32x4*)(fL + 32 + 8 * rg + 4 * hi);
#pragma unroll
        for (int i = 0; i < 4; ++i) { p0[4 * rg + i] -= fa[i]; p1[4 * rg + i] -= fb[i]; }
    }
    if (domask) {
#pragma unroll
        for (int r = 0; r < 16; ++r) { const int kv = (r & 3) + 8 * (r >> 2) + 4 * hi; if (kv > lim) p0[r] = -INFINITY; if (kv + 32 > lim) p1[r] = -INFINITY; }
    }
    float mt = fmaxf(p0[0], p1[0]);
#pragma unroll
    for (int r = 1; r < 16; ++r) mt = fmaxf(mt, fmaxf(p0[r], p1[r]));
    mt = fmaxf(mt, __shfl_xor(mt, 32));
    const float mn = fmaxf(m, mt);
    const float alpha = __builtin_amdgcn_exp2f(m - mn);
    m = mn;
    float rs = 0.f;
#pragma unroll
    for (int r = 0; r < 16; ++r) { p0[r] = __builtin_amdgcn_exp2f(p0[r] - mn); p1[r] = __builtin_amdgcn_exp2f(p1[r] - mn); rs += p0[r] + p1[r]; }
    l = l * alpha + rs;
    if (hi == 0) wsf[r32] = alpha;
    LDS_WAIT();
#pragma unroll
    for (int rg = 0; rg < 4; ++rg) {
        const f32x4 al = *(const LAS f32x4*)(wsf + 8 * rg + 4 * hi);
#pragma unroll
        for (int i = 0; i < 4; ++i) { o[0][4 * rg + i] *= al[i]; o[1][4 * rg + i] *= al[i]; }
    }
    u32x4 pw[4];
    pw[0] = (u32x4){pk2(p0[0], p0[1]), pk2(p0[2], p0[3]), pk2(p0[4], p0[5]), pk2(p0[6], p0[7])};
    pw[1] = (u32x4){pk2(p0[8], p0[9]), pk2(p0[10], p0[11]), pk2(p0[12], p0[13]), pk2(p0[14], p0[15])};
    pw[2] = (u32x4){pk2(p1[0], p1[1]), pk2(p1[2], p1[3]), pk2(p1[4], p1[5]), pk2(p1[6], p1[7])};
    pw[3] = (u32x4){pk2(p1[8], p1[9]), pk2(p1[10], p1[11]), pk2(p1[12], p1[13]), pk2(p1[14], p1[15])};
#pragma unroll
    for (int d0 = 0; d0 < 2; ++d0)
#pragma unroll
        for (int s = 0; s < 4; ++s) {
            const s16x4 lo = *(const LAS s16x4*)(vL + (r32 + 32 * d0) * VP + 16 * s + 4 * hi);
            const s16x4 h4 = *(const LAS s16x4*)(vL + (r32 + 32 * d0) * VP + 16 * s + 8 + 4 * hi);
            const bf16x8 bv = (bf16x8){lo[0], lo[1], lo[2], lo[3], h4[0], h4[1], h4[2], h4[3]};
            o[d0] = __builtin_amdgcn_mfma_f32_32x32x16_bf16(__builtin_bit_cast(bf16x8, pw[s]), bv, o[d0], 0, 0, 0);
        }
    LDS_WAIT();
}
__device__ __forceinline__ void st16(LAS bf16* p, unsigned v) { *(LAS unsigned short*)p = (unsigned short)v; }
__device__ __forceinline__ void attn_prompt_unit(Frame& F, int b, int h, int qb) {
    const int tid = F.tid, lane = F.lane, wave = F.wave, r32 = lane & 31, hi = lane >> 5;
    LAS bf16* kbuf = (LAS bf16*)F.lds; LAS bf16* vbuf = (LAS bf16*)(F.lds + 18432); LAS float* fbuf = (LAS float*)(F.lds + 35840);
    LAS float* wsf = (LAS float*)(F.lds + 36352) + wave * 64;
    const int rowbase = b * 4096, q0 = qb * 256;
    bf16* Qw = F.Q + (size_t)(rowbase + q0 + wave * 32) * DH + h * 64;
    bf16x8 qr[4];
#pragma unroll
    for (int d0 = 0; d0 < 4; ++d0) qr[d0] = *(const bf16x8*)(Qw + (size_t)r32 * DH + d0 * 16 + hi * 8);
    const int NT = 4 * (qb + 1), kvs = tid >> 3, c8 = tid & 7;
    const bf16* kg = F.KB + (size_t)(rowbase + kvs) * DH + h * 64 + 8 * c8;
    const bf16* vg = F.VB + (size_t)(rowbase + kvs) * DH + h * 64 + 8 * c8;
    const float* fg = F.F2P + (size_t)(b * 8 + h) * 4096;
    u32x4 kr = *(const u32x4*)kg, vr = *(const u32x4*)vg; float fr_ = tid < 64 ? fg[tid] : 0.f;
    float m = -1e30f, l = 0.f; f32x16 o[2];
#pragma unroll
    for (int r = 0; r < 16; ++r) { o[0][r] = 0.f; o[1][r] = 0.f; }
    const int qmin = q0 + wave * 32;
#define ATT_WRITE_TILE(t_) do { LAS bf16* kL_ = kbuf + ((t_) & 1) * (64 * KP); LAS bf16* vL_ = vbuf + ((t_) & 1) * (64 * VP); LAS float* fL_ = fbuf + ((t_) & 1) * 64; \
        *(LAS u32x4*)(kL_ + kvs * KP + 8 * c8) = kr; \
        st16(vL_ + (8 * c8 + 0) * VP + kvs, vr.x); st16(vL_ + (8 * c8 + 1) * VP + kvs, vr.x >> 16); \
        st16(vL_ + (8 * c8 + 2) * VP + kvs, vr.y); st16(vL_ + (8 * c8 + 3) * VP + kvs, vr.y >> 16); \
        st16(vL_ + (8 * c8 + 4) * VP + kvs, vr.z); st16(vL_ + (8 * c8 + 5) * VP + kvs, vr.z >> 16); \
        st16(vL_ + (8 * c8 + 6) * VP + kvs, vr.w); st16(vL_ + (8 * c8 + 7) * VP + kvs, vr.w >> 16); \
        if (tid < 64) fL_[tid] = fr_; } while (0)
    ATT_WRITE_TILE(0);
    __syncthreads();
    for (int t = 0; t < NT; ++t) {
        if (t + 1 < NT) { kr = *(const u32x4*)(kg + (size_t)(t + 1) * 64 * DH); vr = *(const u32x4*)(vg + (size_t)(t + 1) * 64 * DH); fr_ = tid < 64 ? fg[(t + 1) * 64 + tid] : 0.f; }
        if (64 * t <= qmin + 31) {
            const bool domask = (64 * t + 63 > qmin);
            attn_tile(kbuf + (t & 1) * (64 * KP), vbuf + (t & 1) * (64 * VP), fbuf + (t & 1) * 64, wsf, qr, o, m, l, domask, qmin + r32 - 64 * t, r32, hi);
        }
        if (t + 1 < NT) ATT_WRITE_TILE(t + 1);
        __syncthreads();
    }
#undef ATT_WRITE_TILE
    l += __shfl_xor(l, 32);
    if (hi == 0) wsf[r32] = 1.0f / l;
    LDS_WAIT();
#pragma unroll
    for (int rg = 0; rg < 4; ++rg) {
        const f32x4 rl = *(const LAS f32x4*)(wsf + 8 * rg + 4 * hi);
#pragma unroll
        for (int i = 0; i < 4; ++i) {
            const int q = 8 * rg + 4 * hi + i;
            Qw[(size_t)q * DH + r32] = (bf16)f2bf(o[0][4 * rg + i] * rl[i]);
            Qw[(size_t)q * DH + 32 + r32] = (bf16)f2bf(o[1][4 * rg + i] * rl[i]);
        }
    }
    LDS_WAIT();
    __syncthreads();
}
__device__ __forceinline__ void attn_sample_unit(Frame& F, int b, int h) {
    const int tid = F.tid, lane = F.lane, wave = F.wave, r32 = lane & 31, hi = lane >> 5;
    LAS unsigned char* wb = F.lds + wave * 18432;
    LAS bf16* kL = (LAS bf16*)wb; LAS bf16* vL = (LAS bf16*)(wb + 9216); LAS float* fL = (LAS float*)(wb + 17920); LAS float* wsf = (LAS float*)(wb + 18176);
    const int qrow0 = NP + b * 32;
    bf16x8 qr[4];
#pragma unroll
    for (int d0 = 0; d0 < 4; ++d0) qr[d0] = *(const bf16x8*)(F.Q + (size_t)(qrow0 + r32) * DH + h * 64 + d0 * 16 + hi * 8);
    float m = -1e30f, l = 0.f; f32x16 o[2];
#pragma unroll
    for (int r = 0; r < 16; ++r) { o[0][r] = 0.f; o[1][r] = 0.f; }
    const float* ck = F.in[4] + ((size_t)b * 4096 * 8 + h) * 64;
    const float* cv = F.in[5] + ((size_t)b * 4096 * 8 + h) * 64;
    const float* f2 = F.F2S + (size_t)(b * 8 + h) * 4128;
    const int c16 = lane & 15, kq = lane >> 4;
    for (int tt = 0; tt < 8; ++tt) {
        const int kv0 = wave * 512 + tt * 64;
#pragma unroll 4
        for (int i = 0; i < 16; ++i) {
            const int kv = kq + 4 * i;
            const f32x4 x = *(const f32x4*)(ck + (size_t)(kv0 + kv) * 512 + 4 * c16);
            const f32x4 y = *(const f32x4*)(cv + (size_t)(kv0 + kv) * 512 + 4 * c16);
            u32x2 w; w.x = pk2(x[0], x[1]); w.y = pk2(x[2], x[3]);
            *(LAS u32x2*)(kL + kv * KP + 4 * c16) = w;
            const unsigned y0 = pk2(y[0], y[1]), y1 = pk2(y[2], y[3]);
            st16(vL + (4 * c16 + 0) * VP + kv, y0); st16(vL + (4 * c16 + 1) * VP + kv, y0 >> 16);
            st16(vL + (4 * c16 + 2) * VP + kv, y1); st16(vL + (4 * c16 + 3) * VP + kv, y1 >> 16);
        }
        fL[lane] = f2[kv0 + lane];
        LDS_WAIT();
        attn_tile(kL, vL, fL, wsf, qr, o, m, l, false, 0, r32, hi);
    }
    if (wave == 7) {
        const int kv = lane >> 1, half = lane & 1;
        const bf16* kn = F.KB + (size_t)(qrow0 + kv) * DH + h * 64 + 32 * half;
        const bf16* vn = F.VB + (size_t)(qrow0 + kv) * DH + h * 64 + 32 * half;
#pragma unroll
        for (int i = 0; i < 4; ++i) {
            const u32x4 x = *(const u32x4*)(kn + 8 * i), y = *(const u32x4*)(vn + 8 * i);
            *(LAS u32x4*)(kL + kv * KP + 32 * half + 8 * i) = x;
            *(LAS u32x4*)(kL + (32 + kv) * KP + 32 * half + 8 * i) = (u32x4){0u, 0u, 0u, 0u};
            const int d = 32 * half + 8 * i;
            st16(vL + (d + 0) * VP + kv, y.x); st16(vL + (d + 1) * VP + kv, y.x >> 16); st16(vL + (d + 2) * VP + kv, y.y); st16(vL + (d + 3) * VP + kv, y.y >> 16);
            st16(vL + (d + 4) * VP + kv, y.z); st16(vL + (d + 5) * VP + kv, y.z >> 16); st16(vL + (d + 6) * VP + kv, y.w); st16(vL + (d + 7) * VP + kv, y.w >> 16);
#pragma unroll
            for (int e = 0; e < 8; ++e) st16(vL + (d + e) * VP + 32 + kv, 0u);
        }
        fL[lane] = lane < 32 ? f2[4096 + lane] : 0.f;
        LDS_WAIT();
        attn_tile(kL, vL, fL, wsf, qr, o, m, l, true, r32, r32, hi);
    }
    l += __shfl_xor(l, 32);
    __syncthreads();
    LAS float* cm = (LAS float*)F.lds; LAS float* cl = cm + 256; LAS float* co = cl + 256;
    if (hi == 0) { cm[wave * 32 + r32] = m; cl[wave * 32 + r32] = l; }
#pragma unroll
    for (int r = 0; r < 16; ++r) {
        const int q = (r & 3) + 8 * (r >> 2) + 4 * hi;
        co[(wave * 32 + q) * 64 + r32] = o[0][r]; co[(wave * 32 + q) * 64 + 32 + r32] = o[1][r];
    }
    __syncthreads();
    {
        const int q = tid >> 4, dg = tid & 15;
        float M = cm[q];
#pragma unroll
        for (int w = 1; w < 8; ++w) M = fmaxf(M, cm[w * 32 + q]);
        float L = 0.f; f32x4 acc = (f32x4){0.f, 0.f, 0.f, 0.f};
#pragma unroll
        for (int w = 0; w < 8; ++w) {
            const float wg = __builtin_amdgcn_exp2f(cm[w * 32 + q] - M);
            L += cl[w * 32 + q] * wg;
            acc += *(const LAS f32x4*)(co + (w * 32 + q) * 64 + 4 * dg) * wg;
        }
        const float rl = 1.0f / L;
        u32x2 w2; w2.x = pk2(acc[0] * rl, acc[1] * rl); w2.y = pk2(acc[2] * rl, acc[3] * rl);
        *(u32x2*)(F.Q + (size_t)(qrow0 + q) * DH + h * 64 + 4 * dg) = w2;
    }
    __syncthreads();
}

__device__ __forceinline__ void s5_decode(int item, int& g, int& ci, int& row0, int& nT) {
    g = item / S5_ITEMS_PER_G; ci = item % S5_ITEMS_PER_G;
    if (ci < 256) { row0 = (ci >> 6) * 4096 + (ci & 63) * 64; nT = 64; } else { row0 = NP + (ci - 256) * 32; nT = 32; }
}
__device__ __forceinline__ void s5_load_u(Frame& F, LAS float* uL, int row0, int g, int nT) {
    if (F.lane < nT) {
        const bf16* up = F.U + (size_t)(row0 + F.lane) * DH + g * 16;
        const u32x4 a = *(const u32x4*)up, b = *(const u32x4*)(up + 8);
        LAS f32x4* d = (LAS f32x4*)(uL + F.lane * 16);
        d[0] = (f32x4){bflo(a.x), bfhi(a.x), bflo(a.y), bfhi(a.y)}; d[1] = (f32x4){bflo(a.z), bfhi(a.z), bflo(a.w), bfhi(a.w)};
        d[2] = (f32x4){bflo(b.x), bfhi(b.x), bflo(b.y), bfhi(b.y)}; d[3] = (f32x4){bflo(b.z), bfhi(b.z), bflo(b.w), bfhi(b.w)};
    }
    LDS_WAIT();
}
__device__ __forceinline__ f32x2 s5_step(const f32x2 a, const f32x2 s, const f32x2 (&bb)[16], const LAS float* ur) {
    const f32x4 u0 = *(const LAS f32x4*)ur, u1 = *(const LAS f32x4*)(ur + 4), u2 = *(const LAS f32x4*)(ur + 8), u3 = *(const LAS f32x4*)(ur + 12);
    f32x2 bu = bb[0] * u0[0];
    bu += bb[1] * u0[1]; bu += bb[2] * u0[2]; bu += bb[3] * u0[3];
    bu += bb[4] * u1[0]; bu += bb[5] * u1[1]; bu += bb[6] * u1[2]; bu += bb[7] * u1[3];
    bu += bb[8] * u2[0]; bu += bb[9] * u2[1]; bu += bb[10] * u2[2]; bu += bb[11] * u2[3];
    bu += bb[12] * u3[0]; bu += bb[13] * u3[1]; bu += bb[14] * u3[2]; bu += bb[15] * u3[3];
    f32x2 n; n.x = a.x * s.x - a.y * s.y + bu.x; n.y = a.x * s.y + a.y * s.x + bu.y;
    return n;
}
__device__ __forceinline__ void s5_pass_a(Frame& F, int wq, int nwq) {
    LAS float* uL = (LAS float*)(F.lds + F.wave * 12800);
    for (int item = wq; item < S5_ITEMS; item += nwq) {
        int g, ci, row0, nT; s5_decode(item, g, ci, row0, nT);
        if (ci >= 256) continue;
        const f32x2 a = F.abar[g * 64 + F.lane];
        f32x2 bb[16];
#pragma unroll
        for (int c = 0; c < 16; ++c) bb[c] = F.bbar[(size_t)(g * 64 + F.lane) * 16 + c];
        s5_load_u(F, uL, row0, g, nT);
        f32x2 s = (f32x2){0.f, 0.f};
#pragma unroll 4
        for (int j = 0; j < 64; ++j) s = s5_step(a, s, bb, uL + j * 16);
        F.E[(size_t)item * 64 + F.lane] = s;
        LDS_WAIT();
    }
}
__device__ __forceinline__ void s5_pass_c(Frame& F) {
    LAS float* uL = (LAS float*)(F.lds + F.wave * 12800);
    LAS bf16* Sb = (LAS bf16*)(F.lds + F.wave * 12800 + 4096);
    const int lane = F.lane, fr = lane & 15, fq = lane >> 4;
    for (int item = F.gw; item < S5_ITEMS; item += F.NGW) {
        int g, ci, row0, nT; s5_decode(item, g, ci, row0, nT);
        const f32x2 a = F.abar[g * 64 + lane];
        f32x2 bb[16];
#pragma unroll
        for (int c = 0; c < 16; ++c) bb[c] = F.bbar[(size_t)(g * 64 + lane) * 16 + c];
        bf16x8 cmf[4];
#pragma unroll
        for (int ks = 0; ks < 4; ++ks) cmf[ks] = *(const bf16x8*)(F.cmt + (g * 16 + fr) * 128 + 32 * ks + 8 * fq);
        const f32x4 dv = *(const f32x4*)(F.in[24] + g * 16 + 4 * fq);
        f32x2 s;
        if (ci < 256) {
            s = (f32x2){0.f, 0.f};
            const f32x2 aa = F.a64[g * 64 + lane];
            const f32x2* ep = F.E + (size_t)(g * S5_ITEMS_PER_G + (ci & ~63)) * 64 + lane;
            const int nprev = ci & 63;
            for (int c = 0; c < nprev; ++c) { const f32x2 e = ep[(size_t)c * 64]; f32x2 n; n.x = aa.x * s.x - aa.y * s.y + e.x; n.y = aa.x * s.y + aa.y * s.x + e.y; s = n; }
        } else {
            const int sb = ci - 256;
            s = (f32x2){F.in[7][(size_t)(sb * 32 + g) * 64 + lane], F.in[8][(size_t)(sb * 32 + g) * 64 + lane]};
        }
        s5_load_u(F, uL, row0, g, nT);
        for (int half = 0; half < (nT >> 5); ++half) {
#pragma unroll 4
            for (int jj = 0; jj < 32; ++jj) {
                s = s5_step(a, s, bb, uL + (half * 32 + jj) * 16);
                st16(Sb + jj * 136 + lane, f2bf(s.x)); st16(Sb + jj * 136 + 64 + lane, f2bf(s.y));
            }
            LDS_WAIT();
#pragma unroll
            for (int jb = 0; jb < 2; ++jb) {
                f32x4 acc = (f32x4){0.f, 0.f, 0.f, 0.f};
#pragma unroll
                for (int ks = 0; ks < 4; ++ks) {
                    const bf16x8 sf = *(const LAS bf16x8*)(Sb + (jb * 16 + fr) * 136 + 32 * ks + 8 * fq);
                    acc = __builtin_amdgcn_mfma_f32_16x16x32_bf16(cmf[ks], sf, acc, 0, 0, 0);
                }
                const int j = half * 32 + jb * 16 + fr;
                const f32x4 u4 = *(const LAS f32x4*)(uL + j * 16 + 4 * fq);
                float y[4];
#pragma unroll
                for (int i = 0; i < 4; ++i) { const float t = acc[i] + dv[i] * u4[i]; y[i] = t * fsigmoid(1.5957691216057308f * (t + 0.044715f * t * t * t)); }
                u32x2 w; w.x = pk2(y[0], y[1]); w.y = pk2(y[2], y[3]);
                *(u32x2*)(F.Z + (size_t)(row0 + j) * DH + g * 16 + 4 * fq) = w;
            }
            LDS_WAIT();
        }
        if (ci >= 256) { const int sb = ci - 256; F.out[O_SRS + (size_t)(sb * 32 + g) * 64 + lane] = s.x; F.out[O_SIS + (size_t)(sb * 32 + g) * 64 + lane] = s.y; }
        else if ((ci & 63) == 63) { const int b = ci >> 6; F.out[O_SRP + (size_t)(b * 32 + g) * 64 + lane] = s.x; F.out[O_SIP + (size_t)(b * 32 + g) * 64 + lane] = s.y; }
    }
}

__global__ void __launch_bounds__(512, 2) mk_fwd(Args args) {
    extern __shared__ __attribute__((aligned(16))) unsigned char lds_raw[];
    cg::grid_group grid = cg::this_grid();
    Frame F;
    F.lds = (LAS unsigned char*)lds_raw;
    F.tid = threadIdx.x; F.lane = F.tid & 63; F.wave = __builtin_amdgcn_readfirstlane(F.tid >> 6);
    F.G = gridDim.x; { const int bx = blockIdx.x; F.vcu = (F.G % 8 == 0) ? (bx % 8) * (F.G / 8) + bx / 8 : bx; }
    F.gw = blockIdx.x * NWAVES + F.wave; F.NGW = F.G * NWAVES;
#pragma unroll
    for (int i = 0; i < 34; ++i) F.in[i] = args.in[i];
    F.out = args.out;
    unsigned char* ws = args.ws;
    F.mod = (float*)(ws + WS_MOD);
    F.abar = (f32x2*)(ws + WS_S5C); F.a64 = (f32x2*)(ws + WS_S5C + 16384); F.bbar = (f32x2*)(ws + WS_S5C + 32768); F.cmt = (bf16*)(ws + WS_S5C + 294912);
    F.F2P = (float*)(ws + WS_F2P); F.F2S = (float*)(ws + WS_F2S); F.E = (f32x2*)(ws + WS_E);
    F.WUP1 = (bf16*)(ws + WS_WUP1); F.WDN1 = (bf16*)(ws + WS_WDN1); F.WIN = (bf16*)(ws + WS_WIN); F.WGLU = (bf16*)(ws + WS_WGLU); F.WOUT = (bf16*)(ws + WS_WOUT);
    F.WUP2 = (bf16*)(ws + WS_WUP2); F.WDN2 = (bf16*)(ws + WS_WDN2); F.HA = (bf16*)(ws + WS_HA); F.HID = (bf16*)(ws + WS_HID);
    F.U = (bf16*)(ws + WS_U); F.Q = (bf16*)(ws + WS_Q); F.KB = (bf16*)(ws + WS_KB); F.VB = (bf16*)(ws + WS_VB); F.Z = (bf16*)(ws + WS_Z);
    const int lo = args.ph_lo, hi = args.ph_hi;
#define IN(k) (lo <= (k) && (k) < hi)
#define SEAM(k) do { if (IN(k) && IN((k) + 1)) grid.sync(); } while (0)
    typedef pg8::StaticOrder SO;
    float* xs_out = F.out + (size_t)NP * DM;

    if (IN(0)) { phase_ada(F); phase_s5const(F); phase_weights(F); }
    SEAM(0);
    if (IN(1)) phase_norm<false>(F, F.in[0], F.in[1], F.in[11], 0, 1);
    SEAM(1);
    if (IN(2)) { pg8::Gemm g{F.HA, F.WUP1, MT, NUP, DM}; SO S; S.init(MT, NUP, F.G, (int)blockIdx.x); EpiSwiglu E{F.HID};
        pg8::gemm_phase<EpiSwiglu, SO, PG8_ALIGN, PG8_SP2>(F.lds, g, S, E); }
    SEAM(2);
    if (IN(3)) { pg8::Gemm g{F.HID, F.WDN1, MT, DM, FF}; SO S; S.init(MT, DM, F.G, (int)blockIdx.x); EpiResid E{F.in[0], F.in[1], F.out, F.mod, 2, 0.5f};
        pg8::gemm_phase<EpiResid, SO, PG8_ALIGN, PG8_SP2>(F.lds, g, S, E); }
    SEAM(3);
    if (IN(4)) phase_norm<true>(F, F.out, xs_out, F.in[14], 3, 4);
    SEAM(4);
    if (IN(5)) { phase_fcum(F);
        pg8::Gemm g{F.HA, F.WIN, MT, 2048, DM}; SO S; S.init(MT, 2048, F.G, (int)blockIdx.x); EpiIn E{F.U, F.Q, F.KB, F.VB, F.out};
        pg8::gemm_phase<EpiIn, SO, PG8_ALIGN, PG8_SP2>(F.lds, g, S, E); }
    SEAM(5);
    if (IN(6)) {
        for (int uix = F.vcu; uix < 256; uix += F.G) {
            const int bh = uix >> 3, s = uix & 7;
            attn_prompt_unit(F, bh >> 3, bh & 7, 15 - s);
            attn_prompt_unit(F, bh >> 3, bh & 7, s);
        }
        const int nsamp_cu = F.G >= 128 ? 64 : 0;
        if (nsamp_cu) {
            if (F.vcu < 64) attn_sample_unit(F, F.vcu >> 3, F.vcu & 7);
            else s5_pass_a(F, (F.vcu - 64) * NWAVES + F.wave, (F.G - 64) * NWAVES);
        } else {
            for (int j = F.vcu; j < 64; j += F.G) attn_sample_unit(F, j >> 3, j & 7);
            s5_pass_a(F, F.gw, F.NGW);
        }
    }
    SEAM(6);
    if (IN(7)) s5_pass_c(F);
    SEAM(7);
    if (IN(8)) { pg8::Gemm g{F.Z, F.WGLU, MT, DH, DH}; SO S; S.init(MT, DH, F.G, (int)blockIdx.x); EpiGlu E{F.Z, F.U, F.in[26]};
        pg8::gemm_phase<EpiGlu, SO, PG8_ALIGN, PG8_SP2>(F.lds, g, S, E); }
    SEAM(8);
    if (IN(9)) phase_mixnorm(F);
    SEAM(9);
    if (IN(10)) { pg8::Gemm g{F.HA, F.WOUT, MT, DM, DM}; SO S; S.init(MT, DM, F.G, (int)blockIdx.x); EpiResid E{F.out, xs_out, F.out, F.mod, 5, 1.0f};
        pg8::gemm_phase<EpiResid, SO, PG8_ALIGN, PG8_SP2>(F.lds, g, S, E); }
    SEAM(10);
    if (IN(11)) phase_norm<false>(F, F.out, xs_out, F.in[30], 6, 7);
    SEAM(11);
    if (IN(12)) { pg8::Gemm g{F.HA, F.WUP2, MT, NUP, DM}; SO S; S.init(MT, NUP, F.G, (int)blockIdx.x); EpiSwiglu E{F.HID};
        pg8::gemm_phase<EpiSwiglu, SO, PG8_ALIGN, PG8_SP2>(F.lds, g, S, E); }
    SEAM(12);
    if (IN(13)) { pg8::Gemm g{F.HID, F.WDN2, MT, DM, FF}; SO S; S.init(MT, DM, F.G, (int)blockIdx.x); EpiResid E{F.out, xs_out, F.out, F.mod, 8, 0.5f};
        pg8::gemm_phase<EpiResid, SO, PG8_ALIGN, PG8_SP2>(F.lds, g, S, E); }
    SEAM(13);
    if (IN(14)) phase_finalnorm(F);
#undef IN
#undef SEAM
}
constexpr int N_PHASES = 15;

#ifndef MK_MULTI
#define MK_MULTI 0
#endif
extern "C" void kernel_launch(void* const* d_in, const int* in_sizes, int n_in, void* d_out, int out_size, void* d_ws, size_t ws_size, hipStream_t stream) {
    static int grid = 0;
    if (grid == 0) {
        int dev = 0, cus = 0, per_cu = 0;
        if (hipGetDevice(&dev) != hipSuccess || hipDeviceGetAttribute(&cus, hipDeviceAttributeMultiprocessorCount, dev) != hipSuccess) { fprintf(stderr, "kernel_launch: device query failed\n"); grid = -1; return; }
        if (hipFuncSetAttribute((const void*)mk_fwd, hipFuncAttributeMaxDynamicSharedMemorySize, LDS_BYTES) != hipSuccess) { fprintf(stderr, "kernel_launch: hipFuncSetAttribute failed\n"); grid = -1; return; }
        if (hipOccupancyMaxActiveBlocksPerMultiprocessor(&per_cu, (const void*)mk_fwd, NWAVES * 64, LDS_BYTES) != hipSuccess || per_cu < 1) per_cu = 1;
        (void)hipGetLastError();
        grid = cus;
        if (n_in != 34 || ws_size < 176 * MiB) fprintf(stderr, "kernel_launch: unexpected n_in %d / ws %zu\n", n_in, ws_size);
    }
    if (grid < 0) return;
    Args a{};
    for (int i = 0; i < 34; ++i) a.in[i] = (const float*)d_in[i];
    a.out = (float*)d_out; a.ws = (unsigned char*)d_ws;
#if MK_MULTI
    for (int p = 0; p < N_PHASES; ++p) { a.ph_lo = p; a.ph_hi = p + 1; hipLaunchKernelGGL(mk_fwd, dim3(grid), dim3(NWAVES * 64), LDS_BYTES, stream, a); }
#else
    a.ph_lo = 0; a.ph_hi = N_PHASES;
    void* kargs[] = {&a};
    const hipError_t e = hipLaunchCooperativeKernel((const void*)mk_fwd, dim3(grid), dim3(NWAVES * 64), kargs, LDS_BYTES, stream);
    if (e != hipSuccess) fprintf(stderr, "kernel_launch: cooperative launch failed: %s (grid %d)\n", hipGetErrorString(e), grid);
#endif
}
```

```cpp
#define MK_REP_MASK 0
#include <hip/hip_runtime.h>
#include <hip/hip_cooperative_groups.h>
#include <cstdio>
#include <cstdint>
namespace cg = cooperative_groups;
namespace pg8 {
#define PG8_LAS __attribute__((address_space(3)))
typedef unsigned short bf16_t;
typedef short bf16x8 __attribute__((ext_vector_type(8)));
typedef float f32x4 __attribute__((ext_vector_type(4)));
typedef unsigned u32x4 __attribute__((ext_vector_type(4)));
constexpr int BM = 256, BK = 64, HALF = 128, HTB = HALF * BK * 2  , STAGE_BYTES = 8 * HTB, NXCD = 8, WGM = 8;

__host__ __device__ __forceinline__ int lds_byte(int r, int c) { const int st = (r >> 4) * 2 + (c >> 5), rr = r & 15, cc = c & 31, ob = rr * 64 + cc * 2; return st * 1024 + (ob ^ (((ob >> 9) & 1) << 5)); }
__host__ __device__ __forceinline__ void stage_rc(int b, int& R, int& C) { const int st = b / 1024, sb = b % 1024, swz = sb ^ (((sb >> 9) & 1) << 5); R = (st >> 1) * 16 + swz / 64; C = (st & 1) * 32 + (swz % 64) / 2; }
__host__ __device__ __forceinline__ int perm32(int rho) { const int n = rho >> 4, i = rho & 15; return 8 * (i >> 2) + 4 * n + (i & 3); }

struct Unit { int pm, pn; };
struct Gemm { const bf16_t* A; const bf16_t* Bt; int M, N, K; };

struct StaticOrder {
    int nM, nN, nwg, G, c;
    __host__ __device__ void init(int M, int N, int G_, int c_) { nM = M / BM; nN = N / BM; nwg = nM * nN; G = G_; c = c_; }
    __host__ __device__ bool next(int i, Unit& u) const {
        const long L = (long)i * G + c; if (L >= nwg) return false;
        int wgid = (int)L; { const int q = nwg / NXCD, r = nwg % NXCD, xcd = wgid % NXCD, off = wgid / NXCD; wgid = (xcd < r ? xcd * (q + 1) : r * (q + 1) + (xcd - r) * q) + off; }
        const int nig = WGM * nN, gid = wgid / nig, fm = gid * WGM, gsz = (nM - fm) < WGM ? (nM - fm) : WGM;
        u.pm = fm + ((wgid % nig) % gsz); u.pn = (wgid % nig) / gsz; return true;
    }
    __device__ __forceinline__ void a_ready(const Unit&) const {}
    __device__ __forceinline__ void done(const Unit&) const {}
};

__device__ __forceinline__ unsigned cvt_pk_bf16(float lo, float hi) { unsigned r; asm volatile("v_cvt_pk_bf16_f32 %0, %1, %2" : "=v"(r) : "v"(lo), "v"(hi)); return r; }
typedef float f32x2 __attribute__((ext_vector_type(2)));
__device__ __forceinline__ f32x2 gelu_pk(f32x2 v) {
    const f32x2 av = __builtin_elementwise_abs(v), d = av * 0.2316418882f + 1.0f;
    f32x2 t; t.x = __builtin_amdgcn_rcpf(d.x); t.y = __builtin_amdgcn_rcpf(d.y);
    f32x2 q = t * 0.5307027145f + (-0.7265760135f); q = q * t + 0.7107068705f; q = q * t + (-0.142248368f); q = q * t + 0.127414796f; q = q * t;
    const f32x2 s = (v * v) * (-0.72134752044f);
    f32x2 e; e.x = __builtin_amdgcn_exp2f(s.x); e.y = __builtin_amdgcn_exp2f(s.y);
    const f32x2 m = v * (q * e), r = v - m;
    f32x2 o; o.x = v.x < 0.f ? m.x : r.x; o.y = v.y < 0.f ? m.y : r.y; return o;
}

template <int ACT  > struct EpiBf16 {
    static constexpr bool PERM = true, AFTER_DRAIN = false; static_assert(ACT == 0 || ACT == 1, "EpiBf16: ACT is 0 (none) or 1 (gelu_pk)");
    bf16_t* O; int ldc; const float* bias; int split_cols; size_t split_stride; float scale0;
    __device__ __forceinline__ void operator()(const f32x4 (&acc)[2][2][4][2], const Unit& u, int wr, int wc, int fr, int fq) const {
        const int row0 = u.pm * BM + wr * 64 + fr; int colt = u.pn * BM; bf16_t* base = O;
        float sc = 1.f; if (split_cols) { const int t = colt / split_cols; base += (size_t)t * split_stride; colt -= t * split_cols; if (t == 0) sc = scale0; }
        const int col0 = colt + wc * 32 + 8 * fq, bcol0 = u.pn * BM + wc * 32 + 8 * fq;
        f32x4 bv[2][2];
#pragma unroll
        for (int bj = 0; bj < 2; ++bj)
#pragma unroll
            for (int n = 0; n < 2; ++n) bv[bj][n] = bias ? *(const f32x4*)(bias + bcol0 + bj * HALF + 4 * n) : (f32x4){0.f, 0.f, 0.f, 0.f};
#pragma unroll
        for (int ai = 0; ai < 2; ++ai)
#pragma unroll
            for (int m = 0; m < 4; ++m) { bf16_t* rowp = base + (size_t)(row0 + ai * HALF + m * 16) * ldc + col0;
#pragma unroll
                for (int bj = 0; bj < 2; ++bj) { f32x4 v0 = acc[ai][bj][m][0] + bv[bj][0], v1 = acc[ai][bj][m][1] + bv[bj][1];
                    if (ACT == 1) { f32x2 a = gelu_pk((f32x2){v0[0], v0[1]}), b = gelu_pk((f32x2){v0[2], v0[3]}), c = gelu_pk((f32x2){v1[0], v1[1]}), d = gelu_pk((f32x2){v1[2], v1[3]});
                        v0 = (f32x4){a.x, a.y, b.x, b.y}; v1 = (f32x4){c.x, c.y, d.x, d.y}; }
                    v0 = v0 * sc; v1 = v1 * sc; u32x4 w; w.x = cvt_pk_bf16(v0[0], v0[1]); w.y = cvt_pk_bf16(v0[2], v0[3]); w.z = cvt_pk_bf16(v1[0], v1[1]); w.w = cvt_pk_bf16(v1[2], v1[3]);
                    *(u32x4*)(rowp + bj * HALF) = w; } }
    }
};


template <class Epi, class Sched, bool ALIGN_EPI = false, bool SP2 = false>
__device__ __forceinline__ void gemm_phase(PG8_LAS unsigned char* lds, const Gemm g, const Sched& S, const Epi& E) {
    const int tid = threadIdx.x, wid = __builtin_amdgcn_readfirstlane(tid >> 6), lane = tid & 63, wr = wid >> 2, wc = wid & 3, fr = lane & 15, fq = lane >> 4;
    const int K = g.K, nt = K / BK;
    unsigned voffA[2], voffB[2];
#pragma unroll
    for (int i = 0; i < 2; ++i) { int R, C; stage_rc(tid * 16 + i * 8192, R, C); const int Rb = Epi::PERM ? ((R & ~31) + perm32(R & 31)) : R;
        voffA[i] = (unsigned)(R * K + C) * 2u; voffB[i] = (unsigned)(Rb * K + C) * 2u; }
    const size_t kstep = (size_t)(BK * 2);
    const size_t hstep = (size_t)HALF * K * 2;
    const size_t tstep = 2 * hstep;
    const unsigned ldsw = (unsigned)wid * 1024u;
    const int aoff = lds_byte(wr * 64 + fr, fq * 8), boff = lds_byte(wc * 32 + fr, fq * 8);
#define PG8_SA(b, h) (((b) * 2 + (h)) * HTB)
#define PG8_SB(b, h) ((4 + (b) * 2 + (h)) * HTB)
#define PG8_STAGE(bufoff, gbase, voff) do { _Pragma("unroll") for (int _i = 0; _i < 2; ++_i) \
        __builtin_amdgcn_global_load_lds((const unsigned*)((const char*)(gbase) + (voff)[_i]), (PG8_LAS unsigned*)(lds + (bufoff) + ldsw + _i * 8192), 16, 0, 0); } while (0)
#define PG8_LDA(dst, b, h) do { _Pragma("unroll") for (int m = 0; m < 4; ++m) _Pragma("unroll") for (int k = 0; k < 2; ++k) dst[m][k] = *(const PG8_LAS bf16x8*)(lds + PG8_SA(b, h) + aoff + m * 2048 + k * 1024); } while (0)
#define PG8_LDB(dst, b, h) do { _Pragma("unroll") for (int n = 0; n < 2; ++n) _Pragma("unroll") for (int k = 0; k < 2; ++k) dst[n][k] = *(const PG8_LAS bf16x8*)(lds + PG8_SB(b, h) + boff + n * 2048 + k * 1024); } while (0)
#define PG8_MMA(ai, bj, At, Bt) do { __builtin_amdgcn_s_setprio(1); _Pragma("unroll") for (int m = 0; m < 4; ++m) _Pragma("unroll") for (int n = 0; n < 2; ++n) _Pragma("unroll") for (int k = 0; k < 2; ++k) \
        acc[ai][bj][m][n] = __builtin_amdgcn_mfma_f32_16x16x32_bf16(Bt[n][k], At[m][k], acc[ai][bj][m][n], 0, 0, 0); __builtin_amdgcn_s_setprio(0); } while (0)
#define PG8_WAIT_V(n) asm volatile("s_waitcnt vmcnt(" #n ")" ::: "memory")
#define PG8_WAIT_L(n) asm volatile("s_waitcnt lgkmcnt(" #n ")" ::: "memory")
#define PG8_BAR __builtin_amdgcn_s_barrier()
#define PG8_SCHED __builtin_amdgcn_sched_barrier(0)
    Unit cur, nxt; int ui = 0;
    if (!S.next(0, cur)) return;
    f32x4 acc[2][2][4][2];
#pragma unroll
    for (int a = 0; a < 2; ++a)
#pragma unroll
        for (int b = 0; b < 2; ++b)
#pragma unroll
            for (int m = 0; m < 4; ++m)
#pragma unroll
                for (int n = 0; n < 2; ++n) acc[a][b][m][n] = (f32x4){0.f, 0.f, 0.f, 0.f};
    bf16x8 At[4][2], B0[2][2], B1[2][2];
    const char* cA = (const char*)g.A + (size_t)cur.pm * tstep; const char* cB = (const char*)g.Bt + (size_t)cur.pn * tstep;
    S.a_ready(cur);
    if constexpr (SP2) {
        PG8_STAGE(PG8_SB(0, 0), cB, voffB); PG8_STAGE(PG8_SB(0, 1), cB + hstep, voffB); PG8_STAGE(PG8_SA(0, 0), cA, voffA); PG8_STAGE(PG8_SA(0, 1), cA + hstep, voffA);
        if (wr == 1) PG8_BAR;
        PG8_WAIT_V(2); PG8_BAR;
        PG8_STAGE(PG8_SB(1, 0), cB + kstep, voffB); PG8_STAGE(PG8_SA(1, 0), cA + kstep, voffA); PG8_STAGE(PG8_SB(1, 1), cB + hstep + kstep, voffB);
        PG8_WAIT_V(6); PG8_BAR;
    } else {
        PG8_STAGE(PG8_SB(0, 0), cB, voffB); PG8_STAGE(PG8_SA(0, 0), cA, voffA); PG8_STAGE(PG8_SB(0, 1), cB + hstep, voffB); PG8_STAGE(PG8_SA(0, 1), cA + hstep, voffA);
        if (wr == 1) PG8_BAR;
        PG8_WAIT_V(4); PG8_BAR;
        PG8_STAGE(PG8_SB(1, 0), cB + kstep, voffB); PG8_STAGE(PG8_SA(1, 0), cA + kstep, voffA); PG8_STAGE(PG8_SB(1, 1), cB + hstep + kstep, voffB);
        PG8_WAIT_V(6); PG8_BAR;
    }
    for (;;) {
        const bool has_next = S.next(ui + 1, nxt);
        const char* nA = has_next ? (const char*)g.A + (size_t)nxt.pm * tstep : cA; const char* nB = has_next ? (const char*)g.Bt + (size_t)nxt.pn * tstep : cB;
        for (int t = 0; t < nt; t += 2) {
            const bool last = (t == nt - 2);
            const char* a1 = cA + (size_t)(t + 1) * kstep;
            const char* a2 = last ? nA : cA + (size_t)(t + 2) * kstep; const char* b2 = last ? nB : cB + (size_t)(t + 2) * kstep;
            const char* a3 = a2 + kstep; const char* b3 = b2 + kstep;
            if (last && has_next) S.a_ready(nxt);
            if constexpr (SP2) {
            PG8_LDB(B0, 0, 0); PG8_LDB(B1, 0, 1); PG8_SCHED; PG8_LDA(At, 0, 0); PG8_STAGE(PG8_SA(1, 1), a1 + hstep, voffA);
            PG8_WAIT_V(8); PG8_WAIT_L(0); PG8_BAR; PG8_MMA(0, 0, At, B0); PG8_MMA(0, 1, At, B1); PG8_BAR; PG8_SCHED;
            PG8_LDA(At, 0, 1); PG8_STAGE(PG8_SB(0, 0), b2, voffB); PG8_STAGE(PG8_SB(0, 1), b2 + hstep, voffB); PG8_STAGE(PG8_SA(0, 0), a2, voffA);
            PG8_WAIT_V(8); PG8_WAIT_L(0); PG8_BAR; PG8_MMA(1, 0, At, B0); PG8_MMA(1, 1, At, B1); PG8_BAR; PG8_SCHED;
            PG8_LDB(B0, 1, 0); PG8_LDB(B1, 1, 1); PG8_SCHED; PG8_LDA(At, 1, 0); PG8_STAGE(PG8_SA(0, 1), a2 + hstep, voffA);
            PG8_WAIT_V(8); PG8_WAIT_L(0); PG8_BAR; PG8_MMA(0, 0, At, B0); PG8_MMA(0, 1, At, B1); PG8_BAR; PG8_SCHED;
            PG8_LDA(At, 1, 1); PG8_STAGE(PG8_SB(1, 0), b3, voffB); PG8_STAGE(PG8_SB(1, 1), b3 + hstep, voffB); PG8_STAGE(PG8_SA(1, 0), a3, voffA);
            PG8_WAIT_V(8); PG8_WAIT_L(0); PG8_BAR; PG8_MMA(1, 0, At, B0); PG8_MMA(1, 1, At, B1); PG8_BAR; PG8_SCHED;
            } else {
            PG8_LDB(B0, 0, 0); PG8_SCHED; PG8_LDA(At, 0, 0); PG8_STAGE(PG8_SA(1, 1), a1 + hstep, voffA);
            PG8_WAIT_L(8); PG8_BAR; PG8_WAIT_L(0); PG8_MMA(0, 0, At, B0); PG8_BAR; PG8_SCHED;
            PG8_LDB(B1, 0, 1); PG8_STAGE(PG8_SB(0, 0), b2, voffB);
            PG8_BAR; PG8_WAIT_L(0); PG8_MMA(0, 1, At, B1); PG8_BAR;
            PG8_LDA(At, 0, 1); PG8_STAGE(PG8_SA(0, 0), a2, voffA);
            PG8_BAR; PG8_WAIT_L(0); PG8_MMA(1, 0, At, B0); PG8_BAR; PG8_SCHED;
            PG8_STAGE(PG8_SB(0, 1), b2 + hstep, voffB);
            PG8_WAIT_V(6); PG8_BAR; PG8_MMA(1, 1, At, B1); PG8_BAR;
            PG8_LDB(B0, 1, 0); PG8_SCHED; PG8_LDA(At, 1, 0); PG8_STAGE(PG8_SA(0, 1), a2 + hstep, voffA);
            PG8_WAIT_L(8); PG8_BAR; PG8_WAIT_L(0); PG8_MMA(0, 0, At, B0); PG8_BAR; PG8_SCHED;
            PG8_LDB(B1, 1, 1); PG8_STAGE(PG8_SB(1, 0), b3, voffB);
            PG8_BAR; PG8_WAIT_L(0); PG8_MMA(0, 1, At, B1); PG8_BAR;
            PG8_LDA(At, 1, 1); PG8_STAGE(PG8_SA(1, 0), a3, voffA);
            PG8_BAR; PG8_WAIT_L(0); PG8_MMA(1, 0, At, B0); PG8_BAR; PG8_SCHED;
            PG8_STAGE(PG8_SB(1, 1), b3 + hstep, voffB);
            PG8_WAIT_V(6); PG8_BAR; PG8_MMA(1, 1, At, B1); PG8_BAR;
            }
        }
        if constexpr (ALIGN_EPI) { if (wr == 0) PG8_BAR; }
        if constexpr (!Epi::AFTER_DRAIN) { E(acc, cur, wr, wc, fr, fq); S.done(cur); }
        if (!has_next) break;
#pragma unroll
        for (int a = 0; a < 2; ++a)
#pragma unroll
            for (int b = 0; b < 2; ++b)
#pragma unroll
                for (int m = 0; m < 4; ++m)
#pragma unroll
                    for (int n = 0; n < 2; ++n) acc[a][b][m][n] = (f32x4){0.f, 0.f, 0.f, 0.f};
        cur = nxt; cA = nA; cB = nB; ++ui;
        if constexpr (ALIGN_EPI) { if (wr == 1) PG8_BAR; }
    }
    PG8_WAIT_V(0);
    if constexpr (!ALIGN_EPI) { if (wr == 0) PG8_BAR; }
    PG8_BAR;
    if constexpr (Epi::AFTER_DRAIN) { E.fused(acc, cur, wr, wc, fr, fq, lds, wid, lane); S.done(cur); }
#undef PG8_SA
#undef PG8_SB
#undef PG8_STAGE
#undef PG8_LDA
#undef PG8_LDB
#undef PG8_MMA
#undef PG8_WAIT_V
#undef PG8_WAIT_L
#undef PG8_BAR
#undef PG8_SCHED
}
}

#ifndef PG8_SP2
#define PG8_SP2 true
#endif
#ifndef PG8_ALIGN
#define PG8_ALIGN true
#endif
#define LAS __attribute__((address_space(3)))
typedef unsigned short bf16;
typedef short bf16x8 __attribute__((ext_vector_type(8)));
typedef short s16x4 __attribute__((ext_vector_type(4)));
typedef float f32x4 __attribute__((ext_vector_type(4)));
typedef float f32x2 __attribute__((ext_vector_type(2)));
typedef float f32x16 __attribute__((ext_vector_type(16)));
typedef unsigned u32x4 __attribute__((ext_vector_type(4)));
typedef unsigned u32x2 __attribute__((ext_vector_type(2)));

constexpr int NP = 16384, NS = 256, MT = NP + NS, DM = 1024, FF = 2816, NUP = 5632, DH = 512, NMOD = 9216, DIN = 2056;
constexpr float EPS = 1e-6f, LOG2E = 1.4426950408889634f, QSCALE = 0.125f * 1.4426950408889634f;
constexpr size_t O_KP = 17039360, O_VP = 25427968, O_LFP = 33816576, O_SRP = 33947648, O_SIP = 33955840, O_KS = 33964032, O_VS = 34095104,
                 O_LFS = 34226176, O_SRS = 34228224, O_SIS = 34244608;
constexpr size_t MiB = 1u << 20;
constexpr size_t WS_MOD = 0, WS_S5C = 1 * MiB, WS_F2P = 2 * MiB, WS_F2S = 2 * MiB + 512 * 1024, WS_E = 4 * MiB, WS_WUP1 = 10 * MiB, WS_WDN1 = 21 * MiB,
                 WS_WIN = 27 * MiB, WS_WGLU = 31 * MiB, WS_WOUT = 32 * MiB, WS_WUP2 = 34 * MiB, WS_WDN2 = 45 * MiB, WS_HA = 52 * MiB, WS_HID = 86 * MiB;
constexpr size_t WS_U = WS_HID, WS_Q = WS_HID + 17 * MiB, WS_KB = WS_HID + 34 * MiB, WS_VB = WS_HID + 51 * MiB, WS_Z = WS_HID + 68 * MiB;
constexpr size_t WS_O = 176 * MiB;
#ifndef MK_REP_MASK
#define MK_REP_MASK 0
#endif
constexpr int S5_ITEMS_PER_G = 264, S5_ITEMS = 32 * 264;
constexpr int LDS_BYTES = 155648;
constexpr int NWAVES = 8;

struct Args { const float* in[34]; float* out; unsigned char* ws; int ph_lo, ph_hi; };

struct Frame {
    LAS unsigned char* lds;
    int tid, lane, wave, G, vcu, gw, NGW;
    const float* in[34];
    float* out;
    float* mod; f32x2* abar; f32x2* a64; f32x2* bbar; bf16* cmt; float* F2P; float* F2S; f32x2* E;
    bf16 *WUP1, *WDN1, *WIN, *WGLU, *WOUT, *WUP2, *WDN2, *HA, *HID, *U, *Q, *KB, *VB, *Z, *O;
};

__device__ __forceinline__ unsigned f2bf(float f) { unsigned u = __builtin_bit_cast(unsigned, f); return (u + 0x7fffu + ((u >> 16) & 1u)) >> 16; }
__device__ __forceinline__ unsigned pk2(float lo, float hi) { return pg8::cvt_pk_bf16(lo, hi); }
__device__ __forceinline__ float bflo(unsigned w) { return __uint_as_float(w << 16); }
__device__ __forceinline__ float bfhi(unsigned w) { return __uint_as_float(w & 0xffff0000u); }
__device__ __forceinline__ float wave_sum(float v) {
#pragma unroll
    for (int o = 1; o < 64; o <<= 1) v += __shfl_xor(v, o);
    return v;
}
__device__ __forceinline__ float fsigmoid(float x) { return __builtin_amdgcn_rcpf(1.f + __builtin_amdgcn_exp2f(-x * LOG2E)); }
__device__ __forceinline__ int bidx(int row) { return row < NP ? (row >> 12) : 4 + ((row - NP) >> 5); }
#define LDS_WAIT() asm volatile("s_waitcnt lgkmcnt(0)" ::: "memory")

using pg8::Unit;
struct EpiSwiglu {
    static constexpr bool PERM = true, AFTER_DRAIN = false;
    bf16* H;
    __device__ __forceinline__ void operator()(const f32x4 (&acc)[2][2][4][2], const Unit& u, int wr, int wc, int fr, int fq) const {
        const int row0 = u.pm * 256 + wr * 64 + fr, col0 = u.pn * 128 + wc * 32 + 8 * fq;
#pragma unroll
        for (int ai = 0; ai < 2; ++ai)
#pragma unroll
            for (int m = 0; m < 4; ++m) {
                const int row = row0 + ai * 128 + m * 16;
                u32x4 w; unsigned ww[4];
#pragma unroll
                for (int n = 0; n < 2; ++n) {
                    const f32x4 g = acc[ai][0][m][n], up = acc[ai][1][m][n]; float r[4];
#pragma unroll
                    for (int i = 0; i < 4; ++i) r[i] = g[i] * fsigmoid(g[i]) * up[i];
                    ww[2 * n] = pk2(r[0], r[1]); ww[2 * n + 1] = pk2(r[2], r[3]);
                }
                w.x = ww[0]; w.y = ww[1]; w.z = ww[2]; w.w = ww[3];
                *(u32x4*)(H + (size_t)row * FF + col0) = w;
            }
    }
};
struct EpiResid {
    static constexpr bool PERM = true, AFTER_DRAIN = false;
    const float* xp; const float* xs; float* out; const float* mod; int gi; float gscale;
    __device__ __forceinline__ void operator()(const f32x4 (&acc)[2][2][4][2], const Unit& u, int wr, int wc, int fr, int fq) const {
        const int row0 = u.pm * 256 + wr * 64 + fr, col0 = u.pn * 256 + wc * 32 + 8 * fq;
#pragma unroll
        for (int ai = 0; ai < 2; ++ai)
#pragma unroll
            for (int m = 0; m < 4; ++m) {
                const int row = row0 + ai * 128 + m * 16;
                const float* xin = row < NP ? xp + (size_t)row * DM : xs + (size_t)(row - NP) * DM;
                const float* gate = mod + bidx(row) * NMOD + gi * DM;
                float* orow = out + (size_t)row * DM;
#pragma unroll
                for (int bj = 0; bj < 2; ++bj) {
                    const int col = col0 + bj * 128;
#pragma unroll
                    for (int n = 0; n < 2; ++n) {
                        const f32x4 g = *(const f32x4*)(gate + col + 4 * n), x = *(const f32x4*)(xin + col + 4 * n);
                        const f32x4 o = x + (g + 1.0f) * gscale * acc[ai][bj][m][n];
                        *(f32x4*)(orow + col + 4 * n) = o;
                    }
                }
            }
    }
};
struct EpiIn {
    static constexpr bool PERM = true, AFTER_DRAIN = false;
    bf16 *U, *Q, *KB, *VB; float* out;
    __device__ __forceinline__ void operator()(const f32x4 (&acc)[2][2][4][2], const Unit& u, int wr, int wc, int fr, int fq) const {
        const int t = u.pn >> 1;
        const int row0 = u.pm * 256 + wr * 64 + fr, col0 = (u.pn & 1) * 256 + wc * 32 + 8 * fq;
        bf16* dst = t == 0 ? U : t == 1 ? Q : t == 2 ? KB : VB;
        const float sc = t == 1 ? QSCALE : 1.0f;
#pragma unroll
        for (int ai = 0; ai < 2; ++ai)
#pragma unroll
            for (int m = 0; m < 4; ++m) {
                const int row = row0 + ai * 128 + m * 16;
                float* fo = row < NP ? out + (t == 2 ? O_KP : O_VP) + (size_t)row * DH : out + (t == 2 ? O_KS : O_VS) + (size_t)(row - NP) * DH;
#pragma unroll
                for (int bj = 0; bj < 2; ++bj) {
                    const int col = col0 + bj * 128;
                    const f32x4 v0 = acc[ai][bj][m][0], v1 = acc[ai][bj][m][1];
                    u32x4 w; w.x = pk2(v0[0] * sc, v0[1] * sc); w.y = pk2(v0[2] * sc, v0[3] * sc); w.z = pk2(v1[0] * sc, v1[1] * sc); w.w = pk2(v1[2] * sc, v1[3] * sc);
                    *(u32x4*)(dst + (size_t)row * DH + col) = w;
                    if (t >= 2) { *(f32x4*)(fo + col) = v0; *(f32x4*)(fo + col + 4) = v1; }
                }
            }
    }
};
struct EpiGlu {
    static constexpr bool PERM = true, AFTER_DRAIN = false;
    const bf16* Z; bf16* Y; const float* bglu;
    __device__ __forceinline__ void operator()(const f32x4 (&acc)[2][2][4][2], const Unit& u, int wr, int wc, int fr, int fq) const {
        const int row0 = u.pm * 256 + wr * 64 + fr, col0 = u.pn * 256 + wc * 32 + 8 * fq;
#pragma unroll
        for (int bj = 0; bj < 2; ++bj) {
            const int col = col0 + bj * 128;
            const f32x4 b0 = *(const f32x4*)(bglu + col), b1 = *(const f32x4*)(bglu + col + 4);
#pragma unroll
            for (int ai = 0; ai < 2; ++ai)
#pragma unroll
                for (int m = 0; m < 4; ++m) {
                    const int row = row0 + ai * 128 + m * 16;
                    const u32x4 z = *(const u32x4*)(Z + (size_t)row * DH + col);
                    const f32x4 a0 = acc[ai][bj][m][0] + b0, a1 = acc[ai][bj][m][1] + b1;
                    u32x4 w;
                    w.x = pk2(bflo(z.x) * fsigmoid(a0[0]), bfhi(z.x) * fsigmoid(a0[1]));
                    w.y = pk2(bflo(z.y) * fsigmoid(a0[2]), bfhi(z.y) * fsigmoid(a0[3]));
                    w.z = pk2(bflo(z.z) * fsigmoid(a1[0]), bfhi(z.z) * fsigmoid(a1[1]));
                    w.w = pk2(bflo(z.w) * fsigmoid(a1[2]), bfhi(z.w) * fsigmoid(a1[3]));
                    *(u32x4*)(Y + (size_t)row * DH + col) = w;
                }
        }
    }
};

__device__ __forceinline__ void phase_ada(Frame& F) {
    LAS float* sm = (LAS float*)F.lds;
    LAS float* red = sm + 12288;
    const float* cp = F.in[2]; const float* cs = F.in[3]; const float* wada = F.in[9]; const float* bada = F.in[10];
    for (int i = F.tid; i < 12288; i += 512) { const int d = i / 12, bi = i % 12; const float c = bi < 4 ? cp[bi * DM + d] : cs[(bi - 4) * DM + d]; sm[i] = c * fsigmoid(c); }
    __syncthreads();
    for (int cb = blockIdx.x; cb < 256; cb += F.G) {
        const int ks = F.tid / 36, cl = F.tid % 36;
        float acc[12];
#pragma unroll
        for (int i = 0; i < 12; ++i) acc[i] = 0.f;
        if (F.tid < 504) {
            const float* wp = wada + (size_t)ks * NMOD + cb * 36 + cl;
            const int nd = (DM - ks + 13) / 14;
            for (int i0 = 0; i0 < nd; i0 += 8) {
                float w[8];
#pragma unroll
                for (int u = 0; u < 8; ++u) w[u] = (i0 + u < nd) ? wp[(size_t)(i0 + u) * 14 * NMOD] : 0.f;
#pragma unroll
                for (int u = 0; u < 8; ++u) {
                    const int d = (i0 + u < nd) ? ks + 14 * (i0 + u) : 0;
                    const f32x4 s0 = *(const LAS f32x4*)(sm + d * 12), s1 = *(const LAS f32x4*)(sm + d * 12 + 4), s2 = *(const LAS f32x4*)(sm + d * 12 + 8);
                    acc[0] += w[u] * s0[0]; acc[1] += w[u] * s0[1]; acc[2] += w[u] * s0[2]; acc[3] += w[u] * s0[3];
                    acc[4] += w[u] * s1[0]; acc[5] += w[u] * s1[1]; acc[6] += w[u] * s1[2]; acc[7] += w[u] * s1[3];
                    acc[8] += w[u] * s2[0]; acc[9] += w[u] * s2[1]; acc[10] += w[u] * s2[2]; acc[11] += w[u] * s2[3];
                }
            }
#pragma unroll
            for (int i = 0; i < 12; ++i) red[(ks * 36 + cl) * 12 + i] = acc[i];
        }
        __syncthreads();
        if (F.tid < 432) {
            const int c2 = F.tid / 12, bi = F.tid % 12; float s = bada[cb * 36 + c2];
#pragma unroll
            for (int k = 0; k < 14; ++k) s += red[(k * 36 + c2) * 12 + bi];
            F.mod[bi * NMOD + cb * 36 + c2] = s;
        }
        __syncthreads();
    }
}
__device__ __forceinline__ void sincos_d(double x, double& s, double& c) {
    const double kf = __builtin_rint(x * 0.63661977236758134308);
    double r = __builtin_fma(-kf, 1.57079632679489655800e+00, x); r = __builtin_fma(-kf, 6.12323399573676603587e-17, r);
    const int k = ((int)kf) & 3; const double r2 = r * r;
    double sp = 1.0 / 6227020800.0; sp = __builtin_fma(sp, r2, -1.0 / 39916800.0); sp = __builtin_fma(sp, r2, 1.0 / 362880.0); sp = __builtin_fma(sp, r2, -1.0 / 5040.0);
    sp = __builtin_fma(sp, r2, 1.0 / 120.0); sp = __builtin_fma(sp, r2, -1.0 / 6.0); sp = __builtin_fma(sp, r2, 1.0); const double sr = sp * r;
    double cq = -1.0 / 87178291200.0; cq = __builtin_fma(cq, r2, 1.0 / 479001600.0); cq = __builtin_fma(cq, r2, -1.0 / 3628800.0); cq = __builtin_fma(cq, r2, 1.0 / 40320.0);
    cq = __builtin_fma(cq, r2, -1.0 / 720.0); cq = __builtin_fma(cq, r2, 1.0 / 24.0); cq = __builtin_fma(cq, r2, -0.5); const double cr = __builtin_fma(cq, r2, 1.0);
    s = (k == 0) ? sr : (k == 1) ? cr : (k == 2) ? -sr : -cr;
    c = (k == 0) ? cr : (k == 1) ? -sr : (k == 2) ? -cr : sr;
}
__device__ __forceinline__ double exp_d(double x) {
    const double n = __builtin_rint(x * 1.4426950408889634074);
    double r = __builtin_fma(-n, 6.93147180369123816490e-01, x); r = __builtin_fma(-n, 1.90821492927058770002e-10, r);
    double p = 1.0 / 6227020800.0;
    p = __builtin_fma(p, r, 1.0 / 479001600.0); p = __builtin_fma(p, r, 1.0 / 39916800.0); p = __builtin_fma(p, r, 1.0 / 3628800.0); p = __builtin_fma(p, r, 1.0 / 362880.0);
    p = __builtin_fma(p, r, 1.0 / 40320.0); p = __builtin_fma(p, r, 1.0 / 5040.0); p = __builtin_fma(p, r, 1.0 / 720.0); p = __builtin_fma(p, r, 1.0 / 120.0);
    p = __builtin_fma(p, r, 1.0 / 24.0); p = __builtin_fma(p, r, 1.0 / 6.0); p = __builtin_fma(p, r, 0.5); p = __builtin_fma(p, r, 1.0); p = __builtin_fma(p, r, 1.0);
    return __builtin_ldexp(p, (int)n);
}
__device__ __forceinline__ void phase_s5const(Frame& F) {
    const int id = blockIdx.x * 512 + F.tid;
    if (id >= 2048) return;
    const int g = id >> 6, p = id & 63;
    const double lre = (double)F.in[17][id], lim = (double)F.in[18][id], dt = exp_d((double)F.in[19][g]);
    const double mag = exp_d(lre * dt); double sn, cs; sincos_d(lim * dt, sn, cs);
    const double are = mag * cs, aim = mag * sn;
    F.abar[id] = (f32x2){(float)are, (float)aim};
    double pr = are, pi = aim;
#pragma unroll
    for (int i = 0; i < 6; ++i) { const double nr = pr * pr - pi * pi, ni = 2.0 * pr * pi; pr = nr; pi = ni; }
    F.a64[id] = (f32x2){(float)pr, (float)pi};
    const double xr = are - 1.0, xi = aim, den = lre * lre + lim * lim;
    const double cr = (xr * lre + xi * lim) / den, ci = (xi * lre - xr * lim) / den;
    const float* bre = F.in[20] + (size_t)id * 16; const float* bim = F.in[21] + (size_t)id * 16;
#pragma unroll
    for (int c = 0; c < 16; ++c) { const double br = bre[c], bi = bim[c]; F.bbar[(size_t)id * 16 + c] = (f32x2){(float)(cr * br - ci * bi), (float)(cr * bi + ci * br)}; }
    const float* cre = F.in[22]; const float* cim = F.in[23];
#pragma unroll
    for (int c = 0; c < 16; ++c) {
        F.cmt[(g * 16 + c) * 128 + p] = (bf16)f2bf(cre[(g * 16 + c) * 64 + p]);
        F.cmt[(g * 16 + c) * 128 + 64 + p] = (bf16)f2bf(-cim[(g * 16 + c) * 64 + p]);
    }
}
__device__ __forceinline__ void transpose_item(const float* W, int ldw, int k0, int n0, bf16* WT, int Kd, int drow0, LAS float* scr, int lane) {
#pragma unroll 8
    for (int i = 0; i < 32; ++i) { const int kk = 2 * i + (lane >> 5); scr[kk * 33 + (lane & 31)] = W[(size_t)(k0 + kk) * ldw + n0 + (lane & 31)]; }
    LDS_WAIT();
    const int c = lane & 7;
#pragma unroll
    for (int j = 0; j < 4; ++j) { const int n = (lane >> 3) + 8 * j; const LAS float* s = scr + (8 * c) * 33 + n;
        u32x4 o; o.x = pk2(s[0 * 33], s[1 * 33]); o.y = pk2(s[2 * 33], s[3 * 33]); o.z = pk2(s[4 * 33], s[5 * 33]); o.w = pk2(s[6 * 33], s[7 * 33]);
        *(u32x4*)(WT + (size_t)(drow0 + n) * Kd + k0 + 8 * c) = o; }
    LDS_WAIT();
}
__device__ __forceinline__ int up_drow(int n0) { return n0 < FF ? 256 * (n0 >> 7) + (n0 & 127) : 256 * ((n0 - FF) >> 7) + 128 + ((n0 - FF) & 127); }
__device__ __forceinline__ void phase_weights(Frame& F) {
    LAS float* scr = (LAS float*)(F.lds + 81920 + F.wave * 8704);
    constexpr int I_UP = 16 * 176, I_DN = 44 * 32, I_IN = 16 * 64, I_GLU = 8 * 16, I_OUT = 16 * 32;
    constexpr int NITEMS = 2 * I_UP + 2 * I_DN + I_IN + I_GLU + I_OUT;
    for (int it = F.gw; it < NITEMS; it += F.NGW) {
        int r = it;
        if (r < I_UP) { const int kb = r / 176, nb = r % 176; transpose_item(F.in[12], NUP, 64 * kb, 32 * nb, F.WUP1, DM, up_drow(32 * nb), scr, F.lane); continue; } r -= I_UP;
        if (r < I_UP) { const int kb = r / 176, nb = r % 176; transpose_item(F.in[31], NUP, 64 * kb, 32 * nb, F.WUP2, DM, up_drow(32 * nb), scr, F.lane); continue; } r -= I_UP;
        if (r < I_DN) { const int kb = r / 32, nb = r % 32; transpose_item(F.in[13], DM, 64 * kb, 32 * nb, F.WDN1, FF, 32 * nb, scr, F.lane); continue; } r -= I_DN;
        if (r < I_DN) { const int kb = r / 32, nb = r % 32; transpose_item(F.in[32], DM, 64 * kb, 32 * nb, F.WDN2, FF, 32 * nb, scr, F.lane); continue; } r -= I_DN;
        if (r < I_IN) { const int kb = r / 64, nb = r % 64; transpose_item(F.in[15], DIN, 64 * kb, 32 * nb, F.WIN, DM, 32 * nb, scr, F.lane); continue; } r -= I_IN;
        if (r < I_GLU) { const int kb = r / 16, nb = r % 16; transpose_item(F.in[25], DH, 64 * kb, 32 * nb, F.WGLU, DH, 32 * nb, scr, F.lane); continue; } r -= I_GLU;
        { const int kb = r / 32, nb = r % 32; transpose_item(F.in[29], DM, 64 * kb, 32 * nb, F.WOUT, DM, 32 * nb, scr, F.lane); }
    }
}

template <bool FG>
__device__ __forceinline__ void phase_norm(Frame& F, const float* xp, const float* xs, const float* gN, int si, int ci) {
    LAS float* wf = (LAS float*)F.lds;
    if (FG) {
        const float* win = F.in[15];
        for (int i = F.tid; i < 8192; i += 512) wf[i] = win[(size_t)(i >> 3) * DIN + 2048 + (i & 7)];
        __syncthreads();
    }
    const int lane = F.lane;
    for (int row = F.gw; row < MT; row += F.NGW) {
        const float* xr = row < NP ? xp + (size_t)row * DM : xs + (size_t)(row - NP) * DM;
        f32x4 v[4]; float ss = 0.f;
#pragma unroll
        for (int j = 0; j < 4; ++j) { v[j] = *(const f32x4*)(xr + 4 * lane + 256 * j); ss += (v[j][0] * v[j][0] + v[j][1] * v[j][1]) + (v[j][2] * v[j][2] + v[j][3] * v[j][3]); }
        const float rstd = 1.0f / sqrtf(wave_sum(ss) * (1.0f / DM) + EPS);
        const float* sh = F.mod + bidx(row) * NMOD + si * DM; const float* sc = F.mod + bidx(row) * NMOD + ci * DM;
        float f[8];
#pragma unroll
        for (int i = 0; i < 8; ++i) f[i] = 0.f;
#pragma unroll
        for (int j = 0; j < 4; ++j) {
            const int col = 4 * lane + 256 * j;
            const f32x4 g4 = *(const f32x4*)(gN + col), s4 = *(const f32x4*)(sc + col), h4 = *(const f32x4*)(sh + col);
            const f32x4 h = v[j] * rstd * g4 * (s4 + 1.0f) + h4;
            u32x2 w; w.x = pk2(h[0], h[1]); w.y = pk2(h[2], h[3]);
            *(u32x2*)(F.HA + (size_t)row * DM + col) = w;
            if (FG) {
#pragma unroll
                for (int e = 0; e < 4; ++e) {
                    const f32x4 w0 = *(const LAS f32x4*)(wf + (col + e) * 8), w1 = *(const LAS f32x4*)(wf + (col + e) * 8 + 4);
                    f[0] += h[e] * w0[0]; f[1] += h[e] * w0[1]; f[2] += h[e] * w0[2]; f[3] += h[e] * w0[3];
                    f[4] += h[e] * w1[0]; f[5] += h[e] * w1[1]; f[6] += h[e] * w1[2]; f[7] += h[e] * w1[3];
                }
            }
        }
        if (FG) {
#pragma unroll
            for (int i = 0; i < 8; ++i) f[i] = wave_sum(f[i]);
            float fv = f[0];
            fv = lane == 1 ? f[1] : fv; fv = lane == 2 ? f[2] : fv; fv = lane == 3 ? f[3] : fv; fv = lane == 4 ? f[4] : fv;
            fv = lane == 5 ? f[5] : fv; fv = lane == 6 ? f[6] : fv; fv = lane == 7 ? f[7] : fv;
            if (lane < 8) {
                const float x = fv + F.in[16][lane];
                const float lf = fminf(x, 0.f) - log1pf(expf(-fabsf(x)));
                float* o = row < NP ? F.out + O_LFP + (size_t)row * 8 : F.out + O_LFS + (size_t)(row - NP) * 8;
                o[lane] = lf;
            }
        }
    }
}
__device__ __forceinline__ void phase_mixnorm(Frame& F) {
    const int lane = F.lane; const float* gs = F.in[27]; const float* gf = F.in[28];
    for (int row = F.gw; row < MT; row += F.NGW) {
#pragma unroll
        for (int part = 0; part < 2; ++part) {
            const bf16* src = (part == 0 ? F.U : F.O) + (size_t)row * DH + 8 * lane;
            const float* g = (part == 0 ? gs : gf) + 8 * lane;
            const u32x4 z = *(const u32x4*)src;
            float v[8] = {bflo(z.x), bfhi(z.x), bflo(z.y), bfhi(z.y), bflo(z.z), bfhi(z.z), bflo(z.w), bfhi(z.w)};
            float ss = 0.f;
#pragma unroll
            for (int i = 0; i < 8; ++i) ss += v[i] * v[i];
            const float rstd = 1.0f / sqrtf(wave_sum(ss) * (1.0f / DH) + EPS);
            const f32x4 g0 = *(const f32x4*)g, g1 = *(const f32x4*)(g + 4);
            u32x4 w; w.x = pk2(v[0] * rstd * g0[0], v[1] * rstd * g0[1]); w.y = pk2(v[2] * rstd * g0[2], v[3] * rstd * g0[3]);
            w.z = pk2(v[4] * rstd * g1[0], v[5] * rstd * g1[1]); w.w = pk2(v[6] * rstd * g1[2], v[7] * rstd * g1[3]);
            *(u32x4*)(F.HA + (size_t)row * DM + part * DH + 8 * lane) = w;
        }
    }
}
__device__ __forceinline__ void phase_finalnorm(Frame& F) {
    const int lane = F.lane; const float* gN = F.in[33];
    for (int row = F.gw; row < MT; row += F.NGW) {
        float* xr = F.out + (size_t)row * DM;
        f32x4 v[4]; float ss = 0.f;
#pragma unroll
        for (int j = 0; j < 4; ++j) { v[j] = *(const f32x4*)(xr + 4 * lane + 256 * j); ss += (v[j][0] * v[j][0] + v[j][1] * v[j][1]) + (v[j][2] * v[j][2] + v[j][3] * v[j][3]); }
        const float rstd = 1.0f / sqrtf(wave_sum(ss) * (1.0f / DM) + EPS);
#pragma unroll
        for (int j = 0; j < 4; ++j) { const f32x4 g4 = *(const f32x4*)(gN + 4 * lane + 256 * j); *(f32x4*)(xr + 4 * lane + 256 * j) = v[j] * rstd * g4; }
    }
}
__device__ __forceinline__ void phase_fcum(Frame& F) {
    LAS float* wt = (LAS float*)F.lds;
    const int tid = F.tid, lane = F.lane, wave = F.wave;
    for (int job = blockIdx.x; job < 96; job += F.G) {
        const float* src; float* dst; int b, h;
        if (job < 32) { b = job >> 3; h = job & 7; src = F.out + O_LFP + (size_t)b * 4096 * 8 + h; dst = F.F2P + (size_t)job * 4096; }
        else { const int j2 = job - 32; b = j2 >> 3; h = j2 & 7; src = F.in[6] + (size_t)b * 4096 * 8 + h; dst = F.F2S + (size_t)j2 * 4128; }
        float v[8]; float tsum = 0.f;
#pragma unroll
        for (int i = 0; i < 8; ++i) { v[i] = src[(size_t)(8 * tid + i) * 8]; tsum += v[i]; }
        float inc = tsum;
#pragma unroll
        for (int o = 1; o < 64; o <<= 1) { const float t = __shfl_up(inc, o); if (lane >= o) inc += t; }
        if (lane == 63) wt[wave] = inc;
        __syncthreads();
        float woff = 0.f, total = 0.f;
#pragma unroll
        for (int w = 0; w < 8; ++w) { const float x = wt[w]; if (w < wave) woff += x; total += x; }
        float run = woff + inc - tsum;
#pragma unroll
        for (int i = 0; i < 8; ++i) { run += v[i]; dst[8 * tid + i] = run * LOG2E; }
        if (job >= 32 && wave == 0) {
            float x = lane < 32 ? F.out[O_LFS + (size_t)(b * 32 + lane) * 8 + h] : 0.f;
#pragma unroll
            for (int o = 1; o < 64; o <<= 1) { const float t = __shfl_up(x, o); if (lane >= o) x += t; }
            if (lane < 32) dst[4096 + lane] = (total + x) * LOG2E;
        }
        __syncthreads();
    }
}

constexpr int KP = 72, VP = 68;
__device__ __forceinline__ void attn_tile(const LAS bf16* kL, const LAS bf16* vL, const LAS float* fL, LAS float* wsf, const bf16x8 (&qr)[4], f32x16 (&o)[2],
                                          float& m, float& l, bool domask, int lim, int r32, int hi) {
    f32x16 p0, p1;
#pragma unroll
    for (int r = 0; r < 16; ++r) { p0[r] = 0.f; p1[r] = 0.f; }
#pragma unroll
    for (int d0 = 0; d0 < 4; ++d0) {
        const bf16x8 a0 = *(const LAS bf16x8*)(kL + r32 * KP + d0 * 16 + hi * 8);
        const bf16x8 a1 = *(const LAS bf16x8*)(kL + (32 + r32) * KP + d0 * 16 + hi * 8);
        p0 = __builtin_amdgcn_mfma_f32_32x32x16_bf16(a0, qr[d0], p0, 0, 0, 0);
        p1 = __builtin_amdgcn_mfma_f32_32x32x16_bf16(a1, qr[d0], p1, 0, 0, 0);
    }
#pragma unroll
    for (int rg = 0; rg < 4; ++rg) {
        const f32x4 fa = *(const LAS f32x4*)(fL + 8 * rg + 4 * hi), fb = *(const LAS f32x4*)(fL + 32 + 8 * rg + 4 * hi);
#pragma unroll
        for (int i = 0; i < 4; ++i) { p0[4 * rg + i] -= fa[i]; p1[4 * rg + i] -= fb[i]; }
    }
    if (domask) {
#pragma unroll
        for (int r = 0; r < 16; ++r) { const int kv = (r & 3) + 8 * (r >> 2) + 4 * hi; if (kv > lim) p0[r] = -INFINITY; if (kv + 32 > lim) p1[r] = -INFINITY; }
    }
    float mt = fmaxf(p0[0], p1[0]);
#pragma unroll
    for (int r = 1; r < 16; ++r) mt = fmaxf(mt, fmaxf(p0[r], p1[r]));
    mt = fmaxf(mt, __shfl_xor(mt, 32));
    const float mn = fmaxf(m, mt);
    const float alpha = __builtin_amdgcn_exp2f(m - mn);
    m = mn;
    float rs = 0.f;
#pragma unroll
    for (int r = 0; r < 16; ++r) { p0[r] = __builtin_amdgcn_exp2f(p0[r] - mn); p1[r] = __builtin_amdgcn_exp2f(p1[r] - mn); rs += p0[r] + p1[r]; }
    l = l * alpha + rs;
    if (hi == 0) wsf[r32] = alpha;
    LDS_WAIT();
#pragma unroll
    for (int rg = 0; rg < 4; ++rg) {
        const f32x4 al = *(const LAS f32x4*)(wsf + 8 * rg + 4 * hi);
#pragma unroll
        for (int i = 0; i < 4; ++i) { o[0][4 * rg + i] *= al[i]; o[1][4 * rg + i] *= al[i]; }
    }
    u32x4 pw[4];
    pw[0] = (u32x4){pk2(p0[0], p0[1]), pk2(p0[2], p0[3]), pk2(p0[4], p0[5]), pk2(p0[6], p0[7])};
    pw[1] = (u32x4){pk2(p0[8], p0[9]), pk2(p0[10], p0[11]), pk2(p0[12], p0[13]), pk2(p0[14], p0[15])};
    pw[2] = (u32x4){pk2(p1[0], p1[1]), pk2(p1[2], p1[3]), pk2(p1[4], p1[5]), pk2(p1[6], p1[7])};
    pw[3] = (u32x4){pk2(p1[8], p1[9]), pk2(p1[10], p1[11]), pk2(p1[12], p1[13]), pk2(p1[14], p1[15])};
#pragma unroll
    for (int d0 = 0; d0 < 2; ++d0)
#pragma unroll
        for (int s = 0; s < 4; ++s) {
            const s16x4 lo = *(const LAS s16x4*)(vL + (r32 + 32 * d0) * VP + 16 * s + 4 * hi);
            const s16x4 h4 = *(const LAS s16x4*)(vL + (r32 + 32 * d0) * VP + 16 * s + 8 + 4 * hi);
            const bf16x8 bv = (bf16x8){lo[0], lo[1], lo[2], lo[3], h4[0], h4[1], h4[2], h4[3]};
            o[d0] = __builtin_amdgcn_mfma_f32_32x32x16_bf16(__builtin_bit_cast(bf16x8, pw[s]), bv, o[d0], 0, 0, 0);
        }
    LDS_WAIT();
}
__device__ __forceinline__ void st16(LAS bf16* p, unsigned v) { *(LAS unsigned short*)p = (unsigned short)v; }
__device__ __forceinline__ void attn_prompt_unit(Frame& F, int b, int h, int qb) {
    const int tid = F.tid, lane = F.lane, wave = F.wave, r32 = lane & 31, hi = lane >> 5;
    LAS bf16* kbuf = (LAS bf16*)F.lds; LAS bf16* vbuf = (LAS bf16*)(F.lds + 18432); LAS float* fbuf = (LAS float*)(F.lds + 35840);
    LAS float* wsf = (LAS float*)(F.lds + 36352) + wave * 64;
    const int rowbase = b * 4096, q0 = qb * 256;
    const bf16* Qw = F.Q + (size_t)(rowbase + q0 + wave * 32) * DH + h * 64;
    bf16* Ow = F.O + (size_t)(rowbase + q0 + wave * 32) * DH + h * 64;
    bf16x8 qr[4];
#pragma unroll
    for (int d0 = 0; d0 < 4; ++d0) qr[d0] = *(const bf16x8*)(Qw + (size_t)r32 * DH + d0 * 16 + hi * 8);
    const int NT = 4 * (qb + 1), kvs = tid >> 3, c8 = tid & 7;
    const bf16* kg = F.KB + (size_t)(rowbase + kvs) * DH + h * 64 + 8 * c8;
    const bf16* vg = F.VB + (size_t)(rowbase + kvs) * DH + h * 64 + 8 * c8;
    const float* fg = F.F2P + (size_t)(b * 8 + h) * 4096;
    u32x4 kr = *(const u32x4*)kg, vr = *(const u32x4*)vg; float fr_ = tid < 64 ? fg[tid] : 0.f;
    float m = -1e30f, l = 0.f; f32x16 o[2];
#pragma unroll
    for (int r = 0; r < 16; ++r) { o[0][r] = 0.f; o[1][r] = 0.f; }
    const int qmin = q0 + wave * 32;
#define ATT_WRITE_TILE(t_) do { LAS bf16* kL_ = kbuf + ((t_) & 1) * (64 * KP); LAS bf16* vL_ = vbuf + ((t_) & 1) * (64 * VP); LAS float* fL_ = fbuf + ((t_) & 1) * 64; \
        *(LAS u32x4*)(kL_ + kvs * KP + 8 * c8) = kr; \
        st16(vL_ + (8 * c8 + 0) * VP + kvs, vr.x); st16(vL_ + (8 * c8 + 1) * VP + kvs, vr.x >> 16); \
        st16(vL_ + (8 * c8 + 2) * VP + kvs, vr.y); st16(vL_ + (8 * c8 + 3) * VP + kvs, vr.y >> 16); \
        st16(vL_ + (8 * c8 + 4) * VP + kvs, vr.z); st16(vL_ + (8 * c8 + 5) * VP + kvs, vr.z >> 16); \
        st16(vL_ + (8 * c8 + 6) * VP + kvs, vr.w); st16(vL_ + (8 * c8 + 7) * VP + kvs, vr.w >> 16); \
        if (tid < 64) fL_[tid] = fr_; } while (0)
    ATT_WRITE_TILE(0);
    __syncthreads();
    for (int t = 0; t < NT; ++t) {
        if (t + 1 < NT) { kr = *(const u32x4*)(kg + (size_t)(t + 1) * 64 * DH); vr = *(const u32x4*)(vg + (size_t)(t + 1) * 64 * DH); fr_ = tid < 64 ? fg[(t + 1) * 64 + tid] : 0.f; }
        if (64 * t <= qmin + 31) {
            const bool domask = (64 * t + 63 > qmin);
            attn_tile(kbuf + (t & 1) * (64 * KP), vbuf + (t & 1) * (64 * VP), fbuf + (t & 1) * 64, wsf, qr, o, m, l, domask, qmin + r32 - 64 * t, r32, hi);
        }
        if (t + 1 < NT) ATT_WRITE_TILE(t + 1);
        __syncthreads();
    }
#undef ATT_WRITE_TILE
    l += __shfl_xor(l, 32);
    if (hi == 0) wsf[r32] = 1.0f / l;
    LDS_WAIT();
#pragma unroll
    for (int rg = 0; rg < 4; ++rg) {
        const f32x4 rl = *(const LAS f32x4*)(wsf + 8 * rg + 4 * hi);
#pragma unroll
        for (int i = 0; i < 4; ++i) {
            const int q = 8 * rg + 4 * hi + i;
            Ow[(size_t)q * DH + r32] = (bf16)f2bf(o[0][4 * rg + i] * rl[i]);
            Ow[(size_t)q * DH + 32 + r32] = (bf16)f2bf(o[1][4 * rg + i] * rl[i]);
        }
    }
    LDS_WAIT();
    __syncthreads();
}
__device__ __forceinline__ void attn_sample_unit(Frame& F, int b, int h) {
    const int tid = F.tid, lane = F.lane, wave = F.wave, r32 = lane & 31, hi = lane >> 5;
    LAS unsigned char* wb = F.lds + wave * 18432;
    LAS bf16* kL = (LAS bf16*)wb; LAS bf16* vL = (LAS bf16*)(wb + 9216); LAS float* fL = (LAS float*)(wb + 17920); LAS float* wsf = (LAS float*)(wb + 18176);
    const int qrow0 = NP + b * 32;
    bf16x8 qr[4];
#pragma unroll
    for (int d0 = 0; d0 < 4; ++d0) qr[d0] = *(const bf16x8*)(F.Q + (size_t)(qrow0 + r32) * DH + h * 64 + d0 * 16 + hi * 8);
    float m = -1e30f, l = 0.f; f32x16 o[2];
#pragma unroll
    for (int r = 0; r < 16; ++r) { o[0][r] = 0.f; o[1][r] = 0.f; }
    const float* ck = F.in[4] + ((size_t)b * 4096 * 8 + h) * 64;
    const float* cv = F.in[5] + ((size_t)b * 4096 * 8 + h) * 64;
    const float* f2 = F.F2S + (size_t)(b * 8 + h) * 4128;
    const int c16 = lane & 15, kq = lane >> 4;
    for (int tt = 0; tt < 8; ++tt) {
        const int kv0 = wave * 512 + tt * 64;
#pragma unroll 4
        for (int i = 0; i < 16; ++i) {
            const int kv = kq + 4 * i;
            const f32x4 x = *(const f32x4*)(ck + (size_t)(kv0 + kv) * 512 + 4 * c16);
            const f32x4 y = *(const f32x4*)(cv + (size_t)(kv0 + kv) * 512 + 4 * c16);
            u32x2 w; w.x = pk2(x[0], x[1]); w.y = pk2(x[2], x[3]);
            *(LAS u32x2*)(kL + kv * KP + 4 * c16) = w;
            const unsigned y0 = pk2(y[0], y[1]), y1 = pk2(y[2], y[3]);
            st16(vL + (4 * c16 + 0) * VP + kv, y0); st16(vL + (4 * c16 + 1) * VP + kv, y0 >> 16);
            st16(vL + (4 * c16 + 2) * VP + kv, y1); st16(vL + (4 * c16 + 3) * VP + kv, y1 >> 16);
        }
        fL[lane] = f2[kv0 + lane];
        LDS_WAIT();
        attn_tile(kL, vL, fL, wsf, qr, o, m, l, false, 0, r32, hi);
    }
    if (wave == 7) {
        const int kv = lane >> 1, half = lane & 1;
        const bf16* kn = F.KB + (size_t)(qrow0 + kv) * DH + h * 64 + 32 * half;
        const bf16* vn = F.VB + (size_t)(qrow0 + kv) * DH + h * 64 + 32 * half;
#pragma unroll
        for (int i = 0; i < 4; ++i) {
            const u32x4 x = *(const u32x4*)(kn + 8 * i), y = *(const u32x4*)(vn + 8 * i);
            *(LAS u32x4*)(kL + kv * KP + 32 * half + 8 * i) = x;
            *(LAS u32x4*)(kL + (32 + kv) * KP + 32 * half + 8 * i) = (u32x4){0u, 0u, 0u, 0u};
            const int d = 32 * half + 8 * i;
            st16(vL + (d + 0) * VP + kv, y.x); st16(vL + (d + 1) * VP + kv, y.x >> 16); st16(vL + (d + 2) * VP + kv, y.y); st16(vL + (d + 3) * VP + kv, y.y >> 16);
            st16(vL + (d + 4) * VP + kv, y.z); st16(vL + (d + 5) * VP + kv, y.z >> 16); st16(vL + (d + 6) * VP + kv, y.w); st16(vL + (d + 7) * VP + kv, y.w >> 16);
#pragma unroll
            for (int e = 0; e < 8; ++e) st16(vL + (d + e) * VP + 32 + kv, 0u);
        }
        fL[lane] = lane < 32 ? f2[4096 + lane] : 0.f;
        LDS_WAIT();
        attn_tile(kL, vL, fL, wsf, qr, o, m, l, true, r32, r32, hi);
    }
    l += __shfl_xor(l, 32);
    __syncthreads();
    LAS float* cm = (LAS float*)F.lds; LAS float* cl = cm + 256; LAS float* co = cl + 256;
    if (hi == 0) { cm[wave * 32 + r32] = m; cl[wave * 32 + r32] = l; }
#pragma unroll
    for (int r = 0; r < 16; ++r) {
        const int q = (r & 3) + 8 * (r >> 2) + 4 * hi;
        co[(wave * 32 + q) * 64 + r32] = o[0][r]; co[(wave * 32 + q) * 64 + 32 + r32] = o[1][r];
    }
    __syncthreads();
    {
        const int q = tid >> 4, dg = tid & 15;
        float M = cm[q];
#pragma unroll
        for (int w = 1; w < 8; ++w) M = fmaxf(M, cm[w * 32 + q]);
        float L = 0.f; f32x4 acc = (f32x4){0.f, 0.f, 0.f, 0.f};
#pragma unroll
        for (int w = 0; w < 8; ++w) {
            const float wg = __builtin_amdgcn_exp2f(cm[w * 32 + q] - M);
            L += cl[w * 32 + q] * wg;
            acc += *(const LAS f32x4*)(co + (w * 32 + q) * 64 + 4 * dg) * wg;
        }
        const float rl = 1.0f / L;
        u32x2 w2; w2.x = pk2(acc[0] * rl, acc[1] * rl); w2.y = pk2(acc[2] * rl, acc[3] * rl);
        *(u32x2*)(F.O + (size_t)(qrow0 + q) * DH + h * 64 + 4 * dg) = w2;
    }
    __syncthreads();
}

__device__ __forceinline__ void s5_decode(int item, int& g, int& ci, int& row0, int& nT) {
    g = item / S5_ITEMS_PER_G; ci = item % S5_ITEMS_PER_G;
    if (ci < 256) { row0 = (ci >> 6) * 4096 + (ci & 63) * 64; nT = 64; } else { row0 = NP + (ci - 256) * 32; nT = 32; }
}
__device__ __forceinline__ void s5_load_u(Frame& F, LAS float* uL, int row0, int g, int nT) {
    if (F.lane < nT) {
        const bf16* up = F.U + (size_t)(row0 + F.lane) * DH + g * 16;
        const u32x4 a = *(const u32x4*)up, b = *(const u32x4*)(up + 8);
        LAS f32x4* d = (LAS f32x4*)(uL + F.lane * 16);
        d[0] = (f32x4){bflo(a.x), bfhi(a.x), bflo(a.y), bfhi(a.y)}; d[1] = (f32x4){bflo(a.z), bfhi(a.z), bflo(a.w), bfhi(a.w)};
        d[2] = (f32x4){bflo(b.x), bfhi(b.x), bflo(b.y), bfhi(b.y)}; d[3] = (f32x4){bflo(b.z), bfhi(b.z), bflo(b.w), bfhi(b.w)};
    }
    LDS_WAIT();
}
__device__ __forceinline__ f32x2 s5_step(const f32x2 a, const f32x2 s, const f32x2 (&bb)[16], const LAS float* ur) {
    const f32x4 u0 = *(const LAS f32x4*)ur, u1 = *(const LAS f32x4*)(ur + 4), u2 = *(const LAS f32x4*)(ur + 8), u3 = *(const LAS f32x4*)(ur + 12);
    f32x2 bu = bb[0] * u0[0];
    bu += bb[1] * u0[1]; bu += bb[2] * u0[2]; bu += bb[3] * u0[3];
    bu += bb[4] * u1[0]; bu += bb[5] * u1[1]; bu += bb[6] * u1[2]; bu += bb[7] * u1[3];
    bu += bb[8] * u2[0]; bu += bb[9] * u2[1]; bu += bb[10] * u2[2]; bu += bb[11] * u2[3];
    bu += bb[12] * u3[0]; bu += bb[13] * u3[1]; bu += bb[14] * u3[2]; bu += bb[15] * u3[3];
    f32x2 n; n.x = a.x * s.x - a.y * s.y + bu.x; n.y = a.x * s.y + a.y * s.x + bu.y;
    return n;
}
__device__ __forceinline__ void s5_pass_a(Frame& F, int wq, int nwq) {
    LAS float* uL = (LAS float*)(F.lds + F.wave * 12800);
    for (int item = wq; item < S5_ITEMS; item += nwq) {
        int g, ci, row0, nT; s5_decode(item, g, ci, row0, nT);
        if (ci >= 256) continue;
        const f32x2 a = F.abar[g * 64 + F.lane];
        f32x2 bb[16];
#pragma unroll
        for (int c = 0; c < 16; ++c) bb[c] = F.bbar[(size_t)(g * 64 + F.lane) * 16 + c];
        s5_load_u(F, uL, row0, g, nT);
        f32x2 s = (f32x2){0.f, 0.f};
#pragma unroll 4
        for (int j = 0; j < 64; ++j) s = s5_step(a, s, bb, uL + j * 16);
        F.E[(size_t)item * 64 + F.lane] = s;
        LDS_WAIT();
    }
}
__device__ __forceinline__ void s5_pass_c(Frame& F) {
    LAS float* uL = (LAS float*)(F.lds + F.wave * 12800);
    LAS bf16* Sb = (LAS bf16*)(F.lds + F.wave * 12800 + 4096);
    const int lane = F.lane, fr = lane & 15, fq = lane >> 4;
    for (int item = F.gw; item < S5_ITEMS; item += F.NGW) {
        int g, ci, row0, nT; s5_decode(item, g, ci, row0, nT);
        const f32x2 a = F.abar[g * 64 + lane];
        f32x2 bb[16];
#pragma unroll
        for (int c = 0; c < 16; ++c) bb[c] = F.bbar[(size_t)(g * 64 + lane) * 16 + c];
        bf16x8 cmf[4];
#pragma unroll
        for (int ks = 0; ks < 4; ++ks) cmf[ks] = *(const bf16x8*)(F.cmt + (g * 16 + fr) * 128 + 32 * ks + 8 * fq);
        const f32x4 dv = *(const f32x4*)(F.in[24] + g * 16 + 4 * fq);
        f32x2 s;
        if (ci < 256) {
            s = (f32x2){0.f, 0.f};
            const f32x2 aa = F.a64[g * 64 + lane];
            const f32x2* ep = F.E + (size_t)(g * S5_ITEMS_PER_G + (ci & ~63)) * 64 + lane;
            const int nprev = ci & 63;
            const int off = (16 - (nprev & 15)) & 15;
            for (int i0 = -off; i0 < nprev; i0 += 16) {
                f32x2 e[16];
#pragma unroll
                for (int u = 0; u < 16; ++u) e[u] = (i0 + u >= 0) ? ep[(size_t)(i0 + u) * 64] : (f32x2){0.f, 0.f};
#pragma unroll
                for (int u = 0; u < 16; ++u) { f32x2 n; n.x = aa.x * s.x - aa.y * s.y + e[u].x; n.y = aa.x * s.y + aa.y * s.x + e[u].y; s = n; }
            }
        } else {
            const int sb = ci - 256;
            s = (f32x2){F.in[7][(size_t)(sb * 32 + g) * 64 + lane], F.in[8][(size_t)(sb * 32 + g) * 64 + lane]};
        }
        s5_load_u(F, uL, row0, g, nT);
        for (int half = 0; half < (nT >> 5); ++half) {
#pragma unroll 4
            for (int jj = 0; jj < 32; ++jj) {
                s = s5_step(a, s, bb, uL + (half * 32 + jj) * 16);
                st16(Sb + jj * 136 + lane, f2bf(s.x)); st16(Sb + jj * 136 + 64 + lane, f2bf(s.y));
            }
            LDS_WAIT();
#pragma unroll
            for (int jb = 0; jb < 2; ++jb) {
                f32x4 acc = (f32x4){0.f, 0.f, 0.f, 0.f};
#pragma unroll
                for (int ks = 0; ks < 4; ++ks) {
                    const bf16x8 sf = *(const LAS bf16x8*)(Sb + (jb * 16 + fr) * 136 + 32 * ks + 8 * fq);
                    acc = __builtin_amdgcn_mfma_f32_16x16x32_bf16(cmf[ks], sf, acc, 0, 0, 0);
                }
                const int j = half * 32 + jb * 16 + fr;
                const f32x4 u4 = *(const LAS f32x4*)(uL + j * 16 + 4 * fq);
                float y[4];
#pragma unroll
                for (int i = 0; i < 4; ++i) { const float t = acc[i] + dv[i] * u4[i]; y[i] = t * fsigmoid(1.5957691216057308f * (t + 0.044715f * t * t * t)); }
                u32x2 w; w.x = pk2(y[0], y[1]); w.y = pk2(y[2], y[3]);
                *(u32x2*)(F.Z + (size_t)(row0 + j) * DH + g * 16 + 4 * fq) = w;
            }
            LDS_WAIT();
        }
        if (ci >= 256) { const int sb = ci - 256; F.out[O_SRS + (size_t)(sb * 32 + g) * 64 + lane] = s.x; F.out[O_SIS + (size_t)(sb * 32 + g) * 64 + lane] = s.y; }
        else if ((ci & 63) == 63) { const int b = ci >> 6; F.out[O_SRP + (size_t)(b * 32 + g) * 64 + lane] = s.x; F.out[O_SIP + (size_t)(b * 32 + g) * 64 + lane] = s.y; }
    }
}


struct SkSwiglu { bf16* H;
    __device__ __forceinline__ int brow(int ct, int nb) const { return 256 * (ct >> 2) + 32 * (ct & 3) + 128 * nb; }
    __device__ __forceinline__ void operator()(int row, int ct, int j0, const float (&v)[2][2]) const {
        const float a = v[0][0] * fsigmoid(v[0][0]) * v[1][0], b = v[0][1] * fsigmoid(v[0][1]) * v[1][1];
        *(unsigned*)(H + (size_t)(NP + row) * FF + 32 * ct + j0) = pk2(a, b); } };
struct SkResid { const float* xin; float* out; const float* mod; int gi; float gscale;
    __device__ __forceinline__ int brow(int ct, int) const { return 32 * ct; }
    __device__ __forceinline__ void operator()(int row, int ct, int j0, const float (&v)[1][2]) const {
        const int col = 32 * ct + j0; const float* gate = mod + (4 + (row >> 5)) * NMOD + gi * DM + col;
        const f32x2 x = *(const f32x2*)(xin + (size_t)row * DM + col), g = *(const f32x2*)gate;
        f32x2 o; o.x = x.x + gscale * (1.f + g.x) * v[0][0]; o.y = x.y + gscale * (1.f + g.y) * v[0][1];
        *(f32x2*)(out + (size_t)row * DM + col) = o; } };
struct SkIn { bf16 *U, *Q, *KB, *VB; float* out;
    __device__ __forceinline__ int brow(int ct, int) const { return 32 * ct; }
    __device__ __forceinline__ void operator()(int row, int ct, int j0, const float (&v)[1][2]) const {
        const int n = 32 * ct + j0, t = n >> 9, col = n & 511; const float sc = t == 1 ? QSCALE : 1.f;
        bf16* dst = U + (size_t)t * (17 * MiB / 2);
        *(unsigned*)(dst + (size_t)(NP + row) * DH + col) = pk2(v[0][0] * sc, v[0][1] * sc);
        if (t >= 2) *(f32x2*)(out + (t == 2 ? O_KS : O_VS) + (size_t)row * DH + col) = (f32x2){v[0][0], v[0][1]}; } };
struct SkGlu { const bf16* Z; bf16* Y; const float* bglu;
    __device__ __forceinline__ int brow(int ct, int) const { return 32 * ct; }
    __device__ __forceinline__ void operator()(int row, int ct, int j0, const float (&v)[1][2]) const {
        const int col = 32 * ct + j0; const unsigned z = *(const unsigned*)(Z + (size_t)(NP + row) * DH + col);
        *(unsigned*)(Y + (size_t)(NP + row) * DH + col) = pk2(bflo(z) * fsigmoid(v[0][0] + bglu[col]), bfhi(z) * fsigmoid(v[0][1] + bglu[col + 1])); } };
template <int NB, int KS, class Epi>
__device__ __forceinline__ void skinny_gemm(Frame& F, const bf16* A, const bf16* Bt, int ntc, const Epi& E) {
    constexpr int K = KS * 128;
    const int lane = F.lane, wave = F.wave, r32 = lane & 31, hi = lane >> 5, tid = F.tid;
    LAS float* red = (LAS float*)F.lds;
    for (int tile = blockIdx.x; tile < 8 * ntc; tile += F.G) {
        const int rt = tile / ntc, ct = tile % ntc;
        const bf16* ap = A + (size_t)(32 * rt + r32) * K + wave * (K / 8) + 8 * hi;
        f32x16 acc[NB];
#pragma unroll
        for (int nb = 0; nb < NB; ++nb)
#pragma unroll
            for (int r = 0; r < 16; ++r) acc[nb][r] = 0.f;
        const bf16* bp0 = Bt + (size_t)(E.brow(ct, 0) + r32) * K + wave * (K / 8) + 8 * hi;
        const bf16* bp1 = Bt + (size_t)(E.brow(ct, NB - 1) + r32) * K + wave * (K / 8) + 8 * hi;
        constexpr int SB = (KS % 11 == 0) ? 11 : KS;
#pragma unroll 1
        for (int s0 = 0; s0 < KS; s0 += SB) {
            bf16x8 af[SB], b0[SB], b1[SB];
#pragma unroll
            for (int s = 0; s < SB; ++s) { af[s] = *(const bf16x8*)(ap + 16 * (s0 + s)); b0[s] = *(const bf16x8*)(bp0 + 16 * (s0 + s)); if (NB == 2) b1[s] = *(const bf16x8*)(bp1 + 16 * (s0 + s)); }
#pragma unroll
            for (int s = 0; s < SB; ++s) {
                acc[0] = __builtin_amdgcn_mfma_f32_32x32x16_bf16(af[s], b0[s], acc[0], 0, 0, 0);
                if (NB == 2) acc[NB - 1] = __builtin_amdgcn_mfma_f32_32x32x16_bf16(af[s], b1[s], acc[NB - 1], 0, 0, 0);
            }
        }
#pragma unroll
        for (int nb = 0; nb < NB; ++nb)
#pragma unroll
            for (int r = 0; r < 16; ++r) red[((wave * NB + nb) * 32 + (r & 3) + 8 * (r >> 2) + 4 * hi) * 32 + r32] = acc[nb][r];
        __syncthreads();
        {
            const int i = tid >> 4, j0 = 2 * (tid & 15);
            float v[NB][2];
#pragma unroll
            for (int nb = 0; nb < NB; ++nb) { v[nb][0] = 0.f; v[nb][1] = 0.f;
#pragma unroll
                for (int w = 0; w < 8; ++w) { const f32x2 x = *(const LAS f32x2*)(red + ((w * NB + nb) * 32 + i) * 32 + j0); v[nb][0] += x.x; v[nb][1] += x.y; } }
            E(32 * rt + i, ct, j0, v);
        }
        __syncthreads();
    }
}

__global__ void __launch_bounds__(512, 2) mk_fwd(Args args) {
    extern __shared__ __attribute__((aligned(16))) unsigned char lds_raw[];
    cg::grid_group grid = cg::this_grid();
    Frame F;
    F.lds = (LAS unsigned char*)lds_raw;
    F.tid = threadIdx.x; F.lane = F.tid & 63; F.wave = __builtin_amdgcn_readfirstlane(F.tid >> 6);
    F.G = gridDim.x; { const int bx = blockIdx.x; F.vcu = (F.G % 8 == 0) ? (bx % 8) * (F.G / 8) + bx / 8 : bx; }
    F.gw = blockIdx.x * NWAVES + F.wave; F.NGW = F.G * NWAVES;
#pragma unroll
    for (int i = 0; i < 34; ++i) F.in[i] = args.in[i];
    F.out = args.out;
    unsigned char* ws = args.ws;
    F.mod = (float*)(ws + WS_MOD);
    F.abar = (f32x2*)(ws + WS_S5C); F.a64 = (f32x2*)(ws + WS_S5C + 16384); F.bbar = (f32x2*)(ws + WS_S5C + 32768); F.cmt = (bf16*)(ws + WS_S5C + 294912);
    F.F2P = (float*)(ws + WS_F2P); F.F2S = (float*)(ws + WS_F2S); F.E = (f32x2*)(ws + WS_E);
    F.WUP1 = (bf16*)(ws + WS_WUP1); F.WDN1 = (bf16*)(ws + WS_WDN1); F.WIN = (bf16*)(ws + WS_WIN); F.WGLU = (bf16*)(ws + WS_WGLU); F.WOUT = (bf16*)(ws + WS_WOUT);
    F.WUP2 = (bf16*)(ws + WS_WUP2); F.WDN2 = (bf16*)(ws + WS_WDN2); F.HA = (bf16*)(ws + WS_HA); F.HID = (bf16*)(ws + WS_HID);
    F.U = (bf16*)(ws + WS_U); F.Q = (bf16*)(ws + WS_Q); F.KB = (bf16*)(ws + WS_KB); F.VB = (bf16*)(ws + WS_VB); F.Z = (bf16*)(ws + WS_Z); F.O = (bf16*)(ws + WS_O);
    const int lo = args.ph_lo, hi = args.ph_hi;
#define IN(k) (lo <= (k) && (k) < hi)
#define REPS(k) _Pragma("nounroll") for (int rep_ = 0; rep_ < 1 + ((MK_REP_MASK >> (k)) & 1); ++rep_)
#define SEAM(k) do { if (IN(k) && IN((k) + 1)) grid.sync(); } while (0)
    typedef pg8::StaticOrder SO;
    float* xs_out = F.out + (size_t)NP * DM;

    if (IN(0)) REPS(0) { phase_ada(F); phase_s5const(F); phase_weights(F); }
    SEAM(0);
    if (IN(1)) REPS(1) phase_norm<false>(F, F.in[0], F.in[1], F.in[11], 0, 1);
    SEAM(1);
    if (IN(2)) REPS(2) { pg8::Gemm g{F.HA, F.WUP1, NP, NUP, DM}; SO S; S.init(NP, NUP, F.G, (int)blockIdx.x); EpiSwiglu E{F.HID};
        pg8::gemm_phase<EpiSwiglu, SO, PG8_ALIGN, PG8_SP2>(F.lds, g, S, E);
        skinny_gemm<2, 8>(F, F.HA + (size_t)NP * DM, F.WUP1, 88, SkSwiglu{F.HID}); }
    SEAM(2);
    if (IN(3)) REPS(3) { pg8::Gemm g{F.HID, F.WDN1, NP, DM, FF}; SO S; S.init(NP, DM, F.G, (int)blockIdx.x); EpiResid E{F.in[0], F.in[1], F.out, F.mod, 2, 0.5f};
        pg8::gemm_phase<EpiResid, SO, PG8_ALIGN, PG8_SP2>(F.lds, g, S, E);
        skinny_gemm<1, 22>(F, F.HID + (size_t)NP * FF, F.WDN1, 32, SkResid{F.in[1], xs_out, F.mod, 2, 0.5f}); }
    SEAM(3);
    if (IN(4)) REPS(4) phase_norm<true>(F, F.out, xs_out, F.in[14], 3, 4);
    SEAM(4);
    if (IN(5)) REPS(5) { phase_fcum(F);
        pg8::Gemm g{F.HA, F.WIN, NP, 2048, DM}; SO S; S.init(NP, 2048, F.G, (int)blockIdx.x); EpiIn E{F.U, F.Q, F.KB, F.VB, F.out};
        pg8::gemm_phase<EpiIn, SO, PG8_ALIGN, PG8_SP2>(F.lds, g, S, E);
        skinny_gemm<1, 8>(F, F.HA + (size_t)NP * DM, F.WIN, 64, SkIn{F.U, F.Q, F.KB, F.VB, F.out}); }
    SEAM(5);
    if (IN(6)) {
        for (int uix_ = F.vcu; uix_ < 256 * (1 + ((MK_REP_MASK >> 6) & 1)); uix_ += F.G) {
            const int uix = uix_ & 255, bh = uix >> 3, s = uix & 7;
            attn_prompt_unit(F, bh >> 3, bh & 7, 15 - s);
            attn_prompt_unit(F, bh >> 3, bh & 7, s);
        }
        const int nsamp_cu = F.G >= 128 ? 64 : 0;
        if (nsamp_cu) {
            if (F.vcu < 64) attn_sample_unit(F, F.vcu >> 3, F.vcu & 7);
            else s5_pass_a(F, (F.vcu - 64) * NWAVES + F.wave, (F.G - 64) * NWAVES);
        } else {
            for (int j = F.vcu; j < 64; j += F.G) attn_sample_unit(F, j >> 3, j & 7);
            s5_pass_a(F, F.gw, F.NGW);
        }
        __syncthreads();
    }
    SEAM(6);
    if (IN(7)) REPS(7) s5_pass_c(F);
    SEAM(7);
    if (IN(8)) REPS(8) { pg8::Gemm g{F.Z, F.WGLU, NP, DH, DH}; SO S; S.init(NP, DH, F.G, (int)blockIdx.x); EpiGlu E{F.Z, F.U, F.in[26]};
        pg8::gemm_phase<EpiGlu, SO, PG8_ALIGN, PG8_SP2>(F.lds, g, S, E);
        skinny_gemm<1, 4>(F, F.Z + (size_t)NP * DH, F.WGLU, 16, SkGlu{F.Z, F.U, F.in[26]}); }
    SEAM(8);
    if (IN(9)) REPS(9) phase_mixnorm(F);
    SEAM(9);
    if (IN(10)) REPS(10) { pg8::Gemm g{F.HA, F.WOUT, NP, DM, DM}; SO S; S.init(NP, DM, F.G, (int)blockIdx.x); EpiResid E{F.out, xs_out, F.out, F.mod, 5, 1.0f};
        pg8::gemm_phase<EpiResid, SO, PG8_ALIGN, PG8_SP2>(F.lds, g, S, E);
        skinny_gemm<1, 8>(F, F.HA + (size_t)NP * DM, F.WOUT, 32, SkResid{xs_out, xs_out, F.mod, 5, 1.0f}); }
    SEAM(10);
    if (IN(11)) REPS(11) phase_norm<false>(F, F.out, xs_out, F.in[30], 6, 7);
    SEAM(11);
    if (IN(12)) REPS(12) { pg8::Gemm g{F.HA, F.WUP2, NP, NUP, DM}; SO S; S.init(NP, NUP, F.G, (int)blockIdx.x); EpiSwiglu E{F.HID};
        pg8::gemm_phase<EpiSwiglu, SO, PG8_ALIGN, PG8_SP2>(F.lds, g, S, E);
        skinny_gemm<2, 8>(F, F.HA + (size_t)NP * DM, F.WUP2, 88, SkSwiglu{F.HID}); }
    SEAM(12);
    if (IN(13)) REPS(13) { pg8::Gemm g{F.HID, F.WDN2, NP, DM, FF}; SO S; S.init(NP, DM, F.G, (int)blockIdx.x); EpiResid E{F.out, xs_out, F.out, F.mod, 8, 0.5f};
        pg8::gemm_phase<EpiResid, SO, PG8_ALIGN, PG8_SP2>(F.lds, g, S, E);
        skinny_gemm<1, 22>(F, F.HID + (size_t)NP * FF, F.WDN2, 32, SkResid{xs_out, xs_out, F.mod, 8, 0.5f}); }
    SEAM(13);
    if (IN(14)) REPS(14) phase_finalnorm(F);
#undef IN
#undef SEAM
}
constexpr int N_PHASES = 15;

#ifndef MK_MULTI
#define MK_MULTI 0
#endif
extern "C" void kernel_launch(void* const* d_in, const int* in_sizes, int n_in, void* d_out, int out_size, void* d_ws, size_t ws_size, hipStream_t stream) {
    static int grid = 0;
    if (grid == 0) {
        int dev = 0, cus = 0, per_cu = 0;
        if (hipGetDevice(&dev) != hipSuccess || hipDeviceGetAttribute(&cus, hipDeviceAttributeMultiprocessorCount, dev) != hipSuccess) { fprintf(stderr, "kernel_launch: device query failed\n"); grid = -1; return; }
        if (hipFuncSetAttribute((const void*)mk_fwd, hipFuncAttributeMaxDynamicSharedMemorySize, LDS_BYTES) != hipSuccess) { fprintf(stderr, "kernel_launch: hipFuncSetAttribute failed\n"); grid = -1; return; }
        if (hipOccupancyMaxActiveBlocksPerMultiprocessor(&per_cu, (const void*)mk_fwd, NWAVES * 64, LDS_BYTES) != hipSuccess || per_cu < 1) per_cu = 1;
        (void)hipGetLastError();
        grid = cus;
        if (n_in != 34 || ws_size < 176 * MiB) fprintf(stderr, "kernel_launch: unexpected n_in %d / ws %zu\n", n_in, ws_size);
    }
    if (grid < 0) return;
    Args a{};
    for (int i = 0; i < 34; ++i) a.in[i] = (const float*)d_in[i];
    a.out = (float*)d_out; a.ws = (unsigned char*)d_ws;
#if MK_MULTI
    for (int p = 0; p < N_PHASES; ++p) { a.ph_lo = p; a.ph_hi = p + 1; hipLaunchKernelGGL(mk_fwd, dim3(grid), dim3(NWAVES * 64), LDS_BYTES, stream, a); }
#else
    a.ph_lo = 0; a.ph_hi = N_PHASES;
    void* kargs[] = {&a};
    const hipError_t e = hipLaunchCooperativeKernel((const void*)mk_fwd, dim3(grid), dim3(NWAVES * 64), kargs, LDS_BYTES, stream);
    if (e != hipSuccess) fprintf(stderr, "kernel_launch: cooperative launch failed: %s (grid %d)\n", hipGetErrorString(e), grid);
#endif
}
```

```cpp
#define MK_REP_MASK 0
#include <hip/hip_runtime.h>
#include <hip/hip_cooperative_groups.h>
#include <cstdio>
#include <cstdint>
namespace cg = cooperative_groups;
namespace pg8 {
#define PG8_LAS __attribute__((address_space(3)))
typedef unsigned short bf16_t;
typedef short bf16x8 __attribute__((ext_vector_type(8)));
typedef float f32x4 __attribute__((ext_vector_type(4)));
typedef unsigned u32x4 __attribute__((ext_vector_type(4)));
constexpr int BM = 256, BK = 64, HALF = 128, HTB = HALF * BK * 2  , STAGE_BYTES = 8 * HTB, NXCD = 8, WGM = 8;

__host__ __device__ __forceinline__ int lds_byte(int r, int c) { const int st = (r >> 4) * 2 + (c >> 5), rr = r & 15, cc = c & 31, ob = rr * 64 + cc * 2; return st * 1024 + (ob ^ (((ob >> 9) & 1) << 5)); }
__host__ __device__ __forceinline__ void stage_rc(int b, int& R, int& C) { const int st = b / 1024, sb = b % 1024, swz = sb ^ (((sb >> 9) & 1) << 5); R = (st >> 1) * 16 + swz / 64; C = (st & 1) * 32 + (swz % 64) / 2; }
__host__ __device__ __forceinline__ int perm32(int rho) { const int n = rho >> 4, i = rho & 15; return 8 * (i >> 2) + 4 * n + (i & 3); }

struct Unit { int pm, pn; };
struct Gemm { const bf16_t* A; const bf16_t* Bt; int M, N, K; };

struct StaticOrder {
    int nM, nN, nwg, G, c;
    __host__ __device__ void init(int M, int N, int G_, int c_) { nM = M / BM; nN = N / BM; nwg = nM * nN; G = G_; c = c_; }
    __host__ __device__ bool next(int i, Unit& u) const {
        const long L = (long)i * G + c; if (L >= nwg) return false;
        int wgid = (int)L; { const int q = nwg / NXCD, r = nwg % NXCD, xcd = wgid % NXCD, off = wgid / NXCD; wgid = (xcd < r ? xcd * (q + 1) : r * (q + 1) + (xcd - r) * q) + off; }
        const int nig = WGM * nN, gid = wgid / nig, fm = gid * WGM, gsz = (nM - fm) < WGM ? (nM - fm) : WGM;
        u.pm = fm + ((wgid % nig) % gsz); u.pn = (wgid % nig) / gsz; return true;
    }
    __device__ __forceinline__ void a_ready(const Unit&) const {}
    __device__ __forceinline__ void done(const Unit&) const {}
};

__device__ __forceinline__ unsigned cvt_pk_bf16(float lo, float hi) { unsigned r; asm volatile("v_cvt_pk_bf16_f32 %0, %1, %2" : "=v"(r) : "v"(lo), "v"(hi)); return r; }
typedef float f32x2 __attribute__((ext_vector_type(2)));
__device__ __forceinline__ f32x2 gelu_pk(f32x2 v) {
    const f32x2 av = __builtin_elementwise_abs(v), d = av * 0.2316418882f + 1.0f;
    f32x2 t; t.x = __builtin_amdgcn_rcpf(d.x); t.y = __builtin_amdgcn_rcpf(d.y);
    f32x2 q = t * 0.5307027145f + (-0.7265760135f); q = q * t + 0.7107068705f; q = q * t + (-0.142248368f); q = q * t + 0.127414796f; q = q * t;
    const f32x2 s = (v * v) * (-0.72134752044f);
    f32x2 e; e.x = __builtin_amdgcn_exp2f(s.x); e.y = __builtin_amdgcn_exp2f(s.y);
    const f32x2 m = v * (q * e), r = v - m;
    f32x2 o; o.x = v.x < 0.f ? m.x : r.x; o.y = v.y < 0.f ? m.y : r.y; return o;
}

template <int ACT  > struct EpiBf16 {
    static constexpr bool PERM = true, AFTER_DRAIN = false; static_assert(ACT == 0 || ACT == 1, "EpiBf16: ACT is 0 (none) or 1 (gelu_pk)");
    bf16_t* O; int ldc; const float* bias; int split_cols; size_t split_stride; float scale0;
    __device__ __forceinline__ void operator()(const f32x4 (&acc)[2][2][4][2], const Unit& u, int wr, int wc, int fr, int fq) const {
        const int row0 = u.pm * BM + wr * 64 + fr; int colt = u.pn * BM; bf16_t* base = O;
        float sc = 1.f; if (split_cols) { const int t = colt / split_cols; base += (size_t)t * split_stride; colt -= t * split_cols; if (t == 0) sc = scale0; }
        const int col0 = colt + wc * 32 + 8 * fq, bcol0 = u.pn * BM + wc * 32 + 8 * fq;
        f32x4 bv[2][2];
#pragma unroll
        for (int bj = 0; bj < 2; ++bj)
#pragma unroll
            for (int n = 0; n < 2; ++n) bv[bj][n] = bias ? *(const f32x4*)(bias + bcol0 + bj * HALF + 4 * n) : (f32x4){0.f, 0.f, 0.f, 0.f};
#pragma unroll
        for (int ai = 0; ai < 2; ++ai)
#pragma unroll
            for (int m = 0; m < 4; ++m) { bf16_t* rowp = base + (size_t)(row0 + ai * HALF + m * 16) * ldc + col0;
#pragma unroll
                for (int bj = 0; bj < 2; ++bj) { f32x4 v0 = acc[ai][bj][m][0] + bv[bj][0], v1 = acc[ai][bj][m][1] + bv[bj][1];
                    if (ACT == 1) { f32x2 a = gelu_pk((f32x2){v0[0], v0[1]}), b = gelu_pk((f32x2){v0[2], v0[3]}), c = gelu_pk((f32x2){v1[0], v1[1]}), d = gelu_pk((f32x2){v1[2], v1[3]});
                        v0 = (f32x4){a.x, a.y, b.x, b.y}; v1 = (f32x4){c.x, c.y, d.x, d.y}; }
                    v0 = v0 * sc; v1 = v1 * sc; u32x4 w; w.x = cvt_pk_bf16(v0[0], v0[1]); w.y = cvt_pk_bf16(v0[2], v0[3]); w.z = cvt_pk_bf16(v1[0], v1[1]); w.w = cvt_pk_bf16(v1[2], v1[3]);
                    *(u32x4*)(rowp + bj * HALF) = w; } }
    }
};


template <class Epi, class Sched, bool ALIGN_EPI = false, bool SP2 = false>
__device__ __forceinline__ void gemm_phase(PG8_LAS unsigned char* lds, const Gemm g, const Sched& S, const Epi& E) {
    const int tid = threadIdx.x, wid = __builtin_amdgcn_readfirstlane(tid >> 6), lane = tid & 63, wr = wid >> 2, wc = wid & 3, fr = lane & 15, fq = lane >> 4;
    const int K = g.K, nt = K / BK;
    unsigned voffA[2], voffB[2];
#pragma unroll
    for (int i = 0; i < 2; ++i) { int R, C; stage_rc(tid * 16 + i * 8192, R, C); const int Rb = Epi::PERM ? ((R & ~31) + perm32(R & 31)) : R;
        voffA[i] = (unsigned)(R * K + C) * 2u; voffB[i] = (unsigned)(Rb * K + C) * 2u; }
    const size_t kstep = (size_t)(BK * 2);
    const size_t hstep = (size_t)HALF * K * 2;
    const size_t tstep = 2 * hstep;
    const unsigned ldsw = (unsigned)wid * 1024u;
    const int aoff = lds_byte(wr * 64 + fr, fq * 8), boff = lds_byte(wc * 32 + fr, fq * 8);
#define PG8_SA(b, h) (((b) * 2 + (h)) * HTB)
#define PG8_SB(b, h) ((4 + (b) * 2 + (h)) * HTB)
#define PG8_STAGE(bufoff, gbase, voff) do { _Pragma("unroll") for (int _i = 0; _i < 2; ++_i) \
        __builtin_amdgcn_global_load_lds((const unsigned*)((const char*)(gbase) + (voff)[_i]), (PG8_LAS unsigned*)(lds + (bufoff) + ldsw + _i * 8192), 16, 0, 0); } while (0)
#define PG8_LDA(dst, b, h) do { _Pragma("unroll") for (int m = 0; m < 4; ++m) _Pragma("unroll") for (int k = 0; k < 2; ++k) dst[m][k] = *(const PG8_LAS bf16x8*)(lds + PG8_SA(b, h) + aoff + m * 2048 + k * 1024); } while (0)
#define PG8_LDB(dst, b, h) do { _Pragma("unroll") for (int n = 0; n < 2; ++n) _Pragma("unroll") for (int k = 0; k < 2; ++k) dst[n][k] = *(const PG8_LAS bf16x8*)(lds + PG8_SB(b, h) + boff + n * 2048 + k * 1024); } while (0)
#define PG8_MMA(ai, bj, At, Bt) do { __builtin_amdgcn_s_setprio(1); _Pragma("unroll") for (int m = 0; m < 4; ++m) _Pragma("unroll") for (int n = 0; n < 2; ++n) _Pragma("unroll") for (int k = 0; k < 2; ++k) \
        acc[ai][bj][m][n] = __builtin_amdgcn_mfma_f32_16x16x32_bf16(Bt[n][k], At[m][k], acc[ai][bj][m][n], 0, 0, 0); __builtin_amdgcn_s_setprio(0); } while (0)
#define PG8_WAIT_V(n) asm volatile("s_waitcnt vmcnt(" #n ")" ::: "memory")
#define PG8_WAIT_L(n) asm volatile("s_waitcnt lgkmcnt(" #n ")" ::: "memory")
#define PG8_BAR __builtin_amdgcn_s_barrier()
#define PG8_SCHED __builtin_amdgcn_sched_barrier(0)
    Unit cur, nxt; int ui = 0;
    if (!S.next(0, cur)) return;
    f32x4 acc[2][2][4][2];
#pragma unroll
    for (int a = 0; a < 2; ++a)
#pragma unroll
        for (int b = 0; b < 2; ++b)
#pragma unroll
            for (int m = 0; m < 4; ++m)
#pragma unroll
                for (int n = 0; n < 2; ++n) acc[a][b][m][n] = (f32x4){0.f, 0.f, 0.f, 0.f};
    bf16x8 At[4][2], B0[2][2], B1[2][2];
    const char* cA = (const char*)g.A + (size_t)cur.pm * tstep; const char* cB = (const char*)g.Bt + (size_t)cur.pn * tstep;
    S.a_ready(cur);
    if constexpr (SP2) {
        PG8_STAGE(PG8_SB(0, 0), cB, voffB); PG8_STAGE(PG8_SB(0, 1), cB + hstep, voffB); PG8_STAGE(PG8_SA(0, 0), cA, voffA); PG8_STAGE(PG8_SA(0, 1), cA + hstep, voffA);
        if (wr == 1) PG8_BAR;
        PG8_WAIT_V(2); PG8_BAR;
        PG8_STAGE(PG8_SB(1, 0), cB + kstep, voffB); PG8_STAGE(PG8_SA(1, 0), cA + kstep, voffA); PG8_STAGE(PG8_SB(1, 1), cB + hstep + kstep, voffB);
        PG8_WAIT_V(6); PG8_BAR;
    } else {
        PG8_STAGE(PG8_SB(0, 0), cB, voffB); PG8_STAGE(PG8_SA(0, 0), cA, voffA); PG8_STAGE(PG8_SB(0, 1), cB + hstep, voffB); PG8_STAGE(PG8_SA(0, 1), cA + hstep, voffA);
        if (wr == 1) PG8_BAR;
        PG8_WAIT_V(4); PG8_BAR;
        PG8_STAGE(PG8_SB(1, 0), cB + kstep, voffB); PG8_STAGE(PG8_SA(1, 0), cA + kstep, voffA); PG8_STAGE(PG8_SB(1, 1), cB + hstep + kstep, voffB);
        PG8_WAIT_V(6); PG8_BAR;
    }
    for (;;) {
        const bool has_next = S.next(ui + 1, nxt);
        const char* nA = has_next ? (const char*)g.A + (size_t)nxt.pm * tstep : cA; const char* nB = has_next ? (const char*)g.Bt + (size_t)nxt.pn * tstep : cB;
        for (int t = 0; t < nt; t += 2) {
            const bool last = (t == nt - 2);
            const char* a1 = cA + (size_t)(t + 1) * kstep;
            const char* a2 = last ? nA : cA + (size_t)(t + 2) * kstep; const char* b2 = last ? nB : cB + (size_t)(t + 2) * kstep;
            const char* a3 = a2 + kstep; const char* b3 = b2 + kstep;
            if (last && has_next) S.a_ready(nxt);
            if constexpr (SP2) {
            PG8_LDB(B0, 0, 0); PG8_LDB(B1, 0, 1); PG8_SCHED; PG8_LDA(At, 0, 0); PG8_STAGE(PG8_SA(1, 1), a1 + hstep, voffA);
            PG8_WAIT_V(8); PG8_WAIT_L(0); PG8_BAR; PG8_MMA(0, 0, At, B0); PG8_MMA(0, 1, At, B1); PG8_BAR; PG8_SCHED;
            PG8_LDA(At, 0, 1); PG8_STAGE(PG8_SB(0, 0), b2, voffB); PG8_STAGE(PG8_SB(0, 1), b2 + hstep, voffB); PG8_STAGE(PG8_SA(0, 0), a2, voffA);
            PG8_WAIT_V(8); PG8_WAIT_L(0); PG8_BAR; PG8_MMA(1, 0, At, B0); PG8_MMA(1, 1, At, B1); PG8_BAR; PG8_SCHED;
            PG8_LDB(B0, 1, 0); PG8_LDB(B1, 1, 1); PG8_SCHED; PG8_LDA(At, 1, 0); PG8_STAGE(PG8_SA(0, 1), a2 + hstep, voffA);
            PG8_WAIT_V(8); PG8_WAIT_L(0); PG8_BAR; PG8_MMA(0, 0, At, B0); PG8_MMA(0, 1, At, B1); PG8_BAR; PG8_SCHED;
            PG8_LDA(At, 1, 1); PG8_STAGE(PG8_SB(1, 0), b3, voffB); PG8_STAGE(PG8_SB(1, 1), b3 + hstep, voffB); PG8_STAGE(PG8_SA(1, 0), a3, voffA);
            PG8_WAIT_V(8); PG8_WAIT_L(0); PG8_BAR; PG8_MMA(1, 0, At, B0); PG8_MMA(1, 1, At, B1); PG8_BAR; PG8_SCHED;
            } else {
            PG8_LDB(B0, 0, 0); PG8_SCHED; PG8_LDA(At, 0, 0); PG8_STAGE(PG8_SA(1, 1), a1 + hstep, voffA);
            PG8_WAIT_L(8); PG8_BAR; PG8_WAIT_L(0); PG8_MMA(0, 0, At, B0); PG8_BAR; PG8_SCHED;
            PG8_LDB(B1, 0, 1); PG8_STAGE(PG8_SB(0, 0), b2, voffB);
            PG8_BAR; PG8_WAIT_L(0); PG8_MMA(0, 1, At, B1); PG8_BAR;
            PG8_LDA(At, 0, 1); PG8_STAGE(PG8_SA(0, 0), a2, voffA);
            PG8_BAR; PG8_WAIT_L(0); PG8_MMA(1, 0, At, B0); PG8_BAR; PG8_SCHED;
            PG8_STAGE(PG8_SB(0, 1), b2 + hstep, voffB);
            PG8_WAIT_V(6); PG8_BAR; PG8_MMA(1, 1, At, B1); PG8_BAR;
            PG8_LDB(B0, 1, 0); PG8_SCHED; PG8_LDA(At, 1, 0); PG8_STAGE(PG8_SA(0, 1), a2 + hstep, voffA);
            PG8_WAIT_L(8); PG8_BAR; PG8_WAIT_L(0); PG8_MMA(0, 0, At, B0); PG8_BAR; PG8_SCHED;
            PG8_LDB(B1, 1, 1); PG8_STAGE(PG8_SB(1, 0), b3, voffB);
            PG8_BAR; PG8_WAIT_L(0); PG8_MMA(0, 1, At, B1); PG8_BAR;
            PG8_LDA(At, 1, 1); PG8_STAGE(PG8_SA(1, 0), a3, voffA);
            PG8_BAR; PG8_WAIT_L(0); PG8_MMA(1, 0, At, B0); PG8_BAR; PG8_SCHED;
            PG8_STAGE(PG8_SB(1, 1), b3 + hstep, voffB);
            PG8_WAIT_V(6); PG8_BAR; PG8_MMA(1, 1, At, B1); PG8_BAR;
            }
        }
        if constexpr (ALIGN_EPI) { if (wr == 0) PG8_BAR; }
        if constexpr (!Epi::AFTER_DRAIN) { E(acc, cur, wr, wc, fr, fq); S.done(cur); }
        if (!has_next) break;
#pragma unroll
        for (int a = 0; a < 2; ++a)
#pragma unroll
            for (int b = 0; b < 2; ++b)
#pragma unroll
                for (int m = 0; m < 4; ++m)
#pragma unroll
                    for (int n = 0; n < 2; ++n) acc[a][b][m][n] = (f32x4){0.f, 0.f, 0.f, 0.f};
        cur = nxt; cA = nA; cB = nB; ++ui;
        if constexpr (ALIGN_EPI) { if (wr == 1) PG8_BAR; }
    }
    PG8_WAIT_V(0);
    if constexpr (!ALIGN_EPI) { if (wr == 0) PG8_BAR; }
    PG8_BAR;
    if constexpr (Epi::AFTER_DRAIN) { E.fused(acc, cur, wr, wc, fr, fq, lds, wid, lane); S.done(cur); }
#undef PG8_SA
#undef PG8_SB
#undef PG8_STAGE
#undef PG8_LDA
#undef PG8_LDB
#undef PG8_MMA
#undef PG8_WAIT_V
#undef PG8_WAIT_L
#undef PG8_BAR
#undef PG8_SCHED
}
}

#ifndef PG8_SP2
#define PG8_SP2 true
#endif
#ifndef PG8_ALIGN
#define PG8_ALIGN true
#endif
#define LAS __attribute__((address_space(3)))
typedef unsigned short bf16;
typedef short bf16x8 __attribute__((ext_vector_type(8)));
typedef short s16x4 __attribute__((ext_vector_type(4)));
typedef float f32x4 __attribute__((ext_vector_type(4)));
typedef float f32x2 __attribute__((ext_vector_type(2)));
typedef float f32x16 __attribute__((ext_vector_type(16)));
typedef unsigned u32x4 __attribute__((ext_vector_type(4)));
typedef unsigned u32x2 __attribute__((ext_vector_type(2)));

constexpr int NP = 16384, NS = 256, MT = NP + NS, DM = 1024, FF = 2816, NUP = 5632, DH = 512, NMOD = 9216, DIN = 2056;
constexpr float EPS = 1e-6f, LOG2E = 1.4426950408889634f, QSCALE = 0.125f * 1.4426950408889634f;
constexpr size_t O_KP = 17039360, O_VP = 25427968, O_LFP = 33816576, O_SRP = 33947648, O_SIP = 33955840, O_KS = 33964032, O_VS = 34095104,
                 O_LFS = 34226176, O_SRS = 34228224, O_SIS = 34244608;
constexpr size_t MiB = 1u << 20;
constexpr size_t WS_MOD = 0, WS_S5C = 1 * MiB, WS_F2P = 2 * MiB, WS_F2S = 2 * MiB + 512 * 1024, WS_E = 4 * MiB, WS_WUP1 = 10 * MiB, WS_WDN1 = 21 * MiB,
                 WS_WIN = 27 * MiB, WS_WGLU = 31 * MiB, WS_WOUT = 32 * MiB, WS_WUP2 = 34 * MiB, WS_WDN2 = 45 * MiB, WS_HA = 52 * MiB, WS_HID = 86 * MiB;
constexpr size_t WS_U = WS_HID, WS_Q = WS_HID + 17 * MiB, WS_KB = WS_HID + 34 * MiB, WS_VB = WS_HID + 51 * MiB, WS_Z = WS_HID + 68 * MiB;
constexpr size_t WS_O = 176 * MiB, WS_BAR = 512 * 1024;
#ifndef MK_REP_MASK
#define MK_REP_MASK 0
#endif
constexpr int S5_ITEMS_PER_G = 264, S5_ITEMS = 32 * 264;
constexpr int LDS_BYTES = 155648;
constexpr int NWAVES = 8;

struct Args { const float* in[34]; float* out; unsigned char* ws; int ph_lo, ph_hi; };

struct Frame {
    LAS unsigned char* lds;
    int tid, lane, wave, G, vcu, gw, NGW;
    const float* in[34];
    float* out;
    float* mod; f32x2* abar; f32x2* a64; f32x2* bbar; bf16* cmt; float* F2P; float* F2S; f32x2* E;
    bf16 *WUP1, *WDN1, *WIN, *WGLU, *WOUT, *WUP2, *WDN2, *HA, *HID, *U, *Q, *KB, *VB, *Z, *O;
};

__device__ __forceinline__ unsigned f2bf(float f) { unsigned u = __builtin_bit_cast(unsigned, f); return (u + 0x7fffu + ((u >> 16) & 1u)) >> 16; }
__device__ __forceinline__ unsigned pk2(float lo, float hi) { return pg8::cvt_pk_bf16(lo, hi); }
__device__ __forceinline__ float bflo(unsigned w) { return __uint_as_float(w << 16); }
__device__ __forceinline__ float bfhi(unsigned w) { return __uint_as_float(w & 0xffff0000u); }
__device__ __forceinline__ float wave_sum(float v) {
#pragma unroll
    for (int o = 1; o < 64; o <<= 1) v += __shfl_xor(v, o);
    return v;
}
__device__ __forceinline__ float fsigmoid(float x) { return __builtin_amdgcn_rcpf(1.f + __builtin_amdgcn_exp2f(-x * LOG2E)); }
__device__ __forceinline__ int bidx(int row) { return row < NP ? (row >> 12) : 4 + ((row - NP) >> 5); }
#define LDS_WAIT() asm volatile("s_waitcnt lgkmcnt(0)" ::: "memory")

using pg8::Unit;
struct EpiSwiglu {
    static constexpr bool PERM = true, AFTER_DRAIN = false;
    bf16* H;
    __device__ __forceinline__ void operator()(const f32x4 (&acc)[2][2][4][2], const Unit& u, int wr, int wc, int fr, int fq) const {
        const int row0 = u.pm * 256 + wr * 64 + fr, col0 = u.pn * 128 + wc * 32 + 8 * fq;
#pragma unroll
        for (int ai = 0; ai < 2; ++ai)
#pragma unroll
            for (int m = 0; m < 4; ++m) {
                const int row = row0 + ai * 128 + m * 16;
                u32x4 w; unsigned ww[4];
#pragma unroll
                for (int n = 0; n < 2; ++n) {
                    const f32x4 g = acc[ai][0][m][n], up = acc[ai][1][m][n]; float r[4];
#pragma unroll
                    for (int i = 0; i < 4; ++i) r[i] = g[i] * fsigmoid(g[i]) * up[i];
                    ww[2 * n] = pk2(r[0], r[1]); ww[2 * n + 1] = pk2(r[2], r[3]);
                }
                w.x = ww[0]; w.y = ww[1]; w.z = ww[2]; w.w = ww[3];
                *(u32x4*)(H + (size_t)row * FF + col0) = w;
            }
    }
};
struct EpiResid {
    static constexpr bool PERM = true, AFTER_DRAIN = false;
    const float* xp; const float* xs; float* out; const float* mod; int gi; float gscale;
    __device__ __forceinline__ void operator()(const f32x4 (&acc)[2][2][4][2], const Unit& u, int wr, int wc, int fr, int fq) const {
        const int row0 = u.pm * 256 + wr * 64 + fr, col0 = u.pn * 256 + wc * 32 + 8 * fq;
#pragma unroll
        for (int ai = 0; ai < 2; ++ai)
#pragma unroll
            for (int m = 0; m < 4; ++m) {
                const int row = row0 + ai * 128 + m * 16;
                const float* xin = row < NP ? xp + (size_t)row * DM : xs + (size_t)(row - NP) * DM;
                const float* gate = mod + bidx(row) * NMOD + gi * DM;
                float* orow = out + (size_t)row * DM;
#pragma unroll
                for (int bj = 0; bj < 2; ++bj) {
                    const int col = col0 + bj * 128;
#pragma unroll
                    for (int n = 0; n < 2; ++n) {
                        const f32x4 g = *(const f32x4*)(gate + col + 4 * n), x = *(const f32x4*)(xin + col + 4 * n);
                        const f32x4 o = x + (g + 1.0f) * gscale * acc[ai][bj][m][n];
                        *(f32x4*)(orow + col + 4 * n) = o;
                    }
                }
            }
    }
};
struct EpiIn {
    static constexpr bool PERM = true, AFTER_DRAIN = false;
    bf16 *U, *Q, *KB, *VB; float* out;
    __device__ __forceinline__ void operator()(const f32x4 (&acc)[2][2][4][2], const Unit& u, int wr, int wc, int fr, int fq) const {
        const int t = u.pn >> 1;
        const int row0 = u.pm * 256 + wr * 64 + fr, col0 = (u.pn & 1) * 256 + wc * 32 + 8 * fq;
        bf16* dst = t == 0 ? U : t == 1 ? Q : t == 2 ? KB : VB;
        const float sc = t == 1 ? QSCALE : 1.0f;
#pragma unroll
        for (int ai = 0; ai < 2; ++ai)
#pragma unroll
            for (int m = 0; m < 4; ++m) {
                const int row = row0 + ai * 128 + m * 16;
                float* fo = row < NP ? out + (t == 2 ? O_KP : O_VP) + (size_t)row * DH : out + (t == 2 ? O_KS : O_VS) + (size_t)(row - NP) * DH;
#pragma unroll
                for (int bj = 0; bj < 2; ++bj) {
                    const int col = col0 + bj * 128;
                    const f32x4 v0 = acc[ai][bj][m][0], v1 = acc[ai][bj][m][1];
                    u32x4 w; w.x = pk2(v0[0] * sc, v0[1] * sc); w.y = pk2(v0[2] * sc, v0[3] * sc); w.z = pk2(v1[0] * sc, v1[1] * sc); w.w = pk2(v1[2] * sc, v1[3] * sc);
                    *(u32x4*)(dst + (size_t)row * DH + col) = w;
                    if (t >= 2) { *(f32x4*)(fo + col) = v0; *(f32x4*)(fo + col + 4) = v1; }
                }
            }
    }
};
struct EpiGlu {
    static constexpr bool PERM = true, AFTER_DRAIN = false;
    const bf16* Z; bf16* Y; const float* bglu;
    __device__ __forceinline__ void operator()(const f32x4 (&acc)[2][2][4][2], const Unit& u, int wr, int wc, int fr, int fq) const {
        const int row0 = u.pm * 256 + wr * 64 + fr, col0 = u.pn * 256 + wc * 32 + 8 * fq;
#pragma unroll
        for (int bj = 0; bj < 2; ++bj) {
            const int col = col0 + bj * 128;
            const f32x4 b0 = *(const f32x4*)(bglu + col), b1 = *(const f32x4*)(bglu + col + 4);
#pragma unroll
            for (int ai = 0; ai < 2; ++ai)
#pragma unroll
                for (int m = 0; m < 4; ++m) {
                    const int row = row0 + ai * 128 + m * 16;
                    const u32x4 z = *(const u32x4*)(Z + (size_t)row * DH + col);
                    const f32x4 a0 = acc[ai][bj][m][0] + b0, a1 = acc[ai][bj][m][1] + b1;
                    u32x4 w;
                    w.x = pk2(bflo(z.x) * fsigmoid(a0[0]), bfhi(z.x) * fsigmoid(a0[1]));
                    w.y = pk2(bflo(z.y) * fsigmoid(a0[2]), bfhi(z.y) * fsigmoid(a0[3]));
                    w.z = pk2(bflo(z.z) * fsigmoid(a1[0]), bfhi(z.z) * fsigmoid(a1[1]));
                    w.w = pk2(bflo(z.w) * fsigmoid(a1[2]), bfhi(z.w) * fsigmoid(a1[3]));
                    *(u32x4*)(Y + (size_t)row * DH + col) = w;
                }
        }
    }
};

__device__ __forceinline__ void phase_ada(Frame& F) {
    LAS float* sm = (LAS float*)F.lds;
    LAS float* red = sm + 12288;
    const float* cp = F.in[2]; const float* cs = F.in[3]; const float* wada = F.in[9]; const float* bada = F.in[10];
    for (int i = F.tid; i < 12288; i += 512) { const int d = i / 12, bi = i % 12; const float c = bi < 4 ? cp[bi * DM + d] : cs[(bi - 4) * DM + d]; sm[i] = c * fsigmoid(c); }
    __syncthreads();
    for (int cb = blockIdx.x; cb < 256; cb += F.G) {
        const int ks = F.tid / 36, cl = F.tid % 36;
        float acc[12];
#pragma unroll
        for (int i = 0; i < 12; ++i) acc[i] = 0.f;
        if (F.tid < 504) {
            const float* wp = wada + (size_t)ks * NMOD + cb * 36 + cl;
            const int nd = (DM - ks + 13) / 14;
            for (int i0 = 0; i0 < nd; i0 += 8) {
                float w[8];
#pragma unroll
                for (int u = 0; u < 8; ++u) w[u] = (i0 + u < nd) ? wp[(size_t)(i0 + u) * 14 * NMOD] : 0.f;
#pragma unroll
                for (int u = 0; u < 8; ++u) {
                    const int d = (i0 + u < nd) ? ks + 14 * (i0 + u) : 0;
                    const f32x4 s0 = *(const LAS f32x4*)(sm + d * 12), s1 = *(const LAS f32x4*)(sm + d * 12 + 4), s2 = *(const LAS f32x4*)(sm + d * 12 + 8);
                    acc[0] += w[u] * s0[0]; acc[1] += w[u] * s0[1]; acc[2] += w[u] * s0[2]; acc[3] += w[u] * s0[3];
                    acc[4] += w[u] * s1[0]; acc[5] += w[u] * s1[1]; acc[6] += w[u] * s1[2]; acc[7] += w[u] * s1[3];
                    acc[8] += w[u] * s2[0]; acc[9] += w[u] * s2[1]; acc[10] += w[u] * s2[2]; acc[11] += w[u] * s2[3];
                }
            }
#pragma unroll
            for (int i = 0; i < 12; ++i) red[(ks * 36 + cl) * 12 + i] = acc[i];
        }
        __syncthreads();
        if (F.tid < 432) {
            const int c2 = F.tid / 12, bi = F.tid % 12; float s = bada[cb * 36 + c2];
#pragma unroll
            for (int k = 0; k < 14; ++k) s += red[(k * 36 + c2) * 12 + bi];
            F.mod[bi * NMOD + cb * 36 + c2] = s;
        }
        __syncthreads();
    }
}
__device__ __forceinline__ void sincos_d(double x, double& s, double& c) {
    const double kf = __builtin_rint(x * 0.63661977236758134308);
    double r = __builtin_fma(-kf, 1.57079632679489655800e+00, x); r = __builtin_fma(-kf, 6.12323399573676603587e-17, r);
    const int k = ((int)kf) & 3; const double r2 = r * r;
    double sp = 1.0 / 6227020800.0; sp = __builtin_fma(sp, r2, -1.0 / 39916800.0); sp = __builtin_fma(sp, r2, 1.0 / 362880.0); sp = __builtin_fma(sp, r2, -1.0 / 5040.0);
    sp = __builtin_fma(sp, r2, 1.0 / 120.0); sp = __builtin_fma(sp, r2, -1.0 / 6.0); sp = __builtin_fma(sp, r2, 1.0); const double sr = sp * r;
    double cq = -1.0 / 87178291200.0; cq = __builtin_fma(cq, r2, 1.0 / 479001600.0); cq = __builtin_fma(cq, r2, -1.0 / 3628800.0); cq = __builtin_fma(cq, r2, 1.0 / 40320.0);
    cq = __builtin_fma(cq, r2, -1.0 / 720.0); cq = __builtin_fma(cq, r2, 1.0 / 24.0); cq = __builtin_fma(cq, r2, -0.5); const double cr = __builtin_fma(cq, r2, 1.0);
    s = (k == 0) ? sr : (k == 1) ? cr : (k == 2) ? -sr : -cr;
    c = (k == 0) ? cr : (k == 1) ? -sr : (k == 2) ? -cr : sr;
}
__device__ __forceinline__ double exp_d(double x) {
    const double n = __builtin_rint(x * 1.4426950408889634074);
    double r = __builtin_fma(-n, 6.93147180369123816490e-01, x); r = __builtin_fma(-n, 1.90821492927058770002e-10, r);
    double p = 1.0 / 6227020800.0;
    p = __builtin_fma(p, r, 1.0 / 479001600.0); p = __builtin_fma(p, r, 1.0 / 39916800.0); p = __builtin_fma(p, r, 1.0 / 3628800.0); p = __builtin_fma(p, r, 1.0 / 362880.0);
    p = __builtin_fma(p, r, 1.0 / 40320.0); p = __builtin_fma(p, r, 1.0 / 5040.0); p = __builtin_fma(p, r, 1.0 / 720.0); p = __builtin_fma(p, r, 1.0 / 120.0);
    p = __builtin_fma(p, r, 1.0 / 24.0); p = __builtin_fma(p, r, 1.0 / 6.0); p = __builtin_fma(p, r, 0.5); p = __builtin_fma(p, r, 1.0); p = __builtin_fma(p, r, 1.0);
    return __builtin_ldexp(p, (int)n);
}
__device__ __forceinline__ void phase_s5const(Frame& F) {
    const int id = blockIdx.x * 512 + F.tid;
    if (id >= 2048) return;
    const int g = id >> 6, p = id & 63;
    const double lre = (double)F.in[17][id], lim = (double)F.in[18][id], dt = exp_d((double)F.in[19][g]);
    const double mag = exp_d(lre * dt); double sn, cs; sincos_d(lim * dt, sn, cs);
    const double are = mag * cs, aim = mag * sn;
    F.abar[id] = (f32x2){(float)are, (float)aim};
    double pr = are, pi = aim;
#pragma unroll
    for (int i = 0; i < 6; ++i) { const double nr = pr * pr - pi * pi, ni = 2.0 * pr * pi; pr = nr; pi = ni; }
    F.a64[id] = (f32x2){(float)pr, (float)pi};
    const double xr = are - 1.0, xi = aim, den = lre * lre + lim * lim;
    const double cr = (xr * lre + xi * lim) / den, ci = (xi * lre - xr * lim) / den;
    const float* bre = F.in[20] + (size_t)id * 16; const float* bim = F.in[21] + (size_t)id * 16;
#pragma unroll
    for (int c = 0; c < 16; ++c) { const double br = bre[c], bi = bim[c]; F.bbar[(size_t)id * 16 + c] = (f32x2){(float)(cr * br - ci * bi), (float)(cr * bi + ci * br)}; }
    const float* cre = F.in[22]; const float* cim = F.in[23];
#pragma unroll
    for (int c = 0; c < 16; ++c) {
        F.cmt[(g * 16 + c) * 128 + p] = (bf16)f2bf(cre[(g * 16 + c) * 64 + p]);
        F.cmt[(g * 16 + c) * 128 + 64 + p] = (bf16)f2bf(-cim[(g * 16 + c) * 64 + p]);
    }
}
__device__ __forceinline__ void transpose_item(const float* W, int ldw, int k0, int n0, bf16* WT, int Kd, int drow0, LAS float* scr, int lane) {
#pragma unroll 8
    for (int i = 0; i < 32; ++i) { const int kk = 2 * i + (lane >> 5); scr[kk * 33 + (lane & 31)] = W[(size_t)(k0 + kk) * ldw + n0 + (lane & 31)]; }
    LDS_WAIT();
    const int c = lane & 7;
#pragma unroll
    for (int j = 0; j < 4; ++j) { const int n = (lane >> 3) + 8 * j; const LAS float* s = scr + (8 * c) * 33 + n;
        u32x4 o; o.x = pk2(s[0 * 33], s[1 * 33]); o.y = pk2(s[2 * 33], s[3 * 33]); o.z = pk2(s[4 * 33], s[5 * 33]); o.w = pk2(s[6 * 33], s[7 * 33]);
        *(u32x4*)(WT + (size_t)(drow0 + n) * Kd + k0 + 8 * c) = o; }
    LDS_WAIT();
}
__device__ __forceinline__ int up_drow(int n0) { return n0 < FF ? 256 * (n0 >> 7) + (n0 & 127) : 256 * ((n0 - FF) >> 7) + 128 + ((n0 - FF) & 127); }
__device__ __forceinline__ void phase_weights(Frame& F) {
    LAS float* scr = (LAS float*)(F.lds + 81920 + F.wave * 8704);
    constexpr int I_UP = 16 * 176, I_DN = 44 * 32, I_IN = 16 * 64, I_GLU = 8 * 16, I_OUT = 16 * 32;
    constexpr int NITEMS = 2 * I_UP + 2 * I_DN + I_IN + I_GLU + I_OUT;
    for (int it = F.gw; it < NITEMS; it += F.NGW) {
        int r = it;
        if (r < I_UP) { const int kb = r / 176, nb = r % 176; transpose_item(F.in[12], NUP, 64 * kb, 32 * nb, F.WUP1, DM, up_drow(32 * nb), scr, F.lane); continue; } r -= I_UP;
        if (r < I_UP) { const int kb = r / 176, nb = r % 176; transpose_item(F.in[31], NUP, 64 * kb, 32 * nb, F.WUP2, DM, up_drow(32 * nb), scr, F.lane); continue; } r -= I_UP;
        if (r < I_DN) { const int kb = r / 32, nb = r % 32; transpose_item(F.in[13], DM, 64 * kb, 32 * nb, F.WDN1, FF, 32 * nb, scr, F.lane); continue; } r -= I_DN;
        if (r < I_DN) { const int kb = r / 32, nb = r % 32; transpose_item(F.in[32], DM, 64 * kb, 32 * nb, F.WDN2, FF, 32 * nb, scr, F.lane); continue; } r -= I_DN;
        if (r < I_IN) { const int kb = r / 64, nb = r % 64; transpose_item(F.in[15], DIN, 64 * kb, 32 * nb, F.WIN, DM, 32 * nb, scr, F.lane); continue; } r -= I_IN;
        if (r < I_GLU) { const int kb = r / 16, nb = r % 16; transpose_item(F.in[25], DH, 64 * kb, 32 * nb, F.WGLU, DH, 32 * nb, scr, F.lane); continue; } r -= I_GLU;
        { const int kb = r / 32, nb = r % 32; transpose_item(F.in[29], DM, 64 * kb, 32 * nb, F.WOUT, DM, 32 * nb, scr, F.lane); }
    }
}

template <bool FG>
__device__ __forceinline__ void phase_norm(Frame& F, const float* xp, const float* xs, const float* gN, int si, int ci) {
    LAS float* wf = (LAS float*)F.lds;
    if (FG) {
        const float* win = F.in[15];
        for (int i = F.tid; i < 8192; i += 512) wf[i] = win[(size_t)(i >> 3) * DIN + 2048 + (i & 7)];
        __syncthreads();
    }
    const int lane = F.lane;
    for (int row = F.gw; row < MT; row += F.NGW) {
        const float* xr = row < NP ? xp + (size_t)row * DM : xs + (size_t)(row - NP) * DM;
        f32x4 v[4]; float ss = 0.f;
#pragma unroll
        for (int j = 0; j < 4; ++j) { v[j] = *(const f32x4*)(xr + 4 * lane + 256 * j); ss += (v[j][0] * v[j][0] + v[j][1] * v[j][1]) + (v[j][2] * v[j][2] + v[j][3] * v[j][3]); }
        const float rstd = 1.0f / sqrtf(wave_sum(ss) * (1.0f / DM) + EPS);
        const float* sh = F.mod + bidx(row) * NMOD + si * DM; const float* sc = F.mod + bidx(row) * NMOD + ci * DM;
        float f[8];
#pragma unroll
        for (int i = 0; i < 8; ++i) f[i] = 0.f;
#pragma unroll
        for (int j = 0; j < 4; ++j) {
            const int col = 4 * lane + 256 * j;
            const f32x4 g4 = *(const f32x4*)(gN + col), s4 = *(const f32x4*)(sc + col), h4 = *(const f32x4*)(sh + col);
            const f32x4 h = v[j] * rstd * g4 * (s4 + 1.0f) + h4;
            u32x2 w; w.x = pk2(h[0], h[1]); w.y = pk2(h[2], h[3]);
            *(u32x2*)(F.HA + (size_t)row * DM + col) = w;
            if (FG) {
#pragma unroll
                for (int e = 0; e < 4; ++e) {
                    const f32x4 w0 = *(const LAS f32x4*)(wf + (col + e) * 8), w1 = *(const LAS f32x4*)(wf + (col + e) * 8 + 4);
                    f[0] += h[e] * w0[0]; f[1] += h[e] * w0[1]; f[2] += h[e] * w0[2]; f[3] += h[e] * w0[3];
                    f[4] += h[e] * w1[0]; f[5] += h[e] * w1[1]; f[6] += h[e] * w1[2]; f[7] += h[e] * w1[3];
                }
            }
        }
        if (FG) {
#pragma unroll
            for (int i = 0; i < 8; ++i) f[i] = wave_sum(f[i]);
            float fv = f[0];
            fv = lane == 1 ? f[1] : fv; fv = lane == 2 ? f[2] : fv; fv = lane == 3 ? f[3] : fv; fv = lane == 4 ? f[4] : fv;
            fv = lane == 5 ? f[5] : fv; fv = lane == 6 ? f[6] : fv; fv = lane == 7 ? f[7] : fv;
            if (lane < 8) {
                const float x = fv + F.in[16][lane];
                const float lf = fminf(x, 0.f) - log1pf(expf(-fabsf(x)));
                float* o = row < NP ? F.out + O_LFP + (size_t)row * 8 : F.out + O_LFS + (size_t)(row - NP) * 8;
                o[lane] = lf;
            }
        }
    }
}
__device__ __forceinline__ void phase_mixnorm(Frame& F) {
    const int lane = F.lane; const float* gs = F.in[27]; const float* gf = F.in[28];
    for (int row = F.gw; row < MT; row += F.NGW) {
#pragma unroll
        for (int part = 0; part < 2; ++part) {
            const bf16* src = (part == 0 ? F.U : F.O) + (size_t)row * DH + 8 * lane;
            const float* g = (part == 0 ? gs : gf) + 8 * lane;
            const u32x4 z = *(const u32x4*)src;
            float v[8] = {bflo(z.x), bfhi(z.x), bflo(z.y), bfhi(z.y), bflo(z.z), bfhi(z.z), bflo(z.w), bfhi(z.w)};
            float ss = 0.f;
#pragma unroll
            for (int i = 0; i < 8; ++i) ss += v[i] * v[i];
            const float rstd = 1.0f / sqrtf(wave_sum(ss) * (1.0f / DH) + EPS);
            const f32x4 g0 = *(const f32x4*)g, g1 = *(const f32x4*)(g + 4);
            u32x4 w; w.x = pk2(v[0] * rstd * g0[0], v[1] * rstd * g0[1]); w.y = pk2(v[2] * rstd * g0[2], v[3] * rstd * g0[3]);
            w.z = pk2(v[4] * rstd * g1[0], v[5] * rstd * g1[1]); w.w = pk2(v[6] * rstd * g1[2], v[7] * rstd * g1[3]);
            *(u32x4*)(F.HA + (size_t)row * DM + part * DH + 8 * lane) = w;
        }
    }
}
__device__ __forceinline__ void phase_finalnorm(Frame& F) {
    const int lane = F.lane; const float* gN = F.in[33];
    for (int row = F.gw; row < MT; row += F.NGW) {
        float* xr = F.out + (size_t)row * DM;
        f32x4 v[4]; float ss = 0.f;
#pragma unroll
        for (int j = 0; j < 4; ++j) { v[j] = *(const f32x4*)(xr + 4 * lane + 256 * j); ss += (v[j][0] * v[j][0] + v[j][1] * v[j][1]) + (v[j][2] * v[j][2] + v[j][3] * v[j][3]); }
        const float rstd = 1.0f / sqrtf(wave_sum(ss) * (1.0f / DM) + EPS);
#pragma unroll
        for (int j = 0; j < 4; ++j) { const f32x4 g4 = *(const f32x4*)(gN + 4 * lane + 256 * j); *(f32x4*)(xr + 4 * lane + 256 * j) = v[j] * rstd * g4; }
    }
}
__device__ __forceinline__ void phase_fcum(Frame& F) {
    LAS float* wt = (LAS float*)F.lds;
    const int tid = F.tid, lane = F.lane, wave = F.wave;
    for (int job = blockIdx.x; job < 96; job += F.G) {
        const float* src; float* dst; int b, h;
        if (job < 32) { b = job >> 3; h = job & 7; src = F.out + O_LFP + (size_t)b * 4096 * 8 + h; dst = F.F2P + (size_t)job * 4096; }
        else { const int j2 = job - 32; b = j2 >> 3; h = j2 & 7; src = F.in[6] + (size_t)b * 4096 * 8 + h; dst = F.F2S + (size_t)j2 * 4128; }
        float v[8]; float tsum = 0.f;
#pragma unroll
        for (int i = 0; i < 8; ++i) { v[i] = src[(size_t)(8 * tid + i) * 8]; tsum += v[i]; }
        float inc = tsum;
#pragma unroll
        for (int o = 1; o < 64; o <<= 1) { const float t = __shfl_up(inc, o); if (lane >= o) inc += t; }
        if (lane == 63) wt[wave] = inc;
        __syncthreads();
        float woff = 0.f, total = 0.f;
#pragma unroll
        for (int w = 0; w < 8; ++w) { const float x = wt[w]; if (w < wave) woff += x; total += x; }
        float run = woff + inc - tsum;
#pragma unroll
        for (int i = 0; i < 8; ++i) { run += v[i]; dst[8 * tid + i] = run * LOG2E; }
        if (job >= 32 && wave == 0) {
            float x = lane < 32 ? F.out[O_LFS + (size_t)(b * 32 + lane) * 8 + h] : 0.f;
#pragma unroll
            for (int o = 1; o < 64; o <<= 1) { const float t = __shfl_up(x, o); if (lane >= o) x += t; }
            if (lane < 32) dst[4096 + lane] = (total + x) * LOG2E;
        }
        __syncthreads();
    }
}
#define XB_TMO      128
#define XB_XCNT(j)  (256  + 64 * (j))
#define XB_XSUB(j)  (1280 + 64 * (j))
#define XB_XGEN(j)  (2304 + 64 * (j))
#define XB_TOP      3328
#define XB_TOPGEN   3392
#define XCD_BAR_WORDS 3456
#define XB_SPIN_CAP (1u << 18)

__device__ __forceinline__ unsigned xb_ld(unsigned* p)              { return __hip_atomic_load(p, __ATOMIC_RELAXED, __HIP_MEMORY_SCOPE_AGENT); }
__device__ __forceinline__ unsigned xb_add(unsigned* p, unsigned v) { return __hip_atomic_fetch_add(p, v, __ATOMIC_RELAXED, __HIP_MEMORY_SCOPE_AGENT); }
__device__ __forceinline__ unsigned xb_xcc_id() { return (unsigned)__builtin_amdgcn_s_getreg((3 << 11) | 20) & 0xFu; }
#define XB_SPIN(cond, bar) do { unsigned _sp = 0; while (cond) { __builtin_amdgcn_s_sleep(1); \
    if ((++_sp & 255u) == 0u) { if (xb_ld(&(bar)[XB_TMO])) break; if (_sp > XB_SPIN_CAP) { atomicAdd(&(bar)[XB_TMO], 1u); break; } } } } while (0)

struct XcdBarrier {
    unsigned* bar; unsigned x;
    volatile LAS unsigned* st;
};

__device__ __forceinline__ XcdBarrier xcd_barrier_post(unsigned* bar, volatile LAS unsigned* st) {
    XcdBarrier b; b.bar = bar; b.x = xb_xcc_id(); b.st = st;
    if (threadIdx.x == 0) (void)xb_add(&bar[XB_XCNT(b.x)], 1u);
    return b;
}
__device__ __forceinline__ void xcd_barrier_complete(unsigned* bar, unsigned x, unsigned& nloc, unsigned& nx) {
    const unsigned G = gridDim.x * gridDim.y * gridDim.z;
    unsigned sum, cnt, mine, sp = 0u;
    for (;;) {
        sum = 0u; cnt = 0u; mine = 0u;
#pragma unroll
        for (unsigned j = 0; j < 16; ++j) { const unsigned c = xb_ld(&bar[XB_XCNT(j)]); sum += c; cnt += (c > 0u) ? 1u : 0u; mine = (j == x) ? c : mine; }
        if (sum == G) break;
        __builtin_amdgcn_s_sleep(1);
        if ((++sp & 255u) == 0u) { if (xb_ld(&bar[XB_TMO])) break; if (sp > XB_SPIN_CAP) { atomicAdd(&bar[XB_TMO], 1u); break; } }
    }
    nloc = mine > 0u ? mine : 1u; nx = cnt > 0u ? cnt : 1u;
}

__device__ __forceinline__ void xcd_barrier(const XcdBarrier& b) {
    asm volatile("s_waitcnt vmcnt(0)" ::: "memory");
    __syncthreads();
    if (threadIdx.x == 0) {
        unsigned* bar = b.bar;
        __builtin_amdgcn_s_waitcnt(0);
        unsigned nloc = b.st[0], nx = b.st[1];
        if (nloc == 0u) { xcd_barrier_complete(bar, b.x, nloc, nx); b.st[0] = nloc; b.st[1] = nx; }
        const unsigned old = xb_add(&bar[XB_XSUB(b.x)], 1u);
        const unsigned gen = old / nloc;
        if (old + 1u == (gen + 1u) * nloc) {
            __builtin_amdgcn_fence(__ATOMIC_RELEASE, "agent");
            asm volatile("s_waitcnt vmcnt(0)" ::: "memory");
            const unsigned og = xb_add(&bar[XB_TOP], 1u);
            const unsigned tg = og / nx;
            if (og + 1u == (tg + 1u) * nx) xb_add(&bar[XB_TOPGEN], 1u);
            else XB_SPIN(xb_ld(&bar[XB_TOPGEN]) == tg, bar);
            __builtin_amdgcn_fence(__ATOMIC_ACQUIRE, "agent");
            xb_add(&bar[XB_XGEN(b.x)], 1u);
            asm volatile("s_waitcnt vmcnt(0)" ::: "memory");
        } else {
            XB_SPIN(xb_ld(&bar[XB_XGEN(b.x)]) == gen, bar);
            __builtin_amdgcn_fence(__ATOMIC_ACQUIRE, "agent");
            asm volatile("s_waitcnt vmcnt(0)" ::: "memory");
        }
    }
    __syncthreads();
}

constexpr int KP = 72, VP = 68;
__device__ __forceinline__ void attn_tile(const LAS bf16* kL, const LAS bf16* vL, const LAS float* fL, LAS float* wsf, const bf16x8 (&qr)[4], f32x16 (&o)[2],
                                          float& m, float& l, bool domask, int lim, int r32, int hi) {
    f32x16 p0, p1;
#pragma unroll
    for (int r = 0; r < 16; ++r) { p0[r] = 0.f; p1[r] = 0.f; }
#pragma unroll
    for (int d0 = 0; d0 < 4; ++d0) {
        const bf16x8 a0 = *(const LAS bf16x8*)(kL + r32 * KP + d0 * 16 + hi * 8);
        const bf16x8 a1 = *(const LAS bf16x8*)(kL + (32 + r32) * KP + d0 * 16 + hi * 8);
        p0 = __builtin_amdgcn_mfma_f32_32x32x16_bf16(a0, qr[d0], p0, 0, 0, 0);
        p1 = __builtin_amdgcn_mfma_f32_32x32x16_bf16(a1, qr[d0], p1, 0, 0, 0);
    }
#pragma unroll
    for (int rg = 0; rg < 4; ++rg) {
        const f32x4 fa = *(const LAS f32x4*)(fL + 8 * rg + 4 * hi), fb = *(const LAS f32x4*)(fL + 32 + 8 * rg + 4 * hi);
#pragma unroll
        for (int i = 0; i < 4; ++i) { p0[4 * rg + i] -= fa[i]; p1[4 * rg + i] -= fb[i]; }
    }
    if (domask) {
#pragma unroll
        for (int r = 0; r < 16; ++r) { const int kv = (r & 3) + 8 * (r >> 2) + 4 * hi; if (kv > lim) p0[r] = -INFINITY; if (kv + 32 > lim) p1[r] = -INFINITY; }
    }
    float mt = fmaxf(p0[0], p1[0]);
#pragma unroll
    for (int r = 1; r < 16; ++r) mt = fmaxf(mt, fmaxf(p0[r], p1[r]));
    mt = fmaxf(mt, __shfl_xor(mt, 32));
    const float mn = fmaxf(m, mt);
    const float alpha = __builtin_amdgcn_exp2f(m - mn);
    m = mn;
    float rs = 0.f;
#pragma unroll
    for (int r = 0; r < 16; ++r) { p0[r] = __builtin_amdgcn_exp2f(p0[r] - mn); p1[r] = __builtin_amdgcn_exp2f(p1[r] - mn); rs += p0[r] + p1[r]; }
    l = l * alpha + rs;
    if (hi == 0) wsf[r32] = alpha;
    LDS_WAIT();
#pragma unroll
    for (int rg = 0; rg < 4; ++rg) {
        const f32x4 al = *(const LAS f32x4*)(wsf + 8 * rg + 4 * hi);
#pragma unroll
        for (int i = 0; i < 4; ++i) { o[0][4 * rg + i] *= al[i]; o[1][4 * rg + i] *= al[i]; }
    }
    u32x4 pw[4];
    pw[0] = (u32x4){pk2(p0[0], p0[1]), pk2(p0[2], p0[3]), pk2(p0[4], p0[5]), pk2(p0[6], p0[7])};
    pw[1] = (u32x4){pk2(p0[8], p0[9]), pk2(p0[10], p0[11]), pk2(p0[12], p0[13]), pk2(p0[14], p0[15])};
    pw[2] = (u32x4){pk2(p1[0], p1[1]), pk2(p1[2], p1[3]), pk2(p1[4], p1[5]), pk2(p1[6], p1[7])};
    pw[3] = (u32x4){pk2(p1[8], p1[9]), pk2(p1[10], p1[11]), pk2(p1[12], p1[13]), pk2(p1[14], p1[15])};
#pragma unroll
    for (int d0 = 0; d0 < 2; ++d0)
#pragma unroll
        for (int s = 0; s < 4; ++s) {
            const s16x4 lo = *(const LAS s16x4*)(vL + (r32 + 32 * d0) * VP + 16 * s + 4 * hi);
            const s16x4 h4 = *(const LAS s16x4*)(vL + (r32 + 32 * d0) * VP + 16 * s + 8 + 4 * hi);
            const bf16x8 bv = (bf16x8){lo[0], lo[1], lo[2], lo[3], h4[0], h4[1], h4[2], h4[3]};
            o[d0] = __builtin_amdgcn_mfma_f32_32x32x16_bf16(__builtin_bit_cast(bf16x8, pw[s]), bv, o[d0], 0, 0, 0);
        }
    LDS_WAIT();
}
__device__ __forceinline__ void st16(LAS bf16* p, unsigned v) { *(LAS unsigned short*)p = (unsigned short)v; }
__device__ __forceinline__ void attn_prompt_unit(Frame& F, int b, int h, int qb) {
    const int tid = F.tid, lane = F.lane, wave = F.wave, r32 = lane & 31, hi = lane >> 5;
    LAS bf16* kbuf = (LAS bf16*)F.lds; LAS bf16* vbuf = (LAS bf16*)(F.lds + 18432); LAS float* fbuf = (LAS float*)(F.lds + 35840);
    LAS float* wsf = (LAS float*)(F.lds + 36352) + wave * 64;
    const int rowbase = b * 4096, q0 = qb * 256;
    const bf16* Qw = F.Q + (size_t)(rowbase + q0 + wave * 32) * DH + h * 64;
    bf16* Ow = F.O + (size_t)(rowbase + q0 + wave * 32) * DH + h * 64;
    bf16x8 qr[4];
#pragma unroll
    for (int d0 = 0; d0 < 4; ++d0) qr[d0] = *(const bf16x8*)(Qw + (size_t)r32 * DH + d0 * 16 + hi * 8);
    const int NT = 4 * (qb + 1), kvs = tid >> 3, c8 = tid & 7;
    const bf16* kg = F.KB + (size_t)(rowbase + kvs) * DH + h * 64 + 8 * c8;
    const bf16* vg = F.VB + (size_t)(rowbase + kvs) * DH + h * 64 + 8 * c8;
    const float* fg = F.F2P + (size_t)(b * 8 + h) * 4096;
    u32x4 kr = *(const u32x4*)kg, vr = *(const u32x4*)vg; float fr_ = tid < 64 ? fg[tid] : 0.f;
    float m = -1e30f, l = 0.f; f32x16 o[2];
#pragma unroll
    for (int r = 0; r < 16; ++r) { o[0][r] = 0.f; o[1][r] = 0.f; }
    const int qmin = q0 + wave * 32;
#define ATT_WRITE_TILE(t_) do { LAS bf16* kL_ = kbuf + ((t_) & 1) * (64 * KP); LAS bf16* vL_ = vbuf + ((t_) & 1) * (64 * VP); LAS float* fL_ = fbuf + ((t_) & 1) * 64; \
        *(LAS u32x4*)(kL_ + kvs * KP + 8 * c8) = kr; \
        st16(vL_ + (8 * c8 + 0) * VP + kvs, vr.x); st16(vL_ + (8 * c8 + 1) * VP + kvs, vr.x >> 16); \
        st16(vL_ + (8 * c8 + 2) * VP + kvs, vr.y); st16(vL_ + (8 * c8 + 3) * VP + kvs, vr.y >> 16); \
        st16(vL_ + (8 * c8 + 4) * VP + kvs, vr.z); st16(vL_ + (8 * c8 + 5) * VP + kvs, vr.z >> 16); \
        st16(vL_ + (8 * c8 + 6) * VP + kvs, vr.w); st16(vL_ + (8 * c8 + 7) * VP + kvs, vr.w >> 16); \
        if (tid < 64) fL_[tid] = fr_; } while (0)
    ATT_WRITE_TILE(0);
    __syncthreads();
    for (int t = 0; t < NT; ++t) {
        if (t + 1 < NT) { kr = *(const u32x4*)(kg + (size_t)(t + 1) * 64 * DH); vr = *(const u32x4*)(vg + (size_t)(t + 1) * 64 * DH); fr_ = tid < 64 ? fg[(t + 1) * 64 + tid] : 0.f; }
        if (64 * t <= qmin + 31) {
            const bool domask = (64 * t + 63 > qmin);
            attn_tile(kbuf + (t & 1) * (64 * KP), vbuf + (t & 1) * (64 * VP), fbuf + (t & 1) * 64, wsf, qr, o, m, l, domask, qmin + r32 - 64 * t, r32, hi);
        }
        if (t + 1 < NT) ATT_WRITE_TILE(t + 1);
        __syncthreads();
    }
#undef ATT_WRITE_TILE
    l += __shfl_xor(l, 32);
    if (hi == 0) wsf[r32] = 1.0f / l;
    LDS_WAIT();
#pragma unroll
    for (int rg = 0; rg < 4; ++rg) {
        const f32x4 rl = *(const LAS f32x4*)(wsf + 8 * rg + 4 * hi);
#pragma unroll
        for (int i = 0; i < 4; ++i) {
            const int q = 8 * rg + 4 * hi + i;
            Ow[(size_t)q * DH + r32] = (bf16)f2bf(o[0][4 * rg + i] * rl[i]);
            Ow[(size_t)q * DH + 32 + r32] = (bf16)f2bf(o[1][4 * rg + i] * rl[i]);
        }
    }
    LDS_WAIT();
    __syncthreads();
}
__device__ __forceinline__ void attn_sample_unit(Frame& F, int b, int h) {
    const int tid = F.tid, lane = F.lane, wave = F.wave, r32 = lane & 31, hi = lane >> 5;
    LAS unsigned char* wb = F.lds + wave * 18432;
    LAS bf16* kL = (LAS bf16*)wb; LAS bf16* vL = (LAS bf16*)(wb + 9216); LAS float* fL = (LAS float*)(wb + 17920); LAS float* wsf = (LAS float*)(wb + 18176);
    const int qrow0 = NP + b * 32;
    bf16x8 qr[4];
#pragma unroll
    for (int d0 = 0; d0 < 4; ++d0) qr[d0] = *(const bf16x8*)(F.Q + (size_t)(qrow0 + r32) * DH + h * 64 + d0 * 16 + hi * 8);
    float m = -1e30f, l = 0.f; f32x16 o[2];
#pragma unroll
    for (int r = 0; r < 16; ++r) { o[0][r] = 0.f; o[1][r] = 0.f; }
    const float* ck = F.in[4] + ((size_t)b * 4096 * 8 + h) * 64;
    const float* cv = F.in[5] + ((size_t)b * 4096 * 8 + h) * 64;
    const float* f2 = F.F2S + (size_t)(b * 8 + h) * 4128;
    const int c16 = lane & 15, kq = lane >> 4;
    for (int tt = 0; tt < 8; ++tt) {
        const int kv0 = wave * 512 + tt * 64;
#pragma unroll 4
        for (int i = 0; i < 16; ++i) {
            const int kv = kq + 4 * i;
            const f32x4 x = *(const f32x4*)(ck + (size_t)(kv0 + kv) * 512 + 4 * c16);
            const f32x4 y = *(const f32x4*)(cv + (size_t)(kv0 + kv) * 512 + 4 * c16);
            u32x2 w; w.x = pk2(x[0], x[1]); w.y = pk2(x[2], x[3]);
            *(LAS u32x2*)(kL + kv * KP + 4 * c16) = w;
            const unsigned y0 = pk2(y[0], y[1]), y1 = pk2(y[2], y[3]);
            st16(vL + (4 * c16 + 0) * VP + kv, y0); st16(vL + (4 * c16 + 1) * VP + kv, y0 >> 16);
            st16(vL + (4 * c16 + 2) * VP + kv, y1); st16(vL + (4 * c16 + 3) * VP + kv, y1 >> 16);
        }
        fL[lane] = f2[kv0 + lane];
        LDS_WAIT();
        attn_tile(kL, vL, fL, wsf, qr, o, m, l, false, 0, r32, hi);
    }
    if (wave == 7) {
        const int kv = lane >> 1, half = lane & 1;
        const bf16* kn = F.KB + (size_t)(qrow0 + kv) * DH + h * 64 + 32 * half;
        const bf16* vn = F.VB + (size_t)(qrow0 + kv) * DH + h * 64 + 32 * half;
#pragma unroll
        for (int i = 0; i < 4; ++i) {
            const u32x4 x = *(const u32x4*)(kn + 8 * i), y = *(const u32x4*)(vn + 8 * i);
            *(LAS u32x4*)(kL + kv * KP + 32 * half + 8 * i) = x;
            *(LAS u32x4*)(kL + (32 + kv) * KP + 32 * half + 8 * i) = (u32x4){0u, 0u, 0u, 0u};
            const int d = 32 * half + 8 * i;
            st16(vL + (d + 0) * VP + kv, y.x); st16(vL + (d + 1) * VP + kv, y.x >> 16); st16(vL + (d + 2) * VP + kv, y.y); st16(vL + (d + 3) * VP + kv, y.y >> 16);
            st16(vL + (d + 4) * VP + kv, y.z); st16(vL + (d + 5) * VP + kv, y.z >> 16); st16(vL + (d + 6) * VP + kv, y.w); st16(vL + (d + 7) * VP + kv, y.w >> 16);
#pragma unroll
            for (int e = 0; e < 8; ++e) st16(vL + (d + e) * VP + 32 + kv, 0u);
        }
        fL[lane] = lane < 32 ? f2[4096 + lane] : 0.f;
        LDS_WAIT();
        attn_tile(kL, vL, fL, wsf, qr, o, m, l, true, r32, r32, hi);
    }
    l += __shfl_xor(l, 32);
    __syncthreads();
    LAS float* cm = (LAS float*)F.lds; LAS float* cl = cm + 256; LAS float* co = cl + 256;
    if (hi == 0) { cm[wave * 32 + r32] = m; cl[wave * 32 + r32] = l; }
#pragma unroll
    for (int r = 0; r < 16; ++r) {
        const int q = (r & 3) + 8 * (r >> 2) + 4 * hi;
        co[(wave * 32 + q) * 64 + r32] = o[0][r]; co[(wave * 32 + q) * 64 + 32 + r32] = o[1][r];
    }
    __syncthreads();
    {
        const int q = tid >> 4, dg = tid & 15;
        float M = cm[q];
#pragma unroll
        for (int w = 1; w < 8; ++w) M = fmaxf(M, cm[w * 32 + q]);
        float L = 0.f; f32x4 acc = (f32x4){0.f, 0.f, 0.f, 0.f};
#pragma unroll
        for (int w = 0; w < 8; ++w) {
            const float wg = __builtin_amdgcn_exp2f(cm[w * 32 + q] - M);
            L += cl[w * 32 + q] * wg;
            acc += *(const LAS f32x4*)(co + (w * 32 + q) * 64 + 4 * dg) * wg;
        }
        const float rl = 1.0f / L;
        u32x2 w2; w2.x = pk2(acc[0] * rl, acc[1] * rl); w2.y = pk2(acc[2] * rl, acc[3] * rl);
        *(u32x2*)(F.O + (size_t)(qrow0 + q) * DH + h * 64 + 4 * dg) = w2;
    }
    __syncthreads();
}

__device__ __forceinline__ void s5_decode(int item, int& g, int& ci, int& row0, int& nT) {
    g = item / S5_ITEMS_PER_G; ci = item % S5_ITEMS_PER_G;
    if (ci < 256) { row0 = (ci >> 6) * 4096 + (ci & 63) * 64; nT = 64; } else { row0 = NP + (ci - 256) * 32; nT = 32; }
}
__device__ __forceinline__ void s5_load_u(Frame& F, LAS float* uL, int row0, int g, int nT) {
    if (F.lane < nT) {
        const bf16* up = F.U + (size_t)(row0 + F.lane) * DH + g * 16;
        const u32x4 a = *(const u32x4*)up, b = *(const u32x4*)(up + 8);
        LAS f32x4* d = (LAS f32x4*)(uL + F.lane * 16);
        d[0] = (f32x4){bflo(a.x), bfhi(a.x), bflo(a.y), bfhi(a.y)}; d[1] = (f32x4){bflo(a.z), bfhi(a.z), bflo(a.w), bfhi(a.w)};
        d[2] = (f32x4){bflo(b.x), bfhi(b.x), bflo(b.y), bfhi(b.y)}; d[3] = (f32x4){bflo(b.z), bfhi(b.z), bflo(b.w), bfhi(b.w)};
    }
    LDS_WAIT();
}
__device__ __forceinline__ f32x2 s5_step(const f32x2 a, const f32x2 s, const f32x2 (&bb)[16], const LAS float* ur) {
    const f32x4 u0 = *(const LAS f32x4*)ur, u1 = *(const LAS f32x4*)(ur + 4), u2 = *(const LAS f32x4*)(ur + 8), u3 = *(const LAS f32x4*)(ur + 12);
    f32x2 bu = bb[0] * u0[0];
    bu += bb[1] * u0[1]; bu += bb[2] * u0[2]; bu += bb[3] * u0[3];
    bu += bb[4] * u1[0]; bu += bb[5] * u1[1]; bu += bb[6] * u1[2]; bu += bb[7] * u1[3];
    bu += bb[8] * u2[0]; bu += bb[9] * u2[1]; bu += bb[10] * u2[2]; bu += bb[11] * u2[3];
    bu += bb[12] * u3[0]; bu += bb[13] * u3[1]; bu += bb[14] * u3[2]; bu += bb[15] * u3[3];
    f32x2 n; n.x = a.x * s.x - a.y * s.y + bu.x; n.y = a.x * s.y + a.y * s.x + bu.y;
    return n;
}
__device__ __forceinline__ void s5_pass_a(Frame& F, int wq, int nwq) {
    LAS float* uL = (LAS float*)(F.lds + F.wave * 12800);
    for (int item = wq; item < S5_ITEMS; item += nwq) {
        int g, ci, row0, nT; s5_decode(item, g, ci, row0, nT);
        if (ci >= 256) continue;
        const f32x2 a = F.abar[g * 64 + F.lane];
        f32x2 bb[16];
#pragma unroll
        for (int c = 0; c < 16; ++c) bb[c] = F.bbar[(size_t)(g * 64 + F.lane) * 16 + c];
        s5_load_u(F, uL, row0, g, nT);
        f32x2 s = (f32x2){0.f, 0.f};
#pragma unroll 4
        for (int j = 0; j < 64; ++j) s = s5_step(a, s, bb, uL + j * 16);
        F.E[(size_t)item * 64 + F.lane] = s;
        LDS_WAIT();
    }
}
__device__ __forceinline__ void s5_pass_c(Frame& F) {
    LAS float* uL = (LAS float*)(F.lds + F.wave * 12800);
    LAS bf16* Sb = (LAS bf16*)(F.lds + F.wave * 12800 + 4096);
    const int lane = F.lane, fr = lane & 15, fq = lane >> 4;
    for (int item = F.gw; item < S5_ITEMS; item += F.NGW) {
        int g, ci, row0, nT; s5_decode(item, g, ci, row0, nT);
        const f32x2 a = F.abar[g * 64 + lane];
        f32x2 bb[16];
#pragma unroll
        for (int c = 0; c < 16; ++c) bb[c] = F.bbar[(size_t)(g * 64 + lane) * 16 + c];
        bf16x8 cmf[4];
#pragma unroll
        for (int ks = 0; ks < 4; ++ks) cmf[ks] = *(const bf16x8*)(F.cmt + (g * 16 + fr) * 128 + 32 * ks + 8 * fq);
        const f32x4 dv = *(const f32x4*)(F.in[24] + g * 16 + 4 * fq);
        f32x2 s;
        if (ci < 256) {
            s = (f32x2){0.f, 0.f};
            const f32x2 aa = F.a64[g * 64 + lane];
            const f32x2* ep = F.E + (size_t)(g * S5_ITEMS_PER_G + (ci & ~63)) * 64 + lane;
            const int nprev = ci & 63;
            const int off = (16 - (nprev & 15)) & 15;
            for (int i0 = -off; i0 < nprev; i0 += 16) {
                f32x2 e[16];
#pragma unroll
                for (int u = 0; u < 16; ++u) e[u] = (i0 + u >= 0) ? ep[(size_t)(i0 + u) * 64] : (f32x2){0.f, 0.f};
#pragma unroll
                for (int u = 0; u < 16; ++u) { f32x2 n; n.x = aa.x * s.x - aa.y * s.y + e[u].x; n.y = aa.x * s.y + aa.y * s.x + e[u].y; s = n; }
            }
        } else {
            const int sb = ci - 256;
            s = (f32x2){F.in[7][(size_t)(sb * 32 + g) * 64 + lane], F.in[8][(size_t)(sb * 32 + g) * 64 + lane]};
        }
        s5_load_u(F, uL, row0, g, nT);
        for (int half = 0; half < (nT >> 5); ++half) {
#pragma unroll 4
            for (int jj = 0; jj < 32; ++jj) {
                s = s5_step(a, s, bb, uL + (half * 32 + jj) * 16);
                st16(Sb + jj * 136 + lane, f2bf(s.x)); st16(Sb + jj * 136 + 64 + lane, f2bf(s.y));
            }
            LDS_WAIT();
#pragma unroll
            for (int jb = 0; jb < 2; ++jb) {
                f32x4 acc = (f32x4){0.f, 0.f, 0.f, 0.f};
#pragma unroll
                for (int ks = 0; ks < 4; ++ks) {
                    const bf16x8 sf = *(const LAS bf16x8*)(Sb + (jb * 16 + fr) * 136 + 32 * ks + 8 * fq);
                    acc = __builtin_amdgcn_mfma_f32_16x16x32_bf16(cmf[ks], sf, acc, 0, 0, 0);
                }
                const int j = half * 32 + jb * 16 + fr;
                const f32x4 u4 = *(const LAS f32x4*)(uL + j * 16 + 4 * fq);
                float y[4];
#pragma unroll
                for (int i = 0; i < 4; ++i) { const float t = acc[i] + dv[i] * u4[i]; y[i] = t * fsigmoid(1.5957691216057308f * (t + 0.044715f * t * t * t)); }
                u32x2 w; w.x = pk2(y[0], y[1]); w.y = pk2(y[2], y[3]);
                *(u32x2*)(F.Z + (size_t)(row0 + j) * DH + g * 16 + 4 * fq) = w;
            }
            LDS_WAIT();
        }
        if (ci >= 256) { const int sb = ci - 256; F.out[O_SRS + (size_t)(sb * 32 + g) * 64 + lane] = s.x; F.out[O_SIS + (size_t)(sb * 32 + g) * 64 + lane] = s.y; }
        else if ((ci & 63) == 63) { const int b = ci >> 6; F.out[O_SRP + (size_t)(b * 32 + g) * 64 + lane] = s.x; F.out[O_SIP + (size_t)(b * 32 + g) * 64 + lane] = s.y; }
    }
}


struct SkSwiglu { bf16* H;
    __device__ __forceinline__ int brow(int ct, int nb) const { return 256 * (ct >> 2) + 32 * (ct & 3) + 128 * nb; }
    __device__ __forceinline__ void operator()(int row, int ct, int j0, const float (&v)[2][2]) const {
        const float a = v[0][0] * fsigmoid(v[0][0]) * v[1][0], b = v[0][1] * fsigmoid(v[0][1]) * v[1][1];
        *(unsigned*)(H + (size_t)(NP + row) * FF + 32 * ct + j0) = pk2(a, b); } };
struct SkResid { const float* xin; float* out; const float* mod; int gi; float gscale;
    __device__ __forceinline__ int brow(int ct, int) const { return 32 * ct; }
    __device__ __forceinline__ void operator()(int row, int ct, int j0, const float (&v)[1][2]) const {
        const int col = 32 * ct + j0; const float* gate = mod + (4 + (row >> 5)) * NMOD + gi * DM + col;
        const f32x2 x = *(const f32x2*)(xin + (size_t)row * DM + col), g = *(const f32x2*)gate;
        f32x2 o; o.x = x.x + gscale * (1.f + g.x) * v[0][0]; o.y = x.y + gscale * (1.f + g.y) * v[0][1];
        *(f32x2*)(out + (size_t)row * DM + col) = o; } };
struct SkIn { bf16 *U, *Q, *KB, *VB; float* out;
    __device__ __forceinline__ int brow(int ct, int) const { return 32 * ct; }
    __device__ __forceinline__ void operator()(int row, int ct, int j0, const float (&v)[1][2]) const {
        const int n = 32 * ct + j0, t = n >> 9, col = n & 511; const float sc = t == 1 ? QSCALE : 1.f;
        bf16* dst = U + (size_t)t * (17 * MiB / 2);
        *(unsigned*)(dst + (size_t)(NP + row) * DH + col) = pk2(v[0][0] * sc, v[0][1] * sc);
        if (t >= 2) *(f32x2*)(out + (t == 2 ? O_KS : O_VS) + (size_t)row * DH + col) = (f32x2){v[0][0], v[0][1]}; } };
struct SkGlu { const bf16* Z; bf16* Y; const float* bglu;
    __device__ __forceinline__ int brow(int ct, int) const { return 32 * ct; }
    __device__ __forceinline__ void operator()(int row, int ct, int j0, const float (&v)[1][2]) const {
        const int col = 32 * ct + j0; const unsigned z = *(const unsigned*)(Z + (size_t)(NP + row) * DH + col);
        *(unsigned*)(Y + (size_t)(NP + row) * DH + col) = pk2(bflo(z) * fsigmoid(v[0][0] + bglu[col]), bfhi(z) * fsigmoid(v[0][1] + bglu[col + 1])); } };
template <int NB, int KS, class Epi>
__device__ __forceinline__ void skinny_gemm(Frame& F, const bf16* A, const bf16* Bt, int ntc, const Epi& E) {
    constexpr int K = KS * 128;
    const int lane = F.lane, wave = F.wave, r32 = lane & 31, hi = lane >> 5, tid = F.tid;
    LAS float* red = (LAS float*)F.lds;
    for (int tile = blockIdx.x; tile < 8 * ntc; tile += F.G) {
        const int rt = tile / ntc, ct = tile % ntc;
        const bf16* ap = A + (size_t)(32 * rt + r32) * K + wave * (K / 8) + 8 * hi;
        f32x16 acc[NB];
#pragma unroll
        for (int nb = 0; nb < NB; ++nb)
#pragma unroll
            for (int r = 0; r < 16; ++r) acc[nb][r] = 0.f;
        const bf16* bp0 = Bt + (size_t)(E.brow(ct, 0) + r32) * K + wave * (K / 8) + 8 * hi;
        const bf16* bp1 = Bt + (size_t)(E.brow(ct, NB - 1) + r32) * K + wave * (K / 8) + 8 * hi;
        constexpr int SB = (KS % 11 == 0) ? 11 : KS;
#pragma unroll 1
        for (int s0 = 0; s0 < KS; s0 += SB) {
            bf16x8 af[SB], b0[SB], b1[SB];
#pragma unroll
            for (int s = 0; s < SB; ++s) { af[s] = *(const bf16x8*)(ap + 16 * (s0 + s)); b0[s] = *(const bf16x8*)(bp0 + 16 * (s0 + s)); if (NB == 2) b1[s] = *(const bf16x8*)(bp1 + 16 * (s0 + s)); }
#pragma unroll
            for (int s = 0; s < SB; ++s) {
                acc[0] = __builtin_amdgcn_mfma_f32_32x32x16_bf16(af[s], b0[s], acc[0], 0, 0, 0);
                if (NB == 2) acc[NB - 1] = __builtin_amdgcn_mfma_f32_32x32x16_bf16(af[s], b1[s], acc[NB - 1], 0, 0, 0);
            }
        }
#pragma unroll
        for (int nb = 0; nb < NB; ++nb)
#pragma unroll
            for (int r = 0; r < 16; ++r) red[((wave * NB + nb) * 32 + (r & 3) + 8 * (r >> 2) + 4 * hi) * 32 + r32] = acc[nb][r];
        __syncthreads();
        {
            const int i = tid >> 4, j0 = 2 * (tid & 15);
            float v[NB][2];
#pragma unroll
            for (int nb = 0; nb < NB; ++nb) { v[nb][0] = 0.f; v[nb][1] = 0.f;
#pragma unroll
                for (int w = 0; w < 8; ++w) { const f32x2 x = *(const LAS f32x2*)(red + ((w * NB + nb) * 32 + i) * 32 + j0); v[nb][0] += x.x; v[nb][1] += x.y; } }
            E(32 * rt + i, ct, j0, v);
        }
        __syncthreads();
    }
}

__global__ void __launch_bounds__(512, 2) mk_fwd(Args args) {
    extern __shared__ __attribute__((aligned(16))) unsigned char lds_raw[];
    cg::grid_group grid = cg::this_grid();
    Frame F;
    F.lds = (LAS unsigned char*)lds_raw;
    F.tid = threadIdx.x; F.lane = F.tid & 63; F.wave = __builtin_amdgcn_readfirstlane(F.tid >> 6);
    F.G = gridDim.x; { const int bx = blockIdx.x; F.vcu = (F.G % 8 == 0) ? (bx % 8) * (F.G / 8) + bx / 8 : bx; }
    F.gw = blockIdx.x * NWAVES + F.wave; F.NGW = F.G * NWAVES;
#pragma unroll
    for (int i = 0; i < 34; ++i) F.in[i] = args.in[i];
    F.out = args.out;
    unsigned char* ws = args.ws;
    F.mod = (float*)(ws + WS_MOD);
    F.abar = (f32x2*)(ws + WS_S5C); F.a64 = (f32x2*)(ws + WS_S5C + 16384); F.bbar = (f32x2*)(ws + WS_S5C + 32768); F.cmt = (bf16*)(ws + WS_S5C + 294912);
    F.F2P = (float*)(ws + WS_F2P); F.F2S = (float*)(ws + WS_F2S); F.E = (f32x2*)(ws + WS_E);
    F.WUP1 = (bf16*)(ws + WS_WUP1); F.WDN1 = (bf16*)(ws + WS_WDN1); F.WIN = (bf16*)(ws + WS_WIN); F.WGLU = (bf16*)(ws + WS_WGLU); F.WOUT = (bf16*)(ws + WS_WOUT);
    F.WUP2 = (bf16*)(ws + WS_WUP2); F.WDN2 = (bf16*)(ws + WS_WDN2); F.HA = (bf16*)(ws + WS_HA); F.HID = (bf16*)(ws + WS_HID);
    F.U = (bf16*)(ws + WS_U); F.Q = (bf16*)(ws + WS_Q); F.KB = (bf16*)(ws + WS_KB); F.VB = (bf16*)(ws + WS_VB); F.Z = (bf16*)(ws + WS_Z); F.O = (bf16*)(ws + WS_O);
    const int lo = args.ph_lo, hi = args.ph_hi;
    volatile LAS unsigned* misc = (volatile LAS unsigned*)(F.lds + LDS_BYTES - 256);
    if (F.tid < 2) misc[F.tid] = 0u;
    __syncthreads();
    XcdBarrier xbar; xbar.bar = (unsigned*)(ws + WS_BAR); xbar.x = 0; xbar.st = nullptr;
    if (hi - lo > 1) xbar = xcd_barrier_post((unsigned*)(ws + WS_BAR), misc);
#define IN(k) (lo <= (k) && (k) < hi)
#define REPS(k) _Pragma("nounroll") for (int rep_ = 0; rep_ < 1 + ((MK_REP_MASK >> (k)) & 1); ++rep_)
#define SEAM(k) do { if (IN(k) && IN((k) + 1)) { if ((k) == 0) grid.sync(); else xcd_barrier(xbar); } } while (0)
    typedef pg8::StaticOrder SO;
    float* xs_out = F.out + (size_t)NP * DM;

    if (IN(0)) REPS(0) { phase_ada(F); phase_s5const(F); phase_weights(F); }
    SEAM(0);
    if (IN(1)) REPS(1) phase_norm<false>(F, F.in[0], F.in[1], F.in[11], 0, 1);
    SEAM(1);
    if (IN(2)) REPS(2) { pg8::Gemm g{F.HA, F.WUP1, NP, NUP, DM}; SO S; S.init(NP, NUP, F.G, (int)blockIdx.x); EpiSwiglu E{F.HID};
        pg8::gemm_phase<EpiSwiglu, SO, PG8_ALIGN, PG8_SP2>(F.lds, g, S, E);
        skinny_gemm<2, 8>(F, F.HA + (size_t)NP * DM, F.WUP1, 88, SkSwiglu{F.HID}); }
    SEAM(2);
    if (IN(3)) REPS(3) { pg8::Gemm g{F.HID, F.WDN1, NP, DM, FF}; SO S; S.init(NP, DM, F.G, (int)blockIdx.x); EpiResid E{F.in[0], F.in[1], F.out, F.mod, 2, 0.5f};
        pg8::gemm_phase<EpiResid, SO, PG8_ALIGN, PG8_SP2>(F.lds, g, S, E);
        skinny_gemm<1, 22>(F, F.HID + (size_t)NP * FF, F.WDN1, 32, SkResid{F.in[1], xs_out, F.mod, 2, 0.5f}); }
    SEAM(3);
    if (IN(4)) REPS(4) phase_norm<true>(F, F.out, xs_out, F.in[14], 3, 4);
    SEAM(4);
    if (IN(5)) REPS(5) { phase_fcum(F);
        pg8::Gemm g{F.HA, F.WIN, NP, 2048, DM}; SO S; S.init(NP, 2048, F.G, (int)blockIdx.x); EpiIn E{F.U, F.Q, F.KB, F.VB, F.out};
        pg8::gemm_phase<EpiIn, SO, PG8_ALIGN, PG8_SP2>(F.lds, g, S, E);
        skinny_gemm<1, 8>(F, F.HA + (size_t)NP * DM, F.WIN, 64, SkIn{F.U, F.Q, F.KB, F.VB, F.out}); }
    SEAM(5);
    if (IN(6)) {
        for (int uix_ = F.vcu; uix_ < 256 * (1 + ((MK_REP_MASK >> 6) & 1)); uix_ += F.G) {
            const int uix = uix_ & 255, bh = uix >> 3, s = uix & 7;
            attn_prompt_unit(F, bh >> 3, bh & 7, 15 - s);
            attn_prompt_unit(F, bh >> 3, bh & 7, s);
        }
        const int nsamp_cu = F.G >= 128 ? 64 : 0;
        if (nsamp_cu) {
            if (F.vcu < 64) attn_sample_unit(F, F.vcu >> 3, F.vcu & 7);
            else s5_pass_a(F, (F.vcu - 64) * NWAVES + F.wave, (F.G - 64) * NWAVES);
        } else {
            for (int j = F.vcu; j < 64; j += F.G) attn_sample_unit(F, j >> 3, j & 7);
            s5_pass_a(F, F.gw, F.NGW);
        }
        __syncthreads();
    }
    SEAM(6);
    if (IN(7)) REPS(7) s5_pass_c(F);
    SEAM(7);
    if (IN(8)) REPS(8) { pg8::Gemm g{F.Z, F.WGLU, NP, DH, DH}; SO S; S.init(NP, DH, F.G, (int)blockIdx.x); EpiGlu E{F.Z, F.U, F.in[26]};
        pg8::gemm_phase<EpiGlu, SO, PG8_ALIGN, PG8_SP2>(F.lds, g, S, E);
        skinny_gemm<1, 4>(F, F.Z + (size_t)NP * DH, F.WGLU, 16, SkGlu{F.Z, F.U, F.in[26]}); }
    SEAM(8);
    if (IN(9)) REPS(9) phase_mixnorm(F);
    SEAM(9);
    if (IN(10)) REPS(10) { pg8::Gemm g{F.HA, F.WOUT, NP, DM, DM}; SO S; S.init(NP, DM, F.G, (int)blockIdx.x); EpiResid E{F.out, xs_out, F.out, F.mod, 5, 1.0f};
        pg8::gemm_phase<EpiResid, SO, PG8_ALIGN, PG8_SP2>(F.lds, g, S, E);
        skinny_gemm<1, 8>(F, F.HA + (size_t)NP * DM, F.WOUT, 32, SkResid{xs_out, xs_out, F.mod, 5, 1.0f}); }
    SEAM(10);
    if (IN(11)) REPS(11) phase_norm<false>(F, F.out, xs_out, F.in[30], 6, 7);
    SEAM(11);
    if (IN(12)) REPS(12) { pg8::Gemm g{F.HA, F.WUP2, NP, NUP, DM}; SO S; S.init(NP, NUP, F.G, (int)blockIdx.x); EpiSwiglu E{F.HID};
        pg8::gemm_phase<EpiSwiglu, SO, PG8_ALIGN, PG8_SP2>(F.lds, g, S, E);
        skinny_gemm<2, 8>(F, F.HA + (size_t)NP * DM, F.WUP2, 88, SkSwiglu{F.HID}); }
    SEAM(12);
    if (IN(13)) REPS(13) { pg8::Gemm g{F.HID, F.WDN2, NP, DM, FF}; SO S; S.init(NP, DM, F.G, (int)blockIdx.x); EpiResid E{F.out, xs_out, F.out, F.mod, 8, 0.5f};
        pg8::gemm_phase<EpiResid, SO, PG8_ALIGN, PG8_SP2>(F.lds, g, S, E);
        skinny_gemm<1, 22>(F, F.HID + (size_t)NP * FF, F.WDN2, 32, SkResid{xs_out, xs_out, F.mod, 8, 0.5f}); }
    SEAM(13);
#ifdef MK_EXTRA_SYNCS
    for (int i_ = 0; i_ < MK_EXTRA_SYNCS; ++i_) xcd_barrier(xbar);
#endif
    if (IN(14)) REPS(14) phase_finalnorm(F);
#undef IN
#undef SEAM
}
constexpr int N_PHASES = 15;

#ifndef MK_MULTI
#define MK_MULTI 0
#endif
extern "C" void kernel_launch(void* const* d_in, const int* in_sizes, int n_in, void* d_out, int out_size, void* d_ws, size_t ws_size, hipStream_t stream) {
    static int grid = 0;
    if (grid == 0) {
        int dev = 0, cus = 0, per_cu = 0;
        if (hipGetDevice(&dev) != hipSuccess || hipDeviceGetAttribute(&cus, hipDeviceAttributeMultiprocessorCount, dev) != hipSuccess) { fprintf(stderr, "kernel_launch: device query failed\n"); grid = -1; return; }
        if (hipFuncSetAttribute((const void*)mk_fwd, hipFuncAttributeMaxDynamicSharedMemorySize, LDS_BYTES) != hipSuccess) { fprintf(stderr, "kernel_launch: hipFuncSetAttribute failed\n"); grid = -1; return; }
        if (hipOccupancyMaxActiveBlocksPerMultiprocessor(&per_cu, (const void*)mk_fwd, NWAVES * 64, LDS_BYTES) != hipSuccess || per_cu < 1) per_cu = 1;
        (void)hipGetLastError();
        grid = cus;
        if (n_in != 34 || ws_size < 176 * MiB) fprintf(stderr, "kernel_launch: unexpected n_in %d / ws %zu\n", n_in, ws_size);
    }
    if (grid < 0) return;
    if (hipMemsetAsync((char*)d_ws + WS_BAR, 0, 16384, stream) != hipSuccess) { fprintf(stderr, "kernel_launch: memset failed\n"); return; }
    Args a{};
    for (int i = 0; i < 34; ++i) a.in[i] = (const float*)d_in[i];
    a.out = (float*)d_out; a.ws = (unsigned char*)d_ws;
#if MK_MULTI
    for (int p = 0; p < N_PHASES; ++p) { a.ph_lo = p; a.ph_hi = p + 1; hipLaunchKernelGGL(mk_fwd, dim3(grid), dim3(NWAVES * 64), LDS_BYTES, stream, a); }
#else
    a.ph_lo = 0; a.ph_hi = N_PHASES;
    void* kargs[] = {&a};
    const hipError_t e = hipLaunchCooperativeKernel((const void*)mk_fwd, dim3(grid), dim3(NWAVES * 64), kargs, LDS_BYTES, stream);
    if (e != hipSuccess) fprintf(stderr, "kernel_launch: cooperative launch failed: %s (grid %d)\n", hipGetErrorString(e), grid);
#endif
}
```

```cpp
#define MK_REP_MASK 0
#include <hip/hip_runtime.h>
#include <hip/hip_cooperative_groups.h>
#include <cstdio>
#include <cstdint>
namespace cg = cooperative_groups;
namespace pg8 {
#define PG8_LAS __attribute__((address_space(3)))
typedef unsigned short bf16_t;
typedef short bf16x8 __attribute__((ext_vector_type(8)));
typedef float f32x4 __attribute__((ext_vector_type(4)));
typedef unsigned u32x4 __attribute__((ext_vector_type(4)));
constexpr int BM = 256, BK = 64, HALF = 128, HTB = HALF * BK * 2  , STAGE_BYTES = 8 * HTB, NXCD = 8, WGM = 8;

__host__ __device__ __forceinline__ int lds_byte(int r, int c) { const int st = (r >> 4) * 2 + (c >> 5), rr = r & 15, cc = c & 31, ob = rr * 64 + cc * 2; return st * 1024 + (ob ^ (((ob >> 9) & 1) << 5)); }
__host__ __device__ __forceinline__ void stage_rc(int b, int& R, int& C) { const int st = b / 1024, sb = b % 1024, swz = sb ^ (((sb >> 9) & 1) << 5); R = (st >> 1) * 16 + swz / 64; C = (st & 1) * 32 + (swz % 64) / 2; }
__host__ __device__ __forceinline__ int perm32(int rho) { const int n = rho >> 4, i = rho & 15; return 8 * (i >> 2) + 4 * n + (i & 3); }

struct Unit { int pm, pn; };
struct Gemm { const bf16_t* A; const bf16_t* Bt; int M, N, K; };

struct StaticOrder {
    int nM, nN, nwg, G, c;
    __host__ __device__ void init(int M, int N, int G_, int c_) { nM = M / BM; nN = N / BM; nwg = nM * nN; G = G_; c = c_; }
    __host__ __device__ bool next(int i, Unit& u) const {
        const long L = (long)i * G + c; if (L >= nwg) return false;
        int wgid = (int)L; { const int q = nwg / NXCD, r = nwg % NXCD, xcd = wgid % NXCD, off = wgid / NXCD; wgid = (xcd < r ? xcd * (q + 1) : r * (q + 1) + (xcd - r) * q) + off; }
        const int nig = WGM * nN, gid = wgid / nig, fm = gid * WGM, gsz = (nM - fm) < WGM ? (nM - fm) : WGM;
        u.pm = fm + ((wgid % nig) % gsz); u.pn = (wgid % nig) / gsz; return true;
    }
    __device__ __forceinline__ void a_ready(const Unit&) const {}
    __device__ __forceinline__ void done(const Unit&) const {}
};

__device__ __forceinline__ unsigned cvt_pk_bf16(float lo, float hi) { unsigned r; asm volatile("v_cvt_pk_bf16_f32 %0, %1, %2" : "=v"(r) : "v"(lo), "v"(hi)); return r; }
typedef float f32x2 __attribute__((ext_vector_type(2)));
__device__ __forceinline__ f32x2 gelu_pk(f32x2 v) {
    const f32x2 av = __builtin_elementwise_abs(v), d = av * 0.2316418882f + 1.0f;
    f32x2 t; t.x = __builtin_amdgcn_rcpf(d.x); t.y = __builtin_amdgcn_rcpf(d.y);
    f32x2 q = t * 0.5307027145f + (-0.7265760135f); q = q * t + 0.7107068705f; q = q * t + (-0.142248368f); q = q * t + 0.127414796f; q = q * t;
    const f32x2 s = (v * v) * (-0.72134752044f);
    f32x2 e; e.x = __builtin_amdgcn_exp2f(s.x); e.y = __builtin_amdgcn_exp2f(s.y);
    const f32x2 m = v * (q * e), r = v - m;
    f32x2 o; o.x = v.x < 0.f ? m.x : r.x; o.y = v.y < 0.f ? m.y : r.y; return o;
}

template <int ACT  > struct EpiBf16 {
    static constexpr bool PERM = true, AFTER_DRAIN = false; static_assert(ACT == 0 || ACT == 1, "EpiBf16: ACT is 0 (none) or 1 (gelu_pk)");
    bf16_t* O; int ldc; const float* bias; int split_cols; size_t split_stride; float scale0;
    __device__ __forceinline__ void operator()(const f32x4 (&acc)[2][2][4][2], const Unit& u, int wr, int wc, int fr, int fq) const {
        const int row0 = u.pm * BM + wr * 64 + fr; int colt = u.pn * BM; bf16_t* base = O;
        float sc = 1.f; if (split_cols) { const int t = colt / split_cols; base += (size_t)t * split_stride; colt -= t * split_cols; if (t == 0) sc = scale0; }
        const int col0 = colt + wc * 32 + 8 * fq, bcol0 = u.pn * BM + wc * 32 + 8 * fq;
        f32x4 bv[2][2];
#pragma unroll
        for (int bj = 0; bj < 2; ++bj)
#pragma unroll
            for (int n = 0; n < 2; ++n) bv[bj][n] = bias ? *(const f32x4*)(bias + bcol0 + bj * HALF + 4 * n) : (f32x4){0.f, 0.f, 0.f, 0.f};
#pragma unroll
        for (int ai = 0; ai < 2; ++ai)
#pragma unroll
            for (int m = 0; m < 4; ++m) { bf16_t* rowp = base + (size_t)(row0 + ai * HALF + m * 16) * ldc + col0;
#pragma unroll
                for (int bj = 0; bj < 2; ++bj) { f32x4 v0 = acc[ai][bj][m][0] + bv[bj][0], v1 = acc[ai][bj][m][1] + bv[bj][1];
                    if (ACT == 1) { f32x2 a = gelu_pk((f32x2){v0[0], v0[1]}), b = gelu_pk((f32x2){v0[2], v0[3]}), c = gelu_pk((f32x2){v1[0], v1[1]}), d = gelu_pk((f32x2){v1[2], v1[3]});
                        v0 = (f32x4){a.x, a.y, b.x, b.y}; v1 = (f32x4){c.x, c.y, d.x, d.y}; }
                    v0 = v0 * sc; v1 = v1 * sc; u32x4 w; w.x = cvt_pk_bf16(v0[0], v0[1]); w.y = cvt_pk_bf16(v0[2], v0[3]); w.z = cvt_pk_bf16(v1[0], v1[1]); w.w = cvt_pk_bf16(v1[2], v1[3]);
                    *(u32x4*)(rowp + bj * HALF) = w; } }
    }
};


template <class Epi, class Sched, bool ALIGN_EPI = false, bool SP2 = false>
__device__ __forceinline__ void gemm_phase(PG8_LAS unsigned char* lds, const Gemm g, const Sched& S, const Epi& E) {
    const int tid = threadIdx.x, wid = __builtin_amdgcn_readfirstlane(tid >> 6), lane = tid & 63, wr = wid >> 2, wc = wid & 3, fr = lane & 15, fq = lane >> 4;
    const int K = g.K, nt = K / BK;
    unsigned voffA[2], voffB[2];
#pragma unroll
    for (int i = 0; i < 2; ++i) { int R, C; stage_rc(tid * 16 + i * 8192, R, C); const int Rb = Epi::PERM ? ((R & ~31) + perm32(R & 31)) : R;
        voffA[i] = (unsigned)(R * K + C) * 2u; voffB[i] = (unsigned)(Rb * K + C) * 2u; }
    const size_t kstep = (size_t)(BK * 2);
    const size_t hstep = (size_t)HALF * K * 2;
    const size_t tstep = 2 * hstep;
    const unsigned ldsw = (unsigned)wid * 1024u;
    const int aoff = lds_byte(wr * 64 + fr, fq * 8), boff = lds_byte(wc * 32 + fr, fq * 8);
#define PG8_SA(b, h) (((b) * 2 + (h)) * HTB)
#define PG8_SB(b, h) ((4 + (b) * 2 + (h)) * HTB)
#define PG8_STAGE(bufoff, gbase, voff) do { _Pragma("unroll") for (int _i = 0; _i < 2; ++_i) \
        __builtin_amdgcn_global_load_lds((const unsigned*)((const char*)(gbase) + (voff)[_i]), (PG8_LAS unsigned*)(lds + (bufoff) + ldsw + _i * 8192), 16, 0, 0); } while (0)
#define PG8_LDA(dst, b, h) do { _Pragma("unroll") for (int m = 0; m < 4; ++m) _Pragma("unroll") for (int k = 0; k < 2; ++k) dst[m][k] = *(const PG8_LAS bf16x8*)(lds + PG8_SA(b, h) + aoff + m * 2048 + k * 1024); } while (0)
#define PG8_LDB(dst, b, h) do { _Pragma("unroll") for (int n = 0; n < 2; ++n) _Pragma("unroll") for (int k = 0; k < 2; ++k) dst[n][k] = *(const PG8_LAS bf16x8*)(lds + PG8_SB(b, h) + boff + n * 2048 + k * 1024); } while (0)
#define PG8_MMA(ai, bj, At, Bt) do { __builtin_amdgcn_s_setprio(1); _Pragma("unroll") for (int m = 0; m < 4; ++m) _Pragma("unroll") for (int n = 0; n < 2; ++n) _Pragma("unroll") for (int k = 0; k < 2; ++k) \
        acc[ai][bj][m][n] = __builtin_amdgcn_mfma_f32_16x16x32_bf16(Bt[n][k], At[m][k], acc[ai][bj][m][n], 0, 0, 0); __builtin_amdgcn_s_setprio(0); } while (0)
#define PG8_WAIT_V(n) asm volatile("s_waitcnt vmcnt(" #n ")" ::: "memory")
#define PG8_WAIT_L(n) asm volatile("s_waitcnt lgkmcnt(" #n ")" ::: "memory")
#define PG8_BAR __builtin_amdgcn_s_barrier()
#define PG8_SCHED __builtin_amdgcn_sched_barrier(0)
    Unit cur, nxt; int ui = 0;
    if (!S.next(0, cur)) return;
    f32x4 acc[2][2][4][2];
#pragma unroll
    for (int a = 0; a < 2; ++a)
#pragma unroll
        for (int b = 0; b < 2; ++b)
#pragma unroll
            for (int m = 0; m < 4; ++m)
#pragma unroll
                for (int n = 0; n < 2; ++n) acc[a][b][m][n] = (f32x4){0.f, 0.f, 0.f, 0.f};
    bf16x8 At[4][2], B0[2][2], B1[2][2];
    const char* cA = (const char*)g.A + (size_t)cur.pm * tstep; const char* cB = (const char*)g.Bt + (size_t)cur.pn * tstep;
    S.a_ready(cur);
    if constexpr (SP2) {
        PG8_STAGE(PG8_SB(0, 0), cB, voffB); PG8_STAGE(PG8_SB(0, 1), cB + hstep, voffB); PG8_STAGE(PG8_SA(0, 0), cA, voffA); PG8_STAGE(PG8_SA(0, 1), cA + hstep, voffA);
        if (wr == 1) PG8_BAR;
        PG8_WAIT_V(2); PG8_BAR;
        PG8_STAGE(PG8_SB(1, 0), cB + kstep, voffB); PG8_STAGE(PG8_SA(1, 0), cA + kstep, voffA); PG8_STAGE(PG8_SB(1, 1), cB + hstep + kstep, voffB);
        PG8_WAIT_V(6); PG8_BAR;
    } else {
        PG8_STAGE(PG8_SB(0, 0), cB, voffB); PG8_STAGE(PG8_SA(0, 0), cA, voffA); PG8_STAGE(PG8_SB(0, 1), cB + hstep, voffB); PG8_STAGE(PG8_SA(0, 1), cA + hstep, voffA);
        if (wr == 1) PG8_BAR;
        PG8_WAIT_V(4); PG8_BAR;
        PG8_STAGE(PG8_SB(1, 0), cB + kstep, voffB); PG8_STAGE(PG8_SA(1, 0), cA + kstep, voffA); PG8_STAGE(PG8_SB(1, 1), cB + hstep + kstep, voffB);
        PG8_WAIT_V(6); PG8_BAR;
    }
    for (;;) {
        const bool has_next = S.next(ui + 1, nxt);
        const char* nA = has_next ? (const char*)g.A + (size_t)nxt.pm * tstep : cA; const char* nB = has_next ? (const char*)g.Bt + (size_t)nxt.pn * tstep : cB;
        for (int t = 0; t < nt; t += 2) {
            const bool last = (t == nt - 2);
            const char* a1 = cA + (size_t)(t + 1) * kstep;
            const char* a2 = last ? nA : cA + (size_t)(t + 2) * kstep; const char* b2 = last ? nB : cB + (size_t)(t + 2) * kstep;
            const char* a3 = a2 + kstep; const char* b3 = b2 + kstep;
            if (last && has_next) S.a_ready(nxt);
            if constexpr (SP2) {
            PG8_LDB(B0, 0, 0); PG8_LDB(B1, 0, 1); PG8_SCHED; PG8_LDA(At, 0, 0); PG8_STAGE(PG8_SA(1, 1), a1 + hstep, voffA);
            PG8_WAIT_V(8); PG8_WAIT_L(0); PG8_BAR; PG8_MMA(0, 0, At, B0); PG8_MMA(0, 1, At, B1); PG8_BAR; PG8_SCHED;
            PG8_LDA(At, 0, 1); PG8_STAGE(PG8_SB(0, 0), b2, voffB); PG8_STAGE(PG8_SB(0, 1), b2 + hstep, voffB); PG8_STAGE(PG8_SA(0, 0), a2, voffA);
            PG8_WAIT_V(8); PG8_WAIT_L(0); PG8_BAR; PG8_MMA(1, 0, At, B0); PG8_MMA(1, 1, At, B1); PG8_BAR; PG8_SCHED;
            PG8_LDB(B0, 1, 0); PG8_LDB(B1, 1, 1); PG8_SCHED; PG8_LDA(At, 1, 0); PG8_STAGE(PG8_SA(0, 1), a2 + hstep, voffA);
            PG8_WAIT_V(8); PG8_WAIT_L(0); PG8_BAR; PG8_MMA(0, 0, At, B0); PG8_MMA(0, 1, At, B1); PG8_BAR; PG8_SCHED;
            PG8_LDA(At, 1, 1); PG8_STAGE(PG8_SB(1, 0), b3, voffB); PG8_STAGE(PG8_SB(1, 1), b3 + hstep, voffB); PG8_STAGE(PG8_SA(1, 0), a3, voffA);
            PG8_WAIT_V(8); PG8_WAIT_L(0); PG8_BAR; PG8_MMA(1, 0, At, B0); PG8_MMA(1, 1, At, B1); PG8_BAR; PG8_SCHED;
            } else {
            PG8_LDB(B0, 0, 0); PG8_SCHED; PG8_LDA(At, 0, 0); PG8_STAGE(PG8_SA(1, 1), a1 + hstep, voffA);
            PG8_WAIT_L(8); PG8_BAR; PG8_WAIT_L(0); PG8_MMA(0, 0, At, B0); PG8_BAR; PG8_SCHED;
            PG8_LDB(B1, 0, 1); PG8_STAGE(PG8_SB(0, 0), b2, voffB);
            PG8_BAR; PG8_WAIT_L(0); PG8_MMA(0, 1, At, B1); PG8_BAR;
            PG8_LDA(At, 0, 1); PG8_STAGE(PG8_SA(0, 0), a2, voffA);
            PG8_BAR; PG8_WAIT_L(0); PG8_MMA(1, 0, At, B0); PG8_BAR; PG8_SCHED;
            PG8_STAGE(PG8_SB(0, 1), b2 + hstep, voffB);
            PG8_WAIT_V(6); PG8_BAR; PG8_MMA(1, 1, At, B1); PG8_BAR;
            PG8_LDB(B0, 1, 0); PG8_SCHED; PG8_LDA(At, 1, 0); PG8_STAGE(PG8_SA(0, 1), a2 + hstep, voffA);
            PG8_WAIT_L(8); PG8_BAR; PG8_WAIT_L(0); PG8_MMA(0, 0, At, B0); PG8_BAR; PG8_SCHED;
            PG8_LDB(B1, 1, 1); PG8_STAGE(PG8_SB(1, 0), b3, voffB);
            PG8_BAR; PG8_WAIT_L(0); PG8_MMA(0, 1, At, B1); PG8_BAR;
            PG8_LDA(At, 1, 1); PG8_STAGE(PG8_SA(1, 0), a3, voffA);
            PG8_BAR; PG8_WAIT_L(0); PG8_MMA(1, 0, At, B0); PG8_BAR; PG8_SCHED;
            PG8_STAGE(PG8_SB(1, 1), b3 + hstep, voffB);
            PG8_WAIT_V(6); PG8_BAR; PG8_MMA(1, 1, At, B1); PG8_BAR;
            }
        }
        if constexpr (ALIGN_EPI) { if (wr == 0) PG8_BAR; }
        if constexpr (!Epi::AFTER_DRAIN) { E(acc, cur, wr, wc, fr, fq); S.done(cur); }
        if (!has_next) break;
#pragma unroll
        for (int a = 0; a < 2; ++a)
#pragma unroll
            for (int b = 0; b < 2; ++b)
#pragma unroll
                for (int m = 0; m < 4; ++m)
#pragma unroll
                    for (int n = 0; n < 2; ++n) acc[a][b][m][n] = (f32x4){0.f, 0.f, 0.f, 0.f};
        cur = nxt; cA = nA; cB = nB; ++ui;
        if constexpr (ALIGN_EPI) { if (wr == 1) PG8_BAR; }
    }
    PG8_WAIT_V(0);
    if constexpr (!ALIGN_EPI) { if (wr == 0) PG8_BAR; }
    PG8_BAR;
    if constexpr (Epi::AFTER_DRAIN) { E.fused(acc, cur, wr, wc, fr, fq, lds, wid, lane); S.done(cur); }
#undef PG8_SA
#undef PG8_SB
#undef PG8_STAGE
#undef PG8_LDA
#undef PG8_LDB
#undef PG8_MMA
#undef PG8_WAIT_V
#undef PG8_WAIT_L
#undef PG8_BAR
#undef PG8_SCHED
}
}

#ifndef PG8_SP2
#define PG8_SP2 true
#endif
#ifndef PG8_ALIGN
#define PG8_ALIGN true
#endif
#define LAS __attribute__((address_space(3)))
typedef unsigned short bf16;
typedef short bf16x8 __attribute__((ext_vector_type(8)));
typedef short s16x4 __attribute__((ext_vector_type(4)));
typedef float f32x4 __attribute__((ext_vector_type(4)));
typedef float f32x2 __attribute__((ext_vector_type(2)));
typedef float f32x16 __attribute__((ext_vector_type(16)));
typedef unsigned u32x4 __attribute__((ext_vector_type(4)));
typedef unsigned u32x2 __attribute__((ext_vector_type(2)));

constexpr int NP = 16384, NS = 256, MT = NP + NS, DM = 1024, FF = 2816, NUP = 5632, DH = 512, NMOD = 9216, DIN = 2056;
constexpr float EPS = 1e-6f, LOG2E = 1.4426950408889634f, QSCALE = 0.125f * 1.4426950408889634f;
constexpr size_t O_KP = 17039360, O_VP = 25427968, O_LFP = 33816576, O_SRP = 33947648, O_SIP = 33955840, O_KS = 33964032, O_VS = 34095104,
                 O_LFS = 34226176, O_SRS = 34228224, O_SIS = 34244608;
constexpr size_t MiB = 1u << 20;
constexpr size_t WS_MOD = 0, WS_S5C = 1 * MiB, WS_F2P = 2 * MiB, WS_F2S = 2 * MiB + 512 * 1024, WS_E = 4 * MiB, WS_WUP1 = 10 * MiB, WS_WDN1 = 21 * MiB,
                 WS_WIN = 27 * MiB, WS_WGLU = 31 * MiB, WS_WOUT = 32 * MiB, WS_WUP2 = 34 * MiB, WS_WDN2 = 45 * MiB, WS_HA = 52 * MiB, WS_HID = 86 * MiB;
constexpr size_t WS_U = WS_HID, WS_Q = WS_HID + 17 * MiB, WS_KB = WS_HID + 34 * MiB, WS_VB = WS_HID + 51 * MiB, WS_Z = WS_HID + 68 * MiB;
constexpr size_t WS_O = 176 * MiB, WS_BAR = 512 * 1024;
#ifndef MK_REP_MASK
#define MK_REP_MASK 0
#endif
constexpr int S5_ITEMS_PER_G = 264, S5_ITEMS = 32 * 264;
constexpr int LDS_BYTES = 155648;
constexpr int NWAVES = 8;

struct Args { const float* in[34]; float* out; unsigned char* ws; int ph_lo, ph_hi; };

struct Frame {
    LAS unsigned char* lds;
    int tid, lane, wave, G, vcu, gw, NGW;
    const float* in[34];
    float* out;
    float* mod; f32x2* abar; f32x2* a64; f32x2* bbar; bf16* cmt; float* F2P; float* F2S; f32x2* E;
    bf16 *WUP1, *WDN1, *WIN, *WGLU, *WOUT, *WUP2, *WDN2, *HA, *HID, *U, *Q, *KB, *VB, *Z, *O;
};

__device__ __forceinline__ unsigned f2bf(float f) { unsigned u = __builtin_bit_cast(unsigned, f); return (u + 0x7fffu + ((u >> 16) & 1u)) >> 16; }
__device__ __forceinline__ unsigned pk2(float lo, float hi) { return pg8::cvt_pk_bf16(lo, hi); }
__device__ __forceinline__ float bflo(unsigned w) { return __uint_as_float(w << 16); }
__device__ __forceinline__ float bfhi(unsigned w) { return __uint_as_float(w & 0xffff0000u); }
__device__ __forceinline__ float wave_sum(float v) {
#pragma unroll
    for (int o = 1; o < 64; o <<= 1) v += __shfl_xor(v, o);
    return v;
}
__device__ __forceinline__ float fsigmoid(float x) { return __builtin_amdgcn_rcpf(1.f + __builtin_amdgcn_exp2f(-x * LOG2E)); }
__device__ __forceinline__ int bidx(int row) { return row < NP ? (row >> 12) : 4 + ((row - NP) >> 5); }
#define LDS_WAIT() asm volatile("s_waitcnt lgkmcnt(0)" ::: "memory")

using pg8::Unit;
struct EpiSwiglu {
    static constexpr bool PERM = true, AFTER_DRAIN = false;
    bf16* H;
    __device__ __forceinline__ void operator()(const f32x4 (&acc)[2][2][4][2], const Unit& u, int wr, int wc, int fr, int fq) const {
        const int row0 = u.pm * 256 + wr * 64 + fr, col0 = u.pn * 128 + wc * 32 + 8 * fq;
#pragma unroll
        for (int ai = 0; ai < 2; ++ai)
#pragma unroll
            for (int m = 0; m < 4; ++m) {
                const int row = row0 + ai * 128 + m * 16;
                u32x4 w; unsigned ww[4];
#pragma unroll
                for (int n = 0; n < 2; ++n) {
                    const f32x4 g = acc[ai][0][m][n], up = acc[ai][1][m][n]; float r[4];
#pragma unroll
                    for (int i = 0; i < 4; ++i) r[i] = g[i] * fsigmoid(g[i]) * up[i];
                    ww[2 * n] = pk2(r[0], r[1]); ww[2 * n + 1] = pk2(r[2], r[3]);
                }
                w.x = ww[0]; w.y = ww[1]; w.z = ww[2]; w.w = ww[3];
                *(u32x4*)(H + (size_t)row * FF + col0) = w;
            }
    }
};
struct EpiResid {
    static constexpr bool PERM = true, AFTER_DRAIN = false;
    const float* xp; const float* xs; float* out; const float* mod; int gi; float gscale;
    __device__ __forceinline__ void operator()(const f32x4 (&acc)[2][2][4][2], const Unit& u, int wr, int wc, int fr, int fq) const {
        const int row0 = u.pm * 256 + wr * 64 + fr, col0 = u.pn * 256 + wc * 32 + 8 * fq;
#pragma unroll
        for (int ai = 0; ai < 2; ++ai)
#pragma unroll
            for (int m = 0; m < 4; ++m) {
                const int row = row0 + ai * 128 + m * 16;
                const float* xin = row < NP ? xp + (size_t)row * DM : xs + (size_t)(row - NP) * DM;
                const float* gate = mod + bidx(row) * NMOD + gi * DM;
                float* orow = out + (size_t)row * DM;
#pragma unroll
                for (int bj = 0; bj < 2; ++bj) {
                    const int col = col0 + bj * 128;
#pragma unroll
                    for (int n = 0; n < 2; ++n) {
                        const f32x4 g = *(const f32x4*)(gate + col + 4 * n), x = *(const f32x4*)(xin + col + 4 * n);
                        const f32x4 o = x + (g + 1.0f) * gscale * acc[ai][bj][m][n];
                        *(f32x4*)(orow + col + 4 * n) = o;
                    }
                }
            }
    }
};
struct EpiIn {
    static constexpr bool PERM = true, AFTER_DRAIN = false;
    bf16 *U, *Q, *KB, *VB; float* out;
    __device__ __forceinline__ void operator()(const f32x4 (&acc)[2][2][4][2], const Unit& u, int wr, int wc, int fr, int fq) const {
        const int t = u.pn >> 1;
        const int row0 = u.pm * 256 + wr * 64 + fr, col0 = (u.pn & 1) * 256 + wc * 32 + 8 * fq;
        bf16* dst = t == 0 ? U : t == 1 ? Q : t == 2 ? KB : VB;
        const float sc = t == 1 ? QSCALE : 1.0f;
#pragma unroll
        for (int ai = 0; ai < 2; ++ai)
#pragma unroll
            for (int m = 0; m < 4; ++m) {
                const int row = row0 + ai * 128 + m * 16;
                float* fo = row < NP ? out + (t == 2 ? O_KP : O_VP) + (size_t)row * DH : out + (t == 2 ? O_KS : O_VS) + (size_t)(row - NP) * DH;
#pragma unroll
                for (int bj = 0; bj < 2; ++bj) {
                    const int col = col0 + bj * 128;
                    const f32x4 v0 = acc[ai][bj][m][0], v1 = acc[ai][bj][m][1];
                    u32x4 w; w.x = pk2(v0[0] * sc, v0[1] * sc); w.y = pk2(v0[2] * sc, v0[3] * sc); w.z = pk2(v1[0] * sc, v1[1] * sc); w.w = pk2(v1[2] * sc, v1[3] * sc);
                    *(u32x4*)(dst + (size_t)row * DH + col) = w;
                    if (t >= 2) { *(f32x4*)(fo + col) = v0; *(f32x4*)(fo + col + 4) = v1; }
                }
            }
    }
};
struct EpiGlu {
    static constexpr bool PERM = true, AFTER_DRAIN = false;
    const bf16* Z; bf16* Y; const float* bglu;
    __device__ __forceinline__ void operator()(const f32x4 (&acc)[2][2][4][2], const Unit& u, int wr, int wc, int fr, int fq) const {
        const int row0 = u.pm * 256 + wr * 64 + fr, col0 = u.pn * 256 + wc * 32 + 8 * fq;
#pragma unroll
        for (int bj = 0; bj < 2; ++bj) {
            const int col = col0 + bj * 128;
            const f32x4 b0 = *(const f32x4*)(bglu + col), b1 = *(const f32x4*)(bglu + col + 4);
#pragma unroll
            for (int ai = 0; ai < 2; ++ai)
#pragma unroll
                for (int m = 0; m < 4; ++m) {
                    const int row = row0 + ai * 128 + m * 16;
                    const u32x4 z = *(const u32x4*)(Z + (size_t)row * DH + col);
                    const f32x4 a0 = acc[ai][bj][m][0] + b0, a1 = acc[ai][bj][m][1] + b1;
                    u32x4 w;
                    w.x = pk2(bflo(z.x) * fsigmoid(a0[0]), bfhi(z.x) * fsigmoid(a0[1]));
                    w.y = pk2(bflo(z.y) * fsigmoid(a0[2]), bfhi(z.y) * fsigmoid(a0[3]));
                    w.z = pk2(bflo(z.z) * fsigmoid(a1[0]), bfhi(z.z) * fsigmoid(a1[1]));
                    w.w = pk2(bflo(z.w) * fsigmoid(a1[2]), bfhi(z.w) * fsigmoid(a1[3]));
                    *(u32x4*)(Y + (size_t)row * DH + col) = w;
                }
        }
    }
};

__device__ __forceinline__ void phase_ada(Frame& F) {
    LAS float* sm = (LAS float*)F.lds;
    LAS float* red = sm + 12288;
    const float* cp = F.in[2]; const float* cs = F.in[3]; const float* wada = F.in[9]; const float* bada = F.in[10];
    for (int i = F.tid; i < 12288; i += 512) { const int d = i / 12, bi = i % 12; const float c = bi < 4 ? cp[bi * DM + d] : cs[(bi - 4) * DM + d]; sm[i] = c * fsigmoid(c); }
    __syncthreads();
    for (int cb = blockIdx.x; cb < 256; cb += F.G) {
        const int ks = F.tid / 36, cl = F.tid % 36;
        float acc[12];
#pragma unroll
        for (int i = 0; i < 12; ++i) acc[i] = 0.f;
        if (F.tid < 504) {
            const float* wp = wada + (size_t)ks * NMOD + cb * 36 + cl;
            const int nd = (DM - ks + 13) / 14;
            for (int i0 = 0; i0 < nd; i0 += 8) {
                float w[8];
#pragma unroll
                for (int u = 0; u < 8; ++u) w[u] = (i0 + u < nd) ? wp[(size_t)(i0 + u) * 14 * NMOD] : 0.f;
#pragma unroll
                for (int u = 0; u < 8; ++u) {
                    const int d = (i0 + u < nd) ? ks + 14 * (i0 + u) : 0;
                    const f32x4 s0 = *(const LAS f32x4*)(sm + d * 12), s1 = *(const LAS f32x4*)(sm + d * 12 + 4), s2 = *(const LAS f32x4*)(sm + d * 12 + 8);
                    acc[0] += w[u] * s0[0]; acc[1] += w[u] * s0[1]; acc[2] += w[u] * s0[2]; acc[3] += w[u] * s0[3];
                    acc[4] += w[u] * s1[0]; acc[5] += w[u] * s1[1]; acc[6] += w[u] * s1[2]; acc[7] += w[u] * s1[3];
                    acc[8] += w[u] * s2[0]; acc[9] += w[u] * s2[1]; acc[10] += w[u] * s2[2]; acc[11] += w[u] * s2[3];
                }
            }
#pragma unroll
            for (int i = 0; i < 12; ++i) red[(ks * 36 + cl) * 12 + i] = acc[i];
        }
        __syncthreads();
        if (F.tid < 432) {
            const int c2 = F.tid / 12, bi = F.tid % 12; float s = bada[cb * 36 + c2];
#pragma unroll
            for (int k = 0; k < 14; ++k) s += red[(k * 36 + c2) * 12 + bi];
            F.mod[bi * NMOD + cb * 36 + c2] = s;
        }
        __syncthreads();
    }
}
__device__ __forceinline__ void sincos_d(double x, double& s, double& c) {
    const double kf = __builtin_rint(x * 0.63661977236758134308);
    double r = __builtin_fma(-kf, 1.57079632679489655800e+00, x); r = __builtin_fma(-kf, 6.12323399573676603587e-17, r);
    const int k = ((int)kf) & 3; const double r2 = r * r;
    double sp = 1.0 / 6227020800.0; sp = __builtin_fma(sp, r2, -1.0 / 39916800.0); sp = __builtin_fma(sp, r2, 1.0 / 362880.0); sp = __builtin_fma(sp, r2, -1.0 / 5040.0);
    sp = __builtin_fma(sp, r2, 1.0 / 120.0); sp = __builtin_fma(sp, r2, -1.0 / 6.0); sp = __builtin_fma(sp, r2, 1.0); const double sr = sp * r;
    double cq = -1.0 / 87178291200.0; cq = __builtin_fma(cq, r2, 1.0 / 479001600.0); cq = __builtin_fma(cq, r2, -1.0 / 3628800.0); cq = __builtin_fma(cq, r2, 1.0 / 40320.0);
    cq = __builtin_fma(cq, r2, -1.0 / 720.0); cq = __builtin_fma(cq, r2, 1.0 / 24.0); cq = __builtin_fma(cq, r2, -0.5); const double cr = __builtin_fma(cq, r2, 1.0);
    s = (k == 0) ? sr : (k == 1) ? cr : (k == 2) ? -sr : -cr;
    c = (k == 0) ? cr : (k == 1) ? -sr : (k == 2) ? -cr : sr;
}
__device__ __forceinline__ double exp_d(double x) {
    const double n = __builtin_rint(x * 1.4426950408889634074);
    double r = __builtin_fma(-n, 6.93147180369123816490e-01, x); r = __builtin_fma(-n, 1.90821492927058770002e-10, r);
    double p = 1.0 / 6227020800.0;
    p = __builtin_fma(p, r, 1.0 / 479001600.0); p = __builtin_fma(p, r, 1.0 / 39916800.0); p = __builtin_fma(p, r, 1.0 / 3628800.0); p = __builtin_fma(p, r, 1.0 / 362880.0);
    p = __builtin_fma(p, r, 1.0 / 40320.0); p = __builtin_fma(p, r, 1.0 / 5040.0); p = __builtin_fma(p, r, 1.0 / 720.0); p = __builtin_fma(p, r, 1.0 / 120.0);
    p = __builtin_fma(p, r, 1.0 / 24.0); p = __builtin_fma(p, r, 1.0 / 6.0); p = __builtin_fma(p, r, 0.5); p = __builtin_fma(p, r, 1.0); p = __builtin_fma(p, r, 1.0);
    return __builtin_ldexp(p, (int)n);
}
__device__ __forceinline__ void phase_s5const(Frame& F) {
    const int id = blockIdx.x * 512 + F.tid;
    if (id >= 2048) return;
    const int g = id >> 6, p = id & 63;
    const double lre = (double)F.in[17][id], lim = (double)F.in[18][id], dt = exp_d((double)F.in[19][g]);
    const double mag = exp_d(lre * dt); double sn, cs; sincos_d(lim * dt, sn, cs);
    const double are = mag * cs, aim = mag * sn;
    F.abar[id] = (f32x2){(float)are, (float)aim};
    double pr = are, pi = aim;
#pragma unroll
    for (int i = 0; i < 6; ++i) { const double nr = pr * pr - pi * pi, ni = 2.0 * pr * pi; pr = nr; pi = ni; }
    F.a64[id] = (f32x2){(float)pr, (float)pi};
    const double xr = are - 1.0, xi = aim, den = lre * lre + lim * lim;
    const double cr = (xr * lre + xi * lim) / den, ci = (xi * lre - xr * lim) / den;
    const float* bre = F.in[20] + (size_t)id * 16; const float* bim = F.in[21] + (size_t)id * 16;
#pragma unroll
    for (int c = 0; c < 16; ++c) { const double br = bre[c], bi = bim[c]; F.bbar[(size_t)id * 16 + c] = (f32x2){(float)(cr * br - ci * bi), (float)(cr * bi + ci * br)}; }
    const float* cre = F.in[22]; const float* cim = F.in[23];
#pragma unroll
    for (int c = 0; c < 16; ++c) {
        F.cmt[(g * 16 + c) * 128 + p] = (bf16)f2bf(cre[(g * 16 + c) * 64 + p]);
        F.cmt[(g * 16 + c) * 128 + 64 + p] = (bf16)f2bf(-cim[(g * 16 + c) * 64 + p]);
    }
}
__device__ __forceinline__ void transpose_item(const float* W, int ldw, int k0, int n0, bf16* WT, int Kd, int drow0, LAS float* scr, int lane) {
#pragma unroll 8
    for (int i = 0; i < 32; ++i) { const int kk = 2 * i + (lane >> 5); scr[kk * 33 + (lane & 31)] = W[(size_t)(k0 + kk) * ldw + n0 + (lane & 31)]; }
    LDS_WAIT();
    const int c = lane & 7;
#pragma unroll
    for (int j = 0; j < 4; ++j) { const int n = (lane >> 3) + 8 * j; const LAS float* s = scr + (8 * c) * 33 + n;
        u32x4 o; o.x = pk2(s[0 * 33], s[1 * 33]); o.y = pk2(s[2 * 33], s[3 * 33]); o.z = pk2(s[4 * 33], s[5 * 33]); o.w = pk2(s[6 * 33], s[7 * 33]);
        *(u32x4*)(WT + (size_t)(drow0 + n) * Kd + k0 + 8 * c) = o; }
    LDS_WAIT();
}
__device__ __forceinline__ int up_drow(int n0) { return n0 < FF ? 256 * (n0 >> 7) + (n0 & 127) : 256 * ((n0 - FF) >> 7) + 128 + ((n0 - FF) & 127); }
__device__ __forceinline__ void phase_weights(Frame& F) {
    LAS float* scr = (LAS float*)(F.lds + 81920 + F.wave * 8704);
    constexpr int I_UP = 16 * 176, I_DN = 44 * 32, I_IN = 16 * 64, I_GLU = 8 * 16, I_OUT = 16 * 32;
    constexpr int NITEMS = 2 * I_UP + 2 * I_DN + I_IN + I_GLU + I_OUT;
    for (int it = F.gw; it < NITEMS; it += F.NGW) {
        int r = it;
        if (r < I_UP) { const int kb = r / 176, nb = r % 176; transpose_item(F.in[12], NUP, 64 * kb, 32 * nb, F.WUP1, DM, up_drow(32 * nb), scr, F.lane); continue; } r -= I_UP;
        if (r < I_UP) { const int kb = r / 176, nb = r % 176; transpose_item(F.in[31], NUP, 64 * kb, 32 * nb, F.WUP2, DM, up_drow(32 * nb), scr, F.lane); continue; } r -= I_UP;
        if (r < I_DN) { const int kb = r / 32, nb = r % 32; transpose_item(F.in[13], DM, 64 * kb, 32 * nb, F.WDN1, FF, 32 * nb, scr, F.lane); continue; } r -= I_DN;
        if (r < I_DN) { const int kb = r / 32, nb = r % 32; transpose_item(F.in[32], DM, 64 * kb, 32 * nb, F.WDN2, FF, 32 * nb, scr, F.lane); continue; } r -= I_DN;
        if (r < I_IN) { const int kb = r / 64, nb = r % 64; transpose_item(F.in[15], DIN, 64 * kb, 32 * nb, F.WIN, DM, 32 * nb, scr, F.lane); continue; } r -= I_IN;
        if (r < I_GLU) { const int kb = r / 16, nb = r % 16; transpose_item(F.in[25], DH, 64 * kb, 32 * nb, F.WGLU, DH, 32 * nb, scr, F.lane); continue; } r -= I_GLU;
        { const int kb = r / 32, nb = r % 32; transpose_item(F.in[29], DM, 64 * kb, 32 * nb, F.WOUT, DM, 32 * nb, scr, F.lane); }
    }
}

template <bool FG>
__device__ __forceinline__ void phase_norm(Frame& F, const float* xp, const float* xs, const float* gN, int si, int ci) {
    LAS float* wf = (LAS float*)F.lds;
    if (FG) {
        const float* win = F.in[15];
        for (int i = F.tid; i < 8192; i += 512) wf[i] = win[(size_t)(i >> 3) * DIN + 2048 + (i & 7)];
        __syncthreads();
    }
    const int lane = F.lane;
    for (int row = F.gw; row < MT; row += F.NGW) {
        const float* xr = row < NP ? xp + (size_t)row * DM : xs + (size_t)(row - NP) * DM;
        f32x4 v[4]; float ss = 0.f;
#pragma unroll
        for (int j = 0; j < 4; ++j) { v[j] = *(const f32x4*)(xr + 4 * lane + 256 * j); ss += (v[j][0] * v[j][0] + v[j][1] * v[j][1]) + (v[j][2] * v[j][2] + v[j][3] * v[j][3]); }
        const float rstd = 1.0f / sqrtf(wave_sum(ss) * (1.0f / DM) + EPS);
        const float* sh = F.mod + bidx(row) * NMOD + si * DM; const float* sc = F.mod + bidx(row) * NMOD + ci * DM;
        float f[8];
#pragma unroll
        for (int i = 0; i < 8; ++i) f[i] = 0.f;
#pragma unroll
        for (int j = 0; j < 4; ++j) {
            const int col = 4 * lane + 256 * j;
            const f32x4 g4 = *(const f32x4*)(gN + col), s4 = *(const f32x4*)(sc + col), h4 = *(const f32x4*)(sh + col);
            const f32x4 h = v[j] * rstd * g4 * (s4 + 1.0f) + h4;
            u32x2 w; w.x = pk2(h[0], h[1]); w.y = pk2(h[2], h[3]);
            *(u32x2*)(F.HA + (size_t)row * DM + col) = w;
            if (FG) {
#pragma unroll
                for (int e = 0; e < 4; ++e) {
                    const f32x4 w0 = *(const LAS f32x4*)(wf + (col + e) * 8), w1 = *(const LAS f32x4*)(wf + (col + e) * 8 + 4);
                    f[0] += h[e] * w0[0]; f[1] += h[e] * w0[1]; f[2] += h[e] * w0[2]; f[3] += h[e] * w0[3];
                    f[4] += h[e] * w1[0]; f[5] += h[e] * w1[1]; f[6] += h[e] * w1[2]; f[7] += h[e] * w1[3];
                }
            }
        }
        if (FG) {
#pragma unroll
            for (int i = 0; i < 8; ++i) f[i] = wave_sum(f[i]);
            float fv = f[0];
            fv = lane == 1 ? f[1] : fv; fv = lane == 2 ? f[2] : fv; fv = lane == 3 ? f[3] : fv; fv = lane == 4 ? f[4] : fv;
            fv = lane == 5 ? f[5] : fv; fv = lane == 6 ? f[6] : fv; fv = lane == 7 ? f[7] : fv;
            if (lane < 8) {
                const float x = fv + F.in[16][lane];
                const float lf = fminf(x, 0.f) - log1pf(expf(-fabsf(x)));
                float* o = row < NP ? F.out + O_LFP + (size_t)row * 8 : F.out + O_LFS + (size_t)(row - NP) * 8;
                o[lane] = lf;
            }
        }
    }
}
__device__ __forceinline__ void phase_mixnorm(Frame& F) {
    const int lane = F.lane; const float* gs = F.in[27]; const float* gf = F.in[28];
    for (int row = F.gw; row < MT; row += F.NGW) {
#pragma unroll
        for (int part = 0; part < 2; ++part) {
            const bf16* src = (part == 0 ? F.U : F.O) + (size_t)row * DH + 8 * lane;
            const float* g = (part == 0 ? gs : gf) + 8 * lane;
            const u32x4 z = *(const u32x4*)src;
            float v[8] = {bflo(z.x), bfhi(z.x), bflo(z.y), bfhi(z.y), bflo(z.z), bfhi(z.z), bflo(z.w), bfhi(z.w)};
            float ss = 0.f;
#pragma unroll
            for (int i = 0; i < 8; ++i) ss += v[i] * v[i];
            const float rstd = 1.0f / sqrtf(wave_sum(ss) * (1.0f / DH) + EPS);
            const f32x4 g0 = *(const f32x4*)g, g1 = *(const f32x4*)(g + 4);
            u32x4 w; w.x = pk2(v[0] * rstd * g0[0], v[1] * rstd * g0[1]); w.y = pk2(v[2] * rstd * g0[2], v[3] * rstd * g0[3]);
            w.z = pk2(v[4] * rstd * g1[0], v[5] * rstd * g1[1]); w.w = pk2(v[6] * rstd * g1[2], v[7] * rstd * g1[3]);
            *(u32x4*)(F.HA + (size_t)row * DM + part * DH + 8 * lane) = w;
        }
    }
}
__device__ __forceinline__ void phase_finalnorm(Frame& F) {
    const int lane = F.lane; const float* gN = F.in[33];
    for (int row = F.gw; row < MT; row += F.NGW) {
        float* xr = F.out + (size_t)row * DM;
        f32x4 v[4]; float ss = 0.f;
#pragma unroll
        for (int j = 0; j < 4; ++j) { v[j] = *(const f32x4*)(xr + 4 * lane + 256 * j); ss += (v[j][0] * v[j][0] + v[j][1] * v[j][1]) + (v[j][2] * v[j][2] + v[j][3] * v[j][3]); }
        const float rstd = 1.0f / sqrtf(wave_sum(ss) * (1.0f / DM) + EPS);
#pragma unroll
        for (int j = 0; j < 4; ++j) { const f32x4 g4 = *(const f32x4*)(gN + 4 * lane + 256 * j); *(f32x4*)(xr + 4 * lane + 256 * j) = v[j] * rstd * g4; }
    }
}
__device__ __forceinline__ void phase_fcum(Frame& F) {
    LAS float* wt = (LAS float*)F.lds;
    const int tid = F.tid, lane = F.lane, wave = F.wave;
    for (int job = blockIdx.x; job < 96; job += F.G) {
        const float* src; float* dst; int b, h;
        if (job < 32) { b = job >> 3; h = job & 7; src = F.out + O_LFP + (size_t)b * 4096 * 8 + h; dst = F.F2P + (size_t)job * 4096; }
        else { const int j2 = job - 32; b = j2 >> 3; h = j2 & 7; src = F.in[6] + (size_t)b * 4096 * 8 + h; dst = F.F2S + (size_t)j2 * 4128; }
        float v[8]; float tsum = 0.f;
#pragma unroll
        for (int i = 0; i < 8; ++i) { v[i] = src[(size_t)(8 * tid + i) * 8]; tsum += v[i]; }
        float inc = tsum;
#pragma unroll
        for (int o = 1; o < 64; o <<= 1) { const float t = __shfl_up(inc, o); if (lane >= o) inc += t; }
        if (lane == 63) wt[wave] = inc;
        __syncthreads();
        float woff = 0.f, total = 0.f;
#pragma unroll
        for (int w = 0; w < 8; ++w) { const float x = wt[w]; if (w < wave) woff += x; total += x; }
        float run = woff + inc - tsum;
#pragma unroll
        for (int i = 0; i < 8; ++i) { run += v[i]; dst[8 * tid + i] = run * LOG2E; }
        if (job >= 32 && wave == 0) {
            float x = lane < 32 ? F.out[O_LFS + (size_t)(b * 32 + lane) * 8 + h] : 0.f;
#pragma unroll
            for (int o = 1; o < 64; o <<= 1) { const float t = __shfl_up(x, o); if (lane >= o) x += t; }
            if (lane < 32) dst[4096 + lane] = (total + x) * LOG2E;
        }
        __syncthreads();
    }
}
#define XB_TMO      128
#define XB_XCNT(j)  (256  + 64 * (j))
#define XB_XSUB(j)  (1280 + 64 * (j))
#define XB_XGEN(j)  (2304 + 64 * (j))
#define XB_TOP      3328
#define XB_TOPGEN   3392
#define XCD_BAR_WORDS 3456
#define XB_SPIN_CAP (1u << 18)

__device__ __forceinline__ unsigned xb_ld(unsigned* p)              { return __hip_atomic_load(p, __ATOMIC_RELAXED, __HIP_MEMORY_SCOPE_AGENT); }
__device__ __forceinline__ unsigned xb_add(unsigned* p, unsigned v) { return __hip_atomic_fetch_add(p, v, __ATOMIC_RELAXED, __HIP_MEMORY_SCOPE_AGENT); }
__device__ __forceinline__ unsigned xb_xcc_id() { return (unsigned)__builtin_amdgcn_s_getreg((3 << 11) | 20) & 0xFu; }
#define XB_SPIN(cond, bar) do { unsigned _sp = 0; while (cond) { __builtin_amdgcn_s_sleep(1); \
    if ((++_sp & 255u) == 0u) { if (xb_ld(&(bar)[XB_TMO])) break; if (_sp > XB_SPIN_CAP) { atomicAdd(&(bar)[XB_TMO], 1u); break; } } } } while (0)

struct XcdBarrier {
    unsigned* bar; unsigned x;
    volatile LAS unsigned* st;
};

__device__ __forceinline__ XcdBarrier xcd_barrier_post(unsigned* bar, volatile LAS unsigned* st) {
    XcdBarrier b; b.bar = bar; b.x = xb_xcc_id(); b.st = st;
    if (threadIdx.x == 0) (void)xb_add(&bar[XB_XCNT(b.x)], 1u);
    return b;
}
__device__ __forceinline__ void xcd_barrier_complete(unsigned* bar, unsigned x, unsigned& nloc, unsigned& nx) {
    const unsigned G = gridDim.x * gridDim.y * gridDim.z;
    unsigned sum, cnt, mine, sp = 0u;
    for (;;) {
        sum = 0u; cnt = 0u; mine = 0u;
#pragma unroll
        for (unsigned j = 0; j < 16; ++j) { const unsigned c = xb_ld(&bar[XB_XCNT(j)]); sum += c; cnt += (c > 0u) ? 1u : 0u; mine = (j == x) ? c : mine; }
        if (sum == G) break;
        __builtin_amdgcn_s_sleep(1);
        if ((++sp & 255u) == 0u) { if (xb_ld(&bar[XB_TMO])) break; if (sp > XB_SPIN_CAP) { atomicAdd(&bar[XB_TMO], 1u); break; } }
    }
    nloc = mine > 0u ? mine : 1u; nx = cnt > 0u ? cnt : 1u;
}

__device__ __forceinline__ void xcd_barrier(const XcdBarrier& b) {
    asm volatile("s_waitcnt vmcnt(0)" ::: "memory");
    __syncthreads();
    if (threadIdx.x == 0) {
        unsigned* bar = b.bar;
        __builtin_amdgcn_s_waitcnt(0);
        unsigned nloc = b.st[0], nx = b.st[1];
        if (nloc == 0u) { xcd_barrier_complete(bar, b.x, nloc, nx); b.st[0] = nloc; b.st[1] = nx; }
        const unsigned old = xb_add(&bar[XB_XSUB(b.x)], 1u);
        const unsigned gen = old / nloc;
        if (old + 1u == (gen + 1u) * nloc) {
            __builtin_amdgcn_fence(__ATOMIC_RELEASE, "agent");
            asm volatile("s_waitcnt vmcnt(0)" ::: "memory");
            const unsigned og = xb_add(&bar[XB_TOP], 1u);
            const unsigned tg = og / nx;
            if (og + 1u == (tg + 1u) * nx) xb_add(&bar[XB_TOPGEN], 1u);
            else XB_SPIN(xb_ld(&bar[XB_TOPGEN]) == tg, bar);
            __builtin_amdgcn_fence(__ATOMIC_ACQUIRE, "agent");
            xb_add(&bar[XB_XGEN(b.x)], 1u);
            asm volatile("s_waitcnt vmcnt(0)" ::: "memory");
        } else {
            XB_SPIN(xb_ld(&bar[XB_XGEN(b.x)]) == gen, bar);
            __builtin_amdgcn_fence(__ATOMIC_ACQUIRE, "agent");
            asm volatile("s_waitcnt vmcnt(0)" ::: "memory");
        }
    }
    __syncthreads();
}

constexpr int KP = 72, VP = 68;
__device__ __forceinline__ void attn_tile(const LAS bf16* kL, const LAS bf16* vL, const LAS float* fL, LAS float* wsf, const bf16x8 (&qr)[4], f32x16 (&o)[2],
                                          float& m, float& l, bool domask, int lim, int r32, int hi) {
    f32x16 p0, p1;
#pragma unroll
    for (int r = 0; r < 16; ++r) { p0[r] = 0.f; p1[r] = 0.f; }
#pragma unroll
    for (int d0 = 0; d0 < 4; ++d0) {
        const bf16x8 a0 = *(const LAS bf16x8*)(kL + r32 * KP + d0 * 16 + hi * 8);
        const bf16x8 a1 = *(const LAS bf16x8*)(kL + (32 + r32) * KP + d0 * 16 + hi * 8);
        p0 = __builtin_amdgcn_mfma_f32_32x32x16_bf16(a0, qr[d0], p0, 0, 0, 0);
        p1 = __builtin_amdgcn_mfma_f32_32x32x16_bf16(a1, qr[d0], p1, 0, 0, 0);
    }
#pragma unroll
    for (int rg = 0; rg < 4; ++rg) {
        const f32x4 fa = *(const LAS f32x4*)(fL + 8 * rg + 4 * hi), fb = *(const LAS f32x4*)(fL + 32 + 8 * rg + 4 * hi);
#pragma unroll
        for (int i = 0; i < 4; ++i) { p0[4 * rg + i] -= fa[i]; p1[4 * rg + i] -= fb[i]; }
    }
    if (domask) {
#pragma unroll
        for (int r = 0; r < 16; ++r) { const int kv = (r & 3) + 8 * (r >> 2) + 4 * hi; if (kv > lim) p0[r] = -INFINITY; if (kv + 32 > lim) p1[r] = -INFINITY; }
    }
    float mt = fmaxf(p0[0], p1[0]);
#pragma unroll
    for (int r = 1; r < 16; ++r) mt = fmaxf(mt, fmaxf(p0[r], p1[r]));
    mt = fmaxf(mt, __shfl_xor(mt, 32));
    const float mn = fmaxf(m, mt);
    const float alpha = __builtin_amdgcn_exp2f(m - mn);
    m = mn;
    float rs = 0.f;
#pragma unroll
    for (int r = 0; r < 16; ++r) { p0[r] = __builtin_amdgcn_exp2f(p0[r] - mn); p1[r] = __builtin_amdgcn_exp2f(p1[r] - mn); rs += p0[r] + p1[r]; }
    l = l * alpha + rs;
    if (hi == 0) wsf[r32] = alpha;
    LDS_WAIT();
#pragma unroll
    for (int rg = 0; rg < 4; ++rg) {
        const f32x4 al = *(const LAS f32x4*)(wsf + 8 * rg + 4 * hi);
#pragma unroll
        for (int i = 0; i < 4; ++i) { o[0][4 * rg + i] *= al[i]; o[1][4 * rg + i] *= al[i]; }
    }
    u32x4 pw[4];
    pw[0] = (u32x4){pk2(p0[0], p0[1]), pk2(p0[2], p0[3]), pk2(p0[4], p0[5]), pk2(p0[6], p0[7])};
    pw[1] = (u32x4){pk2(p0[8], p0[9]), pk2(p0[10], p0[11]), pk2(p0[12], p0[13]), pk2(p0[14], p0[15])};
    pw[2] = (u32x4){pk2(p1[0], p1[1]), pk2(p1[2], p1[3]), pk2(p1[4], p1[5]), pk2(p1[6], p1[7])};
    pw[3] = (u32x4){pk2(p1[8], p1[9]), pk2(p1[10], p1[11]), pk2(p1[12], p1[13]), pk2(p1[14], p1[15])};
#pragma unroll
    for (int d0 = 0; d0 < 2; ++d0)
#pragma unroll
        for (int s = 0; s < 4; ++s) {
            const s16x4 lo = *(const LAS s16x4*)(vL + (r32 + 32 * d0) * VP + 16 * s + 4 * hi);
            const s16x4 h4 = *(const LAS s16x4*)(vL + (r32 + 32 * d0) * VP + 16 * s + 8 + 4 * hi);
            const bf16x8 bv = (bf16x8){lo[0], lo[1], lo[2], lo[3], h4[0], h4[1], h4[2], h4[3]};
            o[d0] = __builtin_amdgcn_mfma_f32_32x32x16_bf16(__builtin_bit_cast(bf16x8, pw[s]), bv, o[d0], 0, 0, 0);
        }
    LDS_WAIT();
}
__device__ __forceinline__ void st16(LAS bf16* p, unsigned v) { *(LAS unsigned short*)p = (unsigned short)v; }
__device__ __forceinline__ void attn_prompt_unit(Frame& F, int b, int h, int qb) {
    const int tid = F.tid, lane = F.lane, wave = F.wave, r32 = lane & 31, hi = lane >> 5;
    LAS bf16* kbuf = (LAS bf16*)F.lds; LAS bf16* vbuf = (LAS bf16*)(F.lds + 18432); LAS float* fbuf = (LAS float*)(F.lds + 35840);
    LAS float* wsf = (LAS float*)(F.lds + 36352) + wave * 64;
    const int rowbase = b * 4096, q0 = qb * 256;
    const bf16* Qw = F.Q + (size_t)(rowbase + q0 + wave * 32) * DH + h * 64;
    bf16* Ow = F.O + (size_t)(rowbase + q0 + wave * 32) * DH + h * 64;
    bf16x8 qr[4];
#pragma unroll
    for (int d0 = 0; d0 < 4; ++d0) qr[d0] = *(const bf16x8*)(Qw + (size_t)r32 * DH + d0 * 16 + hi * 8);
    const int NT = 4 * (qb + 1), kvs = tid >> 3, c8 = tid & 7;
    const bf16* kg = F.KB + (size_t)(rowbase + kvs) * DH + h * 64 + 8 * c8;
    const bf16* vg = F.VB + (size_t)(rowbase + kvs) * DH + h * 64 + 8 * c8;
    const float* fg = F.F2P + (size_t)(b * 8 + h) * 4096;
    u32x4 kr = *(const u32x4*)kg, vr = *(const u32x4*)vg; float fr_ = tid < 64 ? fg[tid] : 0.f;
    float m = -1e30f, l = 0.f; f32x16 o[2];
#pragma unroll
    for (int r = 0; r < 16; ++r) { o[0][r] = 0.f; o[1][r] = 0.f; }
    const int qmin = q0 + wave * 32;
#define ATT_WRITE_TILE(t_) do { LAS bf16* kL_ = kbuf + ((t_) & 1) * (64 * KP); LAS bf16* vL_ = vbuf + ((t_) & 1) * (64 * VP); LAS float* fL_ = fbuf + ((t_) & 1) * 64; \
        *(LAS u32x4*)(kL_ + kvs * KP + 8 * c8) = kr; \
        st16(vL_ + (8 * c8 + 0) * VP + kvs, vr.x); st16(vL_ + (8 * c8 + 1) * VP + kvs, vr.x >> 16); \
        st16(vL_ + (8 * c8 + 2) * VP + kvs, vr.y); st16(vL_ + (8 * c8 + 3) * VP + kvs, vr.y >> 16); \
        st16(vL_ + (8 * c8 + 4) * VP + kvs, vr.z); st16(vL_ + (8 * c8 + 5) * VP + kvs, vr.z >> 16); \
        st16(vL_ + (8 * c8 + 6) * VP + kvs, vr.w); st16(vL_ + (8 * c8 + 7) * VP + kvs, vr.w >> 16); \
        if (tid < 64) fL_[tid] = fr_; } while (0)
    ATT_WRITE_TILE(0);
    __syncthreads();
    for (int t = 0; t < NT; ++t) {
        if (t + 1 < NT) { kr = *(const u32x4*)(kg + (size_t)(t + 1) * 64 * DH); vr = *(const u32x4*)(vg + (size_t)(t + 1) * 64 * DH); fr_ = tid < 64 ? fg[(t + 1) * 64 + tid] : 0.f; }
        if (64 * t <= qmin + 31) {
            const bool domask = (64 * t + 63 > qmin);
            attn_tile(kbuf + (t & 1) * (64 * KP), vbuf + (t & 1) * (64 * VP), fbuf + (t & 1) * 64, wsf, qr, o, m, l, domask, qmin + r32 - 64 * t, r32, hi);
        }
        if (t + 1 < NT) ATT_WRITE_TILE(t + 1);
        __syncthreads();
    }
#undef ATT_WRITE_TILE
    l += __shfl_xor(l, 32);
    if (hi == 0) wsf[r32] = 1.0f / l;
    LDS_WAIT();
#pragma unroll
    for (int rg = 0; rg < 4; ++rg) {
        const f32x4 rl = *(const LAS f32x4*)(wsf + 8 * rg + 4 * hi);
#pragma unroll
        for (int i = 0; i < 4; ++i) {
            const int q = 8 * rg + 4 * hi + i;
            Ow[(size_t)q * DH + r32] = (bf16)f2bf(o[0][4 * rg + i] * rl[i]);
            Ow[(size_t)q * DH + 32 + r32] = (bf16)f2bf(o[1][4 * rg + i] * rl[i]);
        }
    }
    LDS_WAIT();
    __syncthreads();
}
__device__ __forceinline__ void attn_sample_unit(Frame& F, int b, int h) {
    const int tid = F.tid, lane = F.lane, wave = F.wave, r32 = lane & 31, hi = lane >> 5;
    LAS unsigned char* wb = F.lds + wave * 18432;
    LAS bf16* kL = (LAS bf16*)wb; LAS bf16* vL = (LAS bf16*)(wb + 9216); LAS float* fL = (LAS float*)(wb + 17920); LAS float* wsf = (LAS float*)(wb + 18176);
    const int qrow0 = NP + b * 32;
    bf16x8 qr[4];
#pragma unroll
    for (int d0 = 0; d0 < 4; ++d0) qr[d0] = *(const bf16x8*)(F.Q + (size_t)(qrow0 + r32) * DH + h * 64 + d0 * 16 + hi * 8);
    float m = -1e30f, l = 0.f; f32x16 o[2];
#pragma unroll
    for (int r = 0; r < 16; ++r) { o[0][r] = 0.f; o[1][r] = 0.f; }
    const float* ck = F.in[4] + ((size_t)b * 4096 * 8 + h) * 64;
    const float* cv = F.in[5] + ((size_t)b * 4096 * 8 + h) * 64;
    const float* f2 = F.F2S + (size_t)(b * 8 + h) * 4128;
    const int c16 = lane & 15, kq = lane >> 4;
    for (int tt = 0; tt < 8; ++tt) {
        const int kv0 = wave * 512 + tt * 64;
#pragma unroll 4
        for (int i = 0; i < 16; ++i) {
            const int kv = kq + 4 * i;
            const f32x4 x = *(const f32x4*)(ck + (size_t)(kv0 + kv) * 512 + 4 * c16);
            const f32x4 y = *(const f32x4*)(cv + (size_t)(kv0 + kv) * 512 + 4 * c16);
            u32x2 w; w.x = pk2(x[0], x[1]); w.y = pk2(x[2], x[3]);
            *(LAS u32x2*)(kL + kv * KP + 4 * c16) = w;
            const unsigned y0 = pk2(y[0], y[1]), y1 = pk2(y[2], y[3]);
            st16(vL + (4 * c16 + 0) * VP + kv, y0); st16(vL + (4 * c16 + 1) * VP + kv, y0 >> 16);
            st16(vL + (4 * c16 + 2) * VP + kv, y1); st16(vL + (4 * c16 + 3) * VP + kv, y1 >> 16);
        }
        fL[lane] = f2[kv0 + lane];
        LDS_WAIT();
        attn_tile(kL, vL, fL, wsf, qr, o, m, l, false, 0, r32, hi);
    }
    if (wave == 7) {
        const int kv = lane >> 1, half = lane & 1;
        const bf16* kn = F.KB + (size_t)(qrow0 + kv) * DH + h * 64 + 32 * half;
        const bf16* vn = F.VB + (size_t)(qrow0 + kv) * DH + h * 64 + 32 * half;
#pragma unroll
        for (int i = 0; i < 4; ++i) {
            const u32x4 x = *(const u32x4*)(kn + 8 * i), y = *(const u32x4*)(vn + 8 * i);
            *(LAS u32x4*)(kL + kv * KP + 32 * half + 8 * i) = x;
            *(LAS u32x4*)(kL + (32 + kv) * KP + 32 * half + 8 * i) = (u32x4){0u, 0u, 0u, 0u};
            const int d = 32 * half + 8 * i;
            st16(vL + (d + 0) * VP + kv, y.x); st16(vL + (d + 1) * VP + kv, y.x >> 16); st16(vL + (d + 2) * VP + kv, y.y); st16(vL + (d + 3) * VP + kv, y.y >> 16);
            st16(vL + (d + 4) * VP + kv, y.z); st16(vL + (d + 5) * VP + kv, y.z >> 16); st16(vL + (d + 6) * VP + kv, y.w); st16(vL + (d + 7) * VP + kv, y.w >> 16);
#pragma unroll
            for (int e = 0; e < 8; ++e) st16(vL + (d + e) * VP + 32 + kv, 0u);
        }
        fL[lane] = lane < 32 ? f2[4096 + lane] : 0.f;
        LDS_WAIT();
        attn_tile(kL, vL, fL, wsf, qr, o, m, l, true, r32, r32, hi);
    }
    l += __shfl_xor(l, 32);
    __syncthreads();
    LAS float* cm = (LAS float*)F.lds; LAS float* cl = cm + 256; LAS float* co = cl + 256;
    if (hi == 0) { cm[wave * 32 + r32] = m; cl[wave * 32 + r32] = l; }
#pragma unroll
    for (int r = 0; r < 16; ++r) {
        const int q = (r & 3) + 8 * (r >> 2) + 4 * hi;
        co[(wave * 32 + q) * 64 + r32] = o[0][r]; co[(wave * 32 + q) * 64 + 32 + r32] = o[1][r];
    }
    __syncthreads();
    {
        const int q = tid >> 4, dg = tid & 15;
        float M = cm[q];
#pragma unroll
        for (int w = 1; w < 8; ++w) M = fmaxf(M, cm[w * 32 + q]);
        float L = 0.f; f32x4 acc = (f32x4){0.f, 0.f, 0.f, 0.f};
#pragma unroll
        for (int w = 0; w < 8; ++w) {
            const float wg = __builtin_amdgcn_exp2f(cm[w * 32 + q] - M);
            L += cl[w * 32 + q] * wg;
            acc += *(const LAS f32x4*)(co + (w * 32 + q) * 64 + 4 * dg) * wg;
        }
        const float rl = 1.0f / L;
        u32x2 w2; w2.x = pk2(acc[0] * rl, acc[1] * rl); w2.y = pk2(acc[2] * rl, acc[3] * rl);
        *(u32x2*)(F.O + (size_t)(qrow0 + q) * DH + h * 64 + 4 * dg) = w2;
    }
    __syncthreads();
}

__device__ __forceinline__ void s5_decode(int item, int& g, int& ci, int& row0, int& nT) {
    g = item / S5_ITEMS_PER_G; ci = item % S5_ITEMS_PER_G;
    if (ci < 256) { row0 = (ci >> 6) * 4096 + (ci & 63) * 64; nT = 64; } else { row0 = NP + (ci - 256) * 32; nT = 32; }
}
__device__ __forceinline__ void s5_load_u(Frame& F, LAS float* uL, int row0, int g, int nT) {
    if (F.lane < nT) {
        const bf16* up = F.U + (size_t)(row0 + F.lane) * DH + g * 16;
        const u32x4 a = *(const u32x4*)up, b = *(const u32x4*)(up + 8);
        LAS f32x4* d = (LAS f32x4*)(uL + F.lane * 16);
        d[0] = (f32x4){bflo(a.x), bfhi(a.x), bflo(a.y), bfhi(a.y)}; d[1] = (f32x4){bflo(a.z), bfhi(a.z), bflo(a.w), bfhi(a.w)};
        d[2] = (f32x4){bflo(b.x), bfhi(b.x), bflo(b.y), bfhi(b.y)}; d[3] = (f32x4){bflo(b.z), bfhi(b.z), bflo(b.w), bfhi(b.w)};
    }
    LDS_WAIT();
}
__device__ __forceinline__ f32x2 s5_step(const f32x2 a, const f32x2 s, const f32x2 (&bb)[16], const LAS float* ur) {
    const f32x4 u0 = *(const LAS f32x4*)ur, u1 = *(const LAS f32x4*)(ur + 4), u2 = *(const LAS f32x4*)(ur + 8), u3 = *(const LAS f32x4*)(ur + 12);
    f32x2 bu = bb[0] * u0[0];
    bu += bb[1] * u0[1]; bu += bb[2] * u0[2]; bu += bb[3] * u0[3];
    bu += bb[4] * u1[0]; bu += bb[5] * u1[1]; bu += bb[6] * u1[2]; bu += bb[7] * u1[3];
    bu += bb[8] * u2[0]; bu += bb[9] * u2[1]; bu += bb[10] * u2[2]; bu += bb[11] * u2[3];
    bu += bb[12] * u3[0]; bu += bb[13] * u3[1]; bu += bb[14] * u3[2]; bu += bb[15] * u3[3];
    f32x2 n; n.x = a.x * s.x - a.y * s.y + bu.x; n.y = a.x * s.y + a.y * s.x + bu.y;
    return n;
}
__device__ __forceinline__ void s5_pass_a(Frame& F, int wq, int nwq) {
    LAS float* uL = (LAS float*)(F.lds + F.wave * 12800);
    for (int item = wq; item < S5_ITEMS; item += nwq) {
        int g, ci, row0, nT; s5_decode(item, g, ci, row0, nT);
        if (ci >= 256) continue;
        const f32x2 a = F.abar[g * 64 + F.lane];
        f32x2 bb[16];
#pragma unroll
        for (int c = 0; c < 16; ++c) bb[c] = F.bbar[(size_t)(g * 64 + F.lane) * 16 + c];
        s5_load_u(F, uL, row0, g, nT);
        f32x2 s = (f32x2){0.f, 0.f};
#pragma unroll 4
        for (int j = 0; j < 64; ++j) s = s5_step(a, s, bb, uL + j * 16);
        F.E[(size_t)item * 64 + F.lane] = s;
        LDS_WAIT();
    }
}
__device__ __forceinline__ void s5_pass_c(Frame& F) {
    LAS float* uL = (LAS float*)(F.lds + F.wave * 12800);
    LAS bf16* Sb = (LAS bf16*)(F.lds + F.wave * 12800 + 4096);
    const int lane = F.lane, fr = lane & 15, fq = lane >> 4;
    for (int item = F.gw; item < S5_ITEMS; item += F.NGW) {
        int g, ci, row0, nT; s5_decode(item, g, ci, row0, nT);
        const f32x2 a = F.abar[g * 64 + lane];
        f32x2 bb[16];
#pragma unroll
        for (int c = 0; c < 16; ++c) bb[c] = F.bbar[(size_t)(g * 64 + lane) * 16 + c];
        bf16x8 cmf[4];
#pragma unroll
        for (int ks = 0; ks < 4; ++ks) cmf[ks] = *(const bf16x8*)(F.cmt + (g * 16 + fr) * 128 + 32 * ks + 8 * fq);
        const f32x4 dv = *(const f32x4*)(F.in[24] + g * 16 + 4 * fq);
        f32x2 s;
        if (ci < 256) {
            s = (f32x2){0.f, 0.f};
            const f32x2 aa = F.a64[g * 64 + lane];
            const f32x2* ep = F.E + (size_t)(g * S5_ITEMS_PER_G + (ci & ~63)) * 64 + lane;
            const int nprev = ci & 63;
            const int off = (16 - (nprev & 15)) & 15;
            for (int i0 = -off; i0 < nprev; i0 += 16) {
                f32x2 e[16];
#pragma unroll
                for (int u = 0; u < 16; ++u) e[u] = (i0 + u >= 0) ? ep[(size_t)(i0 + u) * 64] : (f32x2){0.f, 0.f};
#pragma unroll
                for (int u = 0; u < 16; ++u) { f32x2 n; n.x = aa.x * s.x - aa.y * s.y + e[u].x; n.y = aa.x * s.y + aa.y * s.x + e[u].y; s = n; }
            }
        } else {
            const int sb = ci - 256;
            s = (f32x2){F.in[7][(size_t)(sb * 32 + g) * 64 + lane], F.in[8][(size_t)(sb * 32 + g) * 64 + lane]};
        }
        s5_load_u(F, uL, row0, g, nT);
        for (int half = 0; half < (nT >> 5); ++half) {
#pragma unroll 4
            for (int jj = 0; jj < 32; ++jj) {
                s = s5_step(a, s, bb, uL + (half * 32 + jj) * 16);
                st16(Sb + jj * 136 + lane, f2bf(s.x)); st16(Sb + jj * 136 + 64 + lane, f2bf(s.y));
            }
            LDS_WAIT();
#pragma unroll
            for (int jb = 0; jb < 2; ++jb) {
                f32x4 acc = (f32x4){0.f, 0.f, 0.f, 0.f};
#pragma unroll
                for (int ks = 0; ks < 4; ++ks) {
                    const bf16x8 sf = *(const LAS bf16x8*)(Sb + (jb * 16 + fr) * 136 + 32 * ks + 8 * fq);
                    acc = __builtin_amdgcn_mfma_f32_16x16x32_bf16(cmf[ks], sf, acc, 0, 0, 0);
                }
                const int j = half * 32 + jb * 16 + fr;
                const f32x4 u4 = *(const LAS f32x4*)(uL + j * 16 + 4 * fq);
                float y[4];
#pragma unroll
                for (int i = 0; i < 4; ++i) { const float t = acc[i] + dv[i] * u4[i]; y[i] = t * fsigmoid(1.5957691216057308f * (t + 0.044715f * t * t * t)); }
                u32x2 w; w.x = pk2(y[0], y[1]); w.y = pk2(y[2], y[3]);
                *(u32x2*)(F.Z + (size_t)(row0 + j) * DH + g * 16 + 4 * fq) = w;
            }
            LDS_WAIT();
        }
        if (ci >= 256) { const int sb = ci - 256; F.out[O_SRS + (size_t)(sb * 32 + g) * 64 + lane] = s.x; F.out[O_SIS + (size_t)(sb * 32 + g) * 64 + lane] = s.y; }
        else if ((ci & 63) == 63) { const int b = ci >> 6; F.out[O_SRP + (size_t)(b * 32 + g) * 64 + lane] = s.x; F.out[O_SIP + (size_t)(b * 32 + g) * 64 + lane] = s.y; }
    }
}


struct SkSwiglu { bf16* H;
    __device__ __forceinline__ int brow(int ct, int nb) const { return 256 * (ct >> 2) + 32 * (ct & 3) + 128 * nb; }
    __device__ __forceinline__ void operator()(int row, int ct, int j0, const float (&v)[2][2]) const {
        const float a = v[0][0] * fsigmoid(v[0][0]) * v[1][0], b = v[0][1] * fsigmoid(v[0][1]) * v[1][1];
        *(unsigned*)(H + (size_t)(NP + row) * FF + 32 * ct + j0) = pk2(a, b); } };
struct SkResid { const float* xin; float* out; const float* mod; int gi; float gscale;
    __device__ __forceinline__ int brow(int ct, int) const { return 32 * ct; }
    __device__ __forceinline__ void operator()(int row, int ct, int j0, const float (&v)[1][2]) const {
        const int col = 32 * ct + j0; const float* gate = mod + (4 + (row >> 5)) * NMOD + gi * DM + col;
        const f32x2 x = *(const f32x2*)(xin + (size_t)row * DM + col), g = *(const f32x2*)gate;
        f32x2 o; o.x = x.x + gscale * (1.f + g.x) * v[0][0]; o.y = x.y + gscale * (1.f + g.y) * v[0][1];
        *(f32x2*)(out + (size_t)row * DM + col) = o; } };
struct SkIn { bf16 *U, *Q, *KB, *VB; float* out;
    __device__ __forceinline__ int brow(int ct, int) const { return 32 * ct; }
    __device__ __forceinline__ void operator()(int row, int ct, int j0, const float (&v)[1][2]) const {
        const int n = 32 * ct + j0, t = n >> 9, col = n & 511; const float sc = t == 1 ? QSCALE : 1.f;
        bf16* dst = U + (size_t)t * (17 * MiB / 2);
        *(unsigned*)(dst + (size_t)(NP + row) * DH + col) = pk2(v[0][0] * sc, v[0][1] * sc);
        if (t >= 2) *(f32x2*)(out + (t == 2 ? O_KS : O_VS) + (size_t)row * DH + col) = (f32x2){v[0][0], v[0][1]}; } };
struct SkGlu { const bf16* Z; bf16* Y; const float* bglu;
    __device__ __forceinline__ int brow(int ct, int) const { return 32 * ct; }
    __device__ __forceinline__ void operator()(int row, int ct, int j0, const float (&v)[1][2]) const {
        const int col = 32 * ct + j0; const unsigned z = *(const unsigned*)(Z + (size_t)(NP + row) * DH + col);
        *(unsigned*)(Y + (size_t)(NP + row) * DH + col) = pk2(bflo(z) * fsigmoid(v[0][0] + bglu[col]), bfhi(z) * fsigmoid(v[0][1] + bglu[col + 1])); } };
template <int NB, int KS, class Epi>
__device__ __forceinline__ void skinny_gemm(Frame& F, const bf16* A, const bf16* Bt, int ntc, const Epi& E) {
    constexpr int K = KS * 128;
    const int lane = F.lane, wave = F.wave, r32 = lane & 31, hi = lane >> 5, tid = F.tid;
    LAS float* red = (LAS float*)F.lds;
    for (int tile = blockIdx.x; tile < 8 * ntc; tile += F.G) {
        const int rt = tile / ntc, ct = tile % ntc;
        const bf16* ap = A + (size_t)(32 * rt + r32) * K + wave * (K / 8) + 8 * hi;
        f32x16 acc[NB];
#pragma unroll
        for (int nb = 0; nb < NB; ++nb)
#pragma unroll
            for (int r = 0; r < 16; ++r) acc[nb][r] = 0.f;
        const bf16* bp0 = Bt + (size_t)(E.brow(ct, 0) + r32) * K + wave * (K / 8) + 8 * hi;
        const bf16* bp1 = Bt + (size_t)(E.brow(ct, NB - 1) + r32) * K + wave * (K / 8) + 8 * hi;
        constexpr int SB = (KS % 11 == 0) ? 11 : KS;
#pragma unroll 1
        for (int s0 = 0; s0 < KS; s0 += SB) {
            bf16x8 af[SB], b0[SB], b1[SB];
#pragma unroll
            for (int s = 0; s < SB; ++s) { af[s] = *(const bf16x8*)(ap + 16 * (s0 + s)); b0[s] = *(const bf16x8*)(bp0 + 16 * (s0 + s)); if (NB == 2) b1[s] = *(const bf16x8*)(bp1 + 16 * (s0 + s)); }
#pragma unroll
            for (int s = 0; s < SB; ++s) {
                acc[0] = __builtin_amdgcn_mfma_f32_32x32x16_bf16(af[s], b0[s], acc[0], 0, 0, 0);
                if (NB == 2) acc[NB - 1] = __builtin_amdgcn_mfma_f32_32x32x16_bf16(af[s], b1[s], acc[NB - 1], 0, 0, 0);
            }
        }
#pragma unroll
        for (int nb = 0; nb < NB; ++nb)
#pragma unroll
            for (int r = 0; r < 16; ++r) red[((wave * NB + nb) * 32 + (r & 3) + 8 * (r >> 2) + 4 * hi) * 32 + r32] = acc[nb][r];
        __syncthreads();
        {
            const int i = tid >> 4, j0 = 2 * (tid & 15);
            float v[NB][2];
#pragma unroll
            for (int nb = 0; nb < NB; ++nb) { v[nb][0] = 0.f; v[nb][1] = 0.f;
#pragma unroll
                for (int w = 0; w < 8; ++w) { const f32x2 x = *(const LAS f32x2*)(red + ((w * NB + nb) * 32 + i) * 32 + j0); v[nb][0] += x.x; v[nb][1] += x.y; } }
            E(32 * rt + i, ct, j0, v);
        }
        __syncthreads();
    }
}

__global__ void __launch_bounds__(512, 2) mk_fwd(Args args) {
    extern __shared__ __attribute__((aligned(16))) unsigned char lds_raw[];
    cg::grid_group grid = cg::this_grid();
    Frame F;
    F.lds = (LAS unsigned char*)lds_raw;
    F.tid = threadIdx.x; F.lane = F.tid & 63; F.wave = __builtin_amdgcn_readfirstlane(F.tid >> 6);
    F.G = gridDim.x; { const int bx = blockIdx.x; F.vcu = (F.G % 8 == 0) ? (bx % 8) * (F.G / 8) + bx / 8 : bx; }
    F.gw = blockIdx.x * NWAVES + F.wave; F.NGW = F.G * NWAVES;
#pragma unroll
    for (int i = 0; i < 34; ++i) F.in[i] = args.in[i];
    F.out = args.out;
    unsigned char* ws = args.ws;
    F.mod = (float*)(ws + WS_MOD);
    F.abar = (f32x2*)(ws + WS_S5C); F.a64 = (f32x2*)(ws + WS_S5C + 16384); F.bbar = (f32x2*)(ws + WS_S5C + 32768); F.cmt = (bf16*)(ws + WS_S5C + 294912);
    F.F2P = (float*)(ws + WS_F2P); F.F2S = (float*)(ws + WS_F2S); F.E = (f32x2*)(ws + WS_E);
    F.WUP1 = (bf16*)(ws + WS_WUP1); F.WDN1 = (bf16*)(ws + WS_WDN1); F.WIN = (bf16*)(ws + WS_WIN); F.WGLU = (bf16*)(ws + WS_WGLU); F.WOUT = (bf16*)(ws + WS_WOUT);
    F.WUP2 = (bf16*)(ws + WS_WUP2); F.WDN2 = (bf16*)(ws + WS_WDN2); F.HA = (bf16*)(ws + WS_HA); F.HID = (bf16*)(ws + WS_HID);
    F.U = (bf16*)(ws + WS_U); F.Q = (bf16*)(ws + WS_Q); F.KB = (bf16*)(ws + WS_KB); F.VB = (bf16*)(ws + WS_VB); F.Z = (bf16*)(ws + WS_Z); F.O = (bf16*)(ws + WS_O);
    const int lo = args.ph_lo, hi = args.ph_hi;
    volatile LAS unsigned* misc = (volatile LAS unsigned*)(F.lds + LDS_BYTES - 256);
    if (F.tid < 2) misc[F.tid] = 0u;
    __syncthreads();
    XcdBarrier xbar; xbar.bar = (unsigned*)(ws + WS_BAR); xbar.x = 0; xbar.st = nullptr;
    if (hi - lo > 1) xbar = xcd_barrier_post((unsigned*)(ws + WS_BAR), misc);
#define IN(k) (lo <= (k) && (k) < hi)
#define REPS(k) _Pragma("nounroll") for (int rep_ = 0; rep_ < 1 + ((MK_REP_MASK >> (k)) & 1); ++rep_)
#define SEAM(k) do { if (IN(k) && IN((k) + 1)) { if ((k) == 100) grid.sync(); else xcd_barrier(xbar); } } while (0)
    typedef pg8::StaticOrder SO;
    float* xs_out = F.out + (size_t)NP * DM;

    if (hi > 1000) grid.sync();
    if (IN(0)) { phase_ada(F); phase_s5const(F); phase_weights(F);
#ifdef MK_PROBE_P0
        __syncthreads(); phase_ada(F); phase_weights(F);
#endif
    }
    SEAM(0);
    if (IN(1)) REPS(1) phase_norm<false>(F, F.in[0], F.in[1], F.in[11], 0, 1);
    SEAM(1);
    if (IN(2)) REPS(2) { pg8::Gemm g{F.HA, F.WUP1, NP, NUP, DM}; SO S; S.init(NP, NUP, F.G, (int)blockIdx.x); EpiSwiglu E{F.HID};
        pg8::gemm_phase<EpiSwiglu, SO, PG8_ALIGN, PG8_SP2>(F.lds, g, S, E);
        skinny_gemm<2, 8>(F, F.HA + (size_t)NP * DM, F.WUP1, 88, SkSwiglu{F.HID}); }
    SEAM(2);
    if (IN(3)) REPS(3) { pg8::Gemm g{F.HID, F.WDN1, NP, DM, FF}; SO S; S.init(NP, DM, F.G, (int)blockIdx.x); EpiResid E{F.in[0], F.in[1], F.out, F.mod, 2, 0.5f};
        pg8::gemm_phase<EpiResid, SO, PG8_ALIGN, PG8_SP2>(F.lds, g, S, E);
        skinny_gemm<1, 22>(F, F.HID + (size_t)NP * FF, F.WDN1, 32, SkResid{F.in[1], xs_out, F.mod, 2, 0.5f}); }
    SEAM(3);
    if (IN(4)) REPS(4) phase_norm<true>(F, F.out, xs_out, F.in[14], 3, 4);
    SEAM(4);
    if (IN(5)) REPS(5) { phase_fcum(F);
        pg8::Gemm g{F.HA, F.WIN, NP, 2048, DM}; SO S; S.init(NP, 2048, F.G, (int)blockIdx.x); EpiIn E{F.U, F.Q, F.KB, F.VB, F.out};
        pg8::gemm_phase<EpiIn, SO, PG8_ALIGN, PG8_SP2>(F.lds, g, S, E);
        skinny_gemm<1, 8>(F, F.HA + (size_t)NP * DM, F.WIN, 64, SkIn{F.U, F.Q, F.KB, F.VB, F.out}); }
    SEAM(5);
    if (IN(6)) {
        for (int uix_ = F.vcu; uix_ < 256 * (1 + ((MK_REP_MASK >> 6) & 1)); uix_ += F.G) {
            const int uix = uix_ & 255, bh = uix >> 3, s = uix & 7;
            attn_prompt_unit(F, bh >> 3, bh & 7, 15 - s);
            attn_prompt_unit(F, bh >> 3, bh & 7, s);
        }
        const int nsamp_cu = F.G >= 128 ? 64 : 0;
        if (nsamp_cu) {
            if (F.vcu < 64) attn_sample_unit(F, F.vcu >> 3, F.vcu & 7);
            else s5_pass_a(F, (F.vcu - 64) * NWAVES + F.wave, (F.G - 64) * NWAVES);
        } else {
            for (int j = F.vcu; j < 64; j += F.G) attn_sample_unit(F, j >> 3, j & 7);
            s5_pass_a(F, F.gw, F.NGW);
        }
        __syncthreads();
#ifdef MK_PROBE_TAIL
        if (F.vcu < 64) attn_sample_unit(F, F.vcu >> 3, F.vcu & 7); else s5_pass_a(F, (F.vcu - 64) * NWAVES + F.wave, (F.G - 64) * NWAVES);
        __syncthreads();
#endif
    }
    SEAM(6);
    if (IN(7)) REPS(7) s5_pass_c(F);
    SEAM(7);
    if (IN(8)) REPS(8) { pg8::Gemm g{F.Z, F.WGLU, NP, DH, DH}; SO S; S.init(NP, DH, F.G, (int)blockIdx.x); EpiGlu E{F.Z, F.U, F.in[26]};
        pg8::gemm_phase<EpiGlu, SO, PG8_ALIGN, PG8_SP2>(F.lds, g, S, E);
        skinny_gemm<1, 4>(F, F.Z + (size_t)NP * DH, F.WGLU, 16, SkGlu{F.Z, F.U, F.in[26]}); }
    SEAM(8);
    if (IN(9)) REPS(9) phase_mixnorm(F);
    SEAM(9);
    if (IN(10)) REPS(10) { pg8::Gemm g{F.HA, F.WOUT, NP, DM, DM}; SO S; S.init(NP, DM, F.G, (int)blockIdx.x); EpiResid E{F.out, xs_out, F.out, F.mod, 5, 1.0f};
        pg8::gemm_phase<EpiResid, SO, PG8_ALIGN, PG8_SP2>(F.lds, g, S, E);
        skinny_gemm<1, 8>(F, F.HA + (size_t)NP * DM, F.WOUT, 32, SkResid{xs_out, xs_out, F.mod, 5, 1.0f}); }
    SEAM(10);
    if (IN(11)) REPS(11) phase_norm<false>(F, F.out, xs_out, F.in[30], 6, 7);
    SEAM(11);
    if (IN(12)) REPS(12) { pg8::Gemm g{F.HA, F.WUP2, NP, NUP, DM}; SO S; S.init(NP, NUP, F.G, (int)blockIdx.x); EpiSwiglu E{F.HID};
        pg8::gemm_phase<EpiSwiglu, SO, PG8_ALIGN, PG8_SP2>(F.lds, g, S, E);
        skinny_gemm<2, 8>(F, F.HA + (size_t)NP * DM, F.WUP2, 88, SkSwiglu{F.HID}); }
    SEAM(12);
    if (IN(13)) REPS(13) { pg8::Gemm g{F.HID, F.WDN2, NP, DM, FF}; SO S; S.init(NP, DM, F.G, (int)blockIdx.x); EpiResid E{F.out, xs_out, F.out, F.mod, 8, 0.5f};
        pg8::gemm_phase<EpiResid, SO, PG8_ALIGN, PG8_SP2>(F.lds, g, S, E);
        skinny_gemm<1, 22>(F, F.HID + (size_t)NP * FF, F.WDN2, 32, SkResid{xs_out, xs_out, F.mod, 8, 0.5f}); }
    SEAM(13);
#ifdef MK_EXTRA_SYNCS
    for (int i_ = 0; i_ < MK_EXTRA_SYNCS; ++i_) xcd_barrier(xbar);
#endif
    if (IN(14)) REPS(14) phase_finalnorm(F);
#undef IN
#undef SEAM
}
constexpr int N_PHASES = 15;

#ifndef MK_MULTI
#define MK_MULTI 0
#endif
extern "C" void kernel_launch(void* const* d_in, const int* in_sizes, int n_in, void* d_out, int out_size, void* d_ws, size_t ws_size, hipStream_t stream) {
    static int grid = 0;
    if (grid == 0) {
        int dev = 0, cus = 0, per_cu = 0;
        if (hipGetDevice(&dev) != hipSuccess || hipDeviceGetAttribute(&cus, hipDeviceAttributeMultiprocessorCount, dev) != hipSuccess) { fprintf(stderr, "kernel_launch: device query failed\n"); grid = -1; return; }
        if (hipFuncSetAttribute((const void*)mk_fwd, hipFuncAttributeMaxDynamicSharedMemorySize, LDS_BYTES) != hipSuccess) { fprintf(stderr, "kernel_launch: hipFuncSetAttribute failed\n"); grid = -1; return; }
        if (hipOccupancyMaxActiveBlocksPerMultiprocessor(&per_cu, (const void*)mk_fwd, NWAVES * 64, LDS_BYTES) != hipSuccess || per_cu < 1) per_cu = 1;
        (void)hipGetLastError();
        grid = cus;
        if (n_in != 34 || ws_size < 176 * MiB) fprintf(stderr, "kernel_launch: unexpected n_in %d / ws %zu\n", n_in, ws_size);
    }
    if (grid < 0) return;
    if (hipMemsetAsync((char*)d_ws + WS_BAR, 0, 16384, stream) != hipSuccess) { fprintf(stderr, "kernel_launch: memset failed\n"); return; }
    Args a{};
    for (int i = 0; i < 34; ++i) a.in[i] = (const float*)d_in[i];
    a.out = (float*)d_out; a.ws = (unsigned char*)d_ws;
#if MK_MULTI
    for (int p = 0; p < N_PHASES; ++p) { a.ph_lo = p; a.ph_hi = p + 1; hipLaunchKernelGGL(mk_fwd, dim3(grid), dim3(NWAVES * 64), LDS_BYTES, stream, a); }
#else
    a.ph_lo = 0; a.ph_hi = N_PHASES;
    void* kargs[] = {&a};
    const hipError_t e = hipLaunchCooperativeKernel((const void*)mk_fwd, dim3(grid), dim3(NWAVES * 64), kargs, LDS_BYTES, stream);
    if (e != hipSuccess) fprintf(stderr, "kernel_launch: cooperative launch failed: %s (grid %d)\n", hipGetErrorString(e), grid);
#endif
}
```

```cpp
#define MK_REP_MASK 0
#include <hip/hip_runtime.h>
#include <hip/hip_cooperative_groups.h>
#include <cstdio>
#include <cstdint>
namespace cg = cooperative_groups;
namespace pg8 {
#define PG8_LAS __attribute__((address_space(3)))
typedef unsigned short bf16_t;
typedef short bf16x8 __attribute__((ext_vector_type(8)));
typedef float f32x4 __attribute__((ext_vector_type(4)));
typedef unsigned u32x4 __attribute__((ext_vector_type(4)));
constexpr int BM = 256, BK = 64, HALF = 128, HTB = HALF * BK * 2  , STAGE_BYTES = 8 * HTB, NXCD = 8, WGM = 8;

__host__ __device__ __forceinline__ int lds_byte(int r, int c) { const int st = (r >> 4) * 2 + (c >> 5), rr = r & 15, cc = c & 31, ob = rr * 64 + cc * 2; return st * 1024 + (ob ^ (((ob >> 9) & 1) << 5)); }
__host__ __device__ __forceinline__ void stage_rc(int b, int& R, int& C) { const int st = b / 1024, sb = b % 1024, swz = sb ^ (((sb >> 9) & 1) << 5); R = (st >> 1) * 16 + swz / 64; C = (st & 1) * 32 + (swz % 64) / 2; }
__host__ __device__ __forceinline__ int perm32(int rho) { const int n = rho >> 4, i = rho & 15; return 8 * (i >> 2) + 4 * n + (i & 3); }

struct Unit { int pm, pn; };
struct Gemm { const bf16_t* A; const bf16_t* Bt; int M, N, K; };

struct StaticOrder {
    int nM, nN, nwg, G, c;
    __host__ __device__ void init(int M, int N, int G_, int c_) { nM = M / BM; nN = N / BM; nwg = nM * nN; G = G_; c = c_; }
    __host__ __device__ bool next(int i, Unit& u) const {
        const long L = (long)i * G + c; if (L >= nwg) return false;
        int wgid = (int)L; { const int q = nwg / NXCD, r = nwg % NXCD, xcd = wgid % NXCD, off = wgid / NXCD; wgid = (xcd < r ? xcd * (q + 1) : r * (q + 1) + (xcd - r) * q) + off; }
        const int nig = WGM * nN, gid = wgid / nig, fm = gid * WGM, gsz = (nM - fm) < WGM ? (nM - fm) : WGM;
        u.pm = fm + ((wgid % nig) % gsz); u.pn = (wgid % nig) / gsz; return true;
    }
    __device__ __forceinline__ void a_ready(const Unit&) const {}
    __device__ __forceinline__ void done(const Unit&) const {}
};

__device__ __forceinline__ unsigned cvt_pk_bf16(float lo, float hi) { unsigned r; asm volatile("v_cvt_pk_bf16_f32 %0, %1, %2" : "=v"(r) : "v"(lo), "v"(hi)); return r; }
typedef float f32x2 __attribute__((ext_vector_type(2)));
__device__ __forceinline__ f32x2 gelu_pk(f32x2 v) {
    const f32x2 av = __builtin_elementwise_abs(v), d = av * 0.2316418882f + 1.0f;
    f32x2 t; t.x = __builtin_amdgcn_rcpf(d.x); t.y = __builtin_amdgcn_rcpf(d.y);
    f32x2 q = t * 0.5307027145f + (-0.7265760135f); q = q * t + 0.7107068705f; q = q * t + (-0.142248368f); q = q * t + 0.127414796f; q = q * t;
    const f32x2 s = (v * v) * (-0.72134752044f);
    f32x2 e; e.x = __builtin_amdgcn_exp2f(s.x); e.y = __builtin_amdgcn_exp2f(s.y);
    const f32x2 m = v * (q * e), r = v - m;
    f32x2 o; o.x = v.x < 0.f ? m.x : r.x; o.y = v.y < 0.f ? m.y : r.y; return o;
}

template <int ACT  > struct EpiBf16 {
    static constexpr bool PERM = true, AFTER_DRAIN = false; static_assert(ACT == 0 || ACT == 1, "EpiBf16: ACT is 0 (none) or 1 (gelu_pk)");
    bf16_t* O; int ldc; const float* bias; int split_cols; size_t split_stride; float scale0;
    __device__ __forceinline__ void operator()(const f32x4 (&acc)[2][2][4][2], const Unit& u, int wr, int wc, int fr, int fq) const {
        const int row0 = u.pm * BM + wr * 64 + fr; int colt = u.pn * BM; bf16_t* base = O;
        float sc = 1.f; if (split_cols) { const int t = colt / split_cols; base += (size_t)t * split_stride; colt -= t * split_cols; if (t == 0) sc = scale0; }
        const int col0 = colt + wc * 32 + 8 * fq, bcol0 = u.pn * BM + wc * 32 + 8 * fq;
        f32x4 bv[2][2];
#pragma unroll
        for (int bj = 0; bj < 2; ++bj)
#pragma unroll
            for (int n = 0; n < 2; ++n) bv[bj][n] = bias ? *(const f32x4*)(bias + bcol0 + bj * HALF + 4 * n) : (f32x4){0.f, 0.f, 0.f, 0.f};
#pragma unroll
        for (int ai = 0; ai < 2; ++ai)
#pragma unroll
            for (int m = 0; m < 4; ++m) { bf16_t* rowp = base + (size_t)(row0 + ai * HALF + m * 16) * ldc + col0;
#pragma unroll
                for (int bj = 0; bj < 2; ++bj) { f32x4 v0 = acc[ai][bj][m][0] + bv[bj][0], v1 = acc[ai][bj][m][1] + bv[bj][1];
                    if (ACT == 1) { f32x2 a = gelu_pk((f32x2){v0[0], v0[1]}), b = gelu_pk((f32x2){v0[2], v0[3]}), c = gelu_pk((f32x2){v1[0], v1[1]}), d = gelu_pk((f32x2){v1[2], v1[3]});
                        v0 = (f32x4){a.x, a.y, b.x, b.y}; v1 = (f32x4){c.x, c.y, d.x, d.y}; }
                    v0 = v0 * sc; v1 = v1 * sc; u32x4 w; w.x = cvt_pk_bf16(v0[0], v0[1]); w.y = cvt_pk_bf16(v0[2], v0[3]); w.z = cvt_pk_bf16(v1[0], v1[1]); w.w = cvt_pk_bf16(v1[2], v1[3]);
                    *(u32x4*)(rowp + bj * HALF) = w; } }
    }
};


template <class Epi, class Sched, bool ALIGN_EPI = false, bool SP2 = false>
__device__ __forceinline__ void gemm_phase(PG8_LAS unsigned char* lds, const Gemm g, const Sched& S, const Epi& E) {
    const int tid = threadIdx.x, wid = __builtin_amdgcn_readfirstlane(tid >> 6), lane = tid & 63, wr = wid >> 2, wc = wid & 3, fr = lane & 15, fq = lane >> 4;
    const int K = g.K, nt = K / BK;
    unsigned voffA[2], voffB[2];
#pragma unroll
    for (int i = 0; i < 2; ++i) { int R, C; stage_rc(tid * 16 + i * 8192, R, C); const int Rb = Epi::PERM ? ((R & ~31) + perm32(R & 31)) : R;
        voffA[i] = (unsigned)(R * K + C) * 2u; voffB[i] = (unsigned)(Rb * K + C) * 2u; }
    const size_t kstep = (size_t)(BK * 2);
    const size_t hstep = (size_t)HALF * K * 2;
    const size_t tstep = 2 * hstep;
    const unsigned ldsw = (unsigned)wid * 1024u;
    const int aoff = lds_byte(wr * 64 + fr, fq * 8), boff = lds_byte(wc * 32 + fr, fq * 8);
#define PG8_SA(b, h) (((b) * 2 + (h)) * HTB)
#define PG8_SB(b, h) ((4 + (b) * 2 + (h)) * HTB)
#define PG8_STAGE(bufoff, gbase, voff) do { _Pragma("unroll") for (int _i = 0; _i < 2; ++_i) \
        __builtin_amdgcn_global_load_lds((const unsigned*)((const char*)(gbase) + (voff)[_i]), (PG8_LAS unsigned*)(lds + (bufoff) + ldsw + _i * 8192), 16, 0, 0); } while (0)
#define PG8_LDA(dst, b, h) do { _Pragma("unroll") for (int m = 0; m < 4; ++m) _Pragma("unroll") for (int k = 0; k < 2; ++k) dst[m][k] = *(const PG8_LAS bf16x8*)(lds + PG8_SA(b, h) + aoff + m * 2048 + k * 1024); } while (0)
#define PG8_LDB(dst, b, h) do { _Pragma("unroll") for (int n = 0; n < 2; ++n) _Pragma("unroll") for (int k = 0; k < 2; ++k) dst[n][k] = *(const PG8_LAS bf16x8*)(lds + PG8_SB(b, h) + boff + n * 2048 + k * 1024); } while (0)
#define PG8_MMA(ai, bj, At, Bt) do { __builtin_amdgcn_s_setprio(1); _Pragma("unroll") for (int m = 0; m < 4; ++m) _Pragma("unroll") for (int n = 0; n < 2; ++n) _Pragma("unroll") for (int k = 0; k < 2; ++k) \
        acc[ai][bj][m][n] = __builtin_amdgcn_mfma_f32_16x16x32_bf16(Bt[n][k], At[m][k], acc[ai][bj][m][n], 0, 0, 0); __builtin_amdgcn_s_setprio(0); } while (0)
#define PG8_WAIT_V(n) asm volatile("s_waitcnt vmcnt(" #n ")" ::: "memory")
#define PG8_WAIT_L(n) asm volatile("s_waitcnt lgkmcnt(" #n ")" ::: "memory")
#define PG8_BAR __builtin_amdgcn_s_barrier()
#define PG8_SCHED __builtin_amdgcn_sched_barrier(0)
    Unit cur, nxt; int ui = 0;
    if (!S.next(0, cur)) return;
    f32x4 acc[2][2][4][2];
#pragma unroll
    for (int a = 0; a < 2; ++a)
#pragma unroll
        for (int b = 0; b < 2; ++b)
#pragma unroll
            for (int m = 0; m < 4; ++m)
#pragma unroll
                for (int n = 0; n < 2; ++n) acc[a][b][m][n] = (f32x4){0.f, 0.f, 0.f, 0.f};
    bf16x8 At[4][2], B0[2][2], B1[2][2];
    const char* cA = (const char*)g.A + (size_t)cur.pm * tstep; const char* cB = (const char*)g.Bt + (size_t)cur.pn * tstep;
    S.a_ready(cur);
    if constexpr (SP2) {
        PG8_STAGE(PG8_SB(0, 0), cB, voffB); PG8_STAGE(PG8_SB(0, 1), cB + hstep, voffB); PG8_STAGE(PG8_SA(0, 0), cA, voffA); PG8_STAGE(PG8_SA(0, 1), cA + hstep, voffA);
        if (wr == 1) PG8_BAR;
        PG8_WAIT_V(2); PG8_BAR;
        PG8_STAGE(PG8_SB(1, 0), cB + kstep, voffB); PG8_STAGE(PG8_SA(1, 0), cA + kstep, voffA); PG8_STAGE(PG8_SB(1, 1), cB + hstep + kstep, voffB);
        PG8_WAIT_V(6); PG8_BAR;
    } else {
        PG8_STAGE(PG8_SB(0, 0), cB, voffB); PG8_STAGE(PG8_SA(0, 0), cA, voffA); PG8_STAGE(PG8_SB(0, 1), cB + hstep, voffB); PG8_STAGE(PG8_SA(0, 1), cA + hstep, voffA);
        if (wr == 1) PG8_BAR;
        PG8_WAIT_V(4); PG8_BAR;
        PG8_STAGE(PG8_SB(1, 0), cB + kstep, voffB); PG8_STAGE(PG8_SA(1, 0), cA + kstep, voffA); PG8_STAGE(PG8_SB(1, 1), cB + hstep + kstep, voffB);
        PG8_WAIT_V(6); PG8_BAR;
    }
    for (;;) {
        const bool has_next = S.next(ui + 1, nxt);
        const char* nA = has_next ? (const char*)g.A + (size_t)nxt.pm * tstep : cA; const char* nB = has_next ? (const char*)g.Bt + (size_t)nxt.pn * tstep : cB;
        for (int t = 0; t < nt; t += 2) {
            const bool last = (t == nt - 2);
            const char* a1 = cA + (size_t)(t + 1) * kstep;
            const char* a2 = last ? nA : cA + (size_t)(t + 2) * kstep; const char* b2 = last ? nB : cB + (size_t)(t + 2) * kstep;
            const char* a3 = a2 + kstep; const char* b3 = b2 + kstep;
            if (last && has_next) S.a_ready(nxt);
            if constexpr (SP2) {
            PG8_LDB(B0, 0, 0); PG8_LDB(B1, 0, 1); PG8_SCHED; PG8_LDA(At, 0, 0); PG8_STAGE(PG8_SA(1, 1), a1 + hstep, voffA);
            PG8_WAIT_V(8); PG8_WAIT_L(0); PG8_BAR; PG8_MMA(0, 0, At, B0); PG8_MMA(0, 1, At, B1); PG8_BAR; PG8_SCHED;
            PG8_LDA(At, 0, 1); PG8_STAGE(PG8_SB(0, 0), b2, voffB); PG8_STAGE(PG8_SB(0, 1), b2 + hstep, voffB); PG8_STAGE(PG8_SA(0, 0), a2, voffA);
            PG8_WAIT_V(8); PG8_WAIT_L(0); PG8_BAR; PG8_MMA(1, 0, At, B0); PG8_MMA(1, 1, At, B1); PG8_BAR; PG8_SCHED;
            PG8_LDB(B0, 1, 0); PG8_LDB(B1, 1, 1); PG8_SCHED; PG8_LDA(At, 1, 0); PG8_STAGE(PG8_SA(0, 1), a2 + hstep, voffA);
            PG8_WAIT_V(8); PG8_WAIT_L(0); PG8_BAR; PG8_MMA(0, 0, At, B0); PG8_MMA(0, 1, At, B1); PG8_BAR; PG8_SCHED;
            PG8_LDA(At, 1, 1); PG8_STAGE(PG8_SB(1, 0), b3, voffB); PG8_STAGE(PG8_SB(1, 1), b3 + hstep, voffB); PG8_STAGE(PG8_SA(1, 0), a3, voffA);
            PG8_WAIT_V(8); PG8_WAIT_L(0); PG8_BAR; PG8_MMA(1, 0, At, B0); PG8_MMA(1, 1, At, B1); PG8_BAR; PG8_SCHED;
            } else {
            PG8_LDB(B0, 0, 0); PG8_SCHED; PG8_LDA(At, 0, 0); PG8_STAGE(PG8_SA(1, 1), a1 + hstep, voffA);
            PG8_WAIT_L(8); PG8_BAR; PG8_WAIT_L(0); PG8_MMA(0, 0, At, B0); PG8_BAR; PG8_SCHED;
            PG8_LDB(B1, 0, 1); PG8_STAGE(PG8_SB(0, 0), b2, voffB);
            PG8_BAR; PG8_WAIT_L(0); PG8_MMA(0, 1, At, B1); PG8_BAR;
            PG8_LDA(At, 0, 1); PG8_STAGE(PG8_SA(0, 0), a2, voffA);
            PG8_BAR; PG8_WAIT_L(0); PG8_MMA(1, 0, At, B0); PG8_BAR; PG8_SCHED;
            PG8_STAGE(PG8_SB(0, 1), b2 + hstep, voffB);
            PG8_WAIT_V(6); PG8_BAR; PG8_MMA(1, 1, At, B1); PG8_BAR;
            PG8_LDB(B0, 1, 0); PG8_SCHED; PG8_LDA(At, 1, 0); PG8_STAGE(PG8_SA(0, 1), a2 + hstep, voffA);
            PG8_WAIT_L(8); PG8_BAR; PG8_WAIT_L(0); PG8_MMA(0, 0, At, B0); PG8_BAR; PG8_SCHED;
            PG8_LDB(B1, 1, 1); PG8_STAGE(PG8_SB(1, 0), b3, voffB);
            PG8_BAR; PG8_WAIT_L(0); PG8_MMA(0, 1, At, B1); PG8_BAR;
            PG8_LDA(At, 1, 1); PG8_STAGE(PG8_SA(1, 0), a3, voffA);
            PG8_BAR; PG8_WAIT_L(0); PG8_MMA(1, 0, At, B0); PG8_BAR; PG8_SCHED;
            PG8_STAGE(PG8_SB(1, 1), b3 + hstep, voffB);
            PG8_WAIT_V(6); PG8_BAR; PG8_MMA(1, 1, At, B1); PG8_BAR;
            }
        }
        if constexpr (ALIGN_EPI) { if (wr == 0) PG8_BAR; }
        if constexpr (!Epi::AFTER_DRAIN) { E(acc, cur, wr, wc, fr, fq); S.done(cur); }
        if (!has_next) break;
#pragma unroll
        for (int a = 0; a < 2; ++a)
#pragma unroll
            for (int b = 0; b < 2; ++b)
#pragma unroll
                for (int m = 0; m < 4; ++m)
#pragma unroll
                    for (int n = 0; n < 2; ++n) acc[a][b][m][n] = (f32x4){0.f, 0.f, 0.f, 0.f};
        cur = nxt; cA = nA; cB = nB; ++ui;
        if constexpr (ALIGN_EPI) { if (wr == 1) PG8_BAR; }
    }
    PG8_WAIT_V(0);
    if constexpr (!ALIGN_EPI) { if (wr == 0) PG8_BAR; }
    PG8_BAR;
    if constexpr (Epi::AFTER_DRAIN) { E.fused(acc, cur, wr, wc, fr, fq, lds, wid, lane); S.done(cur); }
#undef PG8_SA
#undef PG8_SB
#undef PG8_STAGE
#undef PG8_LDA
#undef PG8_LDB
#undef PG8_MMA
#undef PG8_WAIT_V
#undef PG8_WAIT_L
#undef PG8_BAR
#undef PG8_SCHED
}
}

#ifndef PG8_SP2
#define PG8_SP2 true
#endif
#ifndef PG8_ALIGN
#define PG8_ALIGN true
#endif
#define LAS __attribute__((address_space(3)))
typedef unsigned short bf16;
typedef short bf16x8 __attribute__((ext_vector_type(8)));
typedef short s16x4 __attribute__((ext_vector_type(4)));
typedef float f32x4 __attribute__((ext_vector_type(4)));
typedef float f32x2 __attribute__((ext_vector_type(2)));
typedef float f32x16 __attribute__((ext_vector_type(16)));
typedef unsigned u32x4 __attribute__((ext_vector_type(4)));
typedef unsigned u32x2 __attribute__((ext_vector_type(2)));

constexpr int NP = 16384, NS = 256, MT = NP + NS, DM = 1024, FF = 2816, NUP = 5632, DH = 512, NMOD = 9216, DIN = 2056;
constexpr float EPS = 1e-6f, LOG2E = 1.4426950408889634f, QSCALE = 0.125f * 1.4426950408889634f;
constexpr size_t O_KP = 17039360, O_VP = 25427968, O_LFP = 33816576, O_SRP = 33947648, O_SIP = 33955840, O_KS = 33964032, O_VS = 34095104,
                 O_LFS = 34226176, O_SRS = 34228224, O_SIS = 34244608;
constexpr size_t MiB = 1u << 20;
constexpr size_t WS_MOD = 0, WS_S5C = 1 * MiB, WS_F2P = 2 * MiB, WS_F2S = 2 * MiB + 512 * 1024, WS_E = 4 * MiB, WS_WUP1 = 10 * MiB, WS_WDN1 = 21 * MiB,
                 WS_WIN = 27 * MiB, WS_WGLU = 31 * MiB, WS_WOUT = 32 * MiB, WS_WUP2 = 34 * MiB, WS_WDN2 = 45 * MiB, WS_HA = 52 * MiB, WS_HID = 86 * MiB;
constexpr size_t WS_U = WS_HID, WS_Q = WS_HID + 17 * MiB, WS_KB = WS_HID + 34 * MiB, WS_VB = WS_HID + 51 * MiB, WS_Z = WS_HID + 68 * MiB;
constexpr size_t WS_O = 176 * MiB, WS_BAR = 512 * 1024, WS_PB = 194 * MiB;
#ifndef MK_REP_MASK
#define MK_REP_MASK 0
#endif
constexpr int S5_ITEMS_PER_G = 264, S5_ITEMS = 32 * 264;
constexpr int LDS_BYTES = 155648;
constexpr int NWAVES = 8;

struct Args { const float* in[34]; float* out; unsigned char* ws; int ph_lo, ph_hi; };

struct Frame {
    LAS unsigned char* lds;
    int tid, lane, wave, G, vcu, gw, NGW;
    const float* in[34];
    float* out;
    float* mod; f32x2* abar; f32x2* a64; f32x2* bbar; bf16* cmt; float* F2P; float* F2S; f32x2* E;
    bf16 *WUP1, *WDN1, *WIN, *WGLU, *WOUT, *WUP2, *WDN2, *HA, *HID, *U, *Q, *KB, *VB, *Z, *O; float* PB;
};

__device__ __forceinline__ unsigned f2bf(float f) { unsigned u = __builtin_bit_cast(unsigned, f); return (u + 0x7fffu + ((u >> 16) & 1u)) >> 16; }
__device__ __forceinline__ unsigned pk2(float lo, float hi) { return pg8::cvt_pk_bf16(lo, hi); }
__device__ __forceinline__ float bflo(unsigned w) { return __uint_as_float(w << 16); }
__device__ __forceinline__ float bfhi(unsigned w) { return __uint_as_float(w & 0xffff0000u); }
__device__ __forceinline__ float wave_sum(float v) {
#pragma unroll
    for (int o = 1; o < 64; o <<= 1) v += __shfl_xor(v, o);
    return v;
}
__device__ __forceinline__ float fsigmoid(float x) { return __builtin_amdgcn_rcpf(1.f + __builtin_amdgcn_exp2f(-x * LOG2E)); }
__device__ __forceinline__ int bidx(int row) { return row < NP ? (row >> 12) : 4 + ((row - NP) >> 5); }
#define LDS_WAIT() asm volatile("s_waitcnt lgkmcnt(0)" ::: "memory")

using pg8::Unit;
struct EpiSwiglu {
    static constexpr bool PERM = true, AFTER_DRAIN = false;
    bf16* H;
    __device__ __forceinline__ void operator()(const f32x4 (&acc)[2][2][4][2], const Unit& u, int wr, int wc, int fr, int fq) const {
        const int row0 = u.pm * 256 + wr * 64 + fr, col0 = u.pn * 128 + wc * 32 + 8 * fq;
#pragma unroll
        for (int ai = 0; ai < 2; ++ai)
#pragma unroll
            for (int m = 0; m < 4; ++m) {
                const int row = row0 + ai * 128 + m * 16;
                u32x4 w; unsigned ww[4];
#pragma unroll
                for (int n = 0; n < 2; ++n) {
                    const f32x4 g = acc[ai][0][m][n], up = acc[ai][1][m][n]; float r[4];
#pragma unroll
                    for (int i = 0; i < 4; ++i) r[i] = g[i] * fsigmoid(g[i]) * up[i];
                    ww[2 * n] = pk2(r[0], r[1]); ww[2 * n + 1] = pk2(r[2], r[3]);
                }
                w.x = ww[0]; w.y = ww[1]; w.z = ww[2]; w.w = ww[3];
                *(u32x4*)(H + (size_t)row * FF + col0) = w;
            }
    }
};
struct EpiResid {
    static constexpr bool PERM = true, AFTER_DRAIN = false;
    const float* xp; const float* xs; float* out; const float* mod; int gi; float gscale;
    __device__ __forceinline__ void operator()(const f32x4 (&acc)[2][2][4][2], const Unit& u, int wr, int wc, int fr, int fq) const {
        const int row0 = u.pm * 256 + wr * 64 + fr, col0 = u.pn * 256 + wc * 32 + 8 * fq;
#pragma unroll
        for (int ai = 0; ai < 2; ++ai)
#pragma unroll
            for (int m = 0; m < 4; ++m) {
                const int row = row0 + ai * 128 + m * 16;
                const float* xin = row < NP ? xp + (size_t)row * DM : xs + (size_t)(row - NP) * DM;
                const float* gate = mod + bidx(row) * NMOD + gi * DM;
                float* orow = out + (size_t)row * DM;
#pragma unroll
                for (int bj = 0; bj < 2; ++bj) {
                    const int col = col0 + bj * 128;
#pragma unroll
                    for (int n = 0; n < 2; ++n) {
                        const f32x4 g = *(const f32x4*)(gate + col + 4 * n), x = *(const f32x4*)(xin + col + 4 * n);
                        const f32x4 o = x + (g + 1.0f) * gscale * acc[ai][bj][m][n];
                        *(f32x4*)(orow + col + 4 * n) = o;
                    }
                }
            }
    }
};
struct EpiIn {
    static constexpr bool PERM = true, AFTER_DRAIN = false;
    bf16 *U, *Q, *KB, *VB; float* out;
    __device__ __forceinline__ void operator()(const f32x4 (&acc)[2][2][4][2], const Unit& u, int wr, int wc, int fr, int fq) const {
        const int t = u.pn >> 1;
        const int row0 = u.pm * 256 + wr * 64 + fr, col0 = (u.pn & 1) * 256 + wc * 32 + 8 * fq;
        bf16* dst = t == 0 ? U : t == 1 ? Q : t == 2 ? KB : VB;
        const float sc = t == 1 ? QSCALE : 1.0f;
#pragma unroll
        for (int ai = 0; ai < 2; ++ai)
#pragma unroll
            for (int m = 0; m < 4; ++m) {
                const int row = row0 + ai * 128 + m * 16;
                float* fo = row < NP ? out + (t == 2 ? O_KP : O_VP) + (size_t)row * DH : out + (t == 2 ? O_KS : O_VS) + (size_t)(row - NP) * DH;
#pragma unroll
                for (int bj = 0; bj < 2; ++bj) {
                    const int col = col0 + bj * 128;
                    const f32x4 v0 = acc[ai][bj][m][0], v1 = acc[ai][bj][m][1];
                    u32x4 w; w.x = pk2(v0[0] * sc, v0[1] * sc); w.y = pk2(v0[2] * sc, v0[3] * sc); w.z = pk2(v1[0] * sc, v1[1] * sc); w.w = pk2(v1[2] * sc, v1[3] * sc);
                    *(u32x4*)(dst + (size_t)row * DH + col) = w;
                    if (t >= 2) { *(f32x4*)(fo + col) = v0; *(f32x4*)(fo + col + 4) = v1; }
                }
            }
    }
};
struct EpiGlu {
    static constexpr bool PERM = true, AFTER_DRAIN = false;
    const bf16* Z; bf16* Y; const float* bglu;
    __device__ __forceinline__ void operator()(const f32x4 (&acc)[2][2][4][2], const Unit& u, int wr, int wc, int fr, int fq) const {
        const int row0 = u.pm * 256 + wr * 64 + fr, col0 = u.pn * 256 + wc * 32 + 8 * fq;
#pragma unroll
        for (int bj = 0; bj < 2; ++bj) {
            const int col = col0 + bj * 128;
            const f32x4 b0 = *(const f32x4*)(bglu + col), b1 = *(const f32x4*)(bglu + col + 4);
#pragma unroll
            for (int ai = 0; ai < 2; ++ai)
#pragma unroll
                for (int m = 0; m < 4; ++m) {
                    const int row = row0 + ai * 128 + m * 16;
                    const u32x4 z = *(const u32x4*)(Z + (size_t)row * DH + col);
                    const f32x4 a0 = acc[ai][bj][m][0] + b0, a1 = acc[ai][bj][m][1] + b1;
                    u32x4 w;
                    w.x = pk2(bflo(z.x) * fsigmoid(a0[0]), bfhi(z.x) * fsigmoid(a0[1]));
                    w.y = pk2(bflo(z.y) * fsigmoid(a0[2]), bfhi(z.y) * fsigmoid(a0[3]));
                    w.z = pk2(bflo(z.z) * fsigmoid(a1[0]), bfhi(z.z) * fsigmoid(a1[1]));
                    w.w = pk2(bflo(z.w) * fsigmoid(a1[2]), bfhi(z.w) * fsigmoid(a1[3]));
                    *(u32x4*)(Y + (size_t)row * DH + col) = w;
                }
        }
    }
};

__device__ __forceinline__ void phase_ada(Frame& F) {
    LAS float* sm = (LAS float*)F.lds;
    LAS float* red = sm + 12288;
    const float* cp = F.in[2]; const float* cs = F.in[3]; const float* wada = F.in[9]; const float* bada = F.in[10];
    for (int i = F.tid; i < 12288; i += 512) { const int d = i / 12, bi = i % 12; const float c = bi < 4 ? cp[bi * DM + d] : cs[(bi - 4) * DM + d]; sm[i] = c * fsigmoid(c); }
    __syncthreads();
    for (int cb = blockIdx.x; cb < 256; cb += F.G) {
        const int ks = F.tid / 36, cl = F.tid % 36;
        float acc[12];
#pragma unroll
        for (int i = 0; i < 12; ++i) acc[i] = 0.f;
        if (F.tid < 504) {
            const float* wp = wada + (size_t)ks * NMOD + cb * 36 + cl;
            const int nd = (DM - ks + 13) / 14;
            for (int i0 = 0; i0 < nd; i0 += 8) {
                float w[8];
#pragma unroll
                for (int u = 0; u < 8; ++u) w[u] = (i0 + u < nd) ? wp[(size_t)(i0 + u) * 14 * NMOD] : 0.f;
#pragma unroll
                for (int u = 0; u < 8; ++u) {
                    const int d = (i0 + u < nd) ? ks + 14 * (i0 + u) : 0;
                    const f32x4 s0 = *(const LAS f32x4*)(sm + d * 12), s1 = *(const LAS f32x4*)(sm + d * 12 + 4), s2 = *(const LAS f32x4*)(sm + d * 12 + 8);
                    acc[0] += w[u] * s0[0]; acc[1] += w[u] * s0[1]; acc[2] += w[u] * s0[2]; acc[3] += w[u] * s0[3];
                    acc[4] += w[u] * s1[0]; acc[5] += w[u] * s1[1]; acc[6] += w[u] * s1[2]; acc[7] += w[u] * s1[3];
                    acc[8] += w[u] * s2[0]; acc[9] += w[u] * s2[1]; acc[10] += w[u] * s2[2]; acc[11] += w[u] * s2[3];
                }
            }
#pragma unroll
            for (int i = 0; i < 12; ++i) red[(ks * 36 + cl) * 12 + i] = acc[i];
        }
        __syncthreads();
        if (F.tid < 432) {
            const int c2 = F.tid / 12, bi = F.tid % 12; float s = bada[cb * 36 + c2];
#pragma unroll
            for (int k = 0; k < 14; ++k) s += red[(k * 36 + c2) * 12 + bi];
            F.mod[bi * NMOD + cb * 36 + c2] = s;
        }
        __syncthreads();
    }
}
__device__ __forceinline__ void sincos_d(double x, double& s, double& c) {
    const double kf = __builtin_rint(x * 0.63661977236758134308);
    double r = __builtin_fma(-kf, 1.57079632679489655800e+00, x); r = __builtin_fma(-kf, 6.12323399573676603587e-17, r);
    const int k = ((int)kf) & 3; const double r2 = r * r;
    double sp = 1.0 / 6227020800.0; sp = __builtin_fma(sp, r2, -1.0 / 39916800.0); sp = __builtin_fma(sp, r2, 1.0 / 362880.0); sp = __builtin_fma(sp, r2, -1.0 / 5040.0);
    sp = __builtin_fma(sp, r2, 1.0 / 120.0); sp = __builtin_fma(sp, r2, -1.0 / 6.0); sp = __builtin_fma(sp, r2, 1.0); const double sr = sp * r;
    double cq = -1.0 / 87178291200.0; cq = __builtin_fma(cq, r2, 1.0 / 479001600.0); cq = __builtin_fma(cq, r2, -1.0 / 3628800.0); cq = __builtin_fma(cq, r2, 1.0 / 40320.0);
    cq = __builtin_fma(cq, r2, -1.0 / 720.0); cq = __builtin_fma(cq, r2, 1.0 / 24.0); cq = __builtin_fma(cq, r2, -0.5); const double cr = __builtin_fma(cq, r2, 1.0);
    s = (k == 0) ? sr : (k == 1) ? cr : (k == 2) ? -sr : -cr;
    c = (k == 0) ? cr : (k == 1) ? -sr : (k == 2) ? -cr : sr;
}
__device__ __forceinline__ double exp_d(double x) {
    const double n = __builtin_rint(x * 1.4426950408889634074);
    double r = __builtin_fma(-n, 6.93147180369123816490e-01, x); r = __builtin_fma(-n, 1.90821492927058770002e-10, r);
    double p = 1.0 / 6227020800.0;
    p = __builtin_fma(p, r, 1.0 / 479001600.0); p = __builtin_fma(p, r, 1.0 / 39916800.0); p = __builtin_fma(p, r, 1.0 / 3628800.0); p = __builtin_fma(p, r, 1.0 / 362880.0);
    p = __builtin_fma(p, r, 1.0 / 40320.0); p = __builtin_fma(p, r, 1.0 / 5040.0); p = __builtin_fma(p, r, 1.0 / 720.0); p = __builtin_fma(p, r, 1.0 / 120.0);
    p = __builtin_fma(p, r, 1.0 / 24.0); p = __builtin_fma(p, r, 1.0 / 6.0); p = __builtin_fma(p, r, 0.5); p = __builtin_fma(p, r, 1.0); p = __builtin_fma(p, r, 1.0);
    return __builtin_ldexp(p, (int)n);
}
__device__ __forceinline__ void phase_s5const(Frame& F) {
    const int id = blockIdx.x * 512 + F.tid;
    if (id >= 2048) return;
    const int g = id >> 6, p = id & 63;
    const double lre = (double)F.in[17][id], lim = (double)F.in[18][id], dt = exp_d((double)F.in[19][g]);
    const double mag = exp_d(lre * dt); double sn, cs; sincos_d(lim * dt, sn, cs);
    const double are = mag * cs, aim = mag * sn;
    F.abar[id] = (f32x2){(float)are, (float)aim};
    double pr = are, pi = aim;
#pragma unroll
    for (int i = 0; i < 6; ++i) { const double nr = pr * pr - pi * pi, ni = 2.0 * pr * pi; pr = nr; pi = ni; }
    F.a64[id] = (f32x2){(float)pr, (float)pi};
    const double xr = are - 1.0, xi = aim, den = lre * lre + lim * lim;
    const double cr = (xr * lre + xi * lim) / den, ci = (xi * lre - xr * lim) / den;
    const float* bre = F.in[20] + (size_t)id * 16; const float* bim = F.in[21] + (size_t)id * 16;
#pragma unroll
    for (int c = 0; c < 16; ++c) { const double br = bre[c], bi = bim[c]; F.bbar[(size_t)id * 16 + c] = (f32x2){(float)(cr * br - ci * bi), (float)(cr * bi + ci * br)}; }
    const float* cre = F.in[22]; const float* cim = F.in[23];
#pragma unroll
    for (int c = 0; c < 16; ++c) {
        F.cmt[(g * 16 + c) * 128 + p] = (bf16)f2bf(cre[(g * 16 + c) * 64 + p]);
        F.cmt[(g * 16 + c) * 128 + 64 + p] = (bf16)f2bf(-cim[(g * 16 + c) * 64 + p]);
    }
}
__device__ __forceinline__ void transpose_item(const float* W, int ldw, int k0, int n0, bf16* WT, int Kd, int drow0, LAS float* scr, int lane) {
#pragma unroll 8
    for (int i = 0; i < 32; ++i) { const int kk = 2 * i + (lane >> 5); scr[kk * 33 + (lane & 31)] = W[(size_t)(k0 + kk) * ldw + n0 + (lane & 31)]; }
    LDS_WAIT();
    const int c = lane & 7;
#pragma unroll
    for (int j = 0; j < 4; ++j) { const int n = (lane >> 3) + 8 * j; const LAS float* s = scr + (8 * c) * 33 + n;
        u32x4 o; o.x = pk2(s[0 * 33], s[1 * 33]); o.y = pk2(s[2 * 33], s[3 * 33]); o.z = pk2(s[4 * 33], s[5 * 33]); o.w = pk2(s[6 * 33], s[7 * 33]);
        *(u32x4*)(WT + (size_t)(drow0 + n) * Kd + k0 + 8 * c) = o; }
    LDS_WAIT();
}
__device__ __forceinline__ int up_drow(int n0) { return n0 < FF ? 256 * (n0 >> 7) + (n0 & 127) : 256 * ((n0 - FF) >> 7) + 128 + ((n0 - FF) & 127); }
__device__ __forceinline__ void phase_weights(Frame& F) {
    LAS float* scr = (LAS float*)(F.lds + 81920 + F.wave * 8704);
    constexpr int I_UP = 16 * 176, I_DN = 44 * 32, I_IN = 16 * 64, I_GLU = 8 * 16, I_OUT = 16 * 32;
    constexpr int NITEMS = 2 * I_UP + 2 * I_DN + I_IN + I_GLU + I_OUT;
    for (int it = F.gw; it < NITEMS; it += F.NGW) {
        int r = it;
        if (r < I_UP) { const int kb = r / 176, nb = r % 176; transpose_item(F.in[12], NUP, 64 * kb, 32 * nb, F.WUP1, DM, up_drow(32 * nb), scr, F.lane); continue; } r -= I_UP;
        if (r < I_UP) { const int kb = r / 176, nb = r % 176; transpose_item(F.in[31], NUP, 64 * kb, 32 * nb, F.WUP2, DM, up_drow(32 * nb), scr, F.lane); continue; } r -= I_UP;
        if (r < I_DN) { const int kb = r / 32, nb = r % 32; transpose_item(F.in[13], DM, 64 * kb, 32 * nb, F.WDN1, FF, 32 * nb, scr, F.lane); continue; } r -= I_DN;
        if (r < I_DN) { const int kb = r / 32, nb = r % 32; transpose_item(F.in[32], DM, 64 * kb, 32 * nb, F.WDN2, FF, 32 * nb, scr, F.lane); continue; } r -= I_DN;
        if (r < I_IN) { const int kb = r / 64, nb = r % 64; transpose_item(F.in[15], DIN, 64 * kb, 32 * nb, F.WIN, DM, 32 * nb, scr, F.lane); continue; } r -= I_IN;
        if (r < I_GLU) { const int kb = r / 16, nb = r % 16; transpose_item(F.in[25], DH, 64 * kb, 32 * nb, F.WGLU, DH, 32 * nb, scr, F.lane); continue; } r -= I_GLU;
        { const int kb = r / 32, nb = r % 32; transpose_item(F.in[29], DM, 64 * kb, 32 * nb, F.WOUT, DM, 32 * nb, scr, F.lane); }
    }
}

template <bool FG>
__device__ __forceinline__ void phase_norm(Frame& F, const float* xp, const float* xs, const float* gN, int si, int ci) {
    LAS float* wf = (LAS float*)F.lds;
    if (FG) {
        const float* win = F.in[15];
        for (int i = F.tid; i < 8192; i += 512) wf[i] = win[(size_t)(i >> 3) * DIN + 2048 + (i & 7)];
        __syncthreads();
    }
    const int lane = F.lane;
    for (int row = F.gw; row < MT; row += F.NGW) {
        const float* xr = row < NP ? xp + (size_t)row * DM : xs + (size_t)(row - NP) * DM;
        f32x4 v[4]; float ss = 0.f;
#pragma unroll
        for (int j = 0; j < 4; ++j) { v[j] = *(const f32x4*)(xr + 4 * lane + 256 * j); ss += (v[j][0] * v[j][0] + v[j][1] * v[j][1]) + (v[j][2] * v[j][2] + v[j][3] * v[j][3]); }
        const float rstd = 1.0f / sqrtf(wave_sum(ss) * (1.0f / DM) + EPS);
        const float* sh = F.mod + bidx(row) * NMOD + si * DM; const float* sc = F.mod + bidx(row) * NMOD + ci * DM;
        float f[8];
#pragma unroll
        for (int i = 0; i < 8; ++i) f[i] = 0.f;
#pragma unroll
        for (int j = 0; j < 4; ++j) {
            const int col = 4 * lane + 256 * j;
            const f32x4 g4 = *(const f32x4*)(gN + col), s4 = *(const f32x4*)(sc + col), h4 = *(const f32x4*)(sh + col);
            const f32x4 h = v[j] * rstd * g4 * (s4 + 1.0f) + h4;
            u32x2 w; w.x = pk2(h[0], h[1]); w.y = pk2(h[2], h[3]);
            *(u32x2*)(F.HA + (size_t)row * DM + col) = w;
            if (FG) {
#pragma unroll
                for (int e = 0; e < 4; ++e) {
                    const f32x4 w0 = *(const LAS f32x4*)(wf + (col + e) * 8), w1 = *(const LAS f32x4*)(wf + (col + e) * 8 + 4);
                    f[0] += h[e] * w0[0]; f[1] += h[e] * w0[1]; f[2] += h[e] * w0[2]; f[3] += h[e] * w0[3];
                    f[4] += h[e] * w1[0]; f[5] += h[e] * w1[1]; f[6] += h[e] * w1[2]; f[7] += h[e] * w1[3];
                }
            }
        }
        if (FG) {
#pragma unroll
            for (int i = 0; i < 8; ++i) f[i] = wave_sum(f[i]);
            float fv = f[0];
            fv = lane == 1 ? f[1] : fv; fv = lane == 2 ? f[2] : fv; fv = lane == 3 ? f[3] : fv; fv = lane == 4 ? f[4] : fv;
            fv = lane == 5 ? f[5] : fv; fv = lane == 6 ? f[6] : fv; fv = lane == 7 ? f[7] : fv;
            if (lane < 8) {
                const float x = fv + F.in[16][lane];
                const float lf = fminf(x, 0.f) - log1pf(expf(-fabsf(x)));
                float* o = row < NP ? F.out + O_LFP + (size_t)row * 8 : F.out + O_LFS + (size_t)(row - NP) * 8;
                o[lane] = lf;
            }
        }
    }
}
__device__ __forceinline__ void phase_mixnorm(Frame& F) {
    const int lane = F.lane; const float* gs = F.in[27]; const float* gf = F.in[28];
    for (int row = F.gw; row < MT; row += F.NGW) {
#pragma unroll
        for (int part = 0; part < 2; ++part) {
            const float* g = (part == 0 ? gs : gf) + 8 * lane;
            float v[8];
            if (part == 1 && row >= NP) {
                const int b = (row - NP) >> 5, q = (row - NP) & 31, h = lane >> 3, d0 = 8 * (lane & 7);
                const float* pb = F.PB + ((size_t)(((b * 8 + h) * 4) * 32 + q)) * 68;
                float Mi[4], M = -INFINITY;
#pragma unroll
                for (int i = 0; i < 4; ++i) { Mi[i] = pb[(size_t)i * 32 * 68 + 64]; M = fmaxf(M, Mi[i]); }
                float L = 0.f;
#pragma unroll
                for (int e = 0; e < 8; ++e) v[e] = 0.f;
#pragma unroll
                for (int i = 0; i < 4; ++i) {
                    const float wg = __builtin_amdgcn_exp2f(Mi[i] - M); L += pb[(size_t)i * 32 * 68 + 65] * wg;
                    const f32x4 o0 = *(const f32x4*)(pb + (size_t)i * 32 * 68 + d0), o1 = *(const f32x4*)(pb + (size_t)i * 32 * 68 + d0 + 4);
                    v[0] += o0[0] * wg; v[1] += o0[1] * wg; v[2] += o0[2] * wg; v[3] += o0[3] * wg; v[4] += o1[0] * wg; v[5] += o1[1] * wg; v[6] += o1[2] * wg; v[7] += o1[3] * wg;
                }
                const float rl = 1.0f / L;
#pragma unroll
                for (int e = 0; e < 8; ++e) v[e] *= rl;
            } else {
                const bf16* src = (part == 0 ? F.U : F.O) + (size_t)row * DH + 8 * lane;
                const u32x4 z = *(const u32x4*)src;
                v[0] = bflo(z.x); v[1] = bfhi(z.x); v[2] = bflo(z.y); v[3] = bfhi(z.y); v[4] = bflo(z.z); v[5] = bfhi(z.z); v[6] = bflo(z.w); v[7] = bfhi(z.w);
            }
            float ss = 0.f;
#pragma unroll
            for (int i = 0; i < 8; ++i) ss += v[i] * v[i];
            const float rstd = 1.0f / sqrtf(wave_sum(ss) * (1.0f / DH) + EPS);
            const f32x4 g0 = *(const f32x4*)g, g1 = *(const f32x4*)(g + 4);
            u32x4 w; w.x = pk2(v[0] * rstd * g0[0], v[1] * rstd * g0[1]); w.y = pk2(v[2] * rstd * g0[2], v[3] * rstd * g0[3]);
            w.z = pk2(v[4] * rstd * g1[0], v[5] * rstd * g1[1]); w.w = pk2(v[6] * rstd * g1[2], v[7] * rstd * g1[3]);
            *(u32x4*)(F.HA + (size_t)row * DM + part * DH + 8 * lane) = w;
        }
    }
}
__device__ __forceinline__ void phase_finalnorm(Frame& F) {
    const int lane = F.lane; const float* gN = F.in[33];
    for (int row = F.gw; row < MT; row += F.NGW) {
        float* xr = F.out + (size_t)row * DM;
        f32x4 v[4]; float ss = 0.f;
#pragma unroll
        for (int j = 0; j < 4; ++j) { v[j] = *(const f32x4*)(xr + 4 * lane + 256 * j); ss += (v[j][0] * v[j][0] + v[j][1] * v[j][1]) + (v[j][2] * v[j][2] + v[j][3] * v[j][3]); }
        const float rstd = 1.0f / sqrtf(wave_sum(ss) * (1.0f / DM) + EPS);
#pragma unroll
        for (int j = 0; j < 4; ++j) { const f32x4 g4 = *(const f32x4*)(gN + 4 * lane + 256 * j); *(f32x4*)(xr + 4 * lane + 256 * j) = v[j] * rstd * g4; }
    }
}
__device__ __forceinline__ void phase_fcum(Frame& F) {
    LAS float* wt = (LAS float*)F.lds;
    const int tid = F.tid, lane = F.lane, wave = F.wave;
    for (int job = blockIdx.x; job < 96; job += F.G) {
        const float* src; float* dst; int b, h;
        if (job < 32) { b = job >> 3; h = job & 7; src = F.out + O_LFP + (size_t)b * 4096 * 8 + h; dst = F.F2P + (size_t)job * 4096; }
        else { const int j2 = job - 32; b = j2 >> 3; h = j2 & 7; src = F.in[6] + (size_t)b * 4096 * 8 + h; dst = F.F2S + (size_t)j2 * 4128; }
        float v[8]; float tsum = 0.f;
#pragma unroll
        for (int i = 0; i < 8; ++i) { v[i] = src[(size_t)(8 * tid + i) * 8]; tsum += v[i]; }
        float inc = tsum;
#pragma unroll
        for (int o = 1; o < 64; o <<= 1) { const float t = __shfl_up(inc, o); if (lane >= o) inc += t; }
        if (lane == 63) wt[wave] = inc;
        __syncthreads();
        float woff = 0.f, total = 0.f;
#pragma unroll
        for (int w = 0; w < 8; ++w) { const float x = wt[w]; if (w < wave) woff += x; total += x; }
        float run = woff + inc - tsum;
#pragma unroll
        for (int i = 0; i < 8; ++i) { run += v[i]; dst[8 * tid + i] = run * LOG2E; }
        if (job >= 32 && wave == 0) {
            float x = lane < 32 ? F.out[O_LFS + (size_t)(b * 32 + lane) * 8 + h] : 0.f;
#pragma unroll
            for (int o = 1; o < 64; o <<= 1) { const float t = __shfl_up(x, o); if (lane >= o) x += t; }
            if (lane < 32) dst[4096 + lane] = (total + x) * LOG2E;
        }
        __syncthreads();
    }
}
#define XB_TMO      128
#define XB_XCNT(j)  (256  + 64 * (j))
#define XB_XSUB(j)  (1280 + 64 * (j))
#define XB_XGEN(j)  (2304 + 64 * (j))
#define XB_TOP      3328
#define XB_TOPGEN   3392
#define XCD_BAR_WORDS 3456
#define XB_SPIN_CAP (1u << 18)

__device__ __forceinline__ unsigned xb_ld(unsigned* p)              { return __hip_atomic_load(p, __ATOMIC_RELAXED, __HIP_MEMORY_SCOPE_AGENT); }
__device__ __forceinline__ unsigned xb_add(unsigned* p, unsigned v) { return __hip_atomic_fetch_add(p, v, __ATOMIC_RELAXED, __HIP_MEMORY_SCOPE_AGENT); }
__device__ __forceinline__ unsigned xb_xcc_id() { return (unsigned)__builtin_amdgcn_s_getreg((3 << 11) | 20) & 0xFu; }
#define XB_SPIN(cond, bar) do { unsigned _sp = 0; while (cond) { __builtin_amdgcn_s_sleep(1); \
    if ((++_sp & 255u) == 0u) { if (xb_ld(&(bar)[XB_TMO])) break; if (_sp > XB_SPIN_CAP) { atomicAdd(&(bar)[XB_TMO], 1u); break; } } } } while (0)

struct XcdBarrier {
    unsigned* bar; unsigned x;
    volatile LAS unsigned* st;
};

__device__ __forceinline__ XcdBarrier xcd_barrier_post(unsigned* bar, volatile LAS unsigned* st) {
    XcdBarrier b; b.bar = bar; b.x = xb_xcc_id(); b.st = st;
    if (threadIdx.x == 0) (void)xb_add(&bar[XB_XCNT(b.x)], 1u);
    return b;
}
__device__ __forceinline__ void xcd_barrier_complete(unsigned* bar, unsigned x, unsigned& nloc, unsigned& nx) {
    const unsigned G = gridDim.x * gridDim.y * gridDim.z;
    unsigned sum, cnt, mine, sp = 0u;
    for (;;) {
        sum = 0u; cnt = 0u; mine = 0u;
#pragma unroll
        for (unsigned j = 0; j < 16; ++j) { const unsigned c = xb_ld(&bar[XB_XCNT(j)]); sum += c; cnt += (c > 0u) ? 1u : 0u; mine = (j == x) ? c : mine; }
        if (sum == G) break;
        __builtin_amdgcn_s_sleep(1);
        if ((++sp & 255u) == 0u) { if (xb_ld(&bar[XB_TMO])) break; if (sp > XB_SPIN_CAP) { atomicAdd(&bar[XB_TMO], 1u); break; } }
    }
    nloc = mine > 0u ? mine : 1u; nx = cnt > 0u ? cnt : 1u;
}

__device__ __forceinline__ void xcd_barrier(const XcdBarrier& b) {
    asm volatile("s_waitcnt vmcnt(0)" ::: "memory");
    __syncthreads();
    if (threadIdx.x == 0) {
        unsigned* bar = b.bar;
        __builtin_amdgcn_s_waitcnt(0);
        unsigned nloc = b.st[0], nx = b.st[1];
        if (nloc == 0u) { xcd_barrier_complete(bar, b.x, nloc, nx); b.st[0] = nloc; b.st[1] = nx; }
        const unsigned old = xb_add(&bar[XB_XSUB(b.x)], 1u);
        const unsigned gen = old / nloc;
        if (old + 1u == (gen + 1u) * nloc) {
            __builtin_amdgcn_fence(__ATOMIC_RELEASE, "agent");
            asm volatile("s_waitcnt vmcnt(0)" ::: "memory");
            const unsigned og = xb_add(&bar[XB_TOP], 1u);
            const unsigned tg = og / nx;
            if (og + 1u == (tg + 1u) * nx) xb_add(&bar[XB_TOPGEN], 1u);
            else XB_SPIN(xb_ld(&bar[XB_TOPGEN]) == tg, bar);
            __builtin_amdgcn_fence(__ATOMIC_ACQUIRE, "agent");
            xb_add(&bar[XB_XGEN(b.x)], 1u);
            asm volatile("s_waitcnt vmcnt(0)" ::: "memory");
        } else {
            XB_SPIN(xb_ld(&bar[XB_XGEN(b.x)]) == gen, bar);
            __builtin_amdgcn_fence(__ATOMIC_ACQUIRE, "agent");
            asm volatile("s_waitcnt vmcnt(0)" ::: "memory");
        }
    }
    __syncthreads();
}

constexpr int KP = 72, VP = 68;
__device__ __forceinline__ void attn_tile(const LAS bf16* kL, const LAS bf16* vL, const LAS float* fL, LAS float* wsf, const bf16x8 (&qr)[4], f32x16 (&o)[2],
                                          float& m, float& l, bool domask, int lim, int r32, int hi) {
    f32x16 p0, p1;
#pragma unroll
    for (int rg = 0; rg < 4; ++rg) {
        const f32x4 fa = *(const LAS f32x4*)(fL + 8 * rg + 4 * hi), fb = *(const LAS f32x4*)(fL + 32 + 8 * rg + 4 * hi);
#pragma unroll
        for (int i = 0; i < 4; ++i) { p0[4 * rg + i] = fa[i]; p1[4 * rg + i] = fb[i]; }
    }
#pragma unroll
    for (int d0 = 0; d0 < 4; ++d0) {
        const bf16x8 a0 = *(const LAS bf16x8*)(kL + r32 * KP + d0 * 16 + hi * 8);
        const bf16x8 a1 = *(const LAS bf16x8*)(kL + (32 + r32) * KP + d0 * 16 + hi * 8);
        p0 = __builtin_amdgcn_mfma_f32_32x32x16_bf16(a0, qr[d0], p0, 0, 0, 0);
        p1 = __builtin_amdgcn_mfma_f32_32x32x16_bf16(a1, qr[d0], p1, 0, 0, 0);
    }
    if (domask) {
#pragma unroll
        for (int r = 0; r < 16; ++r) { const int kv = (r & 3) + 8 * (r >> 2) + 4 * hi; if (kv > lim) p0[r] = -INFINITY; if (kv + 32 > lim) p1[r] = -INFINITY; }
    }
    float mt = fmaxf(p0[0], p1[0]);
#pragma unroll
    for (int r = 1; r < 16; ++r) mt = fmaxf(mt, fmaxf(p0[r], p1[r]));
    mt = fmaxf(mt, __shfl_xor(mt, 32));
    const float mn = fmaxf(m, mt);
    const float alpha = __builtin_amdgcn_exp2f(m - mn);
    m = mn;
    float rs = 0.f;
#pragma unroll
    for (int r = 0; r < 16; ++r) { p0[r] = __builtin_amdgcn_exp2f(p0[r] - mn); p1[r] = __builtin_amdgcn_exp2f(p1[r] - mn); rs += p0[r] + p1[r]; }
    l = l * alpha + rs;
    if (hi == 0) wsf[r32] = alpha;
    LDS_WAIT();
#pragma unroll
    for (int rg = 0; rg < 4; ++rg) {
        const f32x4 al = *(const LAS f32x4*)(wsf + 8 * rg + 4 * hi);
#pragma unroll
        for (int i = 0; i < 4; ++i) { o[0][4 * rg + i] *= al[i]; o[1][4 * rg + i] *= al[i]; }
    }
    u32x4 pw[4];
    pw[0] = (u32x4){pk2(p0[0], p0[1]), pk2(p0[2], p0[3]), pk2(p0[4], p0[5]), pk2(p0[6], p0[7])};
    pw[1] = (u32x4){pk2(p0[8], p0[9]), pk2(p0[10], p0[11]), pk2(p0[12], p0[13]), pk2(p0[14], p0[15])};
    pw[2] = (u32x4){pk2(p1[0], p1[1]), pk2(p1[2], p1[3]), pk2(p1[4], p1[5]), pk2(p1[6], p1[7])};
    pw[3] = (u32x4){pk2(p1[8], p1[9]), pk2(p1[10], p1[11]), pk2(p1[12], p1[13]), pk2(p1[14], p1[15])};
#pragma unroll
    for (int d0 = 0; d0 < 2; ++d0)
#pragma unroll
        for (int s = 0; s < 4; ++s) {
            const s16x4 lo = *(const LAS s16x4*)(vL + (r32 + 32 * d0) * VP + 16 * s + 4 * hi);
            const s16x4 h4 = *(const LAS s16x4*)(vL + (r32 + 32 * d0) * VP + 16 * s + 8 + 4 * hi);
            const bf16x8 bv = (bf16x8){lo[0], lo[1], lo[2], lo[3], h4[0], h4[1], h4[2], h4[3]};
            o[d0] = __builtin_amdgcn_mfma_f32_32x32x16_bf16(__builtin_bit_cast(bf16x8, pw[s]), bv, o[d0], 0, 0, 0);
        }
    LDS_WAIT();
}
__device__ __forceinline__ void st16(LAS bf16* p, unsigned v) { *(LAS unsigned short*)p = (unsigned short)v; }
__device__ __forceinline__ void attn_prompt_unit(Frame& F, int b, int h, int qb) {
    const int tid = F.tid, lane = F.lane, wave = F.wave, r32 = lane & 31, hi = lane >> 5;
    LAS bf16* kbuf = (LAS bf16*)F.lds; LAS bf16* vbuf = (LAS bf16*)(F.lds + 18432); LAS float* fbuf = (LAS float*)(F.lds + 35840);
    LAS float* wsf = (LAS float*)(F.lds + 36352) + wave * 64;
    const int rowbase = b * 4096, q0 = qb * 256;
    const bf16* Qw = F.Q + (size_t)(rowbase + q0 + wave * 32) * DH + h * 64;
    bf16* Ow = F.O + (size_t)(rowbase + q0 + wave * 32) * DH + h * 64;
    bf16x8 qr[4];
#pragma unroll
    for (int d0 = 0; d0 < 4; ++d0) qr[d0] = *(const bf16x8*)(Qw + (size_t)r32 * DH + d0 * 16 + hi * 8);
    const int NT = 4 * (qb + 1), kvs = tid >> 3, c8 = tid & 7;
    const bf16* kg = F.KB + (size_t)(rowbase + kvs) * DH + h * 64 + 8 * c8;
    const bf16* vg = F.VB + (size_t)(rowbase + kvs) * DH + h * 64 + 8 * c8;
    const float* fg = F.F2P + (size_t)(b * 8 + h) * 4096;
    u32x4 kr = *(const u32x4*)kg, vr = *(const u32x4*)vg; float fr_ = tid < 64 ? fg[tid] : 0.f;
    float m = -1e30f, l = 0.f; f32x16 o[2];
#pragma unroll
    for (int r = 0; r < 16; ++r) { o[0][r] = 0.f; o[1][r] = 0.f; }
    const int qmin = q0 + wave * 32;
#define ATT_WRITE_TILE(t_) do { LAS bf16* kL_ = kbuf + ((t_) & 1) * (64 * KP); LAS bf16* vL_ = vbuf + ((t_) & 1) * (64 * VP); LAS float* fL_ = fbuf + ((t_) & 1) * 64; \
        *(LAS u32x4*)(kL_ + kvs * KP + 8 * c8) = kr; \
        st16(vL_ + (8 * c8 + 0) * VP + kvs, vr.x); st16(vL_ + (8 * c8 + 1) * VP + kvs, vr.x >> 16); \
        st16(vL_ + (8 * c8 + 2) * VP + kvs, vr.y); st16(vL_ + (8 * c8 + 3) * VP + kvs, vr.y >> 16); \
        st16(vL_ + (8 * c8 + 4) * VP + kvs, vr.z); st16(vL_ + (8 * c8 + 5) * VP + kvs, vr.z >> 16); \
        st16(vL_ + (8 * c8 + 6) * VP + kvs, vr.w); st16(vL_ + (8 * c8 + 7) * VP + kvs, vr.w >> 16); \
        if (tid < 64) fL_[tid] = -fr_; } while (0)
    ATT_WRITE_TILE(0);
    __syncthreads();
    for (int t = 0; t < NT; ++t) {
        if (t + 1 < NT) { kr = *(const u32x4*)(kg + (size_t)(t + 1) * 64 * DH); vr = *(const u32x4*)(vg + (size_t)(t + 1) * 64 * DH); fr_ = tid < 64 ? fg[(t + 1) * 64 + tid] : 0.f; }
        if (64 * t <= qmin + 31) {
            const bool domask = (64 * t + 63 > qmin);
            attn_tile(kbuf + (t & 1) * (64 * KP), vbuf + (t & 1) * (64 * VP), fbuf + (t & 1) * 64, wsf, qr, o, m, l, domask, qmin + r32 - 64 * t, r32, hi);
        }
        if (t + 1 < NT) ATT_WRITE_TILE(t + 1);
        __syncthreads();
    }
#undef ATT_WRITE_TILE
    l += __shfl_xor(l, 32);
    if (hi == 0) wsf[r32] = 1.0f / l;
    LDS_WAIT();
#pragma unroll
    for (int rg = 0; rg < 4; ++rg) {
        const f32x4 rl = *(const LAS f32x4*)(wsf + 8 * rg + 4 * hi);
#pragma unroll
        for (int i = 0; i < 4; ++i) {
            const int q = 8 * rg + 4 * hi + i;
            Ow[(size_t)q * DH + r32] = (bf16)f2bf(o[0][4 * rg + i] * rl[i]);
            Ow[(size_t)q * DH + 32 + r32] = (bf16)f2bf(o[1][4 * rg + i] * rl[i]);
        }
    }
    LDS_WAIT();
    __syncthreads();
}
__device__ __forceinline__ void attn_sample_unit(Frame& F, int b, int h, int qd) {
    const int tid = F.tid, lane = F.lane, wave = F.wave, r32 = lane & 31, hi = lane >> 5;
    LAS unsigned char* wb = F.lds + wave * 18432;
    LAS bf16* kL = (LAS bf16*)wb; LAS bf16* vL = (LAS bf16*)(wb + 9216); LAS float* fL = (LAS float*)(wb + 17920); LAS float* wsf = (LAS float*)(wb + 18176);
    const int qrow0 = NP + b * 32;
    bf16x8 qr[4];
#pragma unroll
    for (int d0 = 0; d0 < 4; ++d0) qr[d0] = *(const bf16x8*)(F.Q + (size_t)(qrow0 + r32) * DH + h * 64 + d0 * 16 + hi * 8);
    float m = -1e30f, l = 0.f; f32x16 o[2];
#pragma unroll
    for (int r = 0; r < 16; ++r) { o[0][r] = 0.f; o[1][r] = 0.f; }
    const float* ck = F.in[4] + ((size_t)b * 4096 * 8 + h) * 64;
    const float* cv = F.in[5] + ((size_t)b * 4096 * 8 + h) * 64;
    const float* f2 = F.F2S + (size_t)(b * 8 + h) * 4128;
    const int c16 = lane & 15, kq = lane >> 4;
    for (int tt = 0; tt < 2; ++tt) {
        const int kv0 = qd * 1024 + wave * 128 + tt * 64;
#pragma unroll 4
        for (int i = 0; i < 16; ++i) {
            const int kv = kq + 4 * i;
            const f32x4 x = *(const f32x4*)(ck + (size_t)(kv0 + kv) * 512 + 4 * c16);
            const f32x4 y = *(const f32x4*)(cv + (size_t)(kv0 + kv) * 512 + 4 * c16);
            u32x2 w; w.x = pk2(x[0], x[1]); w.y = pk2(x[2], x[3]);
            *(LAS u32x2*)(kL + kv * KP + 4 * c16) = w;
            const unsigned y0 = pk2(y[0], y[1]), y1 = pk2(y[2], y[3]);
            st16(vL + (4 * c16 + 0) * VP + kv, y0); st16(vL + (4 * c16 + 1) * VP + kv, y0 >> 16);
            st16(vL + (4 * c16 + 2) * VP + kv, y1); st16(vL + (4 * c16 + 3) * VP + kv, y1 >> 16);
        }
        fL[lane] = -f2[kv0 + lane];
        LDS_WAIT();
        attn_tile(kL, vL, fL, wsf, qr, o, m, l, false, 0, r32, hi);
    }
    if (wave == 7 && qd == 3) {
        const int kv = lane >> 1, half = lane & 1;
        const bf16* kn = F.KB + (size_t)(qrow0 + kv) * DH + h * 64 + 32 * half;
        const bf16* vn = F.VB + (size_t)(qrow0 + kv) * DH + h * 64 + 32 * half;
#pragma unroll
        for (int i = 0; i < 4; ++i) {
            const u32x4 x = *(const u32x4*)(kn + 8 * i), y = *(const u32x4*)(vn + 8 * i);
            *(LAS u32x4*)(kL + kv * KP + 32 * half + 8 * i) = x;
            *(LAS u32x4*)(kL + (32 + kv) * KP + 32 * half + 8 * i) = (u32x4){0u, 0u, 0u, 0u};
            const int d = 32 * half + 8 * i;
            st16(vL + (d + 0) * VP + kv, y.x); st16(vL + (d + 1) * VP + kv, y.x >> 16); st16(vL + (d + 2) * VP + kv, y.y); st16(vL + (d + 3) * VP + kv, y.y >> 16);
            st16(vL + (d + 4) * VP + kv, y.z); st16(vL + (d + 5) * VP + kv, y.z >> 16); st16(vL + (d + 6) * VP + kv, y.w); st16(vL + (d + 7) * VP + kv, y.w >> 16);
#pragma unroll
            for (int e = 0; e < 8; ++e) st16(vL + (d + e) * VP + 32 + kv, 0u);
        }
        fL[lane] = lane < 32 ? -f2[4096 + lane] : 0.f;
        LDS_WAIT();
        attn_tile(kL, vL, fL, wsf, qr, o, m, l, true, r32, r32, hi);
    }
    l += __shfl_xor(l, 32);
    __syncthreads();
    LAS float* cm = (LAS float*)F.lds; LAS float* cl = cm + 256; LAS float* co = cl + 256;
    if (hi == 0) { cm[wave * 32 + r32] = m; cl[wave * 32 + r32] = l; }
#pragma unroll
    for (int r = 0; r < 16; ++r) {
        const int q = (r & 3) + 8 * (r >> 2) + 4 * hi;
        co[(wave * 32 + q) * 64 + r32] = o[0][r]; co[(wave * 32 + q) * 64 + 32 + r32] = o[1][r];
    }
    __syncthreads();
    {
        const int q = tid >> 4, dg = tid & 15;
        float M = cm[q];
#pragma unroll
        for (int w = 1; w < 8; ++w) M = fmaxf(M, cm[w * 32 + q]);
        float L = 0.f; f32x4 acc = (f32x4){0.f, 0.f, 0.f, 0.f};
#pragma unroll
        for (int w = 0; w < 8; ++w) {
            const float wg = __builtin_amdgcn_exp2f(cm[w * 32 + q] - M);
            L += cl[w * 32 + q] * wg;
            acc += *(const LAS f32x4*)(co + (w * 32 + q) * 64 + 4 * dg) * wg;
        }
        float* pb = F.PB + ((size_t)(((b * 8 + h) * 4 + qd) * 32 + q)) * 68;
        *(f32x4*)(pb + 4 * dg) = acc;
        if (dg == 0) { pb[64] = M; pb[65] = L; }
    }
    __syncthreads();
}

__device__ __forceinline__ void s5_decode(int item, int& g, int& ci, int& row0, int& nT) {
    g = item / S5_ITEMS_PER_G; ci = item % S5_ITEMS_PER_G;
    if (ci < 256) { row0 = (ci >> 6) * 4096 + (ci & 63) * 64; nT = 64; } else { row0 = NP + (ci - 256) * 32; nT = 32; }
}
__device__ __forceinline__ void s5_load_u(Frame& F, LAS float* uL, int row0, int g, int nT) {
    if (F.lane < nT) {
        const bf16* up = F.U + (size_t)(row0 + F.lane) * DH + g * 16;
        const u32x4 a = *(const u32x4*)up, b = *(const u32x4*)(up + 8);
        LAS f32x4* d = (LAS f32x4*)(uL + F.lane * 16);
        d[0] = (f32x4){bflo(a.x), bfhi(a.x), bflo(a.y), bfhi(a.y)}; d[1] = (f32x4){bflo(a.z), bfhi(a.z), bflo(a.w), bfhi(a.w)};
        d[2] = (f32x4){bflo(b.x), bfhi(b.x), bflo(b.y), bfhi(b.y)}; d[3] = (f32x4){bflo(b.z), bfhi(b.z), bflo(b.w), bfhi(b.w)};
    }
    LDS_WAIT();
}
__device__ __forceinline__ f32x2 s5_step(const f32x2 a, const f32x2 s, const f32x2 (&bb)[16], const LAS float* ur) {
    const f32x4 u0 = *(const LAS f32x4*)ur, u1 = *(const LAS f32x4*)(ur + 4), u2 = *(const LAS f32x4*)(ur + 8), u3 = *(const LAS f32x4*)(ur + 12);
    f32x2 bu = bb[0] * u0[0];
    bu += bb[1] * u0[1]; bu += bb[2] * u0[2]; bu += bb[3] * u0[3];
    bu += bb[4] * u1[0]; bu += bb[5] * u1[1]; bu += bb[6] * u1[2]; bu += bb[7] * u1[3];
    bu += bb[8] * u2[0]; bu += bb[9] * u2[1]; bu += bb[10] * u2[2]; bu += bb[11] * u2[3];
    bu += bb[12] * u3[0]; bu += bb[13] * u3[1]; bu += bb[14] * u3[2]; bu += bb[15] * u3[3];
    f32x2 n; n.x = a.x * s.x - a.y * s.y + bu.x; n.y = a.x * s.y + a.y * s.x + bu.y;
    return n;
}
__device__ __forceinline__ void s5_pass_a(Frame& F, int wq, int nwq) {
    LAS float* uL = (LAS float*)(F.lds + F.wave * 12800);
    for (int item = wq; item < S5_ITEMS; item += nwq) {
        int g, ci, row0, nT; s5_decode(item, g, ci, row0, nT);
        if (ci >= 256) continue;
        const f32x2 a = F.abar[g * 64 + F.lane];
        f32x2 bb[16];
#pragma unroll
        for (int c = 0; c < 16; ++c) bb[c] = F.bbar[(size_t)(g * 64 + F.lane) * 16 + c];
        s5_load_u(F, uL, row0, g, nT);
        f32x2 s = (f32x2){0.f, 0.f};
#pragma unroll 4
        for (int j = 0; j < 64; ++j) s = s5_step(a, s, bb, uL + j * 16);
        F.E[(size_t)item * 64 + F.lane] = s;
        LDS_WAIT();
    }
}
__device__ __forceinline__ void s5_pass_c(Frame& F) {
    LAS float* uL = (LAS float*)(F.lds + F.wave * 12800);
    LAS bf16* Sb = (LAS bf16*)(F.lds + F.wave * 12800 + 4096);
    const int lane = F.lane, fr = lane & 15, fq = lane >> 4;
    for (int item = F.gw; item < S5_ITEMS; item += F.NGW) {
        int g, ci, row0, nT; s5_decode(item, g, ci, row0, nT);
        const f32x2 a = F.abar[g * 64 + lane];
        f32x2 bb[16];
#pragma unroll
        for (int c = 0; c < 16; ++c) bb[c] = F.bbar[(size_t)(g * 64 + lane) * 16 + c];
        bf16x8 cmf[4];
#pragma unroll
        for (int ks = 0; ks < 4; ++ks) cmf[ks] = *(const bf16x8*)(F.cmt + (g * 16 + fr) * 128 + 32 * ks + 8 * fq);
        const f32x4 dv = *(const f32x4*)(F.in[24] + g * 16 + 4 * fq);
        f32x2 s;
        if (ci < 256) {
            s = (f32x2){0.f, 0.f};
            const f32x2 aa = F.a64[g * 64 + lane];
            const f32x2* ep = F.E + (size_t)(g * S5_ITEMS_PER_G + (ci & ~63)) * 64 + lane;
            const int nprev = ci & 63;
            const int off = (16 - (nprev & 15)) & 15;
            for (int i0 = -off; i0 < nprev; i0 += 16) {
                f32x2 e[16];
#pragma unroll
                for (int u = 0; u < 16; ++u) e[u] = (i0 + u >= 0) ? ep[(size_t)(i0 + u) * 64] : (f32x2){0.f, 0.f};
#pragma unroll
                for (int u = 0; u < 16; ++u) { f32x2 n; n.x = aa.x * s.x - aa.y * s.y + e[u].x; n.y = aa.x * s.y + aa.y * s.x + e[u].y; s = n; }
            }
        } else {
            const int sb = ci - 256;
            s = (f32x2){F.in[7][(size_t)(sb * 32 + g) * 64 + lane], F.in[8][(size_t)(sb * 32 + g) * 64 + lane]};
        }
        s5_load_u(F, uL, row0, g, nT);
        for (int half = 0; half < (nT >> 5); ++half) {
#pragma unroll 4
            for (int jj = 0; jj < 32; ++jj) {
                s = s5_step(a, s, bb, uL + (half * 32 + jj) * 16);
                st16(Sb + jj * 136 + lane, f2bf(s.x)); st16(Sb + jj * 136 + 64 + lane, f2bf(s.y));
            }
            LDS_WAIT();
#pragma unroll
            for (int jb = 0; jb < 2; ++jb) {
                f32x4 acc = (f32x4){0.f, 0.f, 0.f, 0.f};
#pragma unroll
                for (int ks = 0; ks < 4; ++ks) {
                    const bf16x8 sf = *(const LAS bf16x8*)(Sb + (jb * 16 + fr) * 136 + 32 * ks + 8 * fq);
                    acc = __builtin_amdgcn_mfma_f32_16x16x32_bf16(cmf[ks], sf, acc, 0, 0, 0);
                }
                const int j = half * 32 + jb * 16 + fr;
                const f32x4 u4 = *(const LAS f32x4*)(uL + j * 16 + 4 * fq);
                float y[4];
#pragma unroll
                for (int i = 0; i < 4; ++i) { const float t = acc[i] + dv[i] * u4[i]; y[i] = t * fsigmoid(1.5957691216057308f * (t + 0.044715f * t * t * t)); }
                u32x2 w; w.x = pk2(y[0], y[1]); w.y = pk2(y[2], y[3]);
                *(u32x2*)(F.Z + (size_t)(row0 + j) * DH + g * 16 + 4 * fq) = w;
            }
            LDS_WAIT();
        }
        if (ci >= 256) { const int sb = ci - 256; F.out[O_SRS + (size_t)(sb * 32 + g) * 64 + lane] = s.x; F.out[O_SIS + (size_t)(sb * 32 + g) * 64 + lane] = s.y; }
        else if ((ci & 63) == 63) { const int b = ci >> 6; F.out[O_SRP + (size_t)(b * 32 + g) * 64 + lane] = s.x; F.out[O_SIP + (size_t)(b * 32 + g) * 64 + lane] = s.y; }
    }
}


struct SkSwiglu { bf16* H;
    __device__ __forceinline__ int brow(int ct, int nb) const { return 256 * (ct >> 2) + 32 * (ct & 3) + 128 * nb; }
    __device__ __forceinline__ void operator()(int row, int ct, int j0, const float (&v)[2][2]) const {
        const float a = v[0][0] * fsigmoid(v[0][0]) * v[1][0], b = v[0][1] * fsigmoid(v[0][1]) * v[1][1];
        *(unsigned*)(H + (size_t)(NP + row) * FF + 32 * ct + j0) = pk2(a, b); } };
struct SkResid { const float* xin; float* out; const float* mod; int gi; float gscale;
    __device__ __forceinline__ int brow(int ct, int) const { return 32 * ct; }
    __device__ __forceinline__ void operator()(int row, int ct, int j0, const float (&v)[1][2]) const {
        const int col = 32 * ct + j0; const float* gate = mod + (4 + (row >> 5)) * NMOD + gi * DM + col;
        const f32x2 x = *(const f32x2*)(xin + (size_t)row * DM + col), g = *(const f32x2*)gate;
        f32x2 o; o.x = x.x + gscale * (1.f + g.x) * v[0][0]; o.y = x.y + gscale * (1.f + g.y) * v[0][1];
        *(f32x2*)(out + (size_t)row * DM + col) = o; } };
struct SkIn { bf16 *U, *Q, *KB, *VB; float* out;
    __device__ __forceinline__ int brow(int ct, int) const { return 32 * ct; }
    __device__ __forceinline__ void operator()(int row, int ct, int j0, const float (&v)[1][2]) const {
        const int n = 32 * ct + j0, t = n >> 9, col = n & 511; const float sc = t == 1 ? QSCALE : 1.f;
        bf16* dst = U + (size_t)t * (17 * MiB / 2);
        *(unsigned*)(dst + (size_t)(NP + row) * DH + col) = pk2(v[0][0] * sc, v[0][1] * sc);
        if (t >= 2) *(f32x2*)(out + (t == 2 ? O_KS : O_VS) + (size_t)row * DH + col) = (f32x2){v[0][0], v[0][1]}; } };
struct SkGlu { const bf16* Z; bf16* Y; const float* bglu;
    __device__ __forceinline__ int brow(int ct, int) const { return 32 * ct; }
    __device__ __forceinline__ void operator()(int row, int ct, int j0, const float (&v)[1][2]) const {
        const int col = 32 * ct + j0; const unsigned z = *(const unsigned*)(Z + (size_t)(NP + row) * DH + col);
        *(unsigned*)(Y + (size_t)(NP + row) * DH + col) = pk2(bflo(z) * fsigmoid(v[0][0] + bglu[col]), bfhi(z) * fsigmoid(v[0][1] + bglu[col + 1])); } };
template <int NB, int KS, class Epi>
__device__ __forceinline__ void skinny_gemm(Frame& F, const bf16* A, const bf16* Bt, int ntc, const Epi& E, int first_cu = 0) {
    constexpr int K = KS * 128;
    const int lane = F.lane, wave = F.wave, r32 = lane & 31, hi = lane >> 5, tid = F.tid;
    LAS float* red = (LAS float*)F.lds;
    if ((int)blockIdx.x < first_cu) return;
    for (int tile = blockIdx.x - first_cu; tile < 8 * ntc; tile += F.G - first_cu) {
        const int rt = tile / ntc, ct = tile % ntc;
        const bf16* ap = A + (size_t)(32 * rt + r32) * K + wave * (K / 8) + 8 * hi;
        f32x16 acc[NB];
#pragma unroll
        for (int nb = 0; nb < NB; ++nb)
#pragma unroll
            for (int r = 0; r < 16; ++r) acc[nb][r] = 0.f;
        const bf16* bp0 = Bt + (size_t)(E.brow(ct, 0) + r32) * K + wave * (K / 8) + 8 * hi;
        const bf16* bp1 = Bt + (size_t)(E.brow(ct, NB - 1) + r32) * K + wave * (K / 8) + 8 * hi;
        constexpr int SB = (KS % 11 == 0) ? 11 : KS;
#pragma unroll 1
        for (int s0 = 0; s0 < KS; s0 += SB) {
            bf16x8 af[SB], b0[SB], b1[SB];
#pragma unroll
            for (int s = 0; s < SB; ++s) { af[s] = *(const bf16x8*)(ap + 16 * (s0 + s)); b0[s] = *(const bf16x8*)(bp0 + 16 * (s0 + s)); if (NB == 2) b1[s] = *(const bf16x8*)(bp1 + 16 * (s0 + s)); }
#pragma unroll
            for (int s = 0; s < SB; ++s) {
                acc[0] = __builtin_amdgcn_mfma_f32_32x32x16_bf16(af[s], b0[s], acc[0], 0, 0, 0);
                if (NB == 2) acc[NB - 1] = __builtin_amdgcn_mfma_f32_32x32x16_bf16(af[s], b1[s], acc[NB - 1], 0, 0, 0);
            }
        }
#pragma unroll
        for (int nb = 0; nb < NB; ++nb)
#pragma unroll
            for (int r = 0; r < 16; ++r) red[((wave * NB + nb) * 32 + (r & 3) + 8 * (r >> 2) + 4 * hi) * 32 + r32] = acc[nb][r];
        __syncthreads();
        {
            const int i = tid >> 4, j0 = 2 * (tid & 15);
            float v[NB][2];
#pragma unroll
            for (int nb = 0; nb < NB; ++nb) { v[nb][0] = 0.f; v[nb][1] = 0.f;
#pragma unroll
                for (int w = 0; w < 8; ++w) { const f32x2 x = *(const LAS f32x2*)(red + ((w * NB + nb) * 32 + i) * 32 + j0); v[nb][0] += x.x; v[nb][1] += x.y; } }
            E(32 * rt + i, ct, j0, v);
        }
        __syncthreads();
    }
}

__global__ void __launch_bounds__(512, 2) mk_fwd(Args args) {
    extern __shared__ __attribute__((aligned(16))) unsigned char lds_raw[];
    cg::grid_group grid = cg::this_grid();
    Frame F;
    F.lds = (LAS unsigned char*)lds_raw;
    F.tid = threadIdx.x; F.lane = F.tid & 63; F.wave = __builtin_amdgcn_readfirstlane(F.tid >> 6);
    F.G = gridDim.x; { const int bx = blockIdx.x; F.vcu = (F.G % 8 == 0) ? (bx % 8) * (F.G / 8) + bx / 8 : bx; }
    F.gw = blockIdx.x * NWAVES + F.wave; F.NGW = F.G * NWAVES;
#pragma unroll
    for (int i = 0; i < 34; ++i) F.in[i] = args.in[i];
    F.out = args.out;
    unsigned char* ws = args.ws;
    F.mod = (float*)(ws + WS_MOD);
    F.abar = (f32x2*)(ws + WS_S5C); F.a64 = (f32x2*)(ws + WS_S5C + 16384); F.bbar = (f32x2*)(ws + WS_S5C + 32768); F.cmt = (bf16*)(ws + WS_S5C + 294912);
    F.F2P = (float*)(ws + WS_F2P); F.F2S = (float*)(ws + WS_F2S); F.E = (f32x2*)(ws + WS_E);
    F.WUP1 = (bf16*)(ws + WS_WUP1); F.WDN1 = (bf16*)(ws + WS_WDN1); F.WIN = (bf16*)(ws + WS_WIN); F.WGLU = (bf16*)(ws + WS_WGLU); F.WOUT = (bf16*)(ws + WS_WOUT);
    F.WUP2 = (bf16*)(ws + WS_WUP2); F.WDN2 = (bf16*)(ws + WS_WDN2); F.HA = (bf16*)(ws + WS_HA); F.HID = (bf16*)(ws + WS_HID);
    F.U = (bf16*)(ws + WS_U); F.Q = (bf16*)(ws + WS_Q); F.KB = (bf16*)(ws + WS_KB); F.VB = (bf16*)(ws + WS_VB); F.Z = (bf16*)(ws + WS_Z); F.O = (bf16*)(ws + WS_O); F.PB = (float*)(ws + WS_PB);
    const int lo = args.ph_lo, hi = args.ph_hi;
    volatile LAS unsigned* misc = (volatile LAS unsigned*)(F.lds + LDS_BYTES - 256);
    if (F.tid < 2) misc[F.tid] = 0u;
    __syncthreads();
    XcdBarrier xbar; xbar.bar = (unsigned*)(ws + WS_BAR); xbar.x = 0; xbar.st = nullptr;
    if (hi - lo > 1) xbar = xcd_barrier_post((unsigned*)(ws + WS_BAR), misc);
#define IN(k) (lo <= (k) && (k) < hi)
#define REPS(k) _Pragma("nounroll") for (int rep_ = 0; rep_ < 1 + ((MK_REP_MASK >> (k)) & 1); ++rep_)
#define SEAM(k) do { if (IN(k) && IN((k) + 1)) { if ((k) == 100) grid.sync(); else xcd_barrier(xbar); } } while (0)
    typedef pg8::StaticOrder SO;
    float* xs_out = F.out + (size_t)NP * DM;

    if (hi > 1000) grid.sync();
    if (IN(0)) { phase_ada(F); phase_s5const(F); phase_weights(F);
#ifdef MK_PROBE_P0
        __syncthreads(); phase_ada(F); phase_weights(F);
#endif
    }
    SEAM(0);
    if (IN(1)) REPS(1) phase_norm<false>(F, F.in[0], F.in[1], F.in[11], 0, 1);
    SEAM(1);
    if (IN(2)) REPS(2) { pg8::Gemm g{F.HA, F.WUP1, NP, NUP, DM}; SO S; S.init(NP, NUP, F.G, (int)blockIdx.x); EpiSwiglu E{F.HID};
        pg8::gemm_phase<EpiSwiglu, SO, PG8_ALIGN, PG8_SP2>(F.lds, g, S, E);
        skinny_gemm<2, 8>(F, F.HA + (size_t)NP * DM, F.WUP1, 88, SkSwiglu{F.HID}, F.G == 256 ? 128 : 0);
#ifdef MK_PROBE_SK
        skinny_gemm<2, 8>(F, F.HA + (size_t)NP * DM, F.WUP1, 88, SkSwiglu{F.HID}, F.G == 256 ? 128 : 0);
#endif
    }
    SEAM(2);
    if (IN(3)) REPS(3) { pg8::Gemm g{F.HID, F.WDN1, NP, DM, FF}; SO S; S.init(NP, DM, F.G, (int)blockIdx.x); EpiResid E{F.in[0], F.in[1], F.out, F.mod, 2, 0.5f};
        pg8::gemm_phase<EpiResid, SO, PG8_ALIGN, PG8_SP2>(F.lds, g, S, E);
        skinny_gemm<1, 22>(F, F.HID + (size_t)NP * FF, F.WDN1, 32, SkResid{F.in[1], xs_out, F.mod, 2, 0.5f});
#ifdef MK_PROBE_SK
        skinny_gemm<1, 22>(F, F.HID + (size_t)NP * FF, F.WDN1, 32, SkResid{F.in[1], xs_out, F.mod, 2, 0.5f});
#endif
    }
    SEAM(3);
    if (IN(4)) REPS(4) phase_norm<true>(F, F.out, xs_out, F.in[14], 3, 4);
    SEAM(4);
    if (IN(5)) REPS(5) { phase_fcum(F);
        pg8::Gemm g{F.HA, F.WIN, NP, 2048, DM}; SO S; S.init(NP, 2048, F.G, (int)blockIdx.x); EpiIn E{F.U, F.Q, F.KB, F.VB, F.out};
        pg8::gemm_phase<EpiIn, SO, PG8_ALIGN, PG8_SP2>(F.lds, g, S, E);
        skinny_gemm<1, 8>(F, F.HA + (size_t)NP * DM, F.WIN, 64, SkIn{F.U, F.Q, F.KB, F.VB, F.out});
#ifdef MK_PROBE_SK
        skinny_gemm<1, 8>(F, F.HA + (size_t)NP * DM, F.WIN, 64, SkIn{F.U, F.Q, F.KB, F.VB, F.out});
#endif
    }
    SEAM(5);
    if (IN(6)) {
        for (int uix_ = F.vcu; uix_ < 256 * (1 + ((MK_REP_MASK >> 6) & 1)); uix_ += F.G) {
            const int uix = uix_ & 255, bh = uix >> 3, s = uix & 7;
            attn_prompt_unit(F, bh >> 3, bh & 7, 15 - s);
            attn_prompt_unit(F, bh >> 3, bh & 7, s);
        }
        for (int j = F.vcu; j < 256; j += F.G) attn_sample_unit(F, j >> 5, (j >> 2) & 7, j & 3);
        s5_pass_a(F, F.gw, F.NGW);
        __syncthreads();
    }
    SEAM(6);
    if (IN(7)) REPS(7) s5_pass_c(F);
    SEAM(7);
    if (IN(8)) REPS(8) { pg8::Gemm g{F.Z, F.WGLU, NP, DH, DH}; SO S; S.init(NP, DH, F.G, (int)blockIdx.x); EpiGlu E{F.Z, F.U, F.in[26]};
        pg8::gemm_phase<EpiGlu, SO, PG8_ALIGN, PG8_SP2>(F.lds, g, S, E);
        skinny_gemm<1, 4>(F, F.Z + (size_t)NP * DH, F.WGLU, 16, SkGlu{F.Z, F.U, F.in[26]});
#ifdef MK_PROBE_SK
        skinny_gemm<1, 4>(F, F.Z + (size_t)NP * DH, F.WGLU, 16, SkGlu{F.Z, F.U, F.in[26]});
#endif
    }
    SEAM(8);
    if (IN(9)) REPS(9) phase_mixnorm(F);
    SEAM(9);
    if (IN(10)) REPS(10) { pg8::Gemm g{F.HA, F.WOUT, NP, DM, DM}; SO S; S.init(NP, DM, F.G, (int)blockIdx.x); EpiResid E{F.out, xs_out, F.out, F.mod, 5, 1.0f};
        pg8::gemm_phase<EpiResid, SO, PG8_ALIGN, PG8_SP2>(F.lds, g, S, E);
        skinny_gemm<1, 8>(F, F.HA + (size_t)NP * DM, F.WOUT, 32, SkResid{xs_out, xs_out, F.mod, 5, 1.0f}); }
    SEAM(10);
    if (IN(11)) REPS(11) phase_norm<false>(F, F.out, xs_out, F.in[30], 6, 7);
    SEAM(11);
    if (IN(12)) REPS(12) { pg8::Gemm g{F.HA, F.WUP2, NP, NUP, DM}; SO S; S.init(NP, NUP, F.G, (int)blockIdx.x); EpiSwiglu E{F.HID};
        pg8::gemm_phase<EpiSwiglu, SO, PG8_ALIGN, PG8_SP2>(F.lds, g, S, E);
        skinny_gemm<2, 8>(F, F.HA + (size_t)NP * DM, F.WUP2, 88, SkSwiglu{F.HID}, F.G == 256 ? 128 : 0);
#ifdef MK_PROBE_SK
        skinny_gemm<2, 8>(F, F.HA + (size_t)NP * DM, F.WUP2, 88, SkSwiglu{F.HID}, F.G == 256 ? 128 : 0);
#endif
    }
    SEAM(12);
    if (IN(13)) REPS(13) { pg8::Gemm g{F.HID, F.WDN2, NP, DM, FF}; SO S; S.init(NP, DM, F.G, (int)blockIdx.x); EpiResid E{F.out, xs_out, F.out, F.mod, 8, 0.5f};
        pg8::gemm_phase<EpiResid, SO, PG8_ALIGN, PG8_SP2>(F.lds, g, S, E);
        skinny_gemm<1, 22>(F, F.HID + (size_t)NP * FF, F.WDN2, 32, SkResid{xs_out, xs_out, F.mod, 8, 0.5f}); }
    SEAM(13);
#ifdef MK_EXTRA_SYNCS
    for (int i_ = 0; i_ < MK_EXTRA_SYNCS; ++i_) xcd_barrier(xbar);
#endif
    if (IN(14)) REPS(14) phase_finalnorm(F);
#undef IN
#undef SEAM
}
constexpr int N_PHASES = 15;

#ifndef MK_MULTI
#define MK_MULTI 0
#endif
extern "C" void kernel_launch(void* const* d_in, const int* in_sizes, int n_in, void* d_out, int out_size, void* d_ws, size_t ws_size, hipStream_t stream) {
    static int grid = 0;
    if (grid == 0) {
        int dev = 0, cus = 0, per_cu = 0;
        if (hipGetDevice(&dev) != hipSuccess || hipDeviceGetAttribute(&cus, hipDeviceAttributeMultiprocessorCount, dev) != hipSuccess) { fprintf(stderr, "kernel_launch: device query failed\n"); grid = -1; return; }
        if (hipFuncSetAttribute((const void*)mk_fwd, hipFuncAttributeMaxDynamicSharedMemorySize, LDS_BYTES) != hipSuccess) { fprintf(stderr, "kernel_launch: hipFuncSetAttribute failed\n"); grid = -1; return; }
        if (hipOccupancyMaxActiveBlocksPerMultiprocessor(&per_cu, (const void*)mk_fwd, NWAVES * 64, LDS_BYTES) != hipSuccess || per_cu < 1) per_cu = 1;
        (void)hipGetLastError();
        grid = cus;
        if (n_in != 34 || ws_size < 176 * MiB) fprintf(stderr, "kernel_launch: unexpected n_in %d / ws %zu\n", n_in, ws_size);
    }
    if (grid < 0) return;
    if (hipMemsetAsync((char*)d_ws + WS_BAR, 0, 16384, stream) != hipSuccess) { fprintf(stderr, "kernel_launch: memset failed\n"); return; }
    Args a{};
    for (int i = 0; i < 34; ++i) a.in[i] = (const float*)d_in[i];
    a.out = (float*)d_out; a.ws = (unsigned char*)d_ws;
#if MK_MULTI
    for (int p = 0; p < N_PHASES; ++p) { a.ph_lo = p; a.ph_hi = p + 1; hipLaunchKernelGGL(mk_fwd, dim3(grid), dim3(NWAVES * 64), LDS_BYTES, stream, a); }
#else
    a.ph_lo = 0; a.ph_hi = N_PHASES;
    void* kargs[] = {&a};
    const hipError_t e = hipLaunchCooperativeKernel((const void*)mk_fwd, dim3(grid), dim3(NWAVES * 64), kargs, LDS_BYTES, stream);
    if (e != hipSuccess) fprintf(stderr, "kernel_launch: cooperative launch failed: %s (grid %d)\n", hipGetErrorString(e), grid);
#endif
}
```

```cpp
#include <hip/hip_runtime.h>
#include <hip/hip_cooperative_groups.h>
#include <cstdio>
#include <cstdint>
namespace cg = cooperative_groups;
namespace pg8 {
#define PG8_LAS __attribute__((address_space(3)))
typedef unsigned short bf16_t;
typedef short bf16x8 __attribute__((ext_vector_type(8)));
typedef float f32x4 __attribute__((ext_vector_type(4)));
typedef unsigned u32x4 __attribute__((ext_vector_type(4)));
constexpr int BM = 256, BK = 64, HALF = 128, HTB = HALF * BK * 2  , STAGE_BYTES = 8 * HTB, NXCD = 8, WGM = 8;

__host__ __device__ __forceinline__ int lds_byte(int r, int c) { const int st = (r >> 4) * 2 + (c >> 5), rr = r & 15, cc = c & 31, ob = rr * 64 + cc * 2; return st * 1024 + (ob ^ (((ob >> 9) & 1) << 5)); }
__host__ __device__ __forceinline__ void stage_rc(int b, int& R, int& C) { const int st = b / 1024, sb = b % 1024, swz = sb ^ (((sb >> 9) & 1) << 5); R = (st >> 1) * 16 + swz / 64; C = (st & 1) * 32 + (swz % 64) / 2; }
__host__ __device__ __forceinline__ int perm32(int rho) { const int n = rho >> 4, i = rho & 15; return 8 * (i >> 2) + 4 * n + (i & 3); }

struct Unit { int pm, pn; };
struct Gemm { const bf16_t* A; const bf16_t* Bt; int M, N, K; };

struct StaticOrder {
    int nM, nN, nwg, G, c;
    __host__ __device__ void init(int M, int N, int G_, int c_) { nM = M / BM; nN = N / BM; nwg = nM * nN; G = G_; c = c_; }
    __host__ __device__ bool next(int i, Unit& u) const {
        const long L = (long)i * G + c; if (L >= nwg) return false;
        int wgid = (int)L; { const int q = nwg / NXCD, r = nwg % NXCD, xcd = wgid % NXCD, off = wgid / NXCD; wgid = (xcd < r ? xcd * (q + 1) : r * (q + 1) + (xcd - r) * q) + off; }
        const int nig = WGM * nN, gid = wgid / nig, fm = gid * WGM, gsz = (nM - fm) < WGM ? (nM - fm) : WGM;
        u.pm = fm + ((wgid % nig) % gsz); u.pn = (wgid % nig) / gsz; return true;
    }
    __device__ __forceinline__ void a_ready(const Unit&) const {}
    __device__ __forceinline__ void done(const Unit&) const {}
};

__device__ __forceinline__ unsigned cvt_pk_bf16(float lo, float hi) { unsigned r; asm volatile("v_cvt_pk_bf16_f32 %0, %1, %2" : "=v"(r) : "v"(lo), "v"(hi)); return r; }
typedef float f32x2 __attribute__((ext_vector_type(2)));
__device__ __forceinline__ f32x2 gelu_pk(f32x2 v) {
    const f32x2 av = __builtin_elementwise_abs(v), d = av * 0.2316418882f + 1.0f;
    f32x2 t; t.x = __builtin_amdgcn_rcpf(d.x); t.y = __builtin_amdgcn_rcpf(d.y);
    f32x2 q = t * 0.5307027145f + (-0.7265760135f); q = q * t + 0.7107068705f; q = q * t + (-0.142248368f); q = q * t + 0.127414796f; q = q * t;
    const f32x2 s = (v * v) * (-0.72134752044f);
    f32x2 e; e.x = __builtin_amdgcn_exp2f(s.x); e.y = __builtin_amdgcn_exp2f(s.y);
    const f32x2 m = v * (q * e), r = v - m;
    f32x2 o; o.x = v.x < 0.f ? m.x : r.x; o.y = v.y < 0.f ? m.y : r.y; return o;
}

template <int ACT  > struct EpiBf16 {
    static constexpr bool PERM = true, AFTER_DRAIN = false; static_assert(ACT == 0 || ACT == 1, "EpiBf16: ACT is 0 (none) or 1 (gelu_pk)");
    bf16_t* O; int ldc; const float* bias; int split_cols; size_t split_stride; float scale0;
    __device__ __forceinline__ void operator()(const f32x4 (&acc)[2][2][4][2], const Unit& u, int wr, int wc, int fr, int fq) const {
        const int row0 = u.pm * BM + wr * 64 + fr; int colt = u.pn * BM; bf16_t* base = O;
        float sc = 1.f; if (split_cols) { const int t = colt / split_cols; base += (size_t)t * split_stride; colt -= t * split_cols; if (t == 0) sc = scale0; }
        const int col0 = colt + wc * 32 + 8 * fq, bcol0 = u.pn * BM + wc * 32 + 8 * fq;
        f32x4 bv[2][2];
#pragma unroll
        for (int bj = 0; bj < 2; ++bj)
#pragma unroll
            for (int n = 0; n < 2; ++n) bv[bj][n] = bias ? *(const f32x4*)(bias + bcol0 + bj * HALF + 4 * n) : (f32x4){0.f, 0.f, 0.f, 0.f};
#pragma unroll
        for (int ai = 0; ai < 2; ++ai)
#pragma unroll
            for (int m = 0; m < 4; ++m) { bf16_t* rowp = base + (size_t)(row0 + ai * HALF + m * 16) * ldc + col0;
#pragma unroll
                for (int bj = 0; bj < 2; ++bj) { f32x4 v0 = acc[ai][bj][m][0] + bv[bj][0], v1 = acc[ai][bj][m][1] + bv[bj][1];
                    if (ACT == 1) { f32x2 a = gelu_pk((f32x2){v0[0], v0[1]}), b = gelu_pk((f32x2){v0[2], v0[3]}), c = gelu_pk((f32x2){v1[0], v1[1]}), d = gelu_pk((f32x2){v1[2], v1[3]});
                        v0 = (f32x4){a.x, a.y, b.x, b.y}; v1 = (f32x4){c.x, c.y, d.x, d.y}; }
                    v0 = v0 * sc; v1 = v1 * sc; u32x4 w; w.x = cvt_pk_bf16(v0[0], v0[1]); w.y = cvt_pk_bf16(v0[2], v0[3]); w.z = cvt_pk_bf16(v1[0], v1[1]); w.w = cvt_pk_bf16(v1[2], v1[3]);
                    *(u32x4*)(rowp + bj * HALF) = w; } }
    }
};


template <class Epi, class Sched, bool ALIGN_EPI = false, bool SP2 = false>
__device__ __forceinline__ void gemm_phase(PG8_LAS unsigned char* lds, const Gemm g, const Sched& S, const Epi& E) {
    const int tid = threadIdx.x, wid = __builtin_amdgcn_readfirstlane(tid >> 6), lane = tid & 63, wr = wid >> 2, wc = wid & 3, fr = lane & 15, fq = lane >> 4;
    const int K = g.K, nt = K / BK;
    unsigned voffA[2], voffB[2];
#pragma unroll
    for (int i = 0; i < 2; ++i) { int R, C; stage_rc(tid * 16 + i * 8192, R, C); const int Rb = Epi::PERM ? ((R & ~31) + perm32(R & 31)) : R;
        voffA[i] = (unsigned)(R * K + C) * 2u; voffB[i] = (unsigned)(Rb * K + C) * 2u; }
    const size_t kstep = (size_t)(BK * 2);
    const size_t hstep = (size_t)HALF * K * 2;
    const size_t tstep = 2 * hstep;
    const unsigned ldsw = (unsigned)wid * 1024u;
    const int aoff = lds_byte(wr * 64 + fr, fq * 8), boff = lds_byte(wc * 32 + fr, fq * 8);
#define PG8_SA(b, h) (((b) * 2 + (h)) * HTB)
#define PG8_SB(b, h) ((4 + (b) * 2 + (h)) * HTB)
#define PG8_STAGE(bufoff, gbase, voff) do { _Pragma("unroll") for (int _i = 0; _i < 2; ++_i) \
        __builtin_amdgcn_global_load_lds((const unsigned*)((const char*)(gbase) + (voff)[_i]), (PG8_LAS unsigned*)(lds + (bufoff) + ldsw + _i * 8192), 16, 0, 0); } while (0)
#define PG8_LDA(dst, b, h) do { _Pragma("unroll") for (int m = 0; m < 4; ++m) _Pragma("unroll") for (int k = 0; k < 2; ++k) dst[m][k] = *(const PG8_LAS bf16x8*)(lds + PG8_SA(b, h) + aoff + m * 2048 + k * 1024); } while (0)
#define PG8_LDB(dst, b, h) do { _Pragma("unroll") for (int n = 0; n < 2; ++n) _Pragma("unroll") for (int k = 0; k < 2; ++k) dst[n][k] = *(const PG8_LAS bf16x8*)(lds + PG8_SB(b, h) + boff + n * 2048 + k * 1024); } while (0)
#define PG8_MMA(ai, bj, At, Bt) do { __builtin_amdgcn_s_setprio(1); _Pragma("unroll") for (int m = 0; m < 4; ++m) _Pragma("unroll") for (int n = 0; n < 2; ++n) _Pragma("unroll") for (int k = 0; k < 2; ++k) \
        acc[ai][bj][m][n] = __builtin_amdgcn_mfma_f32_16x16x32_bf16(Bt[n][k], At[m][k], acc[ai][bj][m][n], 0, 0, 0); __builtin_amdgcn_s_setprio(0); } while (0)
#define PG8_WAIT_V(n) asm volatile("s_waitcnt vmcnt(" #n ")" ::: "memory")
#define PG8_WAIT_L(n) asm volatile("s_waitcnt lgkmcnt(" #n ")" ::: "memory")
#define PG8_BAR __builtin_amdgcn_s_barrier()
#define PG8_SCHED __builtin_amdgcn_sched_barrier(0)
    Unit cur, nxt; int ui = 0;
    if (!S.next(0, cur)) return;
    f32x4 acc[2][2][4][2];
#pragma unroll
    for (int a = 0; a < 2; ++a)
#pragma unroll
        for (int b = 0; b < 2; ++b)
#pragma unroll
            for (int m = 0; m < 4; ++m)
#pragma unroll
                for (int n = 0; n < 2; ++n) acc[a][b][m][n] = (f32x4){0.f, 0.f, 0.f, 0.f};
    bf16x8 At[4][2], B0[2][2], B1[2][2];
    const char* cA = (const char*)g.A + (size_t)cur.pm * tstep; const char* cB = (const char*)g.Bt + (size_t)cur.pn * tstep;
    S.a_ready(cur);
    if constexpr (SP2) {
        PG8_STAGE(PG8_SB(0, 0), cB, voffB); PG8_STAGE(PG8_SB(0, 1), cB + hstep, voffB); PG8_STAGE(PG8_SA(0, 0), cA, voffA); PG8_STAGE(PG8_SA(0, 1), cA + hstep, voffA);
        if (wr == 1) PG8_BAR;
        PG8_WAIT_V(2); PG8_BAR;
        PG8_STAGE(PG8_SB(1, 0), cB + kstep, voffB); PG8_STAGE(PG8_SA(1, 0), cA + kstep, voffA); PG8_STAGE(PG8_SB(1, 1), cB + hstep + kstep, voffB);
        PG8_WAIT_V(6); PG8_BAR;
    } else {
        PG8_STAGE(PG8_SB(0, 0), cB, voffB); PG8_STAGE(PG8_SA(0, 0), cA, voffA); PG8_STAGE(PG8_SB(0, 1), cB + hstep, voffB); PG8_STAGE(PG8_SA(0, 1), cA + hstep, voffA);
        if (wr == 1) PG8_BAR;
        PG8_WAIT_V(4); PG8_BAR;
        PG8_STAGE(PG8_SB(1, 0), cB + kstep, voffB); PG8_STAGE(PG8_SA(1, 0), cA + kstep, voffA); PG8_STAGE(PG8_SB(1, 1), cB + hstep + kstep, voffB);
        PG8_WAIT_V(6); PG8_BAR;
    }
    for (;;) {
        const bool has_next = S.next(ui + 1, nxt);
        const char* nA = has_next ? (const char*)g.A + (size_t)nxt.pm * tstep : cA; const char* nB = has_next ? (const char*)g.Bt + (size_t)nxt.pn * tstep : cB;
        for (int t = 0; t < nt; t += 2) {
            const bool last = (t == nt - 2);
            const char* a1 = cA + (size_t)(t + 1) * kstep;
            const char* a2 = last ? nA : cA + (size_t)(t + 2) * kstep; const char* b2 = last ? nB : cB + (size_t)(t + 2) * kstep;
            const char* a3 = a2 + kstep; const char* b3 = b2 + kstep;
            if (last && has_next) S.a_ready(nxt);
            if constexpr (SP2) {
            PG8_LDB(B0, 0, 0); PG8_LDB(B1, 0, 1); PG8_SCHED; PG8_LDA(At, 0, 0); PG8_STAGE(PG8_SA(1, 1), a1 + hstep, voffA);
            PG8_WAIT_V(8); PG8_WAIT_L(0); PG8_BAR; PG8_MMA(0, 0, At, B0); PG8_MMA(0, 1, At, B1); PG8_BAR; PG8_SCHED;
            PG8_LDA(At, 0, 1); PG8_STAGE(PG8_SB(0, 0), b2, voffB); PG8_STAGE(PG8_SB(0, 1), b2 + hstep, voffB); PG8_STAGE(PG8_SA(0, 0), a2, voffA);
            PG8_WAIT_V(8); PG8_WAIT_L(0); PG8_BAR; PG8_MMA(1, 0, At, B0); PG8_MMA(1, 1, At, B1); PG8_BAR; PG8_SCHED;
            PG8_LDB(B0, 1, 0); PG8_LDB(B1, 1, 1); PG8_SCHED; PG8_LDA(At, 1, 0); PG8_STAGE(PG8_SA(0, 1), a2 + hstep, voffA);
            PG8_WAIT_V(8); PG8_WAIT_L(0); PG8_BAR; PG8_MMA(0, 0, At, B0); PG8_MMA(0, 1, At, B1); PG8_BAR; PG8_SCHED;
            PG8_LDA(At, 1, 1); PG8_STAGE(PG8_SB(1, 0), b3, voffB); PG8_STAGE(PG8_SB(1, 1), b3 + hstep, voffB); PG8_STAGE(PG8_SA(1, 0), a3, voffA);
            PG8_WAIT_V(8); PG8_WAIT_L(0); PG8_BAR; PG8_MMA(1, 0, At, B0); PG8_MMA(1, 1, At, B1); PG8_BAR; PG8_SCHED;
            } else {
            PG8_LDB(B0, 0, 0); PG8_SCHED; PG8_LDA(At, 0, 0); PG8_STAGE(PG8_SA(1, 1), a1 + hstep, voffA);
            PG8_WAIT_L(8); PG8_BAR; PG8_WAIT_L(0); PG8_MMA(0, 0, At, B0); PG8_BAR; PG8_SCHED;
            PG8_LDB(B1, 0, 1); PG8_STAGE(PG8_SB(0, 0), b2, voffB);
            PG8_BAR; PG8_WAIT_L(0); PG8_MMA(0, 1, At, B1); PG8_BAR;
            PG8_LDA(At, 0, 1); PG8_STAGE(PG8_SA(0, 0), a2, voffA);
            PG8_BAR; PG8_WAIT_L(0); PG8_MMA(1, 0, At, B0); PG8_BAR; PG8_SCHED;
            PG8_STAGE(PG8_SB(0, 1), b2 + hstep, voffB);
            PG8_WAIT_V(6); PG8_BAR; PG8_MMA(1, 1, At, B1); PG8_BAR;
            PG8_LDB(B0, 1, 0); PG8_SCHED; PG8_LDA(At, 1, 0); PG8_STAGE(PG8_SA(0, 1), a2 + hstep, voffA);
            PG8_WAIT_L(8); PG8_BAR; PG8_WAIT_L(0); PG8_MMA(0, 0, At, B0); PG8_BAR; PG8_SCHED;
            PG8_LDB(B1, 1, 1); PG8_STAGE(PG8_SB(1, 0), b3, voffB);
            PG8_BAR; PG8_WAIT_L(0); PG8_MMA(0, 1, At, B1); PG8_BAR;
            PG8_LDA(At, 1, 1); PG8_STAGE(PG8_SA(1, 0), a3, voffA);
            PG8_BAR; PG8_WAIT_L(0); PG8_MMA(1, 0, At, B0); PG8_BAR; PG8_SCHED;
            PG8_STAGE(PG8_SB(1, 1), b3 + hstep, voffB);
            PG8_WAIT_V(6); PG8_BAR; PG8_MMA(1, 1, At, B1); PG8_BAR;
            }
        }
        if constexpr (ALIGN_EPI) { if (wr == 0) PG8_BAR; }
        if constexpr (!Epi::AFTER_DRAIN) { E(acc, cur, wr, wc, fr, fq); S.done(cur); }
        if (!has_next) break;
#pragma unroll
        for (int a = 0; a < 2; ++a)
#pragma unroll
            for (int b = 0; b < 2; ++b)
#pragma unroll
                for (int m = 0; m < 4; ++m)
#pragma unroll
                    for (int n = 0; n < 2; ++n) acc[a][b][m][n] = (f32x4){0.f, 0.f, 0.f, 0.f};
        cur = nxt; cA = nA; cB = nB; ++ui;
        if constexpr (ALIGN_EPI) { if (wr == 1) PG8_BAR; }
    }
    PG8_WAIT_V(0);
    if constexpr (!ALIGN_EPI) { if (wr == 0) PG8_BAR; }
    PG8_BAR;
    if constexpr (Epi::AFTER_DRAIN) { E.fused(acc, cur, wr, wc, fr, fq, lds, wid, lane); S.done(cur); }
#undef PG8_SA
#undef PG8_SB
#undef PG8_STAGE
#undef PG8_LDA
#undef PG8_LDB
#undef PG8_MMA
#undef PG8_WAIT_V
#undef PG8_WAIT_L
#undef PG8_BAR
#undef PG8_SCHED
}
}

#ifndef PG8_SP2
#define PG8_SP2 true
#endif
#ifndef PG8_ALIGN
#define PG8_ALIGN true
#endif
#define LAS __attribute__((address_space(3)))
typedef unsigned short bf16;
typedef short bf16x8 __attribute__((ext_vector_type(8)));
typedef short s16x4 __attribute__((ext_vector_type(4)));
typedef float f32x4 __attribute__((ext_vector_type(4)));
typedef float f32x2 __attribute__((ext_vector_type(2)));
typedef float f32x16 __attribute__((ext_vector_type(16)));
typedef unsigned u32x4 __attribute__((ext_vector_type(4)));
typedef unsigned u32x2 __attribute__((ext_vector_type(2)));

constexpr int NP = 16384, NS = 256, MT = NP + NS, DM = 1024, FF = 2816, NUP = 5632, DH = 512, NMOD = 9216, DIN = 2056;
constexpr float EPS = 1e-6f, LOG2E = 1.4426950408889634f, QSCALE = 0.125f * 1.4426950408889634f;
constexpr size_t O_KP = 17039360, O_VP = 25427968, O_LFP = 33816576, O_SRP = 33947648, O_SIP = 33955840, O_KS = 33964032, O_VS = 34095104,
                 O_LFS = 34226176, O_SRS = 34228224, O_SIS = 34244608;
constexpr size_t MiB = 1u << 20;
constexpr size_t WS_MOD = 0, WS_S5C = 1 * MiB, WS_F2P = 2 * MiB, WS_F2S = 2 * MiB + 512 * 1024, WS_E = 4 * MiB, WS_WUP1 = 10 * MiB, WS_WDN1 = 21 * MiB,
                 WS_WIN = 27 * MiB, WS_WGLU = 31 * MiB, WS_WOUT = 32 * MiB, WS_WUP2 = 34 * MiB, WS_WDN2 = 45 * MiB, WS_HA = 52 * MiB, WS_HID = 86 * MiB;
constexpr size_t WS_U = WS_HID, WS_Q = WS_HID + 17 * MiB, WS_KB = WS_HID + 34 * MiB, WS_VB = WS_HID + 51 * MiB, WS_Z = WS_HID + 68 * MiB;
constexpr size_t WS_O = 176 * MiB, WS_BAR = 512 * 1024, WS_PB = 194 * MiB, WS_CNT = 512 * 1024 + 16384, WS_XB = 198 * MiB;
constexpr int CTL_BYTES = 16384 + 6 * 64 * 256;
#ifndef MK_REP_MASK
#define MK_REP_MASK 0
#endif
constexpr int S5_ITEMS_PER_G = 264, S5_ITEMS = 32 * 264;
constexpr int LDS_BYTES = 155648;
constexpr int NWAVES = 8;

struct Args { const float* in[34]; float* out; unsigned char* ws; int ph_lo, ph_hi; };

struct Frame {
    LAS unsigned char* lds;
    int tid, lane, wave, G, vcu, gw, NGW;
    const float* in[34];
    float* out;
    float* mod; f32x2* abar; f32x2* a64; f32x2* bbar; bf16* cmt; bf16* bmh; float* F2P; float* F2S; f32x2* E;
    bf16 *WUP1, *WDN1, *WIN, *WGLU, *WOUT, *WUP2, *WDN2, *HA, *HID, *U, *Q, *KB, *VB, *Z, *O; float* PB;
};

__device__ __forceinline__ unsigned f2bf(float f) { unsigned u = __builtin_bit_cast(unsigned, f); return (u + 0x7fffu + ((u >> 16) & 1u)) >> 16; }
typedef __bf16 bf16x2_t __attribute__((ext_vector_type(2)));
__device__ __forceinline__ unsigned pk2(float lo, float hi) { const f32x2 v = {lo, hi}; const bf16x2_t b = __builtin_convertvector(v, bf16x2_t); return __builtin_bit_cast(unsigned, b); }
__device__ __forceinline__ float bflo(unsigned w) { return __uint_as_float(w << 16); }
__device__ __forceinline__ float bfhi(unsigned w) { return __uint_as_float(w & 0xffff0000u); }
__device__ __forceinline__ float wave_sum(float v) {
#pragma unroll
    for (int o = 1; o < 64; o <<= 1) v += __shfl_xor(v, o);
    return v;
}
__device__ __forceinline__ float fsigmoid(float x) { return __builtin_amdgcn_rcpf(1.f + __builtin_amdgcn_exp2f(-x * LOG2E)); }
__device__ __forceinline__ int bidx(int row) { return row < NP ? (row >> 12) : 4 + ((row - NP) >> 5); }
#define LDS_WAIT() asm volatile("s_waitcnt lgkmcnt(0)" ::: "memory")

using pg8::Unit;
struct EpiSwiglu {
    static constexpr bool PERM = true, AFTER_DRAIN = false;
    bf16* H;
    __device__ __forceinline__ void operator()(const f32x4 (&acc)[2][2][4][2], const Unit& u, int wr, int wc, int fr, int fq) const {
        const int row0 = u.pm * 256 + wr * 64 + fr, col0 = u.pn * 128 + wc * 32 + 8 * fq;
#pragma unroll
        for (int ai = 0; ai < 2; ++ai)
#pragma unroll
            for (int m = 0; m < 4; ++m) {
                const int row = row0 + ai * 128 + m * 16;
                u32x4 w; unsigned ww[4];
#pragma unroll
                for (int n = 0; n < 2; ++n) {
                    const f32x4 g = acc[ai][0][m][n], up = acc[ai][1][m][n];
                    const f32x4 t = g * (-LOG2E);
                    f32x4 d; d[0] = __builtin_amdgcn_exp2f(t[0]); d[1] = __builtin_amdgcn_exp2f(t[1]); d[2] = __builtin_amdgcn_exp2f(t[2]); d[3] = __builtin_amdgcn_exp2f(t[3]);
                    d = d + 1.0f;
                    f32x4 rc; rc[0] = __builtin_amdgcn_rcpf(d[0]); rc[1] = __builtin_amdgcn_rcpf(d[1]); rc[2] = __builtin_amdgcn_rcpf(d[2]); rc[3] = __builtin_amdgcn_rcpf(d[3]);
                    const f32x4 r = (g * up) * rc;
                    ww[2 * n] = pk2(r[0], r[1]); ww[2 * n + 1] = pk2(r[2], r[3]);
                }
                w.x = ww[0]; w.y = ww[1]; w.z = ww[2]; w.w = ww[3];
                *(u32x4*)(H + (size_t)row * FF + col0) = w;
            }
    }
};
struct EpiResid {
    static constexpr bool PERM = true, AFTER_DRAIN = false;
    const float* xp; const float* xs; float* out; const float* mod; int gi; float gscale;
    __device__ __forceinline__ void operator()(const f32x4 (&acc)[2][2][4][2], const Unit& u, int wr, int wc, int fr, int fq) const {
        const int row0 = u.pm * 256 + wr * 64 + fr, col0 = u.pn * 256 + wc * 32 + 8 * fq;
#pragma unroll
        for (int ai = 0; ai < 2; ++ai) {
            f32x4 xv[4][2][2];
#pragma unroll
            for (int m = 0; m < 4; ++m) {
                const int row = row0 + ai * 128 + m * 16;
                const float* xin = row < NP ? xp + (size_t)row * DM : xs + (size_t)(row - NP) * DM;
#pragma unroll
                for (int bj = 0; bj < 2; ++bj)
#pragma unroll
                    for (int n = 0; n < 2; ++n) xv[m][bj][n] = *(const f32x4*)(xin + col0 + bj * 128 + 4 * n);
            }
#pragma unroll
            for (int m = 0; m < 4; ++m) {
                const int row = row0 + ai * 128 + m * 16;
                const float* gate = mod + bidx(row) * NMOD + gi * DM;
                float* orow = out + (size_t)row * DM;
#pragma unroll
                for (int bj = 0; bj < 2; ++bj)
#pragma unroll
                    for (int n = 0; n < 2; ++n) {
                        const int col = col0 + bj * 128 + 4 * n;
                        const f32x4 g = *(const f32x4*)(gate + col);
                        *(f32x4*)(orow + col) = xv[m][bj][n] + (g + 1.0f) * gscale * acc[ai][bj][m][n];
                    }
            }
        }
    }
};
struct EpiIn {
    static constexpr bool PERM = true, AFTER_DRAIN = false;
    bf16 *U, *Q, *KB, *VB; float* out;
    __device__ __forceinline__ void operator()(const f32x4 (&acc)[2][2][4][2], const Unit& u, int wr, int wc, int fr, int fq) const {
        const int t = u.pn >> 1;
        const int row0 = u.pm * 256 + wr * 64 + fr, col0 = (u.pn & 1) * 256 + wc * 32 + 8 * fq;
        bf16* dst = t == 0 ? U : t == 1 ? Q : t == 2 ? KB : VB;
        const float sc = t == 1 ? QSCALE : 1.0f;
#pragma unroll
        for (int ai = 0; ai < 2; ++ai)
#pragma unroll
            for (int m = 0; m < 4; ++m) {
                const int row = row0 + ai * 128 + m * 16;
                float* fo = row < NP ? out + (t == 2 ? O_KP : O_VP) + (size_t)row * DH : out + (t == 2 ? O_KS : O_VS) + (size_t)(row - NP) * DH;
#pragma unroll
                for (int bj = 0; bj < 2; ++bj) {
                    const int col = col0 + bj * 128;
                    const f32x4 v0 = acc[ai][bj][m][0], v1 = acc[ai][bj][m][1];
                    u32x4 w; w.x = pk2(v0[0] * sc, v0[1] * sc); w.y = pk2(v0[2] * sc, v0[3] * sc); w.z = pk2(v1[0] * sc, v1[1] * sc); w.w = pk2(v1[2] * sc, v1[3] * sc);
                    *(u32x4*)(dst + (size_t)row * DH + col) = w;
                    if (t >= 2) { __builtin_nontemporal_store(v0, (f32x4*)(fo + col)); __builtin_nontemporal_store(v1, (f32x4*)(fo + col + 4)); }
                }
            }
    }
};
struct EpiGlu {
    static constexpr bool PERM = true, AFTER_DRAIN = false;
    const bf16* Z; bf16* Y; const float* bglu;
    __device__ __forceinline__ void operator()(const f32x4 (&acc)[2][2][4][2], const Unit& u, int wr, int wc, int fr, int fq) const {
        const int row0 = u.pm * 256 + wr * 64 + fr, col0 = u.pn * 256 + wc * 32 + 8 * fq;
#pragma unroll
        for (int bj = 0; bj < 2; ++bj) {
            const int col = col0 + bj * 128;
            const f32x4 b0 = *(const f32x4*)(bglu + col), b1 = *(const f32x4*)(bglu + col + 4);
            u32x4 zv[2][4];
#pragma unroll
            for (int ai = 0; ai < 2; ++ai)
#pragma unroll
                for (int m = 0; m < 4; ++m) zv[ai][m] = *(const u32x4*)(Z + (size_t)(row0 + ai * 128 + m * 16) * DH + col);
#pragma unroll
            for (int ai = 0; ai < 2; ++ai)
#pragma unroll
                for (int m = 0; m < 4; ++m) {
                    const int row = row0 + ai * 128 + m * 16;
                    const u32x4 z = zv[ai][m];
                    const f32x4 a0 = acc[ai][bj][m][0] + b0, a1 = acc[ai][bj][m][1] + b1;
                    u32x4 w;
                    w.x = pk2(bflo(z.x) * fsigmoid(a0[0]), bfhi(z.x) * fsigmoid(a0[1]));
                    w.y = pk2(bflo(z.y) * fsigmoid(a0[2]), bfhi(z.y) * fsigmoid(a0[3]));
                    w.z = pk2(bflo(z.z) * fsigmoid(a1[0]), bfhi(z.z) * fsigmoid(a1[1]));
                    w.w = pk2(bflo(z.w) * fsigmoid(a1[2]), bfhi(z.w) * fsigmoid(a1[3]));
                    *(u32x4*)(Y + (size_t)row * DH + col) = w;
                }
        }
    }
};

#define RLX_AGENT __ATOMIC_RELAXED, __HIP_MEMORY_SCOPE_AGENT
__device__ __forceinline__ void wait_count(unsigned* cnt, unsigned want) {
    const unsigned long long t0 = __builtin_amdgcn_s_memrealtime();
    for (;;) {
        if ((unsigned)__builtin_amdgcn_readfirstlane(__hip_atomic_load(cnt, RLX_AGENT)) >= want) break;
        if (__builtin_amdgcn_s_memrealtime() - t0 > 2000000ull) break;
        __builtin_amdgcn_s_sleep(2);
    }
    __builtin_amdgcn_fence(__ATOMIC_ACQUIRE, "agent");
}
struct PanelRms {
    float* xbuf;
    unsigned* cnt;
    __device__ __forceinline__ void run(const f32x4 (&v)[2][2][4][2], const Unit& u, int wr, int wc, int fr, int fq, LAS unsigned char* lds, int wid, int lane) const {
        LAS float* P = (LAS float*)lds; LAS float* S = (LAS float*)(lds + 4096);
#pragma unroll
        for (int ai = 0; ai < 2; ++ai)
#pragma unroll
            for (int m = 0; m < 4; ++m) {
                float s = 0.f;
#pragma unroll
                for (int bj = 0; bj < 2; ++bj)
#pragma unroll
                    for (int n = 0; n < 2; ++n) { const f32x4 x = v[ai][bj][m][n]; s += (x[0] * x[0] + x[1] * x[1]) + (x[2] * x[2] + x[3] * x[3]); }
                s += __shfl_xor(s, 16); s += __shfl_xor(s, 32);
                if (fq == 0) P[(ai * 128 + wr * 64 + m * 16 + fr) * 4 + wc] = s;
            }
        LDS_WAIT(); __builtin_amdgcn_s_barrier(); asm volatile("" ::: "memory");
        const int row = wid * 32 + (lane & 31);
        if (lane < 32) {
            const f32x4 a = *(const LAS f32x4*)(P + row * 4);
            __hip_atomic_store(xbuf + (size_t)(u.pm * 256 + row) * 4 + u.pn, (a[0] + a[1]) + (a[2] + a[3]), RLX_AGENT);
        }
        asm volatile("s_waitcnt vmcnt(0)" ::: "memory");
        if (lane == 0) __hip_atomic_fetch_add(cnt + 64 * u.pm, 1u, RLX_AGENT);
        if (wid == 0) wait_count(cnt + 64 * u.pm, 32u);
        asm volatile("s_waitcnt vmcnt(0) lgkmcnt(0)" ::: "memory"); __builtin_amdgcn_s_barrier(); asm volatile("" ::: "memory");
        if (lane < 32) {
            const float* slot = xbuf + (size_t)(u.pm * 256 + row) * 4; float q = 0.f;
#pragma unroll
            for (int t = 0; t < 4; ++t) q += __hip_atomic_load(slot + t, RLX_AGENT);
            S[row] = 1.0f / sqrtf(q * (1.0f / DM) + EPS);
        }
        LDS_WAIT(); __builtin_amdgcn_s_barrier(); asm volatile("" ::: "memory");
    }
};
struct EpiFinalNorm {
    static constexpr bool PERM = true, AFTER_DRAIN = true;
    const float* xin; float* out; const float* mod; int gi; float gscale; const float* gfin; PanelRms st;
    __device__ __forceinline__ void fused(f32x4 (&acc)[2][2][4][2], const Unit& u, int wr, int wc, int fr, int fq, LAS unsigned char* lds, int wid, int lane) const {
        const int row0 = u.pm * 256 + wr * 64 + fr, col0 = u.pn * 256 + wc * 32 + 8 * fq;
        const float* gate = mod + (u.pm >> 4) * NMOD + gi * DM;
#pragma unroll
        for (int ai = 0; ai < 2; ++ai)
#pragma unroll
            for (int m = 0; m < 4; ++m) {
                const float* xr = xin + (size_t)(row0 + ai * 128 + m * 16) * DM;
#pragma unroll
                for (int bj = 0; bj < 2; ++bj)
#pragma unroll
                    for (int n = 0; n < 2; ++n) { const int col = col0 + bj * 128 + 4 * n;
                        const f32x4 g = *(const f32x4*)(gate + col), x = *(const f32x4*)(xr + col);
                        acc[ai][bj][m][n] = x + (g + 1.0f) * gscale * acc[ai][bj][m][n]; }
                asm volatile("" : "+v"(acc[ai][0][m][0]), "+v"(acc[ai][0][m][1]), "+v"(acc[ai][1][m][0]), "+v"(acc[ai][1][m][1]));
                if (m & 1) asm volatile("" ::: "memory");
            }
        st.run(acc, u, wr, wc, fr, fq, lds, wid, lane);
        const LAS float* S = (const LAS float*)(lds + 4096);
#pragma unroll
        for (int ai = 0; ai < 2; ++ai)
#pragma unroll
            for (int m = 0; m < 4; ++m) {
                const float rs = S[ai * 128 + wr * 64 + m * 16 + fr];
                float* orow = out + (size_t)(row0 + ai * 128 + m * 16) * DM;
#pragma unroll
                for (int bj = 0; bj < 2; ++bj)
#pragma unroll
                    for (int n = 0; n < 2; ++n) { const int col = col0 + bj * 128 + 4 * n;
                        *(f32x4*)(orow + col) = acc[ai][bj][m][n] * rs * *(const f32x4*)(gfin + col); }
            }
    }
};

__device__ __forceinline__ void phase_ada(Frame& F) {
    LAS float* sm = (LAS float*)F.lds;
    LAS float* red = sm + 12288;
    const float* cp = F.in[2]; const float* cs = F.in[3]; const float* wada = F.in[9]; const float* bada = F.in[10];
    for (int i = F.tid; i < 12288; i += 512) { const int d = i / 12, bi = i % 12; const float c = bi < 4 ? cp[bi * DM + d] : cs[(bi - 4) * DM + d]; sm[i] = c * fsigmoid(c); }
    __syncthreads();
    for (int cb = blockIdx.x; cb < 256; cb += F.G) {
        const int ks = F.tid / 36, cl = F.tid % 36;
        float acc[12];
#pragma unroll
        for (int i = 0; i < 12; ++i) acc[i] = 0.f;
        if (F.tid < 504) {
            const float* wp = wada + (size_t)ks * NMOD + cb * 36 + cl;
            const int nd = (DM - ks + 13) / 14;
            for (int i0 = 0; i0 < nd; i0 += 16) {
                float w[16];
#pragma unroll
                for (int u = 0; u < 16; ++u) w[u] = (i0 + u < nd) ? __builtin_nontemporal_load(wp + (size_t)(i0 + u) * 14 * NMOD) : 0.f;
#pragma unroll
                for (int u = 0; u < 16; ++u) {
                    const int d = (i0 + u < nd) ? ks + 14 * (i0 + u) : 0;
                    const f32x4 s0 = *(const LAS f32x4*)(sm + d * 12), s1 = *(const LAS f32x4*)(sm + d * 12 + 4), s2 = *(const LAS f32x4*)(sm + d * 12 + 8);
                    acc[0] += w[u] * s0[0]; acc[1] += w[u] * s0[1]; acc[2] += w[u] * s0[2]; acc[3] += w[u] * s0[3];
                    acc[4] += w[u] * s1[0]; acc[5] += w[u] * s1[1]; acc[6] += w[u] * s1[2]; acc[7] += w[u] * s1[3];
                    acc[8] += w[u] * s2[0]; acc[9] += w[u] * s2[1]; acc[10] += w[u] * s2[2]; acc[11] += w[u] * s2[3];
                }
            }
#pragma unroll
            for (int i = 0; i < 12; ++i) red[(ks * 36 + cl) * 12 + i] = acc[i];
        }
        __syncthreads();
        if (F.tid < 432) {
            const int c2 = F.tid / 12, bi = F.tid % 12; float s = bada[cb * 36 + c2];
#pragma unroll
            for (int k = 0; k < 14; ++k) s += red[(k * 36 + c2) * 12 + bi];
            F.mod[bi * NMOD + cb * 36 + c2] = s;
        }
        __syncthreads();
    }
}
__device__ __forceinline__ void sincos_d(double x, double& s, double& c) {
    const double kf = __builtin_rint(x * 0.63661977236758134308);
    double r = __builtin_fma(-kf, 1.57079632679489655800e+00, x); r = __builtin_fma(-kf, 6.12323399573676603587e-17, r);
    const int k = ((int)kf) & 3; const double r2 = r * r;
    double sp = 1.0 / 6227020800.0; sp = __builtin_fma(sp, r2, -1.0 / 39916800.0); sp = __builtin_fma(sp, r2, 1.0 / 362880.0); sp = __builtin_fma(sp, r2, -1.0 / 5040.0);
    sp = __builtin_fma(sp, r2, 1.0 / 120.0); sp = __builtin_fma(sp, r2, -1.0 / 6.0); sp = __builtin_fma(sp, r2, 1.0); const double sr = sp * r;
    double cq = -1.0 / 87178291200.0; cq = __builtin_fma(cq, r2, 1.0 / 479001600.0); cq = __builtin_fma(cq, r2, -1.0 / 3628800.0); cq = __builtin_fma(cq, r2, 1.0 / 40320.0);
    cq = __builtin_fma(cq, r2, -1.0 / 720.0); cq = __builtin_fma(cq, r2, 1.0 / 24.0); cq = __builtin_fma(cq, r2, -0.5); const double cr = __builtin_fma(cq, r2, 1.0);
    s = (k == 0) ? sr : (k == 1) ? cr : (k == 2) ? -sr : -cr;
    c = (k == 0) ? cr : (k == 1) ? -sr : (k == 2) ? -cr : sr;
}
__device__ __forceinline__ double exp_d(double x) {
    const double n = __builtin_rint(x * 1.4426950408889634074);
    double r = __builtin_fma(-n, 6.93147180369123816490e-01, x); r = __builtin_fma(-n, 1.90821492927058770002e-10, r);
    double p = 1.0 / 6227020800.0;
    p = __builtin_fma(p, r, 1.0 / 479001600.0); p = __builtin_fma(p, r, 1.0 / 39916800.0); p = __builtin_fma(p, r, 1.0 / 3628800.0); p = __builtin_fma(p, r, 1.0 / 362880.0);
    p = __builtin_fma(p, r, 1.0 / 40320.0); p = __builtin_fma(p, r, 1.0 / 5040.0); p = __builtin_fma(p, r, 1.0 / 720.0); p = __builtin_fma(p, r, 1.0 / 120.0);
    p = __builtin_fma(p, r, 1.0 / 24.0); p = __builtin_fma(p, r, 1.0 / 6.0); p = __builtin_fma(p, r, 0.5); p = __builtin_fma(p, r, 1.0); p = __builtin_fma(p, r, 1.0);
    return __builtin_ldexp(p, (int)n);
}
__device__ __forceinline__ void phase_s5const(Frame& F) {
    if (F.tid >= 8) return;
    for (int id = blockIdx.x * 8 + F.tid; id < 2048; id += F.G * 8) {
    const int g = id >> 6, p = id & 63;
    const double lre = (double)F.in[17][id], lim = (double)F.in[18][id], dt = exp_d((double)F.in[19][g]);
    const double mag = exp_d(lre * dt); double sn, cs; sincos_d(lim * dt, sn, cs);
    const double are = mag * cs, aim = mag * sn;
    F.abar[id] = (f32x2){(float)are, (float)aim};
    double pr = are, pi = aim;
#pragma unroll
    for (int i = 0; i < 6; ++i) { const double nr = pr * pr - pi * pi, ni = 2.0 * pr * pi; pr = nr; pi = ni; }
    F.a64[id] = (f32x2){(float)pr, (float)pi};
    const double xr = are - 1.0, xi = aim, den = lre * lre + lim * lim;
    const double cr = (xr * lre + xi * lim) / den, ci = (xi * lre - xr * lim) / den;
    const float* bre = F.in[20] + (size_t)id * 16; const float* bim = F.in[21] + (size_t)id * 16;
    const int kre = 64 * (p >> 5) + (p & 31), kim = kre + 32;
#pragma unroll
    for (int c = 0; c < 16; ++c) { const double br = bre[c], bi = bim[c]; const float vr = (float)(cr * br - ci * bi), vi = (float)(cr * bi + ci * br);
        const unsigned hr = f2bf(vr), hi_ = f2bf(vi);
        F.bmh[(size_t)(g * 128 + kre) * 16 + c] = (bf16)hr; F.bmh[(size_t)(g * 128 + kim) * 16 + c] = (bf16)hi_; }
    const float* cre = F.in[22]; const float* cim = F.in[23];
#pragma unroll
    for (int c = 0; c < 16; ++c) {
        F.cmt[(g * 16 + c) * 128 + p] = (bf16)f2bf(cre[(g * 16 + c) * 64 + p]);
        F.cmt[(g * 16 + c) * 128 + 64 + p] = (bf16)f2bf(-cim[(g * 16 + c) * 64 + p]);
    }
    }
}
__device__ __forceinline__ void transpose_item(const float* W, int ldw, int k0, int n0, bf16* WT, int Kd, int drow0, LAS float* scr, int lane) {
    float wv[32];
#pragma unroll
    for (int i = 0; i < 32; ++i) wv[i] = __builtin_nontemporal_load(W + (size_t)(k0 + 2 * i + (lane >> 5)) * ldw + n0 + (lane & 31));
#pragma unroll
    for (int i = 0; i < 32; ++i) scr[(2 * i + (lane >> 5)) * 33 + (lane & 31)] = wv[i];
    LDS_WAIT();
    const int c = lane & 7;
#pragma unroll
    for (int j = 0; j < 4; ++j) { const int n = (lane >> 3) + 8 * j; const LAS float* s = scr + (8 * c) * 33 + n;
        u32x4 o; o.x = pk2(s[0 * 33], s[1 * 33]); o.y = pk2(s[2 * 33], s[3 * 33]); o.z = pk2(s[4 * 33], s[5 * 33]); o.w = pk2(s[6 * 33], s[7 * 33]);
        *(u32x4*)(WT + (size_t)(drow0 + n) * Kd + k0 + 8 * c) = o; }
    LDS_WAIT();
}
__device__ __forceinline__ int up_drow(int n0) { return n0 < FF ? 256 * (n0 >> 7) + (n0 & 127) : 256 * ((n0 - FF) >> 7) + 128 + ((n0 - FF) & 127); }
__device__ __forceinline__ void phase_weights(Frame& F) {
    LAS float* scr = (LAS float*)(F.lds + 81920 + F.wave * 8704);
    constexpr int I_UP = 16 * 176, I_DN = 44 * 32, I_IN = 16 * 64, I_GLU = 8 * 16, I_OUT = 16 * 32;
    constexpr int NITEMS = 2 * I_UP + 2 * I_DN + I_IN + I_GLU + I_OUT;
    for (int it = F.gw; it < NITEMS; it += F.NGW) {
        int r = it;
        if (r < I_UP) { const int kb = r / 176, nb = r % 176; transpose_item(F.in[12], NUP, 64 * kb, 32 * nb, F.WUP1, DM, up_drow(32 * nb), scr, F.lane); continue; } r -= I_UP;
        if (r < I_UP) { const int kb = r / 176, nb = r % 176; transpose_item(F.in[31], NUP, 64 * kb, 32 * nb, F.WUP2, DM, up_drow(32 * nb), scr, F.lane); continue; } r -= I_UP;
        if (r < I_DN) { const int kb = r / 32, nb = r % 32; transpose_item(F.in[13], DM, 64 * kb, 32 * nb, F.WDN1, FF, 32 * nb, scr, F.lane); continue; } r -= I_DN;
        if (r < I_DN) { const int kb = r / 32, nb = r % 32; transpose_item(F.in[32], DM, 64 * kb, 32 * nb, F.WDN2, FF, 32 * nb, scr, F.lane); continue; } r -= I_DN;
        if (r < I_IN) { const int kb = r / 64, nb = r % 64; transpose_item(F.in[15], DIN, 64 * kb, 32 * nb, F.WIN, DM, 32 * nb, scr, F.lane); continue; } r -= I_IN;
        if (r < I_GLU) { const int kb = r / 16, nb = r % 16; transpose_item(F.in[25], DH, 64 * kb, 32 * nb, F.WGLU, DH, 32 * nb, scr, F.lane); continue; } r -= I_GLU;
        { const int kb = r / 32, nb = r % 32; transpose_item(F.in[29], DM, 64 * kb, 32 * nb, F.WOUT, DM, 32 * nb, scr, F.lane); }
    }
}

__device__ __forceinline__ bool row_next(const Frame& F, int k, int& row) {
    if (F.NGW == 2048) { if (k < 8) { row = F.gw + 2048 * k; return true; } if (k == 8 && (F.gw & 7) == 0) { row = NP + (F.gw >> 3); return true; } return false; }
    row = F.gw + k * F.NGW; return row < MT;
}
template <bool FG>
__device__ __forceinline__ void phase_norm(Frame& F, const float* xp, const float* xs, const float* gN, int si, int ci) {
    LAS float* wf = (LAS float*)F.lds;
    if (FG) {
        const float* win = F.in[15];
        for (int i = F.tid; i < 8192; i += 512) wf[i] = win[(size_t)(i >> 3) * DIN + 2048 + (i & 7)];
        __syncthreads();
    }
    const int lane = F.lane;
    int row, nrow; f32x4 v[4], nv[4];
    bool have = row_next(F, 0, row);
    if (have) { const float* xr = row < NP ? xp + (size_t)row * DM : xs + (size_t)(row - NP) * DM;
#pragma unroll
        for (int j = 0; j < 4; ++j) v[j] = *(const f32x4*)(xr + 4 * lane + 256 * j); }
    for (int k_ = 0; have; ++k_) {
        const bool hn = row_next(F, k_ + 1, nrow);
        if (hn) { const float* xr = nrow < NP ? xp + (size_t)nrow * DM : xs + (size_t)(nrow - NP) * DM;
#pragma unroll
            for (int j = 0; j < 4; ++j) nv[j] = *(const f32x4*)(xr + 4 * lane + 256 * j); }
        float ss = 0.f;
#pragma unroll
        for (int j = 0; j < 4; ++j) ss += (v[j][0] * v[j][0] + v[j][1] * v[j][1]) + (v[j][2] * v[j][2] + v[j][3] * v[j][3]);
        const float rstd = 1.0f / sqrtf(wave_sum(ss) * (1.0f / DM) + EPS);
        const float* sh = F.mod + bidx(row) * NMOD + si * DM; const float* sc = F.mod + bidx(row) * NMOD + ci * DM;
        float f[8];
#pragma unroll
        for (int i = 0; i < 8; ++i) f[i] = 0.f;
#pragma unroll
        for (int j = 0; j < 4; ++j) {
            const int col = 4 * lane + 256 * j;
            const f32x4 g4 = *(const f32x4*)(gN + col), s4 = *(const f32x4*)(sc + col), h4 = *(const f32x4*)(sh + col);
            const f32x4 h = v[j] * rstd * g4 * (s4 + 1.0f) + h4;
            u32x2 w; w.x = pk2(h[0], h[1]); w.y = pk2(h[2], h[3]);
            *(u32x2*)(F.HA + (size_t)row * DM + col) = w;
            if (FG) {
#pragma unroll
                for (int e = 0; e < 4; ++e) {
                    const f32x4 w0 = *(const LAS f32x4*)(wf + (col + e) * 8), w1 = *(const LAS f32x4*)(wf + (col + e) * 8 + 4);
                    f[0] += h[e] * w0[0]; f[1] += h[e] * w0[1]; f[2] += h[e] * w0[2]; f[3] += h[e] * w0[3];
                    f[4] += h[e] * w1[0]; f[5] += h[e] * w1[1]; f[6] += h[e] * w1[2]; f[7] += h[e] * w1[3];
                }
            }
        }
        if (FG) {
#pragma unroll
            for (int i = 0; i < 8; ++i) f[i] = wave_sum(f[i]);
            float fv = f[0];
            fv = lane == 1 ? f[1] : fv; fv = lane == 2 ? f[2] : fv; fv = lane == 3 ? f[3] : fv; fv = lane == 4 ? f[4] : fv;
            fv = lane == 5 ? f[5] : fv; fv = lane == 6 ? f[6] : fv; fv = lane == 7 ? f[7] : fv;
            if (lane < 8) {
                const float x = fv + F.in[16][lane];
                const float lf = fminf(x, 0.f) - log1pf(expf(-fabsf(x)));
                float* o = row < NP ? F.out + O_LFP + (size_t)row * 8 : F.out + O_LFS + (size_t)(row - NP) * 8;
                o[lane] = lf;
            }
        }
#pragma unroll
        for (int j = 0; j < 4; ++j) v[j] = nv[j];
        row = nrow; have = hn;
    }
}
__device__ __forceinline__ void phase_mixnorm(Frame& F, int parts, int wq, int nwq) {
    const int lane = F.lane; const float* gs = F.in[27]; const float* gf = F.in[28];
    int row;
    for (int k_ = 0; nwq ? ((row = wq + k_ * nwq) < MT) : row_next(F, k_, row); ++k_) {
#pragma unroll
        for (int part = 0; part < 2; ++part) {
            if (!((parts >> part) & 1)) continue;
            const float* g = (part == 0 ? gs : gf) + 8 * lane;
            float v[8];
            if (part == 1 && row >= NP) {
                const int b = (row - NP) >> 5, q = (row - NP) & 31, h = lane >> 3, d0 = 8 * (lane & 7);
                const float* pb = F.PB + ((size_t)(((b * 8 + h) * 4) * 32 + q)) * 68;
                float Mi[4], M = -INFINITY;
#pragma unroll
                for (int i = 0; i < 4; ++i) { Mi[i] = pb[(size_t)i * 32 * 68 + 64]; M = fmaxf(M, Mi[i]); }
                float L = 0.f;
#pragma unroll
                for (int e = 0; e < 8; ++e) v[e] = 0.f;
#pragma unroll
                for (int i = 0; i < 4; ++i) {
                    const float wg = __builtin_amdgcn_exp2f(Mi[i] - M); L += pb[(size_t)i * 32 * 68 + 65] * wg;
                    const f32x4 o0 = *(const f32x4*)(pb + (size_t)i * 32 * 68 + d0), o1 = *(const f32x4*)(pb + (size_t)i * 32 * 68 + d0 + 4);
                    v[0] += o0[0] * wg; v[1] += o0[1] * wg; v[2] += o0[2] * wg; v[3] += o0[3] * wg; v[4] += o1[0] * wg; v[5] += o1[1] * wg; v[6] += o1[2] * wg; v[7] += o1[3] * wg;
                }
                const float rl = 1.0f / L;
#pragma unroll
                for (int e = 0; e < 8; ++e) v[e] *= rl;
            } else {
                const bf16* src = (part == 0 ? F.U : F.O) + (size_t)row * DH + 8 * lane;
                const u32x4 z = *(const u32x4*)src;
                v[0] = bflo(z.x); v[1] = bfhi(z.x); v[2] = bflo(z.y); v[3] = bfhi(z.y); v[4] = bflo(z.z); v[5] = bfhi(z.z); v[6] = bflo(z.w); v[7] = bfhi(z.w);
            }
            float ss = 0.f;
#pragma unroll
            for (int i = 0; i < 8; ++i) ss += v[i] * v[i];
            const float rstd = 1.0f / sqrtf(wave_sum(ss) * (1.0f / DH) + EPS);
            const f32x4 g0 = *(const f32x4*)g, g1 = *(const f32x4*)(g + 4);
            u32x4 w; w.x = pk2(v[0] * rstd * g0[0], v[1] * rstd * g0[1]); w.y = pk2(v[2] * rstd * g0[2], v[3] * rstd * g0[3]);
            w.z = pk2(v[4] * rstd * g1[0], v[5] * rstd * g1[1]); w.w = pk2(v[6] * rstd * g1[2], v[7] * rstd * g1[3]);
            *(u32x4*)(F.HA + (size_t)row * DM + part * DH + 8 * lane) = w;
        }
    }
}
__device__ __forceinline__ void phase_finalnorm(Frame& F) {
    const int lane = F.lane; const float* gN = F.in[33];
    int row, nrow; f32x4 v[4], nv[4];
    bool have = row_next(F, 0, row);
    if (have) {
#pragma unroll
        for (int j = 0; j < 4; ++j) v[j] = *(const f32x4*)(F.out + (size_t)row * DM + 4 * lane + 256 * j); }
    for (int k_ = 0; have; ++k_) {
        const bool hn = row_next(F, k_ + 1, nrow);
        if (hn) {
#pragma unroll
            for (int j = 0; j < 4; ++j) nv[j] = *(const f32x4*)(F.out + (size_t)nrow * DM + 4 * lane + 256 * j); }
        float* xr = F.out + (size_t)row * DM; float ss = 0.f;
#pragma unroll
        for (int j = 0; j < 4; ++j) ss += (v[j][0] * v[j][0] + v[j][1] * v[j][1]) + (v[j][2] * v[j][2] + v[j][3] * v[j][3]);
        const float rstd = 1.0f / sqrtf(wave_sum(ss) * (1.0f / DM) + EPS);
#pragma unroll
        for (int j = 0; j < 4; ++j) { const f32x4 g4 = *(const f32x4*)(gN + 4 * lane + 256 * j); __builtin_nontemporal_store(v[j] * rstd * g4, (f32x4*)(xr + 4 * lane + 256 * j)); }
#pragma unroll
        for (int j = 0; j < 4; ++j) v[j] = nv[j];
        row = nrow; have = hn;
    }
}
__device__ __forceinline__ void phase_fcum(Frame& F) {
    LAS float* wt = (LAS float*)F.lds;
    const int tid = F.tid, lane = F.lane, wave = F.wave;
    for (int job = blockIdx.x; job < 96; job += F.G) {
        const float* src; float* dst; int b, h;
        if (job < 32) { b = job >> 3; h = job & 7; src = F.out + O_LFP + (size_t)b * 4096 * 8 + h; dst = F.F2P + (size_t)job * 4096; }
        else { const int j2 = job - 32; b = j2 >> 3; h = j2 & 7; src = F.in[6] + (size_t)b * 4096 * 8 + h; dst = F.F2S + (size_t)j2 * 4128; }
        float v[8]; float tsum = 0.f;
#pragma unroll
        for (int i = 0; i < 8; ++i) { v[i] = src[(size_t)(8 * tid + i) * 8]; tsum += v[i]; }
        float inc = tsum;
#pragma unroll
        for (int o = 1; o < 64; o <<= 1) { const float t = __shfl_up(inc, o); if (lane >= o) inc += t; }
        if (lane == 63) wt[wave] = inc;
        __syncthreads();
        float woff = 0.f, total = 0.f;
#pragma unroll
        for (int w = 0; w < 8; ++w) { const float x = wt[w]; if (w < wave) woff += x; total += x; }
        float run = woff + inc - tsum;
#pragma unroll
        for (int i = 0; i < 8; ++i) { run += v[i]; dst[8 * tid + i] = run * LOG2E; }
        if (job >= 32 && wave == 0) {
            float x = lane < 32 ? F.out[O_LFS + (size_t)(b * 32 + lane) * 8 + h] : 0.f;
#pragma unroll
            for (int o = 1; o < 64; o <<= 1) { const float t = __shfl_up(x, o); if (lane >= o) x += t; }
            if (lane < 32) dst[4096 + lane] = (total + x) * LOG2E;
        }
        __syncthreads();
    }
}
#define XB_TMO      128
#define XB_XCNT(j)  (256  + 64 * (j))
#define XB_XSUB(j)  (1280 + 64 * (j))
#define XB_XGEN(j)  (2304 + 64 * (j))
#define XB_TOP      3328
#define XB_TOPGEN   3392
#define XCD_BAR_WORDS 3456
#define XB_SPIN_CAP (1u << 18)

__device__ __forceinline__ unsigned xb_ld(unsigned* p)              { return __hip_atomic_load(p, __ATOMIC_RELAXED, __HIP_MEMORY_SCOPE_AGENT); }
__device__ __forceinline__ unsigned xb_add(unsigned* p, unsigned v) { return __hip_atomic_fetch_add(p, v, __ATOMIC_RELAXED, __HIP_MEMORY_SCOPE_AGENT); }
__device__ __forceinline__ unsigned xb_xcc_id() { return (unsigned)__builtin_amdgcn_s_getreg((3 << 11) | 20) & 0xFu; }
#define XB_SPIN(cond, bar) do { unsigned _sp = 0; while (cond) { __builtin_amdgcn_s_sleep(1); \
    if ((++_sp & 255u) == 0u) { if (xb_ld(&(bar)[XB_TMO])) break; if (_sp > XB_SPIN_CAP) { atomicAdd(&(bar)[XB_TMO], 1u); break; } } } } while (0)

struct XcdBarrier {
    unsigned* bar; unsigned x;
    volatile LAS unsigned* st;
};

__device__ __forceinline__ XcdBarrier xcd_barrier_post(unsigned* bar, volatile LAS unsigned* st) {
    XcdBarrier b; b.bar = bar; b.x = xb_xcc_id(); b.st = st;
    if (threadIdx.x == 0) (void)xb_add(&bar[XB_XCNT(b.x)], 1u);
    return b;
}
__device__ __forceinline__ void xcd_barrier_complete(unsigned* bar, unsigned x, unsigned& nloc, unsigned& nx) {
    const unsigned G = gridDim.x * gridDim.y * gridDim.z;
    unsigned sum, cnt, mine, sp = 0u;
    for (;;) {
        sum = 0u; cnt = 0u; mine = 0u;
#pragma unroll
        for (unsigned j = 0; j < 16; ++j) { const unsigned c = xb_ld(&bar[XB_XCNT(j)]); sum += c; cnt += (c > 0u) ? 1u : 0u; mine = (j == x) ? c : mine; }
        if (sum == G) break;
        __builtin_amdgcn_s_sleep(1);
        if ((++sp & 255u) == 0u) { if (xb_ld(&bar[XB_TMO])) break; if (sp > XB_SPIN_CAP) { atomicAdd(&bar[XB_TMO], 1u); break; } }
    }
    nloc = mine > 0u ? mine : 1u; nx = cnt > 0u ? cnt : 1u;
}

__device__ __forceinline__ void xcd_barrier(const XcdBarrier& b) {
    asm volatile("s_waitcnt vmcnt(0)" ::: "memory");
    __syncthreads();
    if (threadIdx.x == 0) {
        unsigned* bar = b.bar;
        __builtin_amdgcn_s_waitcnt(0);
        unsigned nloc = b.st[0], nx = b.st[1];
        if (nloc == 0u) { xcd_barrier_complete(bar, b.x, nloc, nx); b.st[0] = nloc; b.st[1] = nx; }
        const unsigned old = xb_add(&bar[XB_XSUB(b.x)], 1u);
        const unsigned gen = old / nloc;
        if (old + 1u == (gen + 1u) * nloc) {
            __builtin_amdgcn_fence(__ATOMIC_RELEASE, "agent");
            asm volatile("s_waitcnt vmcnt(0)" ::: "memory");
            const unsigned og = xb_add(&bar[XB_TOP], 1u);
            const unsigned tg = og / nx;
            if (og + 1u == (tg + 1u) * nx) xb_add(&bar[XB_TOPGEN], 1u);
            else XB_SPIN(xb_ld(&bar[XB_TOPGEN]) == tg, bar);
            __builtin_amdgcn_fence(__ATOMIC_ACQUIRE, "agent");
            xb_add(&bar[XB_XGEN(b.x)], 1u);
            asm volatile("s_waitcnt vmcnt(0)" ::: "memory");
        } else {
            XB_SPIN(xb_ld(&bar[XB_XGEN(b.x)]) == gen, bar);
            __builtin_amdgcn_fence(__ATOMIC_ACQUIRE, "agent");
            asm volatile("s_waitcnt vmcnt(0)" ::: "memory");
        }
    }
    __syncthreads();
}

__device__ __forceinline__ void seam_arrive(unsigned* word) {
    asm volatile("s_waitcnt vmcnt(0)" ::: "memory");
    __syncthreads();
    if (threadIdx.x == 0) { __builtin_amdgcn_fence(__ATOMIC_RELEASE, "agent"); asm volatile("s_waitcnt vmcnt(0)" ::: "memory"); (void)xb_add(word, 1u); }
}
__device__ __forceinline__ void seam_wait(unsigned* word, unsigned want) {
    if (threadIdx.x == 0) {
        unsigned sp = 0u;
        while (xb_ld(word) < want) { __builtin_amdgcn_s_sleep(1); if (++sp > (1u << 22)) break; }
        __builtin_amdgcn_fence(__ATOMIC_ACQUIRE, "agent");
        asm volatile("s_waitcnt vmcnt(0)" ::: "memory");
    }
    __syncthreads();
}

constexpr int KP = 72, VP = 68;
typedef short v4i16_t __attribute__((ext_vector_type(4)));
__device__ __forceinline__ s16x4 vtr(const LAS bf16* p) { return __builtin_bit_cast(s16x4, __builtin_amdgcn_ds_read_tr16_b64_v4i16((LAS v4i16_t*)p)); }
template <int NK, int VPT, bool TR>
__device__ __forceinline__ void attn_tile(const LAS bf16* kL, const LAS bf16* vL, const LAS float* fL, LAS float* wsf, const bf16x8 (&qr)[4], f32x16 (&o)[2],
                                          float& m, float& l, bool domask, int lim, int r32, int hi) {
    f32x16 p[2 * NK];
#pragma unroll
    for (int t = 0; t < NK; ++t)
#pragma unroll
        for (int rg = 0; rg < 4; ++rg) {
            const f32x4 fa = *(const LAS f32x4*)(fL + 64 * t + 8 * rg + 4 * hi), fb = *(const LAS f32x4*)(fL + 64 * t + 32 + 8 * rg + 4 * hi);
#pragma unroll
            for (int i = 0; i < 4; ++i) { p[2 * t][4 * rg + i] = fa[i]; p[2 * t + 1][4 * rg + i] = fb[i]; }
        }
#pragma unroll
    for (int t = 0; t < NK; ++t)
#pragma unroll
        for (int d0 = 0; d0 < 4; ++d0) {
            const bf16x8 a0 = *(const LAS bf16x8*)(kL + (64 * t + r32) * KP + d0 * 16 + hi * 8);
            const bf16x8 a1 = *(const LAS bf16x8*)(kL + (64 * t + 32 + r32) * KP + d0 * 16 + hi * 8);
            p[2 * t] = __builtin_amdgcn_mfma_f32_32x32x16_bf16(a0, qr[d0], p[2 * t], 0, 0, 0);
            p[2 * t + 1] = __builtin_amdgcn_mfma_f32_32x32x16_bf16(a1, qr[d0], p[2 * t + 1], 0, 0, 0);
            if (NK > 1 && (d0 & 1)) __builtin_amdgcn_sched_barrier(0);
        }
    if (domask) {
#pragma unroll
        for (int t = 0; t < 2 * NK; ++t)
#pragma unroll
            for (int r = 0; r < 16; ++r) { const int kv = 32 * t + (r & 3) + 8 * (r >> 2) + 4 * hi; if (kv > lim) p[t][r] = -INFINITY; }
    }
    float mt = p[0][0];
#pragma unroll
    for (int t = 0; t < 2 * NK; ++t)
#pragma unroll
        for (int r = 0; r < 16; ++r) mt = fmaxf(mt, p[t][r]);
    { const auto rr = __builtin_amdgcn_permlane32_swap(__float_as_uint(mt), __float_as_uint(mt), false, false); mt = fmaxf(__uint_as_float(rr[0]), __uint_as_float(rr[1])); }
    if (__any(mt > m + 8.0f)) {
        const float mn = (mt > m + 8.0f) ? mt : m;
        const float alpha = __builtin_amdgcn_exp2f(m - mn);
        m = mn; l *= alpha;
        if (hi == 0) wsf[r32] = alpha;
        LDS_WAIT();
#pragma unroll
        for (int rg = 0; rg < 4; ++rg) {
            const f32x4 al = *(const LAS f32x4*)(wsf + 8 * rg + 4 * hi);
#pragma unroll
            for (int i = 0; i < 4; ++i) { o[0][4 * rg + i] *= al[i]; o[1][4 * rg + i] *= al[i]; }
        }
    }
    f32x2 rs2 = (f32x2){0.f, 0.f}; const f32x2 m2 = (f32x2){m, m};
#pragma unroll
    for (int t = 0; t < 2 * NK; ++t)
#pragma unroll
        for (int r = 0; r < 16; r += 2) {
            const f32x2 d = (f32x2){p[t][r], p[t][r + 1]} - m2;
            const f32x2 e = (f32x2){__builtin_amdgcn_exp2f(d.x), __builtin_amdgcn_exp2f(d.y)};
            p[t][r] = e.x; p[t][r + 1] = e.y; rs2 += e;
        }
    l += rs2.x + rs2.y;
#pragma unroll
    for (int t = 0; t < 2 * NK; ++t) {
        if (NK > 1) __builtin_amdgcn_sched_barrier(0);
        u32x4 pw0 = (u32x4){pk2(p[t][0], p[t][1]), pk2(p[t][2], p[t][3]), pk2(p[t][4], p[t][5]), pk2(p[t][6], p[t][7])};
        u32x4 pw1 = (u32x4){pk2(p[t][8], p[t][9]), pk2(p[t][10], p[t][11]), pk2(p[t][12], p[t][13]), pk2(p[t][14], p[t][15])};
#pragma unroll
        for (int d0 = 0; d0 < 2; ++d0)
#pragma unroll
            for (int s = 0; s < 2; ++s) {
                s16x4 lo, h4;
                if (TR) {
                    const LAS bf16* vb = vL + (4 * hi + ((r32 & 15) >> 2)) * VPT + 16 * (r32 >> 4) + 4 * (r32 & 3);
                    lo = vtr(vb + (32 * t + 16 * s) * VPT + 32 * d0); h4 = vtr(vb + (32 * t + 16 * s + 8) * VPT + 32 * d0);
                } else {
                    lo = *(const LAS s16x4*)(vL + (r32 + 32 * d0) * VPT + 32 * t + 16 * s + 4 * hi);
                    h4 = *(const LAS s16x4*)(vL + (r32 + 32 * d0) * VPT + 32 * t + 16 * s + 8 + 4 * hi);
                }
                const bf16x8 bv = (bf16x8){lo[0], lo[1], lo[2], lo[3], h4[0], h4[1], h4[2], h4[3]};
                o[d0] = __builtin_amdgcn_mfma_f32_32x32x16_bf16(__builtin_bit_cast(bf16x8, s == 0 ? pw0 : pw1), bv, o[d0], 0, 0, 0);
            }
    }
    LDS_WAIT();
}
__device__ __forceinline__ void st16(LAS bf16* p, unsigned v) { *(LAS unsigned short*)p = (unsigned short)v; }
__device__ __forceinline__ void attn_prompt_unit(Frame& F, int b, int h, int qb) {
    const int tid = F.tid, lane = F.lane, wave = F.wave, r32 = lane & 31, hi = lane >> 5;
    constexpr int VPR = 96;
    LAS bf16* kbuf = (LAS bf16*)F.lds; LAS bf16* vbuf = (LAS bf16*)(F.lds + 36864); LAS float* fbuf = (LAS float*)(F.lds + 86016);
    LAS float* wsf = (LAS float*)(F.lds + 87040) + wave * 64;
    const int rowbase = b * 4096, q0 = qb * 256;
    const bf16* Qw = F.Q + (size_t)(rowbase + q0 + wave * 32) * DH + h * 64;
    bf16* Ow = F.O + (size_t)(rowbase + q0 + wave * 32) * DH + h * 64;
    bf16x8 qr[4];
#pragma unroll
    for (int d0 = 0; d0 < 4; ++d0) qr[d0] = *(const bf16x8*)(Qw + (size_t)r32 * DH + d0 * 16 + hi * 8);
    const int NT = 4 * (qb + 1), kvs = tid >> 3, c8 = tid & 7;
    const bf16* kg = F.KB + (size_t)(rowbase + kvs) * DH + h * 64 + 8 * c8;
    const bf16* vg = F.VB + (size_t)(rowbase + kvs) * DH + h * 64 + 8 * c8;
    const float* fg = F.F2P + (size_t)(b * 8 + h) * 4096;
    u32x4 kr0 = *(const u32x4*)kg, vr0 = *(const u32x4*)vg, kr1 = *(const u32x4*)(kg + (size_t)64 * DH), vr1 = *(const u32x4*)(vg + (size_t)64 * DH);
    float fr_ = tid < 128 ? fg[tid] : 0.f;
    float m = -1e30f, l = 0.f; f32x16 o[2];
#pragma unroll
    for (int r = 0; r < 16; ++r) { o[0][r] = 0.f; o[1][r] = 0.f; }
    const int qmin = q0 + wave * 32, NS = NT / 2;
#define ATT_WRITE_STEP(t_) do { LAS bf16* kL_ = kbuf + ((t_) & 1) * (128 * KP); LAS bf16* vL_ = vbuf + ((t_) & 1) * (128 * VPR); LAS float* fL_ = fbuf + ((t_) & 1) * 128; \
        *(LAS u32x4*)(kL_ + kvs * KP + 8 * c8) = kr0; *(LAS u32x4*)(kL_ + (64 + kvs) * KP + 8 * c8) = kr1; \
        *(LAS u32x4*)(vL_ + kvs * VPR + 8 * c8) = vr0; *(LAS u32x4*)(vL_ + (64 + kvs) * VPR + 8 * c8) = vr1; \
        if (tid < 128) fL_[tid] = -fr_; } while (0)
    ATT_WRITE_STEP(0);
    __syncthreads();
    for (int t = 0; t < NS; ++t) {
        if (t + 1 < NS) { const size_t go = (size_t)(t + 1) * 128 * DH;
            kr0 = *(const u32x4*)(kg + go); vr0 = *(const u32x4*)(vg + go); kr1 = *(const u32x4*)(kg + go + (size_t)64 * DH); vr1 = *(const u32x4*)(vg + go + (size_t)64 * DH);
            fr_ = tid < 128 ? fg[(t + 1) * 128 + tid] : 0.f; }
        if (128 * t <= qmin + 31) {
            const bool domask = (128 * t + 127 > qmin);
            const LAS bf16* kS = kbuf + (t & 1) * (128 * KP); const LAS bf16* vS = vbuf + (t & 1) * (128 * VPR); const LAS float* fS = fbuf + (t & 1) * 128;
            attn_tile<1, VPR, true>(kS, vS, fS, wsf, qr, o, m, l, (128 * t + 63 > qmin), qmin + r32 - 128 * t, r32, hi);
            if (128 * t + 64 <= qmin + 31) attn_tile<1, VPR, true>(kS + 64 * KP, vS + 64 * VPR, fS + 64, wsf, qr, o, m, l, domask, qmin + r32 - 128 * t - 64, r32, hi);
        }
        if (t + 1 < NS) ATT_WRITE_STEP(t + 1);
        __syncthreads();
    }
#undef ATT_WRITE_STEP
    l += __shfl_xor(l, 32);
    if (hi == 0) wsf[r32] = 1.0f / l;
    LDS_WAIT();
#pragma unroll
    for (int rg = 0; rg < 4; ++rg) {
        const f32x4 rl = *(const LAS f32x4*)(wsf + 8 * rg + 4 * hi);
#pragma unroll
        for (int i = 0; i < 4; ++i) {
            const int q = 8 * rg + 4 * hi + i;
            Ow[(size_t)q * DH + r32] = (bf16)f2bf(o[0][4 * rg + i] * rl[i]);
            Ow[(size_t)q * DH + 32 + r32] = (bf16)f2bf(o[1][4 * rg + i] * rl[i]);
        }
    }
    LDS_WAIT();
    __syncthreads();
}
__device__ __forceinline__ void attn_sample_unit(Frame& F, int b, int h, int qd) {
    const int tid = F.tid, lane = F.lane, wave = F.wave, r32 = lane & 31, hi = lane >> 5;
    LAS unsigned char* wb = F.lds + wave * 18432;
    LAS bf16* kL = (LAS bf16*)wb; LAS bf16* vL = (LAS bf16*)(wb + 9216); LAS float* fL = (LAS float*)(wb + 17920); LAS float* wsf = (LAS float*)(wb + 18176);
    const int qrow0 = NP + b * 32;
    bf16x8 qr[4];
#pragma unroll
    for (int d0 = 0; d0 < 4; ++d0) qr[d0] = *(const bf16x8*)(F.Q + (size_t)(qrow0 + r32) * DH + h * 64 + d0 * 16 + hi * 8);
    float m = -1e30f, l = 0.f; f32x16 o[2];
#pragma unroll
    for (int r = 0; r < 16; ++r) { o[0][r] = 0.f; o[1][r] = 0.f; }
    const float* ck = F.in[4] + ((size_t)b * 4096 * 8 + h) * 64;
    const float* cv = F.in[5] + ((size_t)b * 4096 * 8 + h) * 64;
    const float* f2 = F.F2S + (size_t)(b * 8 + h) * 4128;
    const int c16 = lane & 15, kq = lane >> 4;
    for (int tt = 0; tt < 2; ++tt) {
        const int kv0 = qd * 1024 + wave * 128 + tt * 64;
        {
            f32x4 x[16];
#pragma unroll
            for (int i = 0; i < 16; ++i) x[i] = __builtin_nontemporal_load((const f32x4*)(ck + (size_t)(kv0 + kq + 4 * i) * 512 + 4 * c16));
#pragma unroll
            for (int i = 0; i < 16; ++i) { u32x2 w; w.x = pk2(x[i][0], x[i][1]); w.y = pk2(x[i][2], x[i][3]); *(LAS u32x2*)(kL + (kq + 4 * i) * KP + 4 * c16) = w; }
#pragma unroll
            for (int i = 0; i < 16; ++i) x[i] = __builtin_nontemporal_load((const f32x4*)(cv + (size_t)(kv0 + kq + 4 * i) * 512 + 4 * c16));
#pragma unroll
            for (int i = 0; i < 16; ++i) { const int kv = kq + 4 * i; const unsigned y0 = pk2(x[i][0], x[i][1]), y1 = pk2(x[i][2], x[i][3]);
                st16(vL + (4 * c16 + 0) * VP + kv, y0); st16(vL + (4 * c16 + 1) * VP + kv, y0 >> 16);
                st16(vL + (4 * c16 + 2) * VP + kv, y1); st16(vL + (4 * c16 + 3) * VP + kv, y1 >> 16); }
        }
        fL[lane] = -f2[kv0 + lane];
        LDS_WAIT();
        attn_tile<1, VP, false>(kL, vL, fL, wsf, qr, o, m, l, false, 0, r32, hi);
    }
    if (wave == 7 && qd == 3) {
        const int kv = lane >> 1, half = lane & 1;
        const bf16* kn = F.KB + (size_t)(qrow0 + kv) * DH + h * 64 + 32 * half;
        const bf16* vn = F.VB + (size_t)(qrow0 + kv) * DH + h * 64 + 32 * half;
#pragma unroll
        for (int i = 0; i < 4; ++i) {
            const u32x4 x = *(const u32x4*)(kn + 8 * i), y = *(const u32x4*)(vn + 8 * i);
            *(LAS u32x4*)(kL + kv * KP + 32 * half + 8 * i) = x;
            *(LAS u32x4*)(kL + (32 + kv) * KP + 32 * half + 8 * i) = (u32x4){0u, 0u, 0u, 0u};
            const int d = 32 * half + 8 * i;
            st16(vL + (d + 0) * VP + kv, y.x); st16(vL + (d + 1) * VP + kv, y.x >> 16); st16(vL + (d + 2) * VP + kv, y.y); st16(vL + (d + 3) * VP + kv, y.y >> 16);
            st16(vL + (d + 4) * VP + kv, y.z); st16(vL + (d + 5) * VP + kv, y.z >> 16); st16(vL + (d + 6) * VP + kv, y.w); st16(vL + (d + 7) * VP + kv, y.w >> 16);
#pragma unroll
            for (int e = 0; e < 8; ++e) st16(vL + (d + e) * VP + 32 + kv, 0u);
        }
        fL[lane] = lane < 32 ? -f2[4096 + lane] : 0.f;
        LDS_WAIT();
        attn_tile<1, VP, false>(kL, vL, fL, wsf, qr, o, m, l, true, r32, r32, hi);
    }
    l += __shfl_xor(l, 32);
    __syncthreads();
    LAS float* cm = (LAS float*)F.lds; LAS float* cl = cm + 256; LAS float* co = cl + 256;
    if (hi == 0) { cm[wave * 32 + r32] = m; cl[wave * 32 + r32] = l; }
#pragma unroll
    for (int r = 0; r < 16; ++r) {
        const int q = (r & 3) + 8 * (r >> 2) + 4 * hi;
        co[(wave * 32 + q) * 64 + r32] = o[0][r]; co[(wave * 32 + q) * 64 + 32 + r32] = o[1][r];
    }
    __syncthreads();
    {
        const int q = tid >> 4, dg = tid & 15;
        float M = cm[q];
#pragma unroll
        for (int w = 1; w < 8; ++w) M = fmaxf(M, cm[w * 32 + q]);
        float L = 0.f; f32x4 acc = (f32x4){0.f, 0.f, 0.f, 0.f};
#pragma unroll
        for (int w = 0; w < 8; ++w) {
            const float wg = __builtin_amdgcn_exp2f(cm[w * 32 + q] - M);
            L += cl[w * 32 + q] * wg;
            acc += *(const LAS f32x4*)(co + (w * 32 + q) * 64 + 4 * dg) * wg;
        }
        float* pb = F.PB + ((size_t)(((b * 8 + h) * 4 + qd) * 32 + q)) * 68;
        *(f32x4*)(pb + 4 * dg) = acc;
        if (dg == 0) { pb[64] = M; pb[65] = L; }
    }
    __syncthreads();
}

__device__ __forceinline__ bool s5_pair_next(const Frame& F, int k, bool with_sample, int& q) {
    if (F.NGW == 2048) {
        if (k < 2) { q = k * 2048 + ((F.gw + 531 * k) & 2047); return true; }
        if (k == 2 && with_sample && (F.gw & 15) == 0) { q = 4096 + (F.gw >> 4); return true; }
        return false;
    }
    q = F.gw + k * F.NGW; return q < (with_sample ? 4224 : 4096);
}
__device__ __forceinline__ void s5_pair_item(int q, int hs, int& g, int& item, int& row0) {
    if (q < 4096) { g = q >> 7; const int b = ((q >> 6) & 1) + 2 * hs, ch = q & 63; item = g * S5_ITEMS_PER_G + b * 64 + ch; row0 = b * 4096 + ch * 64; }
    else { const int s = q - 4096; g = s >> 2; const int sb = (s & 3) + 4 * hs; item = g * S5_ITEMS_PER_G + 256 + sb; row0 = NP + sb * 32; }
}
__device__ __forceinline__ void s5_bu(const bf16x8 ua, const bf16x8 (&bmf)[4], f32x16 (&D)[4]) {
#pragma unroll
    for (int kt = 0; kt < 4; ++kt) {
#pragma unroll
        for (int r = 0; r < 16; ++r) D[kt][r] = 0.f;
        D[kt] = __builtin_amdgcn_mfma_f32_32x32x16_bf16(ua, bmf[kt], D[kt], 0, 0, 0);
    }
}
__device__ __forceinline__ void s5_pair_a(Frame& F, int q) {
    const int lane = F.lane, kl = lane & 31, hs = lane >> 5;
    int g, itemA, rowA, itemB, rowB, itemM, rowM;
    s5_pair_item(q, 0, g, itemA, rowA); s5_pair_item(q, 1, g, itemB, rowB); s5_pair_item(q, hs, g, itemM, rowM);
    const f32x2 aA = F.abar[g * 64 + kl], aB = F.abar[g * 64 + 32 + kl];
    bf16x8 bmf[4];
#pragma unroll
    for (int kt = 0; kt < 4; ++kt) bmf[kt] = *(const bf16x8*)(F.bmh + (size_t)(g * 128 + 32 * kt + kl) * 16 + 8 * hs);
    const int ri = (kl & 3) + 4 * (kl >> 3), hsel = (kl >> 2) & 1;
    const bf16* up = F.U + (size_t)((hsel ? rowB : rowA) + ri) * DH + g * 16 + 8 * hs;
    bf16x8 ua[4];
#pragma unroll
    for (int sb = 0; sb < 4; ++sb) ua[sb] = *(const bf16x8*)(up + (size_t)16 * sb * DH);
    f32x2 sA = (f32x2){0.f, 0.f}, sB = (f32x2){0.f, 0.f};
#pragma unroll
    for (int sb = 0; sb < 4; ++sb) {
        f32x16 D[4]; s5_bu(ua[sb], bmf, D);
#pragma unroll
        for (int r = 0; r < 16; ++r) {
            f32x2 n; n.x = aA.x * sA.x - aA.y * sA.y + D[0][r]; n.y = aA.x * sA.y + aA.y * sA.x + D[1][r]; sA = n;
            f32x2 w; w.x = aB.x * sB.x - aB.y * sB.y + D[2][r]; w.y = aB.x * sB.y + aB.y * sB.x + D[3][r]; sB = w;
        }
    }
    F.E[(size_t)itemM * 64 + kl] = sA; F.E[(size_t)itemM * 64 + 32 + kl] = sB;
}
__device__ __forceinline__ void s5_pass_a(Frame& F) {
    int q;
    for (int k = 0; s5_pair_next(F, k, false, q); ++k) s5_pair_a(F, q);
}
__device__ __forceinline__ void s5_pair_c(Frame& F, int q, LAS bf16* Sb) {
    const int lane = F.lane, kl = lane & 31, hs = lane >> 5, fr = lane & 15, fq = lane >> 4;
    int g, itemA, rowA, itemB, rowB, itemM, rowM;
    s5_pair_item(q, 0, g, itemA, rowA); s5_pair_item(q, 1, g, itemB, rowB); s5_pair_item(q, hs, g, itemM, rowM);
    const bool prompt = q < 4096; const int nsb = prompt ? 4 : 2;
    const f32x2 aA = F.abar[g * 64 + kl], aB = F.abar[g * 64 + 32 + kl];
    bf16x8 bmf[4];
#pragma unroll
    for (int kt = 0; kt < 4; ++kt) bmf[kt] = *(const bf16x8*)(F.bmh + (size_t)(g * 128 + 32 * kt + kl) * 16 + 8 * hs);
    bf16x8 cmf[4];
#pragma unroll
    for (int ks = 0; ks < 4; ++ks) cmf[ks] = *(const bf16x8*)(F.cmt + (g * 16 + fr) * 128 + 32 * ks + 8 * fq);
    const f32x4 dv = *(const f32x4*)(F.in[24] + g * 16 + 4 * fq);
    const int ri = (kl & 3) + 4 * (kl >> 3), hsel = (kl >> 2) & 1;
    const bf16* up = F.U + (size_t)((hsel ? rowB : rowA) + ri) * DH + g * 16 + 8 * hs;
    bf16x8 ua[4];
#pragma unroll
    for (int sb = 0; sb < 4; ++sb) ua[sb] = (sb < nsb) ? *(const bf16x8*)(up + (size_t)16 * sb * DH) : (bf16x8){0, 0, 0, 0, 0, 0, 0, 0};
    f32x2 sA, sB;
    if (prompt) {
        sA = (f32x2){0.f, 0.f}; sB = (f32x2){0.f, 0.f};
        const f32x2 cA = F.a64[g * 64 + kl], cB = F.a64[g * 64 + 32 + kl];
        const int nprev = q & 63;
        const f32x2* ep = F.E + (size_t)(itemM - nprev) * 64 + kl;
        const int off = (8 - (nprev & 7)) & 7;
        for (int i0 = -off; i0 < nprev; i0 += 8) {
            f32x2 eA[8], eB[8];
#pragma unroll
            for (int u = 0; u < 8; ++u) { const bool ok = (i0 + u >= 0); eA[u] = ok ? ep[(size_t)(i0 + u) * 64] : (f32x2){0.f, 0.f}; eB[u] = ok ? ep[(size_t)(i0 + u) * 64 + 32] : (f32x2){0.f, 0.f}; }
#pragma unroll
            for (int u = 0; u < 8; ++u) {
                f32x2 n; n.x = cA.x * sA.x - cA.y * sA.y + eA[u].x; n.y = cA.x * sA.y + cA.y * sA.x + eA[u].y; sA = n;
                f32x2 w; w.x = cB.x * sB.x - cB.y * sB.y + eB[u].x; w.y = cB.x * sB.y + cB.y * sB.x + eB[u].y; sB = w;
            }
        }
    } else {
        const int sq = (q - 4096) & 3, sbi = sq + 4 * hs; const size_t si = (size_t)(sbi * 32 + g) * 64;
        sA = (f32x2){F.in[7][si + kl], F.in[8][si + kl]}; sB = (f32x2){F.in[7][si + 32 + kl], F.in[8][si + 32 + kl]};
    }
    for (int sb = 0; sb < nsb; ++sb) {
        f32x16 D[4];
        { const bf16x8 uas = sb == 0 ? ua[0] : sb == 1 ? ua[1] : sb == 2 ? ua[2] : ua[3]; s5_bu(uas, bmf, D); }
#pragma unroll
        for (int r = 0; r < 16; ++r) {
            f32x2 n; n.x = aA.x * sA.x - aA.y * sA.y + D[0][r]; n.y = aA.x * sA.y + aA.y * sA.x + D[1][r]; sA = n;
            f32x2 w; w.x = aB.x * sB.x - aB.y * sB.y + D[2][r]; w.y = aB.x * sB.y + aB.y * sB.x + D[3][r]; sB = w;
            LAS bf16* sp = Sb + (hs * 16 + r) * 136 + kl;
            st16(sp, f2bf(sA.x)); st16(sp + 64, f2bf(sA.y)); st16(sp + 32, f2bf(sB.x)); st16(sp + 96, f2bf(sB.y));
        }
        LDS_WAIT();
#pragma unroll
        for (int it = 0; it < 2; ++it) {
            f32x4 acc = (f32x4){0.f, 0.f, 0.f, 0.f};
#pragma unroll
            for (int ks = 0; ks < 4; ++ks) {
                const bf16x8 sf = *(const LAS bf16x8*)(Sb + (it * 16 + fr) * 136 + 32 * ks + 8 * fq);
                acc = __builtin_amdgcn_mfma_f32_16x16x32_bf16(cmf[ks], sf, acc, 0, 0, 0);
            }
            const size_t row = (size_t)(it ? rowB : rowA) + 16 * sb + fr;
            const u32x2 ub = *(const u32x2*)(F.U + row * DH + g * 16 + 4 * fq);
            const float u4[4] = {bflo(ub.x), bfhi(ub.x), bflo(ub.y), bfhi(ub.y)};
            float y[4];
#pragma unroll
            for (int i = 0; i < 4; ++i) { const float t = acc[i] + dv[i] * u4[i]; y[i] = t * fsigmoid(1.5957691216057308f * (t + 0.044715f * t * t * t)); }
            u32x2 w; w.x = pk2(y[0], y[1]); w.y = pk2(y[2], y[3]);
            *(u32x2*)(F.Z + row * DH + g * 16 + 4 * fq) = w;
        }
        LDS_WAIT();
    }
    if (!prompt) { const int sbi = ((q - 4096) & 3) + 4 * hs; const size_t si = (size_t)(sbi * 32 + g) * 64;
        F.out[O_SRS + si + kl] = sA.x; F.out[O_SIS + si + kl] = sA.y; F.out[O_SRS + si + 32 + kl] = sB.x; F.out[O_SIS + si + 32 + kl] = sB.y; }
    else if ((q & 63) == 63) { const int b = ((q >> 6) & 1) + 2 * hs; const size_t si = (size_t)(b * 32 + g) * 64;
        F.out[O_SRP + si + kl] = sA.x; F.out[O_SIP + si + kl] = sA.y; F.out[O_SRP + si + 32 + kl] = sB.x; F.out[O_SIP + si + 32 + kl] = sB.y; }
}
__device__ __forceinline__ void s5_pass_c(Frame& F) {
    LAS bf16* Sb = (LAS bf16*)(F.lds + F.wave * 12800);
    int q;
    for (int k = 0; s5_pair_next(F, k, true, q); ++k) s5_pair_c(F, q, Sb);
}

struct SkSwiglu { bf16* H;
    __device__ __forceinline__ int brow(int ct, int nb) const { return 256 * (ct >> 2) + 32 * (ct & 3) + 128 * nb; }
    __device__ __forceinline__ void pre(int, int, int, f32x4&) const {}
    __device__ __forceinline__ void operator()(int row, int ct, int j0, const float (&v)[2][2], const f32x4&) const {
        const float a = v[0][0] * fsigmoid(v[0][0]) * v[1][0], b = v[0][1] * fsigmoid(v[0][1]) * v[1][1];
        *(unsigned*)(H + (size_t)(NP + row) * FF + 32 * ct + j0) = pk2(a, b); } };
struct SkResid { const float* xin; float* out; const float* mod; int gi; float gscale;
    __device__ __forceinline__ int brow(int ct, int) const { return 32 * ct; }
    __device__ __forceinline__ void pre(int row, int ct, int j0, f32x4& pf) const {
        const int col = 32 * ct + j0; const float* gate = mod + (4 + (row >> 5)) * NMOD + gi * DM + col;
        const f32x2 x = *(const f32x2*)(xin + (size_t)row * DM + col), g = *(const f32x2*)gate; pf = (f32x4){x.x, x.y, g.x, g.y}; }
    __device__ __forceinline__ void operator()(int row, int ct, int j0, const float (&v)[1][2], const f32x4& pf) const {
        const int col = 32 * ct + j0;
        f32x2 o; o.x = pf[0] + gscale * (1.f + pf[2]) * v[0][0]; o.y = pf[1] + gscale * (1.f + pf[3]) * v[0][1];
        *(f32x2*)(out + (size_t)row * DM + col) = o; } };
struct SkIn { bf16 *U, *Q, *KB, *VB; float* out;
    __device__ __forceinline__ int brow(int ct, int) const { return 32 * ct; }
    __device__ __forceinline__ void pre(int, int, int, f32x4&) const {}
    __device__ __forceinline__ void operator()(int row, int ct, int j0, const float (&v)[1][2], const f32x4&) const {
        const int n = 32 * ct + j0, t = n >> 9, col = n & 511; const float sc = t == 1 ? QSCALE : 1.f;
        bf16* dst = U + (size_t)t * (17 * MiB / 2);
        *(unsigned*)(dst + (size_t)(NP + row) * DH + col) = pk2(v[0][0] * sc, v[0][1] * sc);
        if (t >= 2) *(f32x2*)(out + (t == 2 ? O_KS : O_VS) + (size_t)row * DH + col) = (f32x2){v[0][0], v[0][1]}; } };
struct SkGlu { const bf16* Z; bf16* Y; const float* bglu;
    __device__ __forceinline__ int brow(int ct, int) const { return 32 * ct; }
    __device__ __forceinline__ void pre(int, int, int, f32x4&) const {}
    __device__ __forceinline__ void operator()(int row, int ct, int j0, const float (&v)[1][2], const f32x4&) const {
        const int col = 32 * ct + j0; const unsigned z = *(const unsigned*)(Z + (size_t)(NP + row) * DH + col);
        *(unsigned*)(Y + (size_t)(NP + row) * DH + col) = pk2(bflo(z) * fsigmoid(v[0][0] + bglu[col]), bfhi(z) * fsigmoid(v[0][1] + bglu[col + 1])); } };

struct SkFinalNorm { const float* xin; float* out; const float* mod; int gi; float gscale; const float* gfin; float* xbuf; unsigned* cnt;
    __device__ __forceinline__ int brow(int ct, int) const { return 32 * ct; }
    __device__ __forceinline__ void operator()(int row, int ct, int j0, const float (&v)[1][2]) const {
        const int col = 32 * ct + j0, rt = row >> 5, lane = threadIdx.x & 63; const float* gate = mod + (4 + (row >> 5)) * NMOD + gi * DM + col;
        const f32x2 x = *(const f32x2*)(xin + (size_t)row * DM + col), g = *(const f32x2*)gate;
        f32x2 o; o.x = x.x + gscale * (1.f + g.x) * v[0][0]; o.y = x.y + gscale * (1.f + g.y) * v[0][1];
        float ss = o.x * o.x + o.y * o.y;
        ss += __shfl_xor(ss, 1); ss += __shfl_xor(ss, 2); ss += __shfl_xor(ss, 4); ss += __shfl_xor(ss, 8);
        if ((lane & 15) == 0) __hip_atomic_store(xbuf + (size_t)row * 32 + ct, ss, RLX_AGENT);
        asm volatile("s_waitcnt vmcnt(0)" ::: "memory");
        if (lane == 0) __hip_atomic_fetch_add(cnt + 64 * rt, 1u, RLX_AGENT);
        wait_count(cnt + 64 * rt, 256u);
        const float a = __hip_atomic_load(xbuf + (size_t)row * 32 + 2 * (lane & 15), RLX_AGENT), b = __hip_atomic_load(xbuf + (size_t)row * 32 + 2 * (lane & 15) + 1, RLX_AGENT);
        float q = a + b;
        q += __shfl_xor(q, 1); q += __shfl_xor(q, 2); q += __shfl_xor(q, 4); q += __shfl_xor(q, 8);
        const float rs = 1.0f / sqrtf(q * (1.0f / DM) + EPS);
        *(f32x2*)(out + (size_t)row * DM + col) = (f32x2){o.x * rs * gfin[col], o.y * rs * gfin[col + 1]}; } };
template <int NB, int KS, class Epi>
__device__ __forceinline__ void skinny_gemm(Frame& F, const bf16* A, const bf16* Bt, int ntc, const Epi& E, int first_cu = 0) {
    constexpr int K = KS * 128;
    const int lane = F.lane, wave = F.wave, r32 = lane & 31, hi = lane >> 5, tid = F.tid;
    LAS float* red = (LAS float*)F.lds;
    if ((int)blockIdx.x < first_cu) return;
    for (int tile = blockIdx.x - first_cu; tile < 8 * ntc; tile += F.G - first_cu) {
        const int rt = tile / ntc, ct = tile % ntc;
        f32x4 pf = (f32x4){0.f, 0.f, 0.f, 0.f}; E.pre(32 * rt + (tid >> 4), ct, 2 * (tid & 15), pf);
        const bf16* ap = A + (size_t)(32 * rt + r32) * K + wave * (K / 8) + 8 * hi;
        f32x16 acc[NB];
#pragma unroll
        for (int nb = 0; nb < NB; ++nb)
#pragma unroll
            for (int r = 0; r < 16; ++r) acc[nb][r] = 0.f;
        const bf16* bp0 = Bt + (size_t)(E.brow(ct, 0) + r32) * K + wave * (K / 8) + 8 * hi;
        const bf16* bp1 = Bt + (size_t)(E.brow(ct, NB - 1) + r32) * K + wave * (K / 8) + 8 * hi;
        constexpr int SB = (KS % 11 == 0) ? 11 : KS;
#pragma unroll 1
        for (int s0 = 0; s0 < KS; s0 += SB) {
            bf16x8 af[SB], b0[SB], b1[SB];
#pragma unroll
            for (int s = 0; s < SB; ++s) { af[s] = *(const bf16x8*)(ap + 16 * (s0 + s)); b0[s] = *(const bf16x8*)(bp0 + 16 * (s0 + s)); if (NB == 2) b1[s] = *(const bf16x8*)(bp1 + 16 * (s0 + s)); }
#pragma unroll
            for (int s = 0; s < SB; ++s) {
                acc[0] = __builtin_amdgcn_mfma_f32_32x32x16_bf16(af[s], b0[s], acc[0], 0, 0, 0);
                if (NB == 2) acc[NB - 1] = __builtin_amdgcn_mfma_f32_32x32x16_bf16(af[s], b1[s], acc[NB - 1], 0, 0, 0);
            }
        }
#pragma unroll
        for (int nb = 0; nb < NB; ++nb)
#pragma unroll
            for (int r = 0; r < 16; ++r) red[((wave * NB + nb) * 32 + (r & 3) + 8 * (r >> 2) + 4 * hi) * 32 + r32] = acc[nb][r];
        __syncthreads();
        {
            const int i = tid >> 4, j0 = 2 * (tid & 15);
            float v[NB][2];
#pragma unroll
            for (int nb = 0; nb < NB; ++nb) { v[nb][0] = 0.f; v[nb][1] = 0.f;
#pragma unroll
                for (int w = 0; w < 8; ++w) { const f32x2 x = *(const LAS f32x2*)(red + ((w * NB + nb) * 32 + i) * 32 + j0); v[nb][0] += x.x; v[nb][1] += x.y; } }
            E(32 * rt + i, ct, j0, v, pf);
        }
        __syncthreads();
    }
}

constexpr int N_PHASES_K = 15;

__global__ void __launch_bounds__(512, 2) mk_fwd(Args args) {
    extern __shared__ __attribute__((aligned(16))) unsigned char lds_raw[];
    cg::grid_group grid = cg::this_grid();
    Frame F;
    F.lds = (LAS unsigned char*)lds_raw;
    F.tid = threadIdx.x; F.lane = F.tid & 63; F.wave = __builtin_amdgcn_readfirstlane(F.tid >> 6);
    F.G = gridDim.x; { const int bx = blockIdx.x; F.vcu = (F.G % 8 == 0) ? (bx % 8) * (F.G / 8) + bx / 8 : bx; }
    F.gw = blockIdx.x * NWAVES + F.wave; F.NGW = F.G * NWAVES;
#pragma unroll
    for (int i = 0; i < 34; ++i) F.in[i] = args.in[i];
    F.out = args.out;
    unsigned char* ws = args.ws;
    F.mod = (float*)(ws + WS_MOD);
    F.abar = (f32x2*)(ws + WS_S5C); F.a64 = (f32x2*)(ws + WS_S5C + 16384); F.bbar = (f32x2*)(ws + WS_S5C + 32768); F.cmt = (bf16*)(ws + WS_S5C + 294912); F.bmh = (bf16*)(ws + WS_S5C + 425984);
    F.F2P = (float*)(ws + WS_F2P); F.F2S = (float*)(ws + WS_F2S); F.E = (f32x2*)(ws + WS_E);
    F.WUP1 = (bf16*)(ws + WS_WUP1); F.WDN1 = (bf16*)(ws + WS_WDN1); F.WIN = (bf16*)(ws + WS_WIN); F.WGLU = (bf16*)(ws + WS_WGLU); F.WOUT = (bf16*)(ws + WS_WOUT);
    F.WUP2 = (bf16*)(ws + WS_WUP2); F.WDN2 = (bf16*)(ws + WS_WDN2); F.HA = (bf16*)(ws + WS_HA); F.HID = (bf16*)(ws + WS_HID);
    F.U = (bf16*)(ws + WS_U); F.Q = (bf16*)(ws + WS_Q); F.KB = (bf16*)(ws + WS_KB); F.VB = (bf16*)(ws + WS_VB); F.Z = (bf16*)(ws + WS_Z); F.O = (bf16*)(ws + WS_O); F.PB = (float*)(ws + WS_PB);
    const int lo = args.ph_lo, hi = args.ph_hi;
    volatile LAS unsigned* misc = (volatile LAS unsigned*)(F.lds + LDS_BYTES - 256);
    if (F.tid < 2) misc[F.tid] = 0u;
    __syncthreads();
    XcdBarrier xbar; xbar.bar = (unsigned*)(ws + WS_BAR); xbar.x = 0; xbar.st = nullptr;
    if (hi - lo > 1) xbar = xcd_barrier_post((unsigned*)(ws + WS_BAR), misc);
#define IN(k) (lo <= (k) && (k) < hi)
#define REPS(k) _Pragma("nounroll") for (int rep_ = 0; rep_ < 1 + ((MK_REP_MASK >> (k)) & 1); ++rep_)
#define SEAM(k) do { if (IN(k) && IN((k) + 1)) { if ((k) == 100) grid.sync(); else xcd_barrier(xbar); } } while (0)
    typedef pg8::StaticOrder SO;
    float* xs_out = F.out + (size_t)NP * DM;

    if (hi > 1000) grid.sync();
    unsigned* sw = (unsigned*)(ws + WS_BAR) + 3840;
    const bool one_launch = false;
    const bool one_s5 = false;
    if (IN(0)) { phase_ada(F); if (one_launch) seam_arrive(sw); phase_s5const(F); phase_weights(F); }
    if (!one_launch) SEAM(0);
    if (IN(1)) { if (one_launch) seam_wait(sw, (unsigned)F.G); phase_norm<false>(F, F.in[0], F.in[1], F.in[11], 0, 1); }
    SEAM(1);
    if (IN(2)) REPS(2) { pg8::Gemm g{F.HA, F.WUP1, MT, NUP, DM}; SO S; S.init(MT, NUP, F.G, (int)blockIdx.x); EpiSwiglu E{F.HID};
        pg8::gemm_phase<EpiSwiglu, SO, PG8_ALIGN, PG8_SP2>(F.lds, g, S, E);
    }
    SEAM(2);
    if (IN(3)) REPS(3) { pg8::Gemm g{F.HID, F.WDN1, NP, DM, FF}; SO S; S.init(NP, DM, F.G, (int)blockIdx.x); EpiResid E{F.in[0], F.in[1], F.out, F.mod, 2, 0.5f};
        pg8::gemm_phase<EpiResid, SO, PG8_ALIGN, PG8_SP2>(F.lds, g, S, E);
        skinny_gemm<1, 22>(F, F.HID + (size_t)NP * FF, F.WDN1, 32, SkResid{F.in[1], xs_out, F.mod, 2, 0.5f});
    }
    SEAM(3);
    if (IN(4)) REPS(4) phase_norm<true>(F, F.out, xs_out, F.in[14], 3, 4);
    SEAM(4);
    if (IN(5)) REPS(5) { phase_fcum(F);
        pg8::Gemm g{F.HA, F.WIN, NP, 2048, DM}; SO S; S.init(NP, 2048, F.G, (int)blockIdx.x); EpiIn E{F.U, F.Q, F.KB, F.VB, F.out};
        pg8::gemm_phase<EpiIn, SO, PG8_ALIGN, PG8_SP2>(F.lds, g, S, E);
        skinny_gemm<1, 8>(F, F.HA + (size_t)NP * DM, F.WIN, 64, SkIn{F.U, F.Q, F.KB, F.VB, F.out});
    }
    SEAM(5);
    if (IN(6)) {
        if (one_s5) { s5_pass_a(F); seam_arrive(sw + 64); }
        for (int uix_ = F.vcu; uix_ < 256 * (1 + ((MK_REP_MASK >> 6) & 1)); uix_ += F.G) {
            const int uix = uix_ & 255, bh = uix >> 3, s = uix & 7;
            attn_prompt_unit(F, bh >> 3, bh & 7, 15 - s);
            attn_prompt_unit(F, bh >> 3, bh & 7, s);
        }
        for (int j = F.vcu; j < 256; j += F.G) attn_sample_unit(F, j >> 5, (j >> 2) & 7, j & 3);
        if (!one_s5) s5_pass_a(F);
        __syncthreads();
    }
    if (!one_s5) SEAM(6);
    if (IN(7)) { if (one_s5) seam_wait(sw + 64, (unsigned)F.G); s5_pass_c(F); }
    SEAM(7);
    if (IN(8)) REPS(8) { pg8::Gemm g{F.Z, F.WGLU, MT, DH, DH}; SO S; S.init(MT, DH, F.G, (int)blockIdx.x); EpiGlu E{F.Z, F.U, F.in[26]};
        pg8::gemm_phase<EpiGlu, SO, PG8_ALIGN, PG8_SP2>(F.lds, g, S, E);
        const bool half_idle = (F.G == 256);
        if (half_idle && blockIdx.x >= 130) { phase_mixnorm(F, 2, ((int)blockIdx.x - 130) * NWAVES + F.wave, 126 * NWAVES); }
    }
    SEAM(8);
    if (IN(9)) phase_mixnorm(F, F.G == 256 ? 1 : 3, 0, 0);
    SEAM(9);
    if (IN(10)) REPS(10) { pg8::Gemm g{F.HA, F.WOUT, NP, DM, DM}; SO S; S.init(NP, DM, F.G, (int)blockIdx.x); EpiResid E{F.out, xs_out, F.out, F.mod, 5, 1.0f};
        pg8::gemm_phase<EpiResid, SO, PG8_ALIGN, PG8_SP2>(F.lds, g, S, E);
        skinny_gemm<1, 8>(F, F.HA + (size_t)NP * DM, F.WOUT, 32, SkResid{xs_out, xs_out, F.mod, 5, 1.0f}); }
    SEAM(10);
    if (IN(11)) REPS(11) phase_norm<false>(F, F.out, xs_out, F.in[30], 6, 7);
    SEAM(11);
    if (IN(12)) REPS(12) { pg8::Gemm g{F.HA, F.WUP2, MT, NUP, DM}; SO S; S.init(MT, NUP, F.G, (int)blockIdx.x); EpiSwiglu E{F.HID};
        pg8::gemm_phase<EpiSwiglu, SO, PG8_ALIGN, PG8_SP2>(F.lds, g, S, E);
    }
    SEAM(12);
    if (IN(13)) { pg8::Gemm g{F.HID, F.WDN2, NP, DM, FF}; SO S; S.init(NP, DM, F.G, (int)blockIdx.x); EpiResid E{F.out, xs_out, F.out, F.mod, 8, 0.5f};
        pg8::gemm_phase<EpiResid, SO, PG8_ALIGN, PG8_SP2>(F.lds, g, S, E);
        skinny_gemm<1, 22>(F, F.HID + (size_t)NP * FF, F.WDN2, 32, SkResid{xs_out, xs_out, F.mod, 8, 0.5f}); }
    SEAM(13);
    if (IN(14)) phase_finalnorm(F);
#undef IN
#undef SEAM
}
constexpr int N_PHASES = 15;
static_assert(N_PHASES == N_PHASES_K, "phase count");

#ifndef MK_MULTI
#define MK_MULTI 0
#endif
extern "C" void kernel_launch(void* const* d_in, const int* in_sizes, int n_in, void* d_out, int out_size, void* d_ws, size_t ws_size, hipStream_t stream) {
    static int grid = 0;
    if (grid == 0) {
        int dev = 0, cus = 0, per_cu = 0;
        if (hipGetDevice(&dev) != hipSuccess || hipDeviceGetAttribute(&cus, hipDeviceAttributeMultiprocessorCount, dev) != hipSuccess) { fprintf(stderr, "kernel_launch: device query failed\n"); grid = -1; return; }
        if (hipFuncSetAttribute((const void*)mk_fwd, hipFuncAttributeMaxDynamicSharedMemorySize, LDS_BYTES) != hipSuccess) { fprintf(stderr, "kernel_launch: hipFuncSetAttribute failed\n"); grid = -1; return; }
        if (hipOccupancyMaxActiveBlocksPerMultiprocessor(&per_cu, (const void*)mk_fwd, NWAVES * 64, LDS_BYTES) != hipSuccess || per_cu < 1) per_cu = 1;
        (void)hipGetLastError();
        grid = cus;
        if (n_in != 34 || ws_size < 176 * MiB) fprintf(stderr, "kernel_launch: unexpected n_in %d / ws %zu\n", n_in, ws_size);
    }
    if (grid < 0) return;
    if (hipMemsetAsync((char*)d_ws + WS_BAR, 0, CTL_BYTES, stream) != hipSuccess) { fprintf(stderr, "kernel_launch: memset failed\n"); return; }
    Args a{};
    for (int i = 0; i < 34; ++i) a.in[i] = (const float*)d_in[i];
    a.out = (float*)d_out; a.ws = (unsigned char*)d_ws;
#if MK_MULTI
    for (int p = 0; p < N_PHASES; ++p) { a.ph_lo = p; a.ph_hi = p + 1; hipLaunchKernelGGL(mk_fwd, dim3(grid), dim3(NWAVES * 64), LDS_BYTES, stream, a); }
#else
    a.ph_lo = 0; a.ph_hi = N_PHASES;
    void* kargs[] = {&a};
    const hipError_t e = hipLaunchCooperativeKernel((const void*)mk_fwd, dim3(grid), dim3(NWAVES * 64), kargs, LDS_BYTES, stream);
    if (e != hipSuccess) fprintf(stderr, "kernel_launch: cooperative launch failed: %s (grid %d)\n", hipGetErrorString(e), grid);
#endif
}
```

```cpp
#include <hip/hip_runtime.h>
#include <hip/hip_cooperative_groups.h>
#include <cstdio>
#include <cstdint>
namespace cg = cooperative_groups;
namespace pg8 {
#define PG8_LAS __attribute__((address_space(3)))
typedef unsigned short bf16_t;
typedef short bf16x8 __attribute__((ext_vector_type(8)));
typedef float f32x4 __attribute__((ext_vector_type(4)));
typedef unsigned u32x4 __attribute__((ext_vector_type(4)));
constexpr int BM = 256, BK = 64, HALF = 128, HTB = HALF * BK * 2  , STAGE_BYTES = 8 * HTB, NXCD = 8, WGM = 8;

__host__ __device__ __forceinline__ int lds_byte(int r, int c) { const int st = (r >> 4) * 2 + (c >> 5), rr = r & 15, cc = c & 31, ob = rr * 64 + cc * 2; return st * 1024 + (ob ^ (((ob >> 9) & 1) << 5)); }
__host__ __device__ __forceinline__ void stage_rc(int b, int& R, int& C) { const int st = b / 1024, sb = b % 1024, swz = sb ^ (((sb >> 9) & 1) << 5); R = (st >> 1) * 16 + swz / 64; C = (st & 1) * 32 + (swz % 64) / 2; }
__host__ __device__ __forceinline__ int perm32(int rho) { const int n = rho >> 4, i = rho & 15; return 8 * (i >> 2) + 4 * n + (i & 3); }

struct Unit { int pm, pn; };
struct Gemm { const bf16_t* A; const bf16_t* Bt; int M, N, K; };

struct StaticOrder {
    int nM, nN, nwg, G, c;
    __host__ __device__ void init(int M, int N, int G_, int c_) { nM = M / BM; nN = N / BM; nwg = nM * nN; G = G_; c = c_; }
    __host__ __device__ bool next(int i, Unit& u) const {
        const long L = (long)i * G + c; if (L >= nwg) return false;
        int wgid = (int)L; { const int q = nwg / NXCD, r = nwg % NXCD, xcd = wgid % NXCD, off = wgid / NXCD; wgid = (xcd < r ? xcd * (q + 1) : r * (q + 1) + (xcd - r) * q) + off; }
        const int nig = WGM * nN, gid = wgid / nig, fm = gid * WGM, gsz = (nM - fm) < WGM ? (nM - fm) : WGM;
        u.pm = fm + ((wgid % nig) % gsz); u.pn = (wgid % nig) / gsz; return true;
    }
    __device__ __forceinline__ void a_ready(const Unit&) const {}
    __device__ __forceinline__ void done(const Unit&) const {}
};

__device__ __forceinline__ unsigned cvt_pk_bf16(float lo, float hi) { unsigned r; asm volatile("v_cvt_pk_bf16_f32 %0, %1, %2" : "=v"(r) : "v"(lo), "v"(hi)); return r; }
typedef float f32x2 __attribute__((ext_vector_type(2)));
__device__ __forceinline__ f32x2 gelu_pk(f32x2 v) {
    const f32x2 av = __builtin_elementwise_abs(v), d = av * 0.2316418882f + 1.0f;
    f32x2 t; t.x = __builtin_amdgcn_rcpf(d.x); t.y = __builtin_amdgcn_rcpf(d.y);
    f32x2 q = t * 0.5307027145f + (-0.7265760135f); q = q * t + 0.7107068705f; q = q * t + (-0.142248368f); q = q * t + 0.127414796f; q = q * t;
    const f32x2 s = (v * v) * (-0.72134752044f);
    f32x2 e; e.x = __builtin_amdgcn_exp2f(s.x); e.y = __builtin_amdgcn_exp2f(s.y);
    const f32x2 m = v * (q * e), r = v - m;
    f32x2 o; o.x = v.x < 0.f ? m.x : r.x; o.y = v.y < 0.f ? m.y : r.y; return o;
}

template <int ACT  > struct EpiBf16 {
    static constexpr bool PERM = true, AFTER_DRAIN = false; static_assert(ACT == 0 || ACT == 1, "EpiBf16: ACT is 0 (none) or 1 (gelu_pk)");
    bf16_t* O; int ldc; const float* bias; int split_cols; size_t split_stride; float scale0;
    __device__ __forceinline__ void operator()(const f32x4 (&acc)[2][2][4][2], const Unit& u, int wr, int wc, int fr, int fq) const {
        const int row0 = u.pm * BM + wr * 64 + fr; int colt = u.pn * BM; bf16_t* base = O;
        float sc = 1.f; if (split_cols) { const int t = colt / split_cols; base += (size_t)t * split_stride; colt -= t * split_cols; if (t == 0) sc = scale0; }
        const int col0 = colt + wc * 32 + 8 * fq, bcol0 = u.pn * BM + wc * 32 + 8 * fq;
        f32x4 bv[2][2];
#pragma unroll
        for (int bj = 0; bj < 2; ++bj)
#pragma unroll
            for (int n = 0; n < 2; ++n) bv[bj][n] = bias ? *(const f32x4*)(bias + bcol0 + bj * HALF + 4 * n) : (f32x4){0.f, 0.f, 0.f, 0.f};
#pragma unroll
        for (int ai = 0; ai < 2; ++ai)
#pragma unroll
            for (int m = 0; m < 4; ++m) { bf16_t* rowp = base + (size_t)(row0 + ai * HALF + m * 16) * ldc + col0;
#pragma unroll
                for (int bj = 0; bj < 2; ++bj) { f32x4 v0 = acc[ai][bj][m][0] + bv[bj][0], v1 = acc[ai][bj][m][1] + bv[bj][1];
                    if (ACT == 1) { f32x2 a = gelu_pk((f32x2){v0[0], v0[1]}), b = gelu_pk((f32x2){v0[2], v0[3]}), c = gelu_pk((f32x2){v1[0], v1[1]}), d = gelu_pk((f32x2){v1[2], v1[3]});
                        v0 = (f32x4){a.x, a.y, b.x, b.y}; v1 = (f32x4){c.x, c.y, d.x, d.y}; }
                    v0 = v0 * sc; v1 = v1 * sc; u32x4 w; w.x = cvt_pk_bf16(v0[0], v0[1]); w.y = cvt_pk_bf16(v0[2], v0[3]); w.z = cvt_pk_bf16(v1[0], v1[1]); w.w = cvt_pk_bf16(v1[2], v1[3]);
                    *(u32x4*)(rowp + bj * HALF) = w; } }
    }
};


template <class Epi, class Sched, bool ALIGN_EPI = false, bool SP2 = false>
__device__ __forceinline__ void gemm_phase(PG8_LAS unsigned char* lds, const Gemm g, const Sched& S, const Epi& E) {
    const int tid = threadIdx.x, wid = __builtin_amdgcn_readfirstlane(tid >> 6), lane = tid & 63, wr = wid >> 2, wc = wid & 3, fr = lane & 15, fq = lane >> 4;
    const int K = g.K, nt = K / BK;
    unsigned voffA[2], voffB[2];
#pragma unroll
    for (int i = 0; i < 2; ++i) { int R, C; stage_rc(tid * 16 + i * 8192, R, C); const int Rb = Epi::PERM ? ((R & ~31) + perm32(R & 31)) : R;
        voffA[i] = (unsigned)(R * K + C) * 2u; voffB[i] = (unsigned)(Rb * K + C) * 2u; }
    const size_t kstep = (size_t)(BK * 2);
    const size_t hstep = (size_t)HALF * K * 2;
    const size_t tstep = 2 * hstep;
    const unsigned ldsw = (unsigned)wid * 1024u;
    const int aoff = lds_byte(wr * 64 + fr, fq * 8), boff = lds_byte(wc * 32 + fr, fq * 8);
#define PG8_SA(b, h) (((b) * 2 + (h)) * HTB)
#define PG8_SB(b, h) ((4 + (b) * 2 + (h)) * HTB)
#define PG8_STAGE(bufoff, gbase, voff) do { _Pragma("unroll") for (int _i = 0; _i < 2; ++_i) \
        __builtin_amdgcn_global_load_lds((const unsigned*)((const char*)(gbase) + (voff)[_i]), (PG8_LAS unsigned*)(lds + (bufoff) + ldsw + _i * 8192), 16, 0, 0); } while (0)
#define PG8_LDA(dst, b, h) do { _Pragma("unroll") for (int m = 0; m < 4; ++m) _Pragma("unroll") for (int k = 0; k < 2; ++k) dst[m][k] = *(const PG8_LAS bf16x8*)(lds + PG8_SA(b, h) + aoff + m * 2048 + k * 1024); } while (0)
#define PG8_LDB(dst, b, h) do { _Pragma("unroll") for (int n = 0; n < 2; ++n) _Pragma("unroll") for (int k = 0; k < 2; ++k) dst[n][k] = *(const PG8_LAS bf16x8*)(lds + PG8_SB(b, h) + boff + n * 2048 + k * 1024); } while (0)
#define PG8_MMA(ai, bj, At, Bt) do { __builtin_amdgcn_s_setprio(1); _Pragma("unroll") for (int m = 0; m < 4; ++m) _Pragma("unroll") for (int n = 0; n < 2; ++n) _Pragma("unroll") for (int k = 0; k < 2; ++k) \
        acc[ai][bj][m][n] = __builtin_amdgcn_mfma_f32_16x16x32_bf16(Bt[n][k], At[m][k], acc[ai][bj][m][n], 0, 0, 0); __builtin_amdgcn_s_setprio(0); } while (0)
#define PG8_WAIT_V(n) asm volatile("s_waitcnt vmcnt(" #n ")" ::: "memory")
#define PG8_WAIT_L(n) asm volatile("s_waitcnt lgkmcnt(" #n ")" ::: "memory")
#define PG8_BAR __builtin_amdgcn_s_barrier()
#define PG8_SCHED __builtin_amdgcn_sched_barrier(0)
    Unit cur, nxt; int ui = 0;
    if (!S.next(0, cur)) return;
    f32x4 acc[2][2][4][2];
#pragma unroll
    for (int a = 0; a < 2; ++a)
#pragma unroll
        for (int b = 0; b < 2; ++b)
#pragma unroll
            for (int m = 0; m < 4; ++m)
#pragma unroll
                for (int n = 0; n < 2; ++n) acc[a][b][m][n] = (f32x4){0.f, 0.f, 0.f, 0.f};
    bf16x8 At[4][2], B0[2][2], B1[2][2];
    const char* cA = (const char*)g.A + (size_t)cur.pm * tstep; const char* cB = (const char*)g.Bt + (size_t)cur.pn * tstep;
    S.a_ready(cur);
    if constexpr (SP2) {
        PG8_STAGE(PG8_SB(0, 0), cB, voffB); PG8_STAGE(PG8_SB(0, 1), cB + hstep, voffB); PG8_STAGE(PG8_SA(0, 0), cA, voffA); PG8_STAGE(PG8_SA(0, 1), cA + hstep, voffA);
        if (wr == 1) PG8_BAR;
        PG8_WAIT_V(2); PG8_BAR;
        PG8_STAGE(PG8_SB(1, 0), cB + kstep, voffB); PG8_STAGE(PG8_SA(1, 0), cA + kstep, voffA); PG8_STAGE(PG8_SB(1, 1), cB + hstep + kstep, voffB);
        PG8_WAIT_V(6); PG8_BAR;
    } else {
        PG8_STAGE(PG8_SB(0, 0), cB, voffB); PG8_STAGE(PG8_SA(0, 0), cA, voffA); PG8_STAGE(PG8_SB(0, 1), cB + hstep, voffB); PG8_STAGE(PG8_SA(0, 1), cA + hstep, voffA);
        if (wr == 1) PG8_BAR;
        PG8_WAIT_V(4); PG8_BAR;
        PG8_STAGE(PG8_SB(1, 0), cB + kstep, voffB); PG8_STAGE(PG8_SA(1, 0), cA + kstep, voffA); PG8_STAGE(PG8_SB(1, 1), cB + hstep + kstep, voffB);
        PG8_WAIT_V(6); PG8_BAR;
    }
    for (;;) {
        const bool has_next = S.next(ui + 1, nxt);
        const char* nA = has_next ? (const char*)g.A + (size_t)nxt.pm * tstep : cA; const char* nB = has_next ? (const char*)g.Bt + (size_t)nxt.pn * tstep : cB;
        for (int t = 0; t < nt; t += 2) {
            const bool last = (t == nt - 2);
            const char* a1 = cA + (size_t)(t + 1) * kstep;
            const char* a2 = last ? nA : cA + (size_t)(t + 2) * kstep; const char* b2 = last ? nB : cB + (size_t)(t + 2) * kstep;
            const char* a3 = a2 + kstep; const char* b3 = b2 + kstep;
            if (last && has_next) S.a_ready(nxt);
            if constexpr (SP2) {
            PG8_LDB(B0, 0, 0); PG8_LDB(B1, 0, 1); PG8_SCHED; PG8_LDA(At, 0, 0); PG8_STAGE(PG8_SA(1, 1), a1 + hstep, voffA);
            PG8_WAIT_V(8); PG8_WAIT_L(0); PG8_BAR; PG8_MMA(0, 0, At, B0); PG8_MMA(0, 1, At, B1); PG8_BAR; PG8_SCHED;
            PG8_LDA(At, 0, 1); PG8_STAGE(PG8_SB(0, 0), b2, voffB); PG8_STAGE(PG8_SB(0, 1), b2 + hstep, voffB); PG8_STAGE(PG8_SA(0, 0), a2, voffA);
            PG8_WAIT_V(8); PG8_WAIT_L(0); PG8_BAR; PG8_MMA(1, 0, At, B0); PG8_MMA(1, 1, At, B1); PG8_BAR; PG8_SCHED;
            PG8_LDB(B0, 1, 0); PG8_LDB(B1, 1, 1); PG8_SCHED; PG8_LDA(At, 1, 0); PG8_STAGE(PG8_SA(0, 1), a2 + hstep, voffA);
            PG8_WAIT_V(8); PG8_WAIT_L(0); PG8_BAR; PG8_MMA(0, 0, At, B0); PG8_MMA(0, 1, At, B1); PG8_BAR; PG8_SCHED;
            PG8_LDA(At, 1, 1); PG8_STAGE(PG8_SB(1, 0), b3, voffB); PG8_STAGE(PG8_SB(1, 1), b3 + hstep, voffB); PG8_STAGE(PG8_SA(1, 0), a3, voffA);
            PG8_WAIT_V(8); PG8_WAIT_L(0); PG8_BAR; PG8_MMA(1, 0, At, B0); PG8_MMA(1, 1, At, B1); PG8_BAR; PG8_SCHED;
            } else {
            PG8_LDB(B0, 0, 0); PG8_SCHED; PG8_LDA(At, 0, 0); PG8_STAGE(PG8_SA(1, 1), a1 + hstep, voffA);
            PG8_WAIT_L(8); PG8_BAR; PG8_WAIT_L(0); PG8_MMA(0, 0, At, B0); PG8_BAR; PG8_SCHED;
            PG8_LDB(B1, 0, 1); PG8_STAGE(PG8_SB(0, 0), b2, voffB);
            PG8_BAR; PG8_WAIT_L(0); PG8_MMA(0, 1, At, B1); PG8_BAR;
            PG8_LDA(At, 0, 1); PG8_STAGE(PG8_SA(0, 0), a2, voffA);
            PG8_BAR; PG8_WAIT_L(0); PG8_MMA(1, 0, At, B0); PG8_BAR; PG8_SCHED;
            PG8_STAGE(PG8_SB(0, 1), b2 + hstep, voffB);
            PG8_WAIT_V(6); PG8_BAR; PG8_MMA(1, 1, At, B1); PG8_BAR;
            PG8_LDB(B0, 1, 0); PG8_SCHED; PG8_LDA(At, 1, 0); PG8_STAGE(PG8_SA(0, 1), a2 + hstep, voffA);
            PG8_WAIT_L(8); PG8_BAR; PG8_WAIT_L(0); PG8_MMA(0, 0, At, B0); PG8_BAR; PG8_SCHED;
            PG8_LDB(B1, 1, 1); PG8_STAGE(PG8_SB(1, 0), b3, voffB);
            PG8_BAR; PG8_WAIT_L(0); PG8_MMA(0, 1, At, B1); PG8_BAR;
            PG8_LDA(At, 1, 1); PG8_STAGE(PG8_SA(1, 0), a3, voffA);
            PG8_BAR; PG8_WAIT_L(0); PG8_MMA(1, 0, At, B0); PG8_BAR; PG8_SCHED;
            PG8_STAGE(PG8_SB(1, 1), b3 + hstep, voffB);
            PG8_WAIT_V(6); PG8_BAR; PG8_MMA(1, 1, At, B1); PG8_BAR;
            }
        }
        if constexpr (ALIGN_EPI) { if (wr == 0) PG8_BAR; }
        if constexpr (!Epi::AFTER_DRAIN) { E(acc, cur, wr, wc, fr, fq); S.done(cur); }
        if (!has_next) break;
#pragma unroll
        for (int a = 0; a < 2; ++a)
#pragma unroll
            for (int b = 0; b < 2; ++b)
#pragma unroll
                for (int m = 0; m < 4; ++m)
#pragma unroll
                    for (int n = 0; n < 2; ++n) acc[a][b][m][n] = (f32x4){0.f, 0.f, 0.f, 0.f};
        cur = nxt; cA = nA; cB = nB; ++ui;
        if constexpr (ALIGN_EPI) { if (wr == 1) PG8_BAR; }
    }
    PG8_WAIT_V(0);
    if constexpr (!ALIGN_EPI) { if (wr == 0) PG8_BAR; }
    PG8_BAR;
    if constexpr (Epi::AFTER_DRAIN) { E.fused(acc, cur, wr, wc, fr, fq, lds, wid, lane); S.done(cur); }
#undef PG8_SA
#undef PG8_SB
#undef PG8_STAGE
#undef PG8_LDA
#undef PG8_LDB
#undef PG8_MMA
#undef PG8_WAIT_V
#undef PG8_WAIT_L
#undef PG8_BAR
#undef PG8_SCHED
}
}

#ifndef PG8_SP2
#define PG8_SP2 true
#endif
#ifndef PG8_ALIGN
#define PG8_ALIGN true
#endif
#define LAS __attribute__((address_space(3)))
typedef unsigned short bf16;
typedef short bf16x8 __attribute__((ext_vector_type(8)));
typedef short s16x4 __attribute__((ext_vector_type(4)));
typedef float f32x4 __attribute__((ext_vector_type(4)));
typedef float f32x2 __attribute__((ext_vector_type(2)));
typedef float f32x16 __attribute__((ext_vector_type(16)));
typedef unsigned u32x4 __attribute__((ext_vector_type(4)));
typedef unsigned u32x2 __attribute__((ext_vector_type(2)));

constexpr int NP = 16384, NS = 256, MT = NP + NS, DM = 1024, FF = 2816, NUP = 5632, DH = 512, NMOD = 9216, DIN = 2056;
constexpr float EPS = 1e-6f, LOG2E = 1.4426950408889634f, QSCALE = 0.125f * 1.4426950408889634f;
constexpr size_t O_KP = 17039360, O_VP = 25427968, O_LFP = 33816576, O_SRP = 33947648, O_SIP = 33955840, O_KS = 33964032, O_VS = 34095104,
                 O_LFS = 34226176, O_SRS = 34228224, O_SIS = 34244608;
constexpr size_t MiB = 1u << 20;
constexpr size_t WS_MOD = 0, WS_S5C = 1 * MiB, WS_F2P = 2 * MiB, WS_F2S = 2 * MiB + 512 * 1024, WS_E = 4 * MiB, WS_WUP1 = 10 * MiB, WS_WDN1 = 21 * MiB,
                 WS_WIN = 27 * MiB, WS_WGLU = 31 * MiB, WS_WOUT = 32 * MiB, WS_WUP2 = 34 * MiB, WS_WDN2 = 45 * MiB, WS_HA = 52 * MiB, WS_HID = 86 * MiB;
constexpr size_t WS_U = WS_HID, WS_Q = WS_HID + 17 * MiB, WS_KB = WS_HID + 34 * MiB, WS_VB = WS_HID + 51 * MiB, WS_Z = WS_HID + 68 * MiB;
constexpr size_t WS_O = 176 * MiB, WS_BAR = 512 * 1024, WS_PB = 194 * MiB, WS_CNT = 512 * 1024 + 16384, WS_XB = 198 * MiB;
constexpr int CTL_BYTES = 16384 + 6 * 64 * 256;
#ifndef MK_REP_MASK
#define MK_REP_MASK 0
#endif
constexpr int S5_ITEMS_PER_G = 264, S5_ITEMS = 32 * 264;
constexpr int LDS_BYTES = 155648;
constexpr int NWAVES = 8;

struct Args { const float* in[34]; float* out; unsigned char* ws; int ph_lo, ph_hi; };

struct Frame {
    LAS unsigned char* lds;
    int tid, lane, wave, G, vcu, gw, NGW;
    const float* in[34];
    float* out;
    float* mod; f32x2* abar; f32x2* a64; f32x2* bbar; bf16* cmt; bf16* bmh; float* F2P; float* F2S; f32x2* E;
    bf16 *WUP1, *WDN1, *WIN, *WGLU, *WOUT, *WUP2, *WDN2, *HA, *HID, *U, *Q, *KB, *VB, *Z, *O; float* PB;
};

__device__ __forceinline__ unsigned f2bf(float f) { unsigned u = __builtin_bit_cast(unsigned, f); return (u + 0x7fffu + ((u >> 16) & 1u)) >> 16; }
typedef __bf16 bf16x2_t __attribute__((ext_vector_type(2)));
__device__ __forceinline__ unsigned pk2(float lo, float hi) { const f32x2 v = {lo, hi}; const bf16x2_t b = __builtin_convertvector(v, bf16x2_t); return __builtin_bit_cast(unsigned, b); }
__device__ __forceinline__ float bflo(unsigned w) { return __uint_as_float(w << 16); }
__device__ __forceinline__ float bfhi(unsigned w) { return __uint_as_float(w & 0xffff0000u); }
__device__ __forceinline__ float wave_sum(float v) {
#pragma unroll
    for (int o = 1; o < 64; o <<= 1) v += __shfl_xor(v, o);
    return v;
}
__device__ __forceinline__ float fsigmoid(float x) { return __builtin_amdgcn_rcpf(1.f + __builtin_amdgcn_exp2f(-x * LOG2E)); }
__device__ __forceinline__ int bidx(int row) { return row < NP ? (row >> 12) : 4 + ((row - NP) >> 5); }
#define LDS_WAIT() asm volatile("s_waitcnt lgkmcnt(0)" ::: "memory")

using pg8::Unit;
struct EpiSwiglu {
    static constexpr bool PERM = true, AFTER_DRAIN = false;
    bf16* H;
    __device__ __forceinline__ void operator()(const f32x4 (&acc)[2][2][4][2], const Unit& u, int wr, int wc, int fr, int fq) const {
        const int row0 = u.pm * 256 + wr * 64 + fr, col0 = u.pn * 128 + wc * 32 + 8 * fq;
#pragma unroll
        for (int ai = 0; ai < 2; ++ai)
#pragma unroll
            for (int m = 0; m < 4; ++m) {
                const int row = row0 + ai * 128 + m * 16;
                u32x4 w; unsigned ww[4];
#pragma unroll
                for (int n = 0; n < 2; ++n) {
                    const f32x4 g = acc[ai][0][m][n], up = acc[ai][1][m][n];
                    const f32x4 t = g * (-LOG2E);
                    f32x4 d; d[0] = __builtin_amdgcn_exp2f(t[0]); d[1] = __builtin_amdgcn_exp2f(t[1]); d[2] = __builtin_amdgcn_exp2f(t[2]); d[3] = __builtin_amdgcn_exp2f(t[3]);
                    d = d + 1.0f;
                    f32x4 rc; rc[0] = __builtin_amdgcn_rcpf(d[0]); rc[1] = __builtin_amdgcn_rcpf(d[1]); rc[2] = __builtin_amdgcn_rcpf(d[2]); rc[3] = __builtin_amdgcn_rcpf(d[3]);
                    const f32x4 r = (g * up) * rc;
                    ww[2 * n] = pk2(r[0], r[1]); ww[2 * n + 1] = pk2(r[2], r[3]);
                }
                w.x = ww[0]; w.y = ww[1]; w.z = ww[2]; w.w = ww[3];
                *(u32x4*)(H + (size_t)row * FF + col0) = w;
            }
    }
};
struct EpiResid {
    static constexpr bool PERM = true, AFTER_DRAIN = false;
    const float* xp; const float* xs; float* out; const float* mod; int gi; float gscale;
    __device__ __forceinline__ void operator()(const f32x4 (&acc)[2][2][4][2], const Unit& u, int wr, int wc, int fr, int fq) const {
        const int row0 = u.pm * 256 + wr * 64 + fr, col0 = u.pn * 256 + wc * 32 + 8 * fq;
#pragma unroll
        for (int ai = 0; ai < 2; ++ai) {
            f32x4 xv[4][2][2];
#pragma unroll
            for (int m = 0; m < 4; ++m) {
                const int row = row0 + ai * 128 + m * 16;
                const float* xin = row < NP ? xp + (size_t)row * DM : xs + (size_t)(row - NP) * DM;
#pragma unroll
                for (int bj = 0; bj < 2; ++bj)
#pragma unroll
                    for (int n = 0; n < 2; ++n) xv[m][bj][n] = *(const f32x4*)(xin + col0 + bj * 128 + 4 * n);
            }
#pragma unroll
            for (int m = 0; m < 4; ++m) {
                const int row = row0 + ai * 128 + m * 16;
                const float* gate = mod + bidx(row) * NMOD + gi * DM;
                float* orow = out + (size_t)row * DM;
#pragma unroll
                for (int bj = 0; bj < 2; ++bj)
#pragma unroll
                    for (int n = 0; n < 2; ++n) {
                        const int col = col0 + bj * 128 + 4 * n;
                        const f32x4 g = *(const f32x4*)(gate + col);
                        *(f32x4*)(orow + col) = xv[m][bj][n] + (g + 1.0f) * gscale * acc[ai][bj][m][n];
                    }
            }
        }
    }
};
struct EpiIn {
    static constexpr bool PERM = true, AFTER_DRAIN = false;
    bf16 *U, *Q, *KB, *VB; float* out;
    __device__ __forceinline__ void operator()(const f32x4 (&acc)[2][2][4][2], const Unit& u, int wr, int wc, int fr, int fq) const {
        const int t = u.pn >> 1;
        const int row0 = u.pm * 256 + wr * 64 + fr, col0 = (u.pn & 1) * 256 + wc * 32 + 8 * fq;
        bf16* dst = t == 0 ? U : t == 1 ? Q : t == 2 ? KB : VB;
        const float sc = t == 1 ? QSCALE : 1.0f;
#pragma unroll
        for (int ai = 0; ai < 2; ++ai)
#pragma unroll
            for (int m = 0; m < 4; ++m) {
                const int row = row0 + ai * 128 + m * 16;
                float* fo = row < NP ? out + (t == 2 ? O_KP : O_VP) + (size_t)row * DH : out + (t == 2 ? O_KS : O_VS) + (size_t)(row - NP) * DH;
#pragma unroll
                for (int bj = 0; bj < 2; ++bj) {
                    const int col = col0 + bj * 128;
                    const f32x4 v0 = acc[ai][bj][m][0], v1 = acc[ai][bj][m][1];
                    u32x4 w; w.x = pk2(v0[0] * sc, v0[1] * sc); w.y = pk2(v0[2] * sc, v0[3] * sc); w.z = pk2(v1[0] * sc, v1[1] * sc); w.w = pk2(v1[2] * sc, v1[3] * sc);
                    *(u32x4*)(dst + (size_t)row * DH + col) = w;
                    if (t >= 2) { *(f32x4*)(fo + col) = v0; *(f32x4*)(fo + col + 4) = v1; }
                }
            }
    }
};
struct EpiGlu {
    static constexpr bool PERM = true, AFTER_DRAIN = false;
    const bf16* Z; bf16* Y; const float* bglu;
    __device__ __forceinline__ void operator()(const f32x4 (&acc)[2][2][4][2], const Unit& u, int wr, int wc, int fr, int fq) const {
        const int row0 = u.pm * 256 + wr * 64 + fr, col0 = u.pn * 256 + wc * 32 + 8 * fq;
#pragma unroll
        for (int bj = 0; bj < 2; ++bj) {
            const int col = col0 + bj * 128;
            const f32x4 b0 = *(const f32x4*)(bglu + col), b1 = *(const f32x4*)(bglu + col + 4);
            u32x4 zv[2][4];
#pragma unroll
            for (int ai = 0; ai < 2; ++ai)
#pragma unroll
                for (int m = 0; m < 4; ++m) zv[ai][m] = *(const u32x4*)(Z + (size_t)(row0 + ai * 128 + m * 16) * DH + col);
#pragma unroll
            for (int ai = 0; ai < 2; ++ai)
#pragma unroll
                for (int m = 0; m < 4; ++m) {
                    const int row = row0 + ai * 128 + m * 16;
                    const u32x4 z = zv[ai][m];
                    const f32x4 a0 = acc[ai][bj][m][0] + b0, a1 = acc[ai][bj][m][1] + b1;
                    u32x4 w;
                    w.x = pk2(bflo(z.x) * fsigmoid(a0[0]), bfhi(z.x) * fsigmoid(a0[1]));
                    w.y = pk2(bflo(z.y) * fsigmoid(a0[2]), bfhi(z.y) * fsigmoid(a0[3]));
                    w.z = pk2(bflo(z.z) * fsigmoid(a1[0]), bfhi(z.z) * fsigmoid(a1[1]));
                    w.w = pk2(bflo(z.w) * fsigmoid(a1[2]), bfhi(z.w) * fsigmoid(a1[3]));
                    *(u32x4*)(Y + (size_t)row * DH + col) = w;
                }
        }
    }
};

#define RLX_AGENT __ATOMIC_RELAXED, __HIP_MEMORY_SCOPE_AGENT
__device__ __forceinline__ void wait_count(unsigned* cnt, unsigned want) {
    const unsigned long long t0 = __builtin_amdgcn_s_memrealtime();
    for (;;) {
        if ((unsigned)__builtin_amdgcn_readfirstlane(__hip_atomic_load(cnt, RLX_AGENT)) >= want) break;
        if (__builtin_amdgcn_s_memrealtime() - t0 > 2000000ull) break;
        __builtin_amdgcn_s_sleep(2);
    }
    __builtin_amdgcn_fence(__ATOMIC_ACQUIRE, "agent");
}
struct PanelRms {
    float* xbuf;
    unsigned* cnt;
    __device__ __forceinline__ void run(const f32x4 (&v)[2][2][4][2], const Unit& u, int wr, int wc, int fr, int fq, LAS unsigned char* lds, int wid, int lane) const {
        LAS float* P = (LAS float*)lds; LAS float* S = (LAS float*)(lds + 4096);
#pragma unroll
        for (int ai = 0; ai < 2; ++ai)
#pragma unroll
            for (int m = 0; m < 4; ++m) {
                float s = 0.f;
#pragma unroll
                for (int bj = 0; bj < 2; ++bj)
#pragma unroll
                    for (int n = 0; n < 2; ++n) { const f32x4 x = v[ai][bj][m][n]; s += (x[0] * x[0] + x[1] * x[1]) + (x[2] * x[2] + x[3] * x[3]); }
                s += __shfl_xor(s, 16); s += __shfl_xor(s, 32);
                if (fq == 0) P[(ai * 128 + wr * 64 + m * 16 + fr) * 4 + wc] = s;
            }
        LDS_WAIT(); __builtin_amdgcn_s_barrier(); asm volatile("" ::: "memory");
        const int row = wid * 32 + (lane & 31);
        if (lane < 32) {
            const f32x4 a = *(const LAS f32x4*)(P + row * 4);
            __hip_atomic_store(xbuf + (size_t)(u.pm * 256 + row) * 4 + u.pn, (a[0] + a[1]) + (a[2] + a[3]), RLX_AGENT);
        }
        asm volatile("s_waitcnt vmcnt(0)" ::: "memory");
        if (lane == 0) __hip_atomic_fetch_add(cnt + 64 * u.pm, 1u, RLX_AGENT);
        if (wid == 0) wait_count(cnt + 64 * u.pm, 32u);
        asm volatile("s_waitcnt vmcnt(0) lgkmcnt(0)" ::: "memory"); __builtin_amdgcn_s_barrier(); asm volatile("" ::: "memory");
        if (lane < 32) {
            const float* slot = xbuf + (size_t)(u.pm * 256 + row) * 4; float q = 0.f;
#pragma unroll
            for (int t = 0; t < 4; ++t) q += __hip_atomic_load(slot + t, RLX_AGENT);
            S[row] = 1.0f / sqrtf(q * (1.0f / DM) + EPS);
        }
        LDS_WAIT(); __builtin_amdgcn_s_barrier(); asm volatile("" ::: "memory");
    }
};
struct EpiFinalNorm {
    static constexpr bool PERM = true, AFTER_DRAIN = true;
    const float* xin; float* out; const float* mod; int gi; float gscale; const float* gfin; PanelRms st;
    __device__ __forceinline__ void fused(f32x4 (&acc)[2][2][4][2], const Unit& u, int wr, int wc, int fr, int fq, LAS unsigned char* lds, int wid, int lane) const {
        const int row0 = u.pm * 256 + wr * 64 + fr, col0 = u.pn * 256 + wc * 32 + 8 * fq;
        const float* gate = mod + (u.pm >> 4) * NMOD + gi * DM;
#pragma unroll
        for (int ai = 0; ai < 2; ++ai)
#pragma unroll
            for (int m = 0; m < 4; ++m) {
                const float* xr = xin + (size_t)(row0 + ai * 128 + m * 16) * DM;
#pragma unroll
                for (int bj = 0; bj < 2; ++bj)
#pragma unroll
                    for (int n = 0; n < 2; ++n) { const int col = col0 + bj * 128 + 4 * n;
                        const f32x4 g = *(const f32x4*)(gate + col), x = *(const f32x4*)(xr + col);
                        acc[ai][bj][m][n] = x + (g + 1.0f) * gscale * acc[ai][bj][m][n]; }
                asm volatile("" : "+v"(acc[ai][0][m][0]), "+v"(acc[ai][0][m][1]), "+v"(acc[ai][1][m][0]), "+v"(acc[ai][1][m][1]));
                if (m & 1) asm volatile("" ::: "memory");
            }
        st.run(acc, u, wr, wc, fr, fq, lds, wid, lane);
        const LAS float* S = (const LAS float*)(lds + 4096);
#pragma unroll
        for (int ai = 0; ai < 2; ++ai)
#pragma unroll
            for (int m = 0; m < 4; ++m) {
                const float rs = S[ai * 128 + wr * 64 + m * 16 + fr];
                float* orow = out + (size_t)(row0 + ai * 128 + m * 16) * DM;
#pragma unroll
                for (int bj = 0; bj < 2; ++bj)
#pragma unroll
                    for (int n = 0; n < 2; ++n) { const int col = col0 + bj * 128 + 4 * n;
                        *(f32x4*)(orow + col) = acc[ai][bj][m][n] * rs * *(const f32x4*)(gfin + col); }
            }
    }
};

__device__ __forceinline__ void phase_ada(Frame& F) {
    LAS float* sm = (LAS float*)F.lds;
    LAS float* red = sm + 12288;
    const float* cp = F.in[2]; const float* cs = F.in[3]; const float* wada = F.in[9]; const float* bada = F.in[10];
    for (int i = F.tid; i < 12288; i += 512) { const int d = i / 12, bi = i % 12; const float c = bi < 4 ? cp[bi * DM + d] : cs[(bi - 4) * DM + d]; sm[i] = c * fsigmoid(c); }
    __syncthreads();
    for (int cb = blockIdx.x; cb < 256; cb += F.G) {
        const int ks = F.tid / 36, cl = F.tid % 36;
        float acc[12];
#pragma unroll
        for (int i = 0; i < 12; ++i) acc[i] = 0.f;
        if (F.tid < 504) {
            const float* wp = wada + (size_t)ks * NMOD + cb * 36 + cl;
            const int nd = (DM - ks + 13) / 14;
            for (int i0 = 0; i0 < nd; i0 += 16) {
                float w[16];
#pragma unroll
                for (int u = 0; u < 16; ++u) w[u] = (i0 + u < nd) ? __builtin_nontemporal_load(wp + (size_t)(i0 + u) * 14 * NMOD) : 0.f;
#pragma unroll
                for (int u = 0; u < 16; ++u) {
                    const int d = (i0 + u < nd) ? ks + 14 * (i0 + u) : 0;
                    const f32x4 s0 = *(const LAS f32x4*)(sm + d * 12), s1 = *(const LAS f32x4*)(sm + d * 12 + 4), s2 = *(const LAS f32x4*)(sm + d * 12 + 8);
                    acc[0] += w[u] * s0[0]; acc[1] += w[u] * s0[1]; acc[2] += w[u] * s0[2]; acc[3] += w[u] * s0[3];
                    acc[4] += w[u] * s1[0]; acc[5] += w[u] * s1[1]; acc[6] += w[u] * s1[2]; acc[7] += w[u] * s1[3];
                    acc[8] += w[u] * s2[0]; acc[9] += w[u] * s2[1]; acc[10] += w[u] * s2[2]; acc[11] += w[u] * s2[3];
                }
            }
#pragma unroll
            for (int i = 0; i < 12; ++i) red[(ks * 36 + cl) * 12 + i] = acc[i];
        }
        __syncthreads();
        if (F.tid < 432) {
            const int c2 = F.tid / 12, bi = F.tid % 12; float s = bada[cb * 36 + c2];
#pragma unroll
            for (int k = 0; k < 14; ++k) s += red[(k * 36 + c2) * 12 + bi];
            F.mod[bi * NMOD + cb * 36 + c2] = s;
        }
        __syncthreads();
    }
}
__device__ __forceinline__ void sincos_d(double x, double& s, double& c) {
    const double kf = __builtin_rint(x * 0.63661977236758134308);
    double r = __builtin_fma(-kf, 1.57079632679489655800e+00, x); r = __builtin_fma(-kf, 6.12323399573676603587e-17, r);
    const int k = ((int)kf) & 3; const double r2 = r * r;
    double sp = 1.0 / 6227020800.0; sp = __builtin_fma(sp, r2, -1.0 / 39916800.0); sp = __builtin_fma(sp, r2, 1.0 / 362880.0); sp = __builtin_fma(sp, r2, -1.0 / 5040.0);
    sp = __builtin_fma(sp, r2, 1.0 / 120.0); sp = __builtin_fma(sp, r2, -1.0 / 6.0); sp = __builtin_fma(sp, r2, 1.0); const double sr = sp * r;
    double cq = -1.0 / 87178291200.0; cq = __builtin_fma(cq, r2, 1.0 / 479001600.0); cq = __builtin_fma(cq, r2, -1.0 / 3628800.0); cq = __builtin_fma(cq, r2, 1.0 / 40320.0);
    cq = __builtin_fma(cq, r2, -1.0 / 720.0); cq = __builtin_fma(cq, r2, 1.0 / 24.0); cq = __builtin_fma(cq, r2, -0.5); const double cr = __builtin_fma(cq, r2, 1.0);
    s = (k == 0) ? sr : (k == 1) ? cr : (k == 2) ? -sr : -cr;
    c = (k == 0) ? cr : (k == 1) ? -sr : (k == 2) ? -cr : sr;
}
__device__ __forceinline__ double exp_d(double x) {
    const double n = __builtin_rint(x * 1.4426950408889634074);
    double r = __builtin_fma(-n, 6.93147180369123816490e-01, x); r = __builtin_fma(-n, 1.90821492927058770002e-10, r);
    double p = 1.0 / 6227020800.0;
    p = __builtin_fma(p, r, 1.0 / 479001600.0); p = __builtin_fma(p, r, 1.0 / 39916800.0); p = __builtin_fma(p, r, 1.0 / 3628800.0); p = __builtin_fma(p, r, 1.0 / 362880.0);
    p = __builtin_fma(p, r, 1.0 / 40320.0); p = __builtin_fma(p, r, 1.0 / 5040.0); p = __builtin_fma(p, r, 1.0 / 720.0); p = __builtin_fma(p, r, 1.0 / 120.0);
    p = __builtin_fma(p, r, 1.0 / 24.0); p = __builtin_fma(p, r, 1.0 / 6.0); p = __builtin_fma(p, r, 0.5); p = __builtin_fma(p, r, 1.0); p = __builtin_fma(p, r, 1.0);
    return __builtin_ldexp(p, (int)n);
}
__device__ __forceinline__ void phase_s5const(Frame& F) {
    if (F.tid >= 8) return;
    for (int id = blockIdx.x * 8 + F.tid; id < 2048; id += F.G * 8) {
    const int g = id >> 6, p = id & 63;
    const double lre = (double)F.in[17][id], lim = (double)F.in[18][id], dt = exp_d((double)F.in[19][g]);
    const double mag = exp_d(lre * dt); double sn, cs; sincos_d(lim * dt, sn, cs);
    const double are = mag * cs, aim = mag * sn;
    F.abar[id] = (f32x2){(float)are, (float)aim};
    double pr = are, pi = aim;
#pragma unroll
    for (int i = 0; i < 6; ++i) { const double nr = pr * pr - pi * pi, ni = 2.0 * pr * pi; pr = nr; pi = ni; }
    F.a64[id] = (f32x2){(float)pr, (float)pi};
    const double xr = are - 1.0, xi = aim, den = lre * lre + lim * lim;
    const double cr = (xr * lre + xi * lim) / den, ci = (xi * lre - xr * lim) / den;
    const float* bre = F.in[20] + (size_t)id * 16; const float* bim = F.in[21] + (size_t)id * 16;
    const int kre = 64 * (p >> 5) + (p & 31), kim = kre + 32;
#pragma unroll
    for (int c = 0; c < 16; ++c) { const double br = bre[c], bi = bim[c]; const float vr = (float)(cr * br - ci * bi), vi = (float)(cr * bi + ci * br);
        const unsigned hr = f2bf(vr), hi_ = f2bf(vi);
        F.bmh[(size_t)(g * 128 + kre) * 16 + c] = (bf16)hr; F.bmh[(size_t)(g * 128 + kim) * 16 + c] = (bf16)hi_; }
    const float* cre = F.in[22]; const float* cim = F.in[23];
#pragma unroll
    for (int c = 0; c < 16; ++c) {
        F.cmt[(g * 16 + c) * 128 + p] = (bf16)f2bf(cre[(g * 16 + c) * 64 + p]);
        F.cmt[(g * 16 + c) * 128 + 64 + p] = (bf16)f2bf(-cim[(g * 16 + c) * 64 + p]);
    }
    }
}
__device__ __forceinline__ void transpose_item(const float* W, int ldw, int k0, int n0, bf16* WT, int Kd, int drow0, LAS float* scr, int lane) {
    float wv[32];
#pragma unroll
    for (int i = 0; i < 32; ++i) wv[i] = __builtin_nontemporal_load(W + (size_t)(k0 + 2 * i + (lane >> 5)) * ldw + n0 + (lane & 31));
#pragma unroll
    for (int i = 0; i < 32; ++i) scr[(2 * i + (lane >> 5)) * 33 + (lane & 31)] = wv[i];
    LDS_WAIT();
    const int c = lane & 7;
#pragma unroll
    for (int j = 0; j < 4; ++j) { const int n = (lane >> 3) + 8 * j; const LAS float* s = scr + (8 * c) * 33 + n;
        u32x4 o; o.x = pk2(s[0 * 33], s[1 * 33]); o.y = pk2(s[2 * 33], s[3 * 33]); o.z = pk2(s[4 * 33], s[5 * 33]); o.w = pk2(s[6 * 33], s[7 * 33]);
        *(u32x4*)(WT + (size_t)(drow0 + n) * Kd + k0 + 8 * c) = o; }
    LDS_WAIT();
}
__device__ __forceinline__ int up_drow(int n0) { return n0 < FF ? 256 * (n0 >> 7) + (n0 & 127) : 256 * ((n0 - FF) >> 7) + 128 + ((n0 - FF) & 127); }
__device__ __forceinline__ void phase_weights(Frame& F) {
    LAS float* scr = (LAS float*)(F.lds + 81920 + F.wave * 8704);
    constexpr int I_UP = 16 * 176, I_DN = 44 * 32, I_IN = 16 * 64, I_GLU = 8 * 16, I_OUT = 16 * 32;
    constexpr int NITEMS = 2 * I_UP + 2 * I_DN + I_IN + I_GLU + I_OUT;
    for (int it = F.gw; it < NITEMS; it += F.NGW) {
        int r = it;
        if (r < I_UP) { const int kb = r / 176, nb = r % 176; transpose_item(F.in[12], NUP, 64 * kb, 32 * nb, F.WUP1, DM, up_drow(32 * nb), scr, F.lane); continue; } r -= I_UP;
        if (r < I_UP) { const int kb = r / 176, nb = r % 176; transpose_item(F.in[31], NUP, 64 * kb, 32 * nb, F.WUP2, DM, up_drow(32 * nb), scr, F.lane); continue; } r -= I_UP;
        if (r < I_DN) { const int kb = r / 32, nb = r % 32; transpose_item(F.in[13], DM, 64 * kb, 32 * nb, F.WDN1, FF, 32 * nb, scr, F.lane); continue; } r -= I_DN;
        if (r < I_DN) { const int kb = r / 32, nb = r % 32; transpose_item(F.in[32], DM, 64 * kb, 32 * nb, F.WDN2, FF, 32 * nb, scr, F.lane); continue; } r -= I_DN;
        if (r < I_IN) { const int kb = r / 64, nb = r % 64; transpose_item(F.in[15], DIN, 64 * kb, 32 * nb, F.WIN, DM, 32 * nb, scr, F.lane); continue; } r -= I_IN;
        if (r < I_GLU) { const int kb = r / 16, nb = r % 16; transpose_item(F.in[25], DH, 64 * kb, 32 * nb, F.WGLU, DH, 32 * nb, scr, F.lane); continue; } r -= I_GLU;
        { const int kb = r / 32, nb = r % 32; transpose_item(F.in[29], DM, 64 * kb, 32 * nb, F.WOUT, DM, 32 * nb, scr, F.lane); }
    }
}

__device__ __forceinline__ bool row_next(const Frame& F, int k, int& row) {
    if (F.NGW == 2048) { if (k < 8) { row = F.gw + 2048 * k; return true; } if (k == 8 && (F.gw & 7) == 0) { row = NP + (F.gw >> 3); return true; } return false; }
    row = F.gw + k * F.NGW; return row < MT;
}
template <bool FG>
__device__ __forceinline__ void phase_norm(Frame& F, const float* xp, const float* xs, const float* gN, int si, int ci) {
    LAS float* wf = (LAS float*)F.lds;
    if (FG) {
        const float* win = F.in[15];
        for (int i = F.tid; i < 8192; i += 512) wf[i] = win[(size_t)(i >> 3) * DIN + 2048 + (i & 7)];
        __syncthreads();
    }
    const int lane = F.lane;
    int row, nrow; f32x4 v[4], nv[4];
    bool have = row_next(F, 0, row);
    if (have) { const float* xr = row < NP ? xp + (size_t)row * DM : xs + (size_t)(row - NP) * DM;
#pragma unroll
        for (int j = 0; j < 4; ++j) v[j] = *(const f32x4*)(xr + 4 * lane + 256 * j); }
    for (int k_ = 0; have; ++k_) {
        const bool hn = row_next(F, k_ + 1, nrow);
        if (hn) { const float* xr = nrow < NP ? xp + (size_t)nrow * DM : xs + (size_t)(nrow - NP) * DM;
#pragma unroll
            for (int j = 0; j < 4; ++j) nv[j] = *(const f32x4*)(xr + 4 * lane + 256 * j); }
        float ss = 0.f;
#pragma unroll
        for (int j = 0; j < 4; ++j) ss += (v[j][0] * v[j][0] + v[j][1] * v[j][1]) + (v[j][2] * v[j][2] + v[j][3] * v[j][3]);
        const float rstd = 1.0f / sqrtf(wave_sum(ss) * (1.0f / DM) + EPS);
        const float* sh = F.mod + bidx(row) * NMOD + si * DM; const float* sc = F.mod + bidx(row) * NMOD + ci * DM;
        float f[8];
#pragma unroll
        for (int i = 0; i < 8; ++i) f[i] = 0.f;
#pragma unroll
        for (int j = 0; j < 4; ++j) {
            const int col = 4 * lane + 256 * j;
            const f32x4 g4 = *(const f32x4*)(gN + col), s4 = *(const f32x4*)(sc + col), h4 = *(const f32x4*)(sh + col);
            const f32x4 h = v[j] * rstd * g4 * (s4 + 1.0f) + h4;
            u32x2 w; w.x = pk2(h[0], h[1]); w.y = pk2(h[2], h[3]);
            *(u32x2*)(F.HA + (size_t)row * DM + col) = w;
            if (FG) {
#pragma unroll
                for (int e = 0; e < 4; ++e) {
                    const f32x4 w0 = *(const LAS f32x4*)(wf + (col + e) * 8), w1 = *(const LAS f32x4*)(wf + (col + e) * 8 + 4);
                    f[0] += h[e] * w0[0]; f[1] += h[e] * w0[1]; f[2] += h[e] * w0[2]; f[3] += h[e] * w0[3];
                    f[4] += h[e] * w1[0]; f[5] += h[e] * w1[1]; f[6] += h[e] * w1[2]; f[7] += h[e] * w1[3];
                }
            }
        }
        if (FG) {
#pragma unroll
            for (int i = 0; i < 8; ++i) f[i] = wave_sum(f[i]);
            float fv = f[0];
            fv = lane == 1 ? f[1] : fv; fv = lane == 2 ? f[2] : fv; fv = lane == 3 ? f[3] : fv; fv = lane == 4 ? f[4] : fv;
            fv = lane == 5 ? f[5] : fv; fv = lane == 6 ? f[6] : fv; fv = lane == 7 ? f[7] : fv;
            if (lane < 8) {
                const float x = fv + F.in[16][lane];
                const float lf = fminf(x, 0.f) - log1pf(expf(-fabsf(x)));
                float* o = row < NP ? F.out + O_LFP + (size_t)row * 8 : F.out + O_LFS + (size_t)(row - NP) * 8;
                o[lane] = lf;
            }
        }
#pragma unroll
        for (int j = 0; j < 4; ++j) v[j] = nv[j];
        row = nrow; have = hn;
    }
}
__device__ __forceinline__ void phase_mixnorm(Frame& F, int parts, int wq, int nwq) {
    const int lane = F.lane; const float* gs = F.in[27]; const float* gf = F.in[28];
    int row;
    for (int k_ = 0; nwq ? ((row = wq + k_ * nwq) < MT) : row_next(F, k_, row); ++k_) {
#pragma unroll
        for (int part = 0; part < 2; ++part) {
            if (!((parts >> part) & 1)) continue;
            const float* g = (part == 0 ? gs : gf) + 8 * lane;
            float v[8];
            if (part == 1 && row >= NP) {
                const int b = (row - NP) >> 5, q = (row - NP) & 31, h = lane >> 3, d0 = 8 * (lane & 7);
                const float* pb = F.PB + ((size_t)(((b * 8 + h) * 4) * 32 + q)) * 68;
                float Mi[4], M = -INFINITY;
#pragma unroll
                for (int i = 0; i < 4; ++i) { Mi[i] = pb[(size_t)i * 32 * 68 + 64]; M = fmaxf(M, Mi[i]); }
                float L = 0.f;
#pragma unroll
                for (int e = 0; e < 8; ++e) v[e] = 0.f;
#pragma unroll
                for (int i = 0; i < 4; ++i) {
                    const float wg = __builtin_amdgcn_exp2f(Mi[i] - M); L += pb[(size_t)i * 32 * 68 + 65] * wg;
                    const f32x4 o0 = *(const f32x4*)(pb + (size_t)i * 32 * 68 + d0), o1 = *(const f32x4*)(pb + (size_t)i * 32 * 68 + d0 + 4);
                    v[0] += o0[0] * wg; v[1] += o0[1] * wg; v[2] += o0[2] * wg; v[3] += o0[3] * wg; v[4] += o1[0] * wg; v[5] += o1[1] * wg; v[6] += o1[2] * wg; v[7] += o1[3] * wg;
                }
                const float rl = 1.0f / L;
#pragma unroll
                for (int e = 0; e < 8; ++e) v[e] *= rl;
            } else {
                const bf16* src = (part == 0 ? F.U : F.O) + (size_t)row * DH + 8 * lane;
                const u32x4 z = *(const u32x4*)src;
                v[0] = bflo(z.x); v[1] = bfhi(z.x); v[2] = bflo(z.y); v[3] = bfhi(z.y); v[4] = bflo(z.z); v[5] = bfhi(z.z); v[6] = bflo(z.w); v[7] = bfhi(z.w);
            }
            float ss = 0.f;
#pragma unroll
            for (int i = 0; i < 8; ++i) ss += v[i] * v[i];
            const float rstd = 1.0f / sqrtf(wave_sum(ss) * (1.0f / DH) + EPS);
            const f32x4 g0 = *(const f32x4*)g, g1 = *(const f32x4*)(g + 4);
            u32x4 w; w.x = pk2(v[0] * rstd * g0[0], v[1] * rstd * g0[1]); w.y = pk2(v[2] * rstd * g0[2], v[3] * rstd * g0[3]);
            w.z = pk2(v[4] * rstd * g1[0], v[5] * rstd * g1[1]); w.w = pk2(v[6] * rstd * g1[2], v[7] * rstd * g1[3]);
            *(u32x4*)(F.HA + (size_t)row * DM + part * DH + 8 * lane) = w;
        }
    }
}
__device__ __forceinline__ void phase_finalnorm(Frame& F) {
    const int lane = F.lane; const float* gN = F.in[33];
    int row, nrow; f32x4 v[4], nv[4];
    bool have = row_next(F, 0, row);
    if (have) {
#pragma unroll
        for (int j = 0; j < 4; ++j) v[j] = *(const f32x4*)(F.out + (size_t)row * DM + 4 * lane + 256 * j); }
    for (int k_ = 0; have; ++k_) {
        const bool hn = row_next(F, k_ + 1, nrow);
        if (hn) {
#pragma unroll
            for (int j = 0; j < 4; ++j) nv[j] = *(const f32x4*)(F.out + (size_t)nrow * DM + 4 * lane + 256 * j); }
        float* xr = F.out + (size_t)row * DM; float ss = 0.f;
#pragma unroll
        for (int j = 0; j < 4; ++j) ss += (v[j][0] * v[j][0] + v[j][1] * v[j][1]) + (v[j][2] * v[j][2] + v[j][3] * v[j][3]);
        const float rstd = 1.0f / sqrtf(wave_sum(ss) * (1.0f / DM) + EPS);
#pragma unroll
        for (int j = 0; j < 4; ++j) { const f32x4 g4 = *(const f32x4*)(gN + 4 * lane + 256 * j); *(f32x4*)(xr + 4 * lane + 256 * j) = v[j] * rstd * g4; }
#pragma unroll
        for (int j = 0; j < 4; ++j) v[j] = nv[j];
        row = nrow; have = hn;
    }
}
__device__ __forceinline__ void phase_fcum(Frame& F) {
    LAS float* wt = (LAS float*)F.lds;
    const int tid = F.tid, lane = F.lane, wave = F.wave;
    for (int job = blockIdx.x; job < 96; job += F.G) {
        const float* src; float* dst; int b, h;
        if (job < 32) { b = job >> 3; h = job & 7; src = F.out + O_LFP + (size_t)b * 4096 * 8 + h; dst = F.F2P + (size_t)job * 4096; }
        else { const int j2 = job - 32; b = j2 >> 3; h = j2 & 7; src = F.in[6] + (size_t)b * 4096 * 8 + h; dst = F.F2S + (size_t)j2 * 4128; }
        float v[8]; float tsum = 0.f;
#pragma unroll
        for (int i = 0; i < 8; ++i) { v[i] = src[(size_t)(8 * tid + i) * 8]; tsum += v[i]; }
        float inc = tsum;
#pragma unroll
        for (int o = 1; o < 64; o <<= 1) { const float t = __shfl_up(inc, o); if (lane >= o) inc += t; }
        if (lane == 63) wt[wave] = inc;
        __syncthreads();
        float woff = 0.f, total = 0.f;
#pragma unroll
        for (int w = 0; w < 8; ++w) { const float x = wt[w]; if (w < wave) woff += x; total += x; }
        float run = woff + inc - tsum;
#pragma unroll
        for (int i = 0; i < 8; ++i) { run += v[i]; dst[8 * tid + i] = run * LOG2E; }
        if (job >= 32 && wave == 0) {
            float x = lane < 32 ? F.out[O_LFS + (size_t)(b * 32 + lane) * 8 + h] : 0.f;
#pragma unroll
            for (int o = 1; o < 64; o <<= 1) { const float t = __shfl_up(x, o); if (lane >= o) x += t; }
            if (lane < 32) dst[4096 + lane] = (total + x) * LOG2E;
        }
        __syncthreads();
    }
}
#define XB_TMO      128
#define XB_XCNT(j)  (256  + 64 * (j))
#define XB_XSUB(j)  (1280 + 64 * (j))
#define XB_XGEN(j)  (2304 + 64 * (j))
#define XB_TOP      3328
#define XB_TOPGEN   3392
#define XCD_BAR_WORDS 3456
#define XB_SPIN_CAP (1u << 18)

__device__ __forceinline__ unsigned xb_ld(unsigned* p)              { return __hip_atomic_load(p, __ATOMIC_RELAXED, __HIP_MEMORY_SCOPE_AGENT); }
__device__ __forceinline__ unsigned xb_add(unsigned* p, unsigned v) { return __hip_atomic_fetch_add(p, v, __ATOMIC_RELAXED, __HIP_MEMORY_SCOPE_AGENT); }
__device__ __forceinline__ unsigned xb_xcc_id() { return (unsigned)__builtin_amdgcn_s_getreg((3 << 11) | 20) & 0xFu; }
#define XB_SPIN(cond, bar) do { unsigned _sp = 0; while (cond) { __builtin_amdgcn_s_sleep(1); \
    if ((++_sp & 255u) == 0u) { if (xb_ld(&(bar)[XB_TMO])) break; if (_sp > XB_SPIN_CAP) { atomicAdd(&(bar)[XB_TMO], 1u); break; } } } } while (0)

struct XcdBarrier {
    unsigned* bar; unsigned x;
    volatile LAS unsigned* st;
};

__device__ __forceinline__ XcdBarrier xcd_barrier_post(unsigned* bar, volatile LAS unsigned* st) {
    XcdBarrier b; b.bar = bar; b.x = xb_xcc_id(); b.st = st;
    if (threadIdx.x == 0) (void)xb_add(&bar[XB_XCNT(b.x)], 1u);
    return b;
}
__device__ __forceinline__ void xcd_barrier_complete(unsigned* bar, unsigned x, unsigned& nloc, unsigned& nx) {
    const unsigned G = gridDim.x * gridDim.y * gridDim.z;
    unsigned sum, cnt, mine, sp = 0u;
    for (;;) {
        sum = 0u; cnt = 0u; mine = 0u;
#pragma unroll
        for (unsigned j = 0; j < 16; ++j) { const unsigned c = xb_ld(&bar[XB_XCNT(j)]); sum += c; cnt += (c > 0u) ? 1u : 0u; mine = (j == x) ? c : mine; }
        if (sum == G) break;
        __builtin_amdgcn_s_sleep(1);
        if ((++sp & 255u) == 0u) { if (xb_ld(&bar[XB_TMO])) break; if (sp > XB_SPIN_CAP) { atomicAdd(&bar[XB_TMO], 1u); break; } }
    }
    nloc = mine > 0u ? mine : 1u; nx = cnt > 0u ? cnt : 1u;
}

__device__ __forceinline__ void xcd_barrier(const XcdBarrier& b) {
    asm volatile("s_waitcnt vmcnt(0)" ::: "memory");
    __syncthreads();
    if (threadIdx.x == 0) {
        unsigned* bar = b.bar;
        __builtin_amdgcn_s_waitcnt(0);
        unsigned nloc = b.st[0], nx = b.st[1];
        if (nloc == 0u) { xcd_barrier_complete(bar, b.x, nloc, nx); b.st[0] = nloc; b.st[1] = nx; }
        const unsigned old = xb_add(&bar[XB_XSUB(b.x)], 1u);
        const unsigned gen = old / nloc;
        if (old + 1u == (gen + 1u) * nloc) {
            __builtin_amdgcn_fence(__ATOMIC_RELEASE, "agent");
            asm volatile("s_waitcnt vmcnt(0)" ::: "memory");
            const unsigned og = xb_add(&bar[XB_TOP], 1u);
            const unsigned tg = og / nx;
            if (og + 1u == (tg + 1u) * nx) xb_add(&bar[XB_TOPGEN], 1u);
            else XB_SPIN(xb_ld(&bar[XB_TOPGEN]) == tg, bar);
            __builtin_amdgcn_fence(__ATOMIC_ACQUIRE, "agent");
            xb_add(&bar[XB_XGEN(b.x)], 1u);
            asm volatile("s_waitcnt vmcnt(0)" ::: "memory");
        } else {
            XB_SPIN(xb_ld(&bar[XB_XGEN(b.x)]) == gen, bar);
            __builtin_amdgcn_fence(__ATOMIC_ACQUIRE, "agent");
            asm volatile("s_waitcnt vmcnt(0)" ::: "memory");
        }
    }
    __syncthreads();
}

__device__ __forceinline__ void seam_arrive(unsigned* word) {
    asm volatile("s_waitcnt vmcnt(0)" ::: "memory");
    __syncthreads();
    if (threadIdx.x == 0) { __builtin_amdgcn_fence(__ATOMIC_RELEASE, "agent"); asm volatile("s_waitcnt vmcnt(0)" ::: "memory"); (void)xb_add(word, 1u); }
}
__device__ __forceinline__ void seam_wait(unsigned* word, unsigned want) {
    if (threadIdx.x == 0) {
        unsigned sp = 0u;
        while (xb_ld(word) < want) { __builtin_amdgcn_s_sleep(1); if (++sp > (1u << 22)) break; }
        __builtin_amdgcn_fence(__ATOMIC_ACQUIRE, "agent");
        asm volatile("s_waitcnt vmcnt(0)" ::: "memory");
    }
    __syncthreads();
}

constexpr int KP = 72, VP = 68;
typedef short v4i16_t __attribute__((ext_vector_type(4)));
__device__ __forceinline__ s16x4 vtr(const LAS bf16* p) { return __builtin_bit_cast(s16x4, __builtin_amdgcn_ds_read_tr16_b64_v4i16((LAS v4i16_t*)p)); }
template <int NK, int VPT, bool TR>
__device__ __forceinline__ void attn_tile(const LAS bf16* kL, const LAS bf16* vL, const LAS float* fL, LAS float* wsf, const bf16x8 (&qr)[4], f32x16 (&o)[2],
                                          float& m, float& l, bool domask, int lim, int r32, int hi) {
    f32x16 p[2 * NK];
#pragma unroll
    for (int t = 0; t < NK; ++t)
#pragma unroll
        for (int rg = 0; rg < 4; ++rg) {
            const f32x4 fa = *(const LAS f32x4*)(fL + 64 * t + 8 * rg + 4 * hi), fb = *(const LAS f32x4*)(fL + 64 * t + 32 + 8 * rg + 4 * hi);
#pragma unroll
            for (int i = 0; i < 4; ++i) { p[2 * t][4 * rg + i] = fa[i]; p[2 * t + 1][4 * rg + i] = fb[i]; }
        }
#pragma unroll
    for (int t = 0; t < NK; ++t)
#pragma unroll
        for (int d0 = 0; d0 < 4; ++d0) {
            const bf16x8 a0 = *(const LAS bf16x8*)(kL + (64 * t + r32) * KP + d0 * 16 + hi * 8);
            const bf16x8 a1 = *(const LAS bf16x8*)(kL + (64 * t + 32 + r32) * KP + d0 * 16 + hi * 8);
            p[2 * t] = __builtin_amdgcn_mfma_f32_32x32x16_bf16(a0, qr[d0], p[2 * t], 0, 0, 0);
            p[2 * t + 1] = __builtin_amdgcn_mfma_f32_32x32x16_bf16(a1, qr[d0], p[2 * t + 1], 0, 0, 0);
            if (NK > 1 && (d0 & 1)) __builtin_amdgcn_sched_barrier(0);
        }
    if (domask) {
#pragma unroll
        for (int t = 0; t < 2 * NK; ++t)
#pragma unroll
            for (int r = 0; r < 16; ++r) { const int kv = 32 * t + (r & 3) + 8 * (r >> 2) + 4 * hi; if (kv > lim) p[t][r] = -INFINITY; }
    }
    float mt = p[0][0];
#pragma unroll
    for (int t = 0; t < 2 * NK; ++t)
#pragma unroll
        for (int r = 0; r < 16; ++r) mt = fmaxf(mt, p[t][r]);
    { const auto rr = __builtin_amdgcn_permlane32_swap(__float_as_uint(mt), __float_as_uint(mt), false, false); mt = fmaxf(__uint_as_float(rr[0]), __uint_as_float(rr[1])); }
    if (__any(mt > m + 8.0f)) {
        const float mn = (mt > m + 8.0f) ? mt : m;
        const float alpha = __builtin_amdgcn_exp2f(m - mn);
        m = mn; l *= alpha;
        if (hi == 0) wsf[r32] = alpha;
        LDS_WAIT();
#pragma unroll
        for (int rg = 0; rg < 4; ++rg) {
            const f32x4 al = *(const LAS f32x4*)(wsf + 8 * rg + 4 * hi);
#pragma unroll
            for (int i = 0; i < 4; ++i) { o[0][4 * rg + i] *= al[i]; o[1][4 * rg + i] *= al[i]; }
        }
    }
    f32x2 rs2 = (f32x2){0.f, 0.f}; const f32x2 m2 = (f32x2){m, m};
#pragma unroll
    for (int t = 0; t < 2 * NK; ++t)
#pragma unroll
        for (int r = 0; r < 16; r += 2) {
            const f32x2 d = (f32x2){p[t][r], p[t][r + 1]} - m2;
            const f32x2 e = (f32x2){__builtin_amdgcn_exp2f(d.x), __builtin_amdgcn_exp2f(d.y)};
            p[t][r] = e.x; p[t][r + 1] = e.y; rs2 += e;
        }
    l += rs2.x + rs2.y;
#pragma unroll
    for (int t = 0; t < 2 * NK; ++t) {
        if (NK > 1) __builtin_amdgcn_sched_barrier(0);
        u32x4 pw0 = (u32x4){pk2(p[t][0], p[t][1]), pk2(p[t][2], p[t][3]), pk2(p[t][4], p[t][5]), pk2(p[t][6], p[t][7])};
        u32x4 pw1 = (u32x4){pk2(p[t][8], p[t][9]), pk2(p[t][10], p[t][11]), pk2(p[t][12], p[t][13]), pk2(p[t][14], p[t][15])};
#pragma unroll
        for (int d0 = 0; d0 < 2; ++d0)
#pragma unroll
            for (int s = 0; s < 2; ++s) {
                s16x4 lo, h4;
                if (TR) {
                    const LAS bf16* vb = vL + (4 * hi + ((r32 & 15) >> 2)) * VPT + 16 * (r32 >> 4) + 4 * (r32 & 3);
                    lo = vtr(vb + (32 * t + 16 * s) * VPT + 32 * d0); h4 = vtr(vb + (32 * t + 16 * s + 8) * VPT + 32 * d0);
                } else {
                    lo = *(const LAS s16x4*)(vL + (r32 + 32 * d0) * VPT + 32 * t + 16 * s + 4 * hi);
                    h4 = *(const LAS s16x4*)(vL + (r32 + 32 * d0) * VPT + 32 * t + 16 * s + 8 + 4 * hi);
                }
                const bf16x8 bv = (bf16x8){lo[0], lo[1], lo[2], lo[3], h4[0], h4[1], h4[2], h4[3]};
                o[d0] = __builtin_amdgcn_mfma_f32_32x32x16_bf16(__builtin_bit_cast(bf16x8, s == 0 ? pw0 : pw1), bv, o[d0], 0, 0, 0);
            }
    }
    LDS_WAIT();
}
__device__ __forceinline__ void st16(LAS bf16* p, unsigned v) { *(LAS unsigned short*)p = (unsigned short)v; }
__device__ __forceinline__ void attn_prompt_unit(Frame& F, int b, int h, int qb) {
    const int tid = F.tid, lane = F.lane, wave = F.wave, r32 = lane & 31, hi = lane >> 5;
    constexpr int VPR = 96;
    LAS bf16* kbuf = (LAS bf16*)F.lds; LAS bf16* vbuf = (LAS bf16*)(F.lds + 36864); LAS float* fbuf = (LAS float*)(F.lds + 86016);
    LAS float* wsf = (LAS float*)(F.lds + 87040) + wave * 64;
    const int rowbase = b * 4096, q0 = qb * 256;
    const bf16* Qw = F.Q + (size_t)(rowbase + q0 + wave * 32) * DH + h * 64;
    bf16* Ow = F.O + (size_t)(rowbase + q0 + wave * 32) * DH + h * 64;
    bf16x8 qr[4];
#pragma unroll
    for (int d0 = 0; d0 < 4; ++d0) qr[d0] = *(const bf16x8*)(Qw + (size_t)r32 * DH + d0 * 16 + hi * 8);
    const int NT = 4 * (qb + 1), kvs = tid >> 3, c8 = tid & 7;
    const bf16* kg = F.KB + (size_t)(rowbase + kvs) * DH + h * 64 + 8 * c8;
    const bf16* vg = F.VB + (size_t)(rowbase + kvs) * DH + h * 64 + 8 * c8;
    const float* fg = F.F2P + (size_t)(b * 8 + h) * 4096;
    u32x4 kr0 = *(const u32x4*)kg, vr0 = *(const u32x4*)vg, kr1 = *(const u32x4*)(kg + (size_t)64 * DH), vr1 = *(const u32x4*)(vg + (size_t)64 * DH);
    float fr_ = tid < 128 ? fg[tid] : 0.f;
    float m = -1e30f, l = 0.f; f32x16 o[2];
#pragma unroll
    for (int r = 0; r < 16; ++r) { o[0][r] = 0.f; o[1][r] = 0.f; }
    const int qmin = q0 + wave * 32, NS = NT / 2;
#define ATT_WRITE_STEP(t_) do { LAS bf16* kL_ = kbuf + ((t_) & 1) * (128 * KP); LAS bf16* vL_ = vbuf + ((t_) & 1) * (128 * VPR); LAS float* fL_ = fbuf + ((t_) & 1) * 128; \
        *(LAS u32x4*)(kL_ + kvs * KP + 8 * c8) = kr0; *(LAS u32x4*)(kL_ + (64 + kvs) * KP + 8 * c8) = kr1; \
        *(LAS u32x4*)(vL_ + kvs * VPR + 8 * c8) = vr0; *(LAS u32x4*)(vL_ + (64 + kvs) * VPR + 8 * c8) = vr1; \
        if (tid < 128) fL_[tid] = -fr_; } while (0)
    ATT_WRITE_STEP(0);
    __syncthreads();
    for (int t = 0; t < NS; ++t) {
        if (t + 1 < NS) { const size_t go = (size_t)(t + 1) * 128 * DH;
            kr0 = *(const u32x4*)(kg + go); vr0 = *(const u32x4*)(vg + go); kr1 = *(const u32x4*)(kg + go + (size_t)64 * DH); vr1 = *(const u32x4*)(vg + go + (size_t)64 * DH);
            fr_ = tid < 128 ? fg[(t + 1) * 128 + tid] : 0.f; }
        if (128 * t <= qmin + 31) {
            const bool domask = (128 * t + 127 > qmin);
            const LAS bf16* kS = kbuf + (t & 1) * (128 * KP); const LAS bf16* vS = vbuf + (t & 1) * (128 * VPR); const LAS float* fS = fbuf + (t & 1) * 128;
            attn_tile<1, VPR, true>(kS, vS, fS, wsf, qr, o, m, l, (128 * t + 63 > qmin), qmin + r32 - 128 * t, r32, hi);
            if (128 * t + 64 <= qmin + 31) attn_tile<1, VPR, true>(kS + 64 * KP, vS + 64 * VPR, fS + 64, wsf, qr, o, m, l, domask, qmin + r32 - 128 * t - 64, r32, hi);
        }
        if (t + 1 < NS) ATT_WRITE_STEP(t + 1);
        __syncthreads();
    }
#undef ATT_WRITE_STEP
    l += __shfl_xor(l, 32);
    if (hi == 0) wsf[r32] = 1.0f / l;
    LDS_WAIT();
#pragma unroll
    for (int rg = 0; rg < 4; ++rg) {
        const f32x4 rl = *(const LAS f32x4*)(wsf + 8 * rg + 4 * hi);
#pragma unroll
        for (int i = 0; i < 4; ++i) {
            const int q = 8 * rg + 4 * hi + i;
            Ow[(size_t)q * DH + r32] = (bf16)f2bf(o[0][4 * rg + i] * rl[i]);
            Ow[(size_t)q * DH + 32 + r32] = (bf16)f2bf(o[1][4 * rg + i] * rl[i]);
        }
    }
    LDS_WAIT();
    __syncthreads();
}
__device__ __forceinline__ void attn_sample_unit(Frame& F, int b, int h, int qd) {
    const int tid = F.tid, lane = F.lane, wave = F.wave, r32 = lane & 31, hi = lane >> 5;
    LAS unsigned char* wb = F.lds + wave * 18432;
    LAS bf16* kL = (LAS bf16*)wb; LAS bf16* vL = (LAS bf16*)(wb + 9216); LAS float* fL = (LAS float*)(wb + 17920); LAS float* wsf = (LAS float*)(wb + 18176);
    const int qrow0 = NP + b * 32;
    bf16x8 qr[4];
#pragma unroll
    for (int d0 = 0; d0 < 4; ++d0) qr[d0] = *(const bf16x8*)(F.Q + (size_t)(qrow0 + r32) * DH + h * 64 + d0 * 16 + hi * 8);
    float m = -1e30f, l = 0.f; f32x16 o[2];
#pragma unroll
    for (int r = 0; r < 16; ++r) { o[0][r] = 0.f; o[1][r] = 0.f; }
    const float* ck = F.in[4] + ((size_t)b * 4096 * 8 + h) * 64;
    const float* cv = F.in[5] + ((size_t)b * 4096 * 8 + h) * 64;
    const float* f2 = F.F2S + (size_t)(b * 8 + h) * 4128;
    const int c16 = lane & 15, kq = lane >> 4;
    for (int tt = 0; tt < 2; ++tt) {
        const int kv0 = qd * 1024 + wave * 128 + tt * 64;
        {
            f32x4 x[16];
#pragma unroll
            for (int i = 0; i < 16; ++i) x[i] = __builtin_nontemporal_load((const f32x4*)(ck + (size_t)(kv0 + kq + 4 * i) * 512 + 4 * c16));
#pragma unroll
            for (int i = 0; i < 16; ++i) { u32x2 w; w.x = pk2(x[i][0], x[i][1]); w.y = pk2(x[i][2], x[i][3]); *(LAS u32x2*)(kL + (kq + 4 * i) * KP + 4 * c16) = w; }
#pragma unroll
            for (int i = 0; i < 16; ++i) x[i] = __builtin_nontemporal_load((const f32x4*)(cv + (size_t)(kv0 + kq + 4 * i) * 512 + 4 * c16));
#pragma unroll
            for (int i = 0; i < 16; ++i) { const int kv = kq + 4 * i; const unsigned y0 = pk2(x[i][0], x[i][1]), y1 = pk2(x[i][2], x[i][3]);
                st16(vL + (4 * c16 + 0) * VP + kv, y0); st16(vL + (4 * c16 + 1) * VP + kv, y0 >> 16);
                st16(vL + (4 * c16 + 2) * VP + kv, y1); st16(vL + (4 * c16 + 3) * VP + kv, y1 >> 16); }
        }
        fL[lane] = -f2[kv0 + lane];
        LDS_WAIT();
        attn_tile<1, VP, false>(kL, vL, fL, wsf, qr, o, m, l, false, 0, r32, hi);
    }
    if (wave == 7 && qd == 3) {
        const int kv = lane >> 1, half = lane & 1;
        const bf16* kn = F.KB + (size_t)(qrow0 + kv) * DH + h * 64 + 32 * half;
        const bf16* vn = F.VB + (size_t)(qrow0 + kv) * DH + h * 64 + 32 * half;
#pragma unroll
        for (int i = 0; i < 4; ++i) {
            const u32x4 x = *(const u32x4*)(kn + 8 * i), y = *(const u32x4*)(vn + 8 * i);
            *(LAS u32x4*)(kL + kv * KP + 32 * half + 8 * i) = x;
            *(LAS u32x4*)(kL + (32 + kv) * KP + 32 * half + 8 * i) = (u32x4){0u, 0u, 0u, 0u};
            const int d = 32 * half + 8 * i;
            st16(vL + (d + 0) * VP + kv, y.x); st16(vL + (d + 1) * VP + kv, y.x >> 16); st16(vL + (d + 2) * VP + kv, y.y); st16(vL + (d + 3) * VP + kv, y.y >> 16);
            st16(vL + (d + 4) * VP + kv, y.z); st16(vL + (d + 5) * VP + kv, y.z >> 16); st16(vL + (d + 6) * VP + kv, y.w); st16(vL + (d + 7) * VP + kv, y.w >> 16);
#pragma unroll
            for (int e = 0; e < 8; ++e) st16(vL + (d + e) * VP + 32 + kv, 0u);
        }
        fL[lane] = lane < 32 ? -f2[4096 + lane] : 0.f;
        LDS_WAIT();
        attn_tile<1, VP, false>(kL, vL, fL, wsf, qr, o, m, l, true, r32, r32, hi);
    }
    l += __shfl_xor(l, 32);
    __syncthreads();
    LAS float* cm = (LAS float*)F.lds; LAS float* cl = cm + 256; LAS float* co = cl + 256;
    if (hi == 0) { cm[wave * 32 + r32] = m; cl[wave * 32 + r32] = l; }
#pragma unroll
    for (int r = 0; r < 16; ++r) {
        const int q = (r & 3) + 8 * (r >> 2) + 4 * hi;
        co[(wave * 32 + q) * 64 + r32] = o[0][r]; co[(wave * 32 + q) * 64 + 32 + r32] = o[1][r];
    }
    __syncthreads();
    {
        const int q = tid >> 4, dg = tid & 15;
        float M = cm[q];
#pragma unroll
        for (int w = 1; w < 8; ++w) M = fmaxf(M, cm[w * 32 + q]);
        float L = 0.f; f32x4 acc = (f32x4){0.f, 0.f, 0.f, 0.f};
#pragma unroll
        for (int w = 0; w < 8; ++w) {
            const float wg = __builtin_amdgcn_exp2f(cm[w * 32 + q] - M);
            L += cl[w * 32 + q] * wg;
            acc += *(const LAS f32x4*)(co + (w * 32 + q) * 64 + 4 * dg) * wg;
        }
        float* pb = F.PB + ((size_t)(((b * 8 + h) * 4 + qd) * 32 + q)) * 68;
        *(f32x4*)(pb + 4 * dg) = acc;
        if (dg == 0) { pb[64] = M; pb[65] = L; }
    }
    __syncthreads();
}

__device__ __forceinline__ bool s5_pair_next(const Frame& F, int k, bool with_sample, int& q) {
    if (F.NGW == 2048) {
        if (k < 2) { q = k * 2048 + ((F.gw + 531 * k) & 2047); return true; }
        if (k == 2 && with_sample && (F.gw & 15) == 0) { q = 4096 + (F.gw >> 4); return true; }
        return false;
    }
    q = F.gw + k * F.NGW; return q < (with_sample ? 4224 : 4096);
}
__device__ __forceinline__ void s5_pair_item(int q, int hs, int& g, int& item, int& row0) {
    if (q < 4096) { g = q >> 7; const int b = ((q >> 6) & 1) + 2 * hs, ch = q & 63; item = g * S5_ITEMS_PER_G + b * 64 + ch; row0 = b * 4096 + ch * 64; }
    else { const int s = q - 4096; g = s >> 2; const int sb = (s & 3) + 4 * hs; item = g * S5_ITEMS_PER_G + 256 + sb; row0 = NP + sb * 32; }
}
__device__ __forceinline__ void s5_bu(const bf16x8 ua, const bf16x8 (&bmf)[4], f32x16 (&D)[4]) {
#pragma unroll
    for (int kt = 0; kt < 4; ++kt) {
#pragma unroll
        for (int r = 0; r < 16; ++r) D[kt][r] = 0.f;
        D[kt] = __builtin_amdgcn_mfma_f32_32x32x16_bf16(ua, bmf[kt], D[kt], 0, 0, 0);
    }
}
__device__ __forceinline__ void s5_pair_a(Frame& F, int q) {
    const int lane = F.lane, kl = lane & 31, hs = lane >> 5;
    int g, itemA, rowA, itemB, rowB, itemM, rowM;
    s5_pair_item(q, 0, g, itemA, rowA); s5_pair_item(q, 1, g, itemB, rowB); s5_pair_item(q, hs, g, itemM, rowM);
    const f32x2 aA = F.abar[g * 64 + kl], aB = F.abar[g * 64 + 32 + kl];
    bf16x8 bmf[4];
#pragma unroll
    for (int kt = 0; kt < 4; ++kt) bmf[kt] = *(const bf16x8*)(F.bmh + (size_t)(g * 128 + 32 * kt + kl) * 16 + 8 * hs);
    const int ri = (kl & 3) + 4 * (kl >> 3), hsel = (kl >> 2) & 1;
    const bf16* up = F.U + (size_t)((hsel ? rowB : rowA) + ri) * DH + g * 16 + 8 * hs;
    bf16x8 ua[4];
#pragma unroll
    for (int sb = 0; sb < 4; ++sb) ua[sb] = *(const bf16x8*)(up + (size_t)16 * sb * DH);
    f32x2 sA = (f32x2){0.f, 0.f}, sB = (f32x2){0.f, 0.f};
#pragma unroll
    for (int sb = 0; sb < 4; ++sb) {
        f32x16 D[4]; s5_bu(ua[sb], bmf, D);
#pragma unroll
        for (int r = 0; r < 16; ++r) {
            f32x2 n; n.x = aA.x * sA.x - aA.y * sA.y + D[0][r]; n.y = aA.x * sA.y + aA.y * sA.x + D[1][r]; sA = n;
            f32x2 w; w.x = aB.x * sB.x - aB.y * sB.y + D[2][r]; w.y = aB.x * sB.y + aB.y * sB.x + D[3][r]; sB = w;
        }
    }
    F.E[(size_t)itemM * 64 + kl] = sA; F.E[(size_t)itemM * 64 + 32 + kl] = sB;
}
__device__ __forceinline__ void s5_pass_a(Frame& F) {
    int q;
    for (int k = 0; s5_pair_next(F, k, false, q); ++k) s5_pair_a(F, q);
}
__device__ __forceinline__ void s5_pair_c(Frame& F, int q, LAS bf16* Sb) {
    const int lane = F.lane, kl = lane & 31, hs = lane >> 5, fr = lane & 15, fq = lane >> 4;
    int g, itemA, rowA, itemB, rowB, itemM, rowM;
    s5_pair_item(q, 0, g, itemA, rowA); s5_pair_item(q, 1, g, itemB, rowB); s5_pair_item(q, hs, g, itemM, rowM);
    const bool prompt = q < 4096; const int nsb = prompt ? 4 : 2;
    const f32x2 aA = F.abar[g * 64 + kl], aB = F.abar[g * 64 + 32 + kl];
    bf16x8 bmf[4];
#pragma unroll
    for (int kt = 0; kt < 4; ++kt) bmf[kt] = *(const bf16x8*)(F.bmh + (size_t)(g * 128 + 32 * kt + kl) * 16 + 8 * hs);
    bf16x8 cmf[4];
#pragma unroll
    for (int ks = 0; ks < 4; ++ks) cmf[ks] = *(const bf16x8*)(F.cmt + (g * 16 + fr) * 128 + 32 * ks + 8 * fq);
    const f32x4 dv = *(const f32x4*)(F.in[24] + g * 16 + 4 * fq);
    const int ri = (kl & 3) + 4 * (kl >> 3), hsel = (kl >> 2) & 1;
    const bf16* up = F.U + (size_t)((hsel ? rowB : rowA) + ri) * DH + g * 16 + 8 * hs;
    bf16x8 ua[4];
#pragma unroll
    for (int sb = 0; sb < 4; ++sb) ua[sb] = (sb < nsb) ? *(const bf16x8*)(up + (size_t)16 * sb * DH) : (bf16x8){0, 0, 0, 0, 0, 0, 0, 0};
    f32x2 sA, sB;
    if (prompt) {
        sA = (f32x2){0.f, 0.f}; sB = (f32x2){0.f, 0.f};
        const f32x2 cA = F.a64[g * 64 + kl], cB = F.a64[g * 64 + 32 + kl];
        const int nprev = q & 63;
        const f32x2* ep = F.E + (size_t)(itemM - nprev) * 64 + kl;
        const int off = (8 - (nprev & 7)) & 7;
        for (int i0 = -off; i0 < nprev; i0 += 8) {
            f32x2 eA[8], eB[8];
#pragma unroll
            for (int u = 0; u < 8; ++u) { const bool ok = (i0 + u >= 0); eA[u] = ok ? ep[(size_t)(i0 + u) * 64] : (f32x2){0.f, 0.f}; eB[u] = ok ? ep[(size_t)(i0 + u) * 64 + 32] : (f32x2){0.f, 0.f}; }
#pragma unroll
            for (int u = 0; u < 8; ++u) {
                f32x2 n; n.x = cA.x * sA.x - cA.y * sA.y + eA[u].x; n.y = cA.x * sA.y + cA.y * sA.x + eA[u].y; sA = n;
                f32x2 w; w.x = cB.x * sB.x - cB.y * sB.y + eB[u].x; w.y = cB.x * sB.y + cB.y * sB.x + eB[u].y; sB = w;
            }
        }
    } else {
        const int sq = (q - 4096) & 3, sbi = sq + 4 * hs; const size_t si = (size_t)(sbi * 32 + g) * 64;
        sA = (f32x2){F.in[7][si + kl], F.in[8][si + kl]}; sB = (f32x2){F.in[7][si + 32 + kl], F.in[8][si + 32 + kl]};
    }
    for (int sb = 0; sb < nsb; ++sb) {
        f32x16 D[4];
        { const bf16x8 uas = sb == 0 ? ua[0] : sb == 1 ? ua[1] : sb == 2 ? ua[2] : ua[3]; s5_bu(uas, bmf, D); }
#pragma unroll
        for (int r = 0; r < 16; ++r) {
            f32x2 n; n.x = aA.x * sA.x - aA.y * sA.y + D[0][r]; n.y = aA.x * sA.y + aA.y * sA.x + D[1][r]; sA = n;
            f32x2 w; w.x = aB.x * sB.x - aB.y * sB.y + D[2][r]; w.y = aB.x * sB.y + aB.y * sB.x + D[3][r]; sB = w;
            LAS bf16* sp = Sb + (hs * 16 + r) * 136 + kl;
            st16(sp, f2bf(sA.x)); st16(sp + 64, f2bf(sA.y)); st16(sp + 32, f2bf(sB.x)); st16(sp + 96, f2bf(sB.y));
        }
        LDS_WAIT();
#pragma unroll
        for (int it = 0; it < 2; ++it) {
            f32x4 acc = (f32x4){0.f, 0.f, 0.f, 0.f};
#pragma unroll
            for (int ks = 0; ks < 4; ++ks) {
                const bf16x8 sf = *(const LAS bf16x8*)(Sb + (it * 16 + fr) * 136 + 32 * ks + 8 * fq);
                acc = __builtin_amdgcn_mfma_f32_16x16x32_bf16(cmf[ks], sf, acc, 0, 0, 0);
            }
            const size_t row = (size_t)(it ? rowB : rowA) + 16 * sb + fr;
            const u32x2 ub = *(const u32x2*)(F.U + row * DH + g * 16 + 4 * fq);
            const float u4[4] = {bflo(ub.x), bfhi(ub.x), bflo(ub.y), bfhi(ub.y)};
            float y[4];
#pragma unroll
            for (int i = 0; i < 4; ++i) { const float t = acc[i] + dv[i] * u4[i]; y[i] = t * fsigmoid(1.5957691216057308f * (t + 0.044715f * t * t * t)); }
            u32x2 w; w.x = pk2(y[0], y[1]); w.y = pk2(y[2], y[3]);
            *(u32x2*)(F.Z + row * DH + g * 16 + 4 * fq) = w;
        }
        LDS_WAIT();
    }
    if (!prompt) { const int sbi = ((q - 4096) & 3) + 4 * hs; const size_t si = (size_t)(sbi * 32 + g) * 64;
        F.out[O_SRS + si + kl] = sA.x; F.out[O_SIS + si + kl] = sA.y; F.out[O_SRS + si + 32 + kl] = sB.x; F.out[O_SIS + si + 32 + kl] = sB.y; }
    else if ((q & 63) == 63) { const int b = ((q >> 6) & 1) + 2 * hs; const size_t si = (size_t)(b * 32 + g) * 64;
        F.out[O_SRP + si + kl] = sA.x; F.out[O_SIP + si + kl] = sA.y; F.out[O_SRP + si + 32 + kl] = sB.x; F.out[O_SIP + si + 32 + kl] = sB.y; }
}
__device__ __forceinline__ void s5_pass_c(Frame& F) {
    LAS bf16* Sb = (LAS bf16*)(F.lds + F.wave * 12800);
    int q;
    for (int k = 0; s5_pair_next(F, k, true, q); ++k) s5_pair_c(F, q, Sb);
}

struct SkSwiglu { bf16* H;
    __device__ __forceinline__ int brow(int ct, int nb) const { return 256 * (ct >> 2) + 32 * (ct & 3) + 128 * nb; }
    __device__ __forceinline__ void pre(int, int, int, f32x4&) const {}
    __device__ __forceinline__ void operator()(int row, int ct, int j0, const float (&v)[2][2], const f32x4&) const {
        const float a = v[0][0] * fsigmoid(v[0][0]) * v[1][0], b = v[0][1] * fsigmoid(v[0][1]) * v[1][1];
        *(unsigned*)(H + (size_t)(NP + row) * FF + 32 * ct + j0) = pk2(a, b); } };
struct SkResid { const float* xin; float* out; const float* mod; int gi; float gscale;
    __device__ __forceinline__ int brow(int ct, int) const { return 32 * ct; }
    __device__ __forceinline__ void pre(int row, int ct, int j0, f32x4& pf) const {
        const int col = 32 * ct + j0; const float* gate = mod + (4 + (row >> 5)) * NMOD + gi * DM + col;
        const f32x2 x = *(const f32x2*)(xin + (size_t)row * DM + col), g = *(const f32x2*)gate; pf = (f32x4){x.x, x.y, g.x, g.y}; }
    __device__ __forceinline__ void operator()(int row, int ct, int j0, const float (&v)[1][2], const f32x4& pf) const {
        const int col = 32 * ct + j0;
        f32x2 o; o.x = pf[0] + gscale * (1.f + pf[2]) * v[0][0]; o.y = pf[1] + gscale * (1.f + pf[3]) * v[0][1];
        *(f32x2*)(out + (size_t)row * DM + col) = o; } };
struct SkIn { bf16 *U, *Q, *KB, *VB; float* out;
    __device__ __forceinline__ int brow(int ct, int) const { return 32 * ct; }
    __device__ __forceinline__ void pre(int, int, int, f32x4&) const {}
    __device__ __forceinline__ void operator()(int row, int ct, int j0, const float (&v)[1][2], const f32x4&) const {
        const int n = 32 * ct + j0, t = n >> 9, col = n & 511; const float sc = t == 1 ? QSCALE : 1.f;
        bf16* dst = U + (size_t)t * (17 * MiB / 2);
        *(unsigned*)(dst + (size_t)(NP + row) * DH + col) = pk2(v[0][0] * sc, v[0][1] * sc);
        if (t >= 2) *(f32x2*)(out + (t == 2 ? O_KS : O_VS) + (size_t)row * DH + col) = (f32x2){v[0][0], v[0][1]}; } };
struct SkGlu { const bf16* Z; bf16* Y; const float* bglu;
    __device__ __forceinline__ int brow(int ct, int) const { return 32 * ct; }
    __device__ __forceinline__ void pre(int, int, int, f32x4&) const {}
    __device__ __forceinline__ void operator()(int row, int ct, int j0, const float (&v)[1][2], const f32x4&) const {
        const int col = 32 * ct + j0; const unsigned z = *(const unsigned*)(Z + (size_t)(NP + row) * DH + col);
        *(unsigned*)(Y + (size_t)(NP + row) * DH + col) = pk2(bflo(z) * fsigmoid(v[0][0] + bglu[col]), bfhi(z) * fsigmoid(v[0][1] + bglu[col + 1])); } };

struct SkFinalNorm { const float* xin; float* out; const float* mod; int gi; float gscale; const float* gfin; float* xbuf; unsigned* cnt;
    __device__ __forceinline__ int brow(int ct, int) const { return 32 * ct; }
    __device__ __forceinline__ void operator()(int row, int ct, int j0, const float (&v)[1][2]) const {
        const int col = 32 * ct + j0, rt = row >> 5, lane = threadIdx.x & 63; const float* gate = mod + (4 + (row >> 5)) * NMOD + gi * DM + col;
        const f32x2 x = *(const f32x2*)(xin + (size_t)row * DM + col), g = *(const f32x2*)gate;
        f32x2 o; o.x = x.x + gscale * (1.f + g.x) * v[0][0]; o.y = x.y + gscale * (1.f + g.y) * v[0][1];
        float ss = o.x * o.x + o.y * o.y;
        ss += __shfl_xor(ss, 1); ss += __shfl_xor(ss, 2); ss += __shfl_xor(ss, 4); ss += __shfl_xor(ss, 8);
        if ((lane & 15) == 0) __hip_atomic_store(xbuf + (size_t)row * 32 + ct, ss, RLX_AGENT);
        asm volatile("s_waitcnt vmcnt(0)" ::: "memory");
        if (lane == 0) __hip_atomic_fetch_add(cnt + 64 * rt, 1u, RLX_AGENT);
        wait_count(cnt + 64 * rt, 256u);
        const float a = __hip_atomic_load(xbuf + (size_t)row * 32 + 2 * (lane & 15), RLX_AGENT), b = __hip_atomic_load(xbuf + (size_t)row * 32 + 2 * (lane & 15) + 1, RLX_AGENT);
        float q = a + b;
        q += __shfl_xor(q, 1); q += __shfl_xor(q, 2); q += __shfl_xor(q, 4); q += __shfl_xor(q, 8);
        const float rs = 1.0f / sqrtf(q * (1.0f / DM) + EPS);
        *(f32x2*)(out + (size_t)row * DM + col) = (f32x2){o.x * rs * gfin[col], o.y * rs * gfin[col + 1]}; } };
template <int NB, int KS, class Epi>
__device__ __forceinline__ void skinny_gemm(Frame& F, const bf16* A, const bf16* Bt, int ntc, const Epi& E, int first_cu = 0) {
    constexpr int K = KS * 128;
    const int lane = F.lane, wave = F.wave, r32 = lane & 31, hi = lane >> 5, tid = F.tid;
    LAS float* red = (LAS float*)F.lds;
    if ((int)blockIdx.x < first_cu) return;
    for (int tile = blockIdx.x - first_cu; tile < 8 * ntc; tile += F.G - first_cu) {
        const int rt = tile / ntc, ct = tile % ntc;
        f32x4 pf = (f32x4){0.f, 0.f, 0.f, 0.f}; E.pre(32 * rt + (tid >> 4), ct, 2 * (tid & 15), pf);
        const bf16* ap = A + (size_t)(32 * rt + r32) * K + wave * (K / 8) + 8 * hi;
        f32x16 acc[NB];
#pragma unroll
        for (int nb = 0; nb < NB; ++nb)
#pragma unroll
            for (int r = 0; r < 16; ++r) acc[nb][r] = 0.f;
        const bf16* bp0 = Bt + (size_t)(E.brow(ct, 0) + r32) * K + wave * (K / 8) + 8 * hi;
        const bf16* bp1 = Bt + (size_t)(E.brow(ct, NB - 1) + r32) * K + wave * (K / 8) + 8 * hi;
        constexpr int SB = (KS % 11 == 0) ? 11 : KS;
#pragma unroll 1
        for (int s0 = 0; s0 < KS; s0 += SB) {
            bf16x8 af[SB], b0[SB], b1[SB];
#pragma unroll
            for (int s = 0; s < SB; ++s) { af[s] = *(const bf16x8*)(ap + 16 * (s0 + s)); b0[s] = *(const bf16x8*)(bp0 + 16 * (s0 + s)); if (NB == 2) b1[s] = *(const bf16x8*)(bp1 + 16 * (s0 + s)); }
#pragma unroll
            for (int s = 0; s < SB; ++s) {
                acc[0] = __builtin_amdgcn_mfma_f32_32x32x16_bf16(af[s], b0[s], acc[0], 0, 0, 0);
                if (NB == 2) acc[NB - 1] = __builtin_amdgcn_mfma_f32_32x32x16_bf16(af[s], b1[s], acc[NB - 1], 0, 0, 0);
            }
        }
#pragma unroll
        for (int nb = 0; nb < NB; ++nb)
#pragma unroll
            for (int r = 0; r < 16; ++r) red[((wave * NB + nb) * 32 + (r & 3) + 8 * (r >> 2) + 4 * hi) * 32 + r32] = acc[nb][r];
        __syncthreads();
        {
            const int i = tid >> 4, j0 = 2 * (tid & 15);
            float v[NB][2];
#pragma unroll
            for (int nb = 0; nb < NB; ++nb) { v[nb][0] = 0.f; v[nb][1] = 0.f;
#pragma unroll
                for (int w = 0; w < 8; ++w) { const f32x2 x = *(const LAS f32x2*)(red + ((w * NB + nb) * 32 + i) * 32 + j0); v[nb][0] += x.x; v[nb][1] += x.y; } }
            E(32 * rt + i, ct, j0, v, pf);
        }
        __syncthreads();
    }
}

constexpr int N_PHASES_K = 15;

__global__ void __launch_bounds__(512, 2) mk_fwd(Args args) {
    extern __shared__ __attribute__((aligned(16))) unsigned char lds_raw[];
    cg::grid_group grid = cg::this_grid();
    Frame F;
    F.lds = (LAS unsigned char*)lds_raw;
    F.tid = threadIdx.x; F.lane = F.tid & 63; F.wave = __builtin_amdgcn_readfirstlane(F.tid >> 6);
    F.G = gridDim.x; { const int bx = blockIdx.x; F.vcu = (F.G % 8 == 0) ? (bx % 8) * (F.G / 8) + bx / 8 : bx; }
    F.gw = blockIdx.x * NWAVES + F.wave; F.NGW = F.G * NWAVES;
#pragma unroll
    for (int i = 0; i < 34; ++i) F.in[i] = args.in[i];
    F.out = args.out;
    unsigned char* ws = args.ws;
    F.mod = (float*)(ws + WS_MOD);
    F.abar = (f32x2*)(ws + WS_S5C); F.a64 = (f32x2*)(ws + WS_S5C + 16384); F.bbar = (f32x2*)(ws + WS_S5C + 32768); F.cmt = (bf16*)(ws + WS_S5C + 294912); F.bmh = (bf16*)(ws + WS_S5C + 425984);
    F.F2P = (float*)(ws + WS_F2P); F.F2S = (float*)(ws + WS_F2S); F.E = (f32x2*)(ws + WS_E);
    F.WUP1 = (bf16*)(ws + WS_WUP1); F.WDN1 = (bf16*)(ws + WS_WDN1); F.WIN = (bf16*)(ws + WS_WIN); F.WGLU = (bf16*)(ws + WS_WGLU); F.WOUT = (bf16*)(ws + WS_WOUT);
    F.WUP2 = (bf16*)(ws + WS_WUP2); F.WDN2 = (bf16*)(ws + WS_WDN2); F.HA = (bf16*)(ws + WS_HA); F.HID = (bf16*)(ws + WS_HID);
    F.U = (bf16*)(ws + WS_U); F.Q = (bf16*)(ws + WS_Q); F.KB = (bf16*)(ws + WS_KB); F.VB = (bf16*)(ws + WS_VB); F.Z = (bf16*)(ws + WS_Z); F.O = (bf16*)(ws + WS_O); F.PB = (float*)(ws + WS_PB);
    const int lo = args.ph_lo, hi = args.ph_hi;
    volatile LAS unsigned* misc = (volatile LAS unsigned*)(F.lds + LDS_BYTES - 256);
    if (F.tid < 2) misc[F.tid] = 0u;
    __syncthreads();
    XcdBarrier xbar; xbar.bar = (unsigned*)(ws + WS_BAR); xbar.x = 0; xbar.st = nullptr;
    if (hi - lo > 1) xbar = xcd_barrier_post((unsigned*)(ws + WS_BAR), misc);
#define IN(k) (lo <= (k) && (k) < hi)
#define REPS(k) _Pragma("nounroll") for (int rep_ = 0; rep_ < 1 + ((MK_REP_MASK >> (k)) & 1); ++rep_)
#define SEAM(k) do { if (IN(k) && IN((k) + 1)) { if ((k) == 100) grid.sync(); else xcd_barrier(xbar); } } while (0)
    typedef pg8::StaticOrder SO;
    float* xs_out = F.out + (size_t)NP * DM;

    if (hi > 1000) grid.sync();
    unsigned* sw = (unsigned*)(ws + WS_BAR) + 3840;
    const bool one_launch = false;
    const bool one_s5 = false;
    if (IN(0)) { phase_ada(F); if (one_launch) seam_arrive(sw); phase_s5const(F); phase_weights(F); }
    if (!one_launch) SEAM(0);
    if (IN(1)) { if (one_launch) seam_wait(sw, (unsigned)F.G); phase_norm<false>(F, F.in[0], F.in[1], F.in[11], 0, 1); }
    SEAM(1);
    if (IN(2)) REPS(2) { pg8::Gemm g{F.HA, F.WUP1, MT, NUP, DM}; SO S; S.init(MT, NUP, F.G, (int)blockIdx.x); EpiSwiglu E{F.HID};
        pg8::gemm_phase<EpiSwiglu, SO, PG8_ALIGN, PG8_SP2>(F.lds, g, S, E);
    }
    SEAM(2);
    if (IN(3)) REPS(3) { pg8::Gemm g{F.HID, F.WDN1, NP, DM, FF}; SO S; S.init(NP, DM, F.G, (int)blockIdx.x); EpiResid E{F.in[0], F.in[1], F.out, F.mod, 2, 0.5f};
        pg8::gemm_phase<EpiResid, SO, PG8_ALIGN, PG8_SP2>(F.lds, g, S, E);
        skinny_gemm<1, 22>(F, F.HID + (size_t)NP * FF, F.WDN1, 32, SkResid{F.in[1], xs_out, F.mod, 2, 0.5f});
    }
    SEAM(3);
    if (IN(4)) REPS(4) phase_norm<true>(F, F.out, xs_out, F.in[14], 3, 4);
    SEAM(4);
    if (IN(5)) REPS(5) { phase_fcum(F);
        pg8::Gemm g{F.HA, F.WIN, NP, 2048, DM}; SO S; S.init(NP, 2048, F.G, (int)blockIdx.x); EpiIn E{F.U, F.Q, F.KB, F.VB, F.out};
        pg8::gemm_phase<EpiIn, SO, PG8_ALIGN, PG8_SP2>(F.lds, g, S, E);
        skinny_gemm<1, 8>(F, F.HA + (size_t)NP * DM, F.WIN, 64, SkIn{F.U, F.Q, F.KB, F.VB, F.out});
    }
    SEAM(5);
    if (IN(6)) {
        if (one_s5) { s5_pass_a(F); seam_arrive(sw + 64); }
        for (int j = F.vcu; j < 256; j += F.G) attn_sample_unit(F, j >> 5, (j >> 2) & 7, j & 3);
        for (int uix_ = F.vcu; uix_ < 256 * (1 + ((MK_REP_MASK >> 6) & 1)); uix_ += F.G) {
            const int uix = uix_ & 255, bh = uix >> 3, s = uix & 7;
            attn_prompt_unit(F, bh >> 3, bh & 7, 15 - s);
            attn_prompt_unit(F, bh >> 3, bh & 7, s);
        }
        if (!one_s5) s5_pass_a(F);
        __syncthreads();
    }
    if (!one_s5) SEAM(6);
    if (IN(7)) { if (one_s5) seam_wait(sw + 64, (unsigned)F.G); s5_pass_c(F); }
    SEAM(7);
    if (IN(8)) REPS(8) { pg8::Gemm g{F.Z, F.WGLU, MT, DH, DH}; SO S; S.init(MT, DH, F.G, (int)blockIdx.x); EpiGlu E{F.Z, F.U, F.in[26]};
        pg8::gemm_phase<EpiGlu, SO, PG8_ALIGN, PG8_SP2>(F.lds, g, S, E);
        const bool half_idle = (F.G == 256);
        if (half_idle && blockIdx.x >= 130) { phase_mixnorm(F, 2, ((int)blockIdx.x - 130) * NWAVES + F.wave, 126 * NWAVES); }
    }
    SEAM(8);
    if (IN(9)) phase_mixnorm(F, F.G == 256 ? 1 : 3, 0, 0);
    SEAM(9);
    if (IN(10)) REPS(10) { pg8::Gemm g{F.HA, F.WOUT, NP, DM, DM}; SO S; S.init(NP, DM, F.G, (int)blockIdx.x); EpiResid E{F.out, xs_out, F.out, F.mod, 5, 1.0f};
        pg8::gemm_phase<EpiResid, SO, PG8_ALIGN, PG8_SP2>(F.lds, g, S, E);
        skinny_gemm<1, 8>(F, F.HA + (size_t)NP * DM, F.WOUT, 32, SkResid{xs_out, xs_out, F.mod, 5, 1.0f}); }
    SEAM(10);
    if (IN(11)) REPS(11) phase_norm<false>(F, F.out, xs_out, F.in[30], 6, 7);
    SEAM(11);
    if (IN(12)) REPS(12) { pg8::Gemm g{F.HA, F.WUP2, MT, NUP, DM}; SO S; S.init(MT, NUP, F.G, (int)blockIdx.x); EpiSwiglu E{F.HID};
        pg8::gemm_phase<EpiSwiglu, SO, PG8_ALIGN, PG8_SP2>(F.lds, g, S, E);
    }
    SEAM(12);
    if (IN(13)) { pg8::Gemm g{F.HID, F.WDN2, NP, DM, FF}; SO S; S.init(NP, DM, F.G, (int)blockIdx.x); EpiResid E{F.out, xs_out, F.out, F.mod, 8, 0.5f};
        pg8::gemm_phase<EpiResid, SO, PG8_ALIGN, PG8_SP2>(F.lds, g, S, E);
        skinny_gemm<1, 22>(F, F.HID + (size_t)NP * FF, F.WDN2, 32, SkResid{xs_out, xs_out, F.mod, 8, 0.5f}); }
    SEAM(13);
    if (IN(14)) phase_finalnorm(F);
#undef IN
#undef SEAM
}
constexpr int N_PHASES = 15;
static_assert(N_PHASES == N_PHASES_K, "phase count");

#ifndef MK_MULTI
#define MK_MULTI 0
#endif
extern "C" void kernel_launch(void* const* d_in, const int* in_sizes, int n_in, void* d_out, int out_size, void* d_ws, size_t ws_size, hipStream_t stream) {
    static int grid = 0;
    if (grid == 0) {
        int dev = 0, cus = 0, per_cu = 0;
        if (hipGetDevice(&dev) != hipSuccess || hipDeviceGetAttribute(&cus, hipDeviceAttributeMultiprocessorCount, dev) != hipSuccess) { fprintf(stderr, "kernel_launch: device query failed\n"); grid = -1; return; }
        if (hipFuncSetAttribute((const void*)mk_fwd, hipFuncAttributeMaxDynamicSharedMemorySize, LDS_BYTES) != hipSuccess) { fprintf(stderr, "kernel_launch: hipFuncSetAttribute failed\n"); grid = -1; return; }
        if (hipOccupancyMaxActiveBlocksPerMultiprocessor(&per_cu, (const void*)mk_fwd, NWAVES * 64, LDS_BYTES) != hipSuccess || per_cu < 1) per_cu = 1;
        (void)hipGetLastError();
        grid = cus;
        if (n_in != 34 || ws_size < 176 * MiB) fprintf(stderr, "kernel_launch: unexpected n_in %d / ws %zu\n", n_in, ws_size);
    }
    if (grid < 0) return;
    if (hipMemsetAsync((char*)d_ws + WS_BAR, 0, CTL_BYTES, stream) != hipSuccess) { fprintf(stderr, "kernel_launch: memset failed\n"); return; }
    Args a{};
    for (int i = 0; i < 34; ++i) a.in[i] = (const float*)d_in[i];
    a.out = (float*)d_out; a.ws = (unsigned char*)d_ws;
#if MK_MULTI
    for (int p = 0; p < N_PHASES; ++p) { a.ph_lo = p; a.ph_hi = p + 1; hipLaunchKernelGGL(mk_fwd, dim3(grid), dim3(NWAVES * 64), LDS_BYTES, stream, a); }
#else
    a.ph_lo = 0; a.ph_hi = N_PHASES;
    void* kargs[] = {&a};
    const hipError_t e = hipLaunchCooperativeKernel((const void*)mk_fwd, dim3(grid), dim3(NWAVES * 64), kargs, LDS_BYTES, stream);
    if (e != hipSuccess) fprintf(stderr, "kernel_launch: cooperative launch failed: %s (grid %d)\n", hipGetErrorString(e), grid);
#endif
}
```

```cpp
#include <hip/hip_runtime.h>
#include <hip/hip_cooperative_groups.h>
#include <cstdio>
#include <cstdint>
namespace cg = cooperative_groups;
namespace pg8 {
#define PG8_LAS __attribute__((address_space(3)))
typedef unsigned short bf16_t;
typedef short bf16x8 __attribute__((ext_vector_type(8)));
typedef float f32x4 __attribute__((ext_vector_type(4)));
typedef unsigned u32x4 __attribute__((ext_vector_type(4)));
constexpr int BM = 256, BK = 64, HALF = 128, HTB = HALF * BK * 2  , STAGE_BYTES = 8 * HTB, NXCD = 8, WGM = 8;

__host__ __device__ __forceinline__ int lds_byte(int r, int c) { const int st = (r >> 4) * 2 + (c >> 5), rr = r & 15, cc = c & 31, ob = rr * 64 + cc * 2; return st * 1024 + (ob ^ (((ob >> 9) & 1) << 5)); }
__host__ __device__ __forceinline__ void stage_rc(int b, int& R, int& C) { const int st = b / 1024, sb = b % 1024, swz = sb ^ (((sb >> 9) & 1) << 5); R = (st >> 1) * 16 + swz / 64; C = (st & 1) * 32 + (swz % 64) / 2; }
__host__ __device__ __forceinline__ int perm32(int rho) { const int n = rho >> 4, i = rho & 15; return 8 * (i >> 2) + 4 * n + (i & 3); }

struct Unit { int pm, pn; };
struct Gemm { const bf16_t* A; const bf16_t* Bt; int M, N, K; };

struct StaticOrder {
    int nM, nN, nwg, G, c;
    __host__ __device__ void init(int M, int N, int G_, int c_) { nM = M / BM; nN = N / BM; nwg = nM * nN; G = G_; c = c_; }
    __host__ __device__ bool next(int i, Unit& u) const {
        const long L = (long)i * G + c; if (L >= nwg) return false;
        int wgid = (int)L; { const int q = nwg / NXCD, r = nwg % NXCD, xcd = wgid % NXCD, off = wgid / NXCD; wgid = (xcd < r ? xcd * (q + 1) : r * (q + 1) + (xcd - r) * q) + off; }
        const int nig = WGM * nN, gid = wgid / nig, fm = gid * WGM, gsz = (nM - fm) < WGM ? (nM - fm) : WGM;
        u.pm = fm + ((wgid % nig) % gsz); u.pn = (wgid % nig) / gsz; return true;
    }
    __device__ __forceinline__ void a_ready(const Unit&) const {}
    __device__ __forceinline__ void done(const Unit&) const {}
};

__device__ __forceinline__ unsigned cvt_pk_bf16(float lo, float hi) { unsigned r; asm volatile("v_cvt_pk_bf16_f32 %0, %1, %2" : "=v"(r) : "v"(lo), "v"(hi)); return r; }
typedef float f32x2 __attribute__((ext_vector_type(2)));
__device__ __forceinline__ f32x2 gelu_pk(f32x2 v) {
    const f32x2 av = __builtin_elementwise_abs(v), d = av * 0.2316418882f + 1.0f;
    f32x2 t; t.x = __builtin_amdgcn_rcpf(d.x); t.y = __builtin_amdgcn_rcpf(d.y);
    f32x2 q = t * 0.5307027145f + (-0.7265760135f); q = q * t + 0.7107068705f; q = q * t + (-0.142248368f); q = q * t + 0.127414796f; q = q * t;
    const f32x2 s = (v * v) * (-0.72134752044f);
    f32x2 e; e.x = __builtin_amdgcn_exp2f(s.x); e.y = __builtin_amdgcn_exp2f(s.y);
    const f32x2 m = v * (q * e), r = v - m;
    f32x2 o; o.x = v.x < 0.f ? m.x : r.x; o.y = v.y < 0.f ? m.y : r.y; return o;
}

template <int ACT  > struct EpiBf16 {
    static constexpr bool PERM = true, AFTER_DRAIN = false; static_assert(ACT == 0 || ACT == 1, "EpiBf16: ACT is 0 (none) or 1 (gelu_pk)");
    bf16_t* O; int ldc; const float* bias; int split_cols; size_t split_stride; float scale0;
    __device__ __forceinline__ void operator()(const f32x4 (&acc)[2][2][4][2], const Unit& u, int wr, int wc, int fr, int fq) const {
        const int row0 = u.pm * BM + wr * 64 + fr; int colt = u.pn * BM; bf16_t* base = O;
        float sc = 1.f; if (split_cols) { const int t = colt / split_cols; base += (size_t)t * split_stride; colt -= t * split_cols; if (t == 0) sc = scale0; }
        const int col0 = colt + wc * 32 + 8 * fq, bcol0 = u.pn * BM + wc * 32 + 8 * fq;
        f32x4 bv[2][2];
#pragma unroll
        for (int bj = 0; bj < 2; ++bj)
#pragma unroll
            for (int n = 0; n < 2; ++n) bv[bj][n] = bias ? *(const f32x4*)(bias + bcol0 + bj * HALF + 4 * n) : (f32x4){0.f, 0.f, 0.f, 0.f};
#pragma unroll
        for (int ai = 0; ai < 2; ++ai)
#pragma unroll
            for (int m = 0; m < 4; ++m) { bf16_t* rowp = base + (size_t)(row0 + ai * HALF + m * 16) * ldc + col0;
#pragma unroll
                for (int bj = 0; bj < 2; ++bj) { f32x4 v0 = acc[ai][bj][m][0] + bv[bj][0], v1 = acc[ai][bj][m][1] + bv[bj][1];
                    if (ACT == 1) { f32x2 a = gelu_pk((f32x2){v0[0], v0[1]}), b = gelu_pk((f32x2){v0[2], v0[3]}), c = gelu_pk((f32x2){v1[0], v1[1]}), d = gelu_pk((f32x2){v1[2], v1[3]});
                        v0 = (f32x4){a.x, a.y, b.x, b.y}; v1 = (f32x4){c.x, c.y, d.x, d.y}; }
                    v0 = v0 * sc; v1 = v1 * sc; u32x4 w; w.x = cvt_pk_bf16(v0[0], v0[1]); w.y = cvt_pk_bf16(v0[2], v0[3]); w.z = cvt_pk_bf16(v1[0], v1[1]); w.w = cvt_pk_bf16(v1[2], v1[3]);
                    *(u32x4*)(rowp + bj * HALF) = w; } }
    }
};


template <class Epi, class Sched, bool ALIGN_EPI = false, bool SP2 = false>
__device__ __forceinline__ void gemm_phase(PG8_LAS unsigned char* lds, const Gemm g, const Sched& S, const Epi& E) {
    const int tid = threadIdx.x, wid = __builtin_amdgcn_readfirstlane(tid >> 6), lane = tid & 63, wr = wid >> 2, wc = wid & 3, fr = lane & 15, fq = lane >> 4;
    const int K = g.K, nt = K / BK;
    unsigned voffA[2], voffB[2];
#pragma unroll
    for (int i = 0; i < 2; ++i) { int R, C; stage_rc(tid * 16 + i * 8192, R, C); const int Rb = Epi::PERM ? ((R & ~31) + perm32(R & 31)) : R;
        voffA[i] = (unsigned)(R * K + C) * 2u; voffB[i] = (unsigned)(Rb * K + C) * 2u; }
    const size_t kstep = (size_t)(BK * 2);
    const size_t hstep = (size_t)HALF * K * 2;
    const size_t tstep = 2 * hstep;
    const unsigned ldsw = (unsigned)wid * 1024u;
    const int aoff = lds_byte(wr * 64 + fr, fq * 8), boff = lds_byte(wc * 32 + fr, fq * 8);
#define PG8_SA(b, h) (((b) * 2 + (h)) * HTB)
#define PG8_SB(b, h) ((4 + (b) * 2 + (h)) * HTB)
#define PG8_STAGE(bufoff, gbase, voff) do { _Pragma("unroll") for (int _i = 0; _i < 2; ++_i) \
        __builtin_amdgcn_global_load_lds((const unsigned*)((const char*)(gbase) + (voff)[_i]), (PG8_LAS unsigned*)(lds + (bufoff) + ldsw + _i * 8192), 16, 0, 0); } while (0)
#define PG8_LDA(dst, b, h) do { _Pragma("unroll") for (int m = 0; m < 4; ++m) _Pragma("unroll") for (int k = 0; k < 2; ++k) dst[m][k] = *(const PG8_LAS bf16x8*)(lds + PG8_SA(b, h) + aoff + m * 2048 + k * 1024); } while (0)
#define PG8_LDB(dst, b, h) do { _Pragma("unroll") for (int n = 0; n < 2; ++n) _Pragma("unroll") for (int k = 0; k < 2; ++k) dst[n][k] = *(const PG8_LAS bf16x8*)(lds + PG8_SB(b, h) + boff + n * 2048 + k * 1024); } while (0)
#define PG8_MMA(ai, bj, At, Bt) do { __builtin_amdgcn_s_setprio(1); _Pragma("unroll") for (int m = 0; m < 4; ++m) _Pragma("unroll") for (int n = 0; n < 2; ++n) _Pragma("unroll") for (int k = 0; k < 2; ++k) \
        acc[ai][bj][m][n] = __builtin_amdgcn_mfma_f32_16x16x32_bf16(Bt[n][k], At[m][k], acc[ai][bj][m][n], 0, 0, 0); __builtin_amdgcn_s_setprio(0); } while (0)
#define PG8_WAIT_V(n) asm volatile("s_waitcnt vmcnt(" #n ")" ::: "memory")
#define PG8_WAIT_L(n) asm volatile("s_waitcnt lgkmcnt(" #n ")" ::: "memory")
#define PG8_BAR __builtin_amdgcn_s_barrier()
#define PG8_SCHED __builtin_amdgcn_sched_barrier(0)
    Unit cur, nxt; int ui = 0;
    if (!S.next(0, cur)) return;
    f32x4 acc[2][2][4][2];
#pragma unroll
    for (int a = 0; a < 2; ++a)
#pragma unroll
        for (int b = 0; b < 2; ++b)
#pragma unroll
            for (int m = 0; m < 4; ++m)
#pragma unroll
                for (int n = 0; n < 2; ++n) acc[a][b][m][n] = (f32x4){0.f, 0.f, 0.f, 0.f};
    bf16x8 At[4][2], B0[2][2], B1[2][2];
    const char* cA = (const char*)g.A + (size_t)cur.pm * tstep; const char* cB = (const char*)g.Bt + (size_t)cur.pn * tstep;
    S.a_ready(cur);
    if constexpr (SP2) {
        PG8_STAGE(PG8_SB(0, 0), cB, voffB); PG8_STAGE(PG8_SB(0, 1), cB + hstep, voffB); PG8_STAGE(PG8_SA(0, 0), cA, voffA); PG8_STAGE(PG8_SA(0, 1), cA + hstep, voffA);
        if (wr == 1) PG8_BAR;
        PG8_WAIT_V(2); PG8_BAR;
        PG8_STAGE(PG8_SB(1, 0), cB + kstep, voffB); PG8_STAGE(PG8_SA(1, 0), cA + kstep, voffA); PG8_STAGE(PG8_SB(1, 1), cB + hstep + kstep, voffB);
        PG8_WAIT_V(6); PG8_BAR;
    } else {
        PG8_STAGE(PG8_SB(0, 0), cB, voffB); PG8_STAGE(PG8_SA(0, 0), cA, voffA); PG8_STAGE(PG8_SB(0, 1), cB + hstep, voffB); PG8_STAGE(PG8_SA(0, 1), cA + hstep, voffA);
        if (wr == 1) PG8_BAR;
        PG8_WAIT_V(4); PG8_BAR;
        PG8_STAGE(PG8_SB(1, 0), cB + kstep, voffB); PG8_STAGE(PG8_SA(1, 0), cA + kstep, voffA); PG8_STAGE(PG8_SB(1, 1), cB + hstep + kstep, voffB);
        PG8_WAIT_V(6); PG8_BAR;
    }
    for (;;) {
        const bool has_next = S.next(ui + 1, nxt);
        const char* nA = has_next ? (const char*)g.A + (size_t)nxt.pm * tstep : cA; const char* nB = has_next ? (const char*)g.Bt + (size_t)nxt.pn * tstep : cB;
        for (int t = 0; t < nt; t += 2) {
            const bool last = (t == nt - 2);
            const char* a1 = cA + (size_t)(t + 1) * kstep;
            const char* a2 = last ? nA : cA + (size_t)(t + 2) * kstep; const char* b2 = last ? nB : cB + (size_t)(t + 2) * kstep;
            const char* a3 = a2 + kstep; const char* b3 = b2 + kstep;
            if (last && has_next) S.a_ready(nxt);
            if constexpr (SP2) {
            PG8_LDB(B0, 0, 0); PG8_LDB(B1, 0, 1); PG8_SCHED; PG8_LDA(At, 0, 0); PG8_STAGE(PG8_SA(1, 1), a1 + hstep, voffA);
            PG8_WAIT_V(8); PG8_WAIT_L(0); PG8_BAR; PG8_MMA(0, 0, At, B0); PG8_MMA(0, 1, At, B1); PG8_BAR; PG8_SCHED;
            PG8_LDA(At, 0, 1); PG8_STAGE(PG8_SB(0, 0), b2, voffB); PG8_STAGE(PG8_SB(0, 1), b2 + hstep, voffB); PG8_STAGE(PG8_SA(0, 0), a2, voffA);
            PG8_WAIT_V(8); PG8_WAIT_L(0); PG8_BAR; PG8_MMA(1, 0, At, B0); PG8_MMA(1, 1, At, B1); PG8_BAR; PG8_SCHED;
            PG8_LDB(B0, 1, 0); PG8_LDB(B1, 1, 1); PG8_SCHED; PG8_LDA(At, 1, 0); PG8_STAGE(PG8_SA(0, 1), a2 + hstep, voffA);
            PG8_WAIT_V(8); PG8_WAIT_L(0); PG8_BAR; PG8_MMA(0, 0, At, B0); PG8_MMA(0, 1, At, B1); PG8_BAR; PG8_SCHED;
            PG8_LDA(At, 1, 1); PG8_STAGE(PG8_SB(1, 0), b3, voffB); PG8_STAGE(PG8_SB(1, 1), b3 + hstep, voffB); PG8_STAGE(PG8_SA(1, 0), a3, voffA);
            PG8_WAIT_V(8); PG8_WAIT_L(0); PG8_BAR; PG8_MMA(1, 0, At, B0); PG8_MMA(1, 1, At, B1); PG8_BAR; PG8_SCHED;
            } else {
            PG8_LDB(B0, 0, 0); PG8_SCHED; PG8_LDA(At, 0, 0); PG8_STAGE(PG8_SA(1, 1), a1 + hstep, voffA);
            PG8_WAIT_L(8); PG8_BAR; PG8_WAIT_L(0); PG8_MMA(0, 0, At, B0); PG8_BAR; PG8_SCHED;
            PG8_LDB(B1, 0, 1); PG8_STAGE(PG8_SB(0, 0), b2, voffB);
            PG8_BAR; PG8_WAIT_L(0); PG8_MMA(0, 1, At, B1); PG8_BAR;
            PG8_LDA(At, 0, 1); PG8_STAGE(PG8_SA(0, 0), a2, voffA);
            PG8_BAR; PG8_WAIT_L(0); PG8_MMA(1, 0, At, B0); PG8_BAR; PG8_SCHED;
            PG8_STAGE(PG8_SB(0, 1), b2 + hstep, voffB);
            PG8_WAIT_V(6); PG8_BAR; PG8_MMA(1, 1, At, B1); PG8_BAR;
            PG8_LDB(B0, 1, 0); PG8_SCHED; PG8_LDA(At, 1, 0); PG8_STAGE(PG8_SA(0, 1), a2 + hstep, voffA);
            PG8_WAIT_L(8); PG8_BAR; PG8_WAIT_L(0); PG8_MMA(0, 0, At, B0); PG8_BAR; PG8_SCHED;
            PG8_LDB(B1, 1, 1); PG8_STAGE(PG8_SB(1, 0), b3, voffB);
            PG8_BAR; PG8_WAIT_L(0); PG8_MMA(0, 1, At, B1); PG8_BAR;
            PG8_LDA(At, 1, 1); PG8_STAGE(PG8_SA(1, 0), a3, voffA);
            PG8_BAR; PG8_WAIT_L(0); PG8_MMA(1, 0, At, B0); PG8_BAR; PG8_SCHED;
            PG8_STAGE(PG8_SB(1, 1), b3 + hstep, voffB);
            PG8_WAIT_V(6); PG8_BAR; PG8_MMA(1, 1, At, B1); PG8_BAR;
            }
        }
        if constexpr (ALIGN_EPI) { if (wr == 0) PG8_BAR; }
        if constexpr (!Epi::AFTER_DRAIN) { E(acc, cur, wr, wc, fr, fq); S.done(cur); }
        if (!has_next) break;
#pragma unroll
        for (int a = 0; a < 2; ++a)
#pragma unroll
            for (int b = 0; b < 2; ++b)
#pragma unroll
                for (int m = 0; m < 4; ++m)
#pragma unroll
                    for (int n = 0; n < 2; ++n) acc[a][b][m][n] = (f32x4){0.f, 0.f, 0.f, 0.f};
        cur = nxt; cA = nA; cB = nB; ++ui;
        if constexpr (ALIGN_EPI) { if (wr == 1) PG8_BAR; }
    }
    PG8_WAIT_V(0);
    if constexpr (!ALIGN_EPI) { if (wr == 0) PG8_BAR; }
    PG8_BAR;
    if constexpr (Epi::AFTER_DRAIN) { E.fused(acc, cur, wr, wc, fr, fq, lds, wid, lane); S.done(cur); }
#undef PG8_SA
#undef PG8_SB
#undef PG8_STAGE
#undef PG8_LDA
#undef PG8_LDB
#undef PG8_MMA
#undef PG8_WAIT_V
#undef PG8_WAIT_L
#undef PG8_BAR
#undef PG8_SCHED
}
}

#ifndef PG8_SP2
#define PG8_SP2 true
#endif
#ifndef PG8_ALIGN
#define PG8_ALIGN true
#endif
#define LAS __attribute__((address_space(3)))
typedef unsigned short bf16;
typedef short bf16x8 __attribute__((ext_vector_type(8)));
typedef short s16x4 __attribute__((ext_vector_type(4)));
typedef float f32x4 __attribute__((ext_vector_type(4)));
typedef float f32x2 __attribute__((ext_vector_type(2)));
typedef float f32x16 __attribute__((ext_vector_type(16)));
typedef unsigned u32x4 __attribute__((ext_vector_type(4)));
typedef unsigned u32x2 __attribute__((ext_vector_type(2)));

constexpr int NP = 16384, NS = 256, MT = NP + NS, DM = 1024, FF = 2816, NUP = 5632, DH = 512, NMOD = 9216, DIN = 2056;
constexpr float EPS = 1e-6f, LOG2E = 1.4426950408889634f, QSCALE = 0.125f * 1.4426950408889634f;
constexpr size_t O_KP = 17039360, O_VP = 25427968, O_LFP = 33816576, O_SRP = 33947648, O_SIP = 33955840, O_KS = 33964032, O_VS = 34095104,
                 O_LFS = 34226176, O_SRS = 34228224, O_SIS = 34244608;
constexpr size_t MiB = 1u << 20;
constexpr size_t WS_MOD = 0, WS_S5C = 1 * MiB, WS_F2P = 2 * MiB, WS_F2S = 2 * MiB + 512 * 1024, WS_E = 4 * MiB, WS_WUP1 = 10 * MiB, WS_WDN1 = 21 * MiB,
                 WS_WIN = 27 * MiB, WS_WGLU = 31 * MiB, WS_WOUT = 32 * MiB, WS_WUP2 = 34 * MiB, WS_WDN2 = 45 * MiB, WS_HA = 52 * MiB, WS_HID = 86 * MiB;
constexpr size_t WS_U = WS_HID, WS_Q = WS_HID + 17 * MiB, WS_KB = WS_HID + 34 * MiB, WS_VB = WS_HID + 51 * MiB, WS_Z = WS_HID + 68 * MiB;
constexpr size_t WS_O = 176 * MiB, WS_BAR = 512 * 1024, WS_PB = 194 * MiB, WS_CNT = 512 * 1024 + 16384, WS_XB = 198 * MiB;
constexpr int CTL_BYTES = 16384 + 6 * 64 * 256;
#ifndef MK_REP_MASK
#define MK_REP_MASK 0
#endif
constexpr int S5_ITEMS_PER_G = 264, S5_ITEMS = 32 * 264;
constexpr int LDS_BYTES = 155648;
constexpr int NWAVES = 8;

struct Args { const float* in[34]; float* out; unsigned char* ws; int ph_lo, ph_hi; };

struct Frame {
    LAS unsigned char* lds;
    int tid, lane, wave, G, vcu, gw, NGW;
    const float* in[34];
    float* out;
    float* mod; f32x2* abar; f32x2* a64; f32x2* bbar; bf16* cmt; bf16* bmh; float* F2P; float* F2S; f32x2* E;
    bf16 *WUP1, *WDN1, *WIN, *WGLU, *WOUT, *WUP2, *WDN2, *HA, *HID, *U, *Q, *KB, *VB, *Z, *O; float* PB;
};

__device__ __forceinline__ unsigned f2bf(float f) { unsigned u = __builtin_bit_cast(unsigned, f); return (u + 0x7fffu + ((u >> 16) & 1u)) >> 16; }
typedef __bf16 bf16x2_t __attribute__((ext_vector_type(2)));
__device__ __forceinline__ unsigned pk2(float lo, float hi) { const f32x2 v = {lo, hi}; const bf16x2_t b = __builtin_convertvector(v, bf16x2_t); return __builtin_bit_cast(unsigned, b); }
__device__ __forceinline__ float bflo(unsigned w) { return __uint_as_float(w << 16); }
__device__ __forceinline__ float bfhi(unsigned w) { return __uint_as_float(w & 0xffff0000u); }
__device__ __forceinline__ float wave_sum(float v) {
#pragma unroll
    for (int o = 1; o < 64; o <<= 1) v += __shfl_xor(v, o);
    return v;
}
__device__ __forceinline__ float fsigmoid(float x) { return __builtin_amdgcn_rcpf(1.f + __builtin_amdgcn_exp2f(-x * LOG2E)); }
__device__ __forceinline__ int bidx(int row) { return row < NP ? (row >> 12) : 4 + ((row - NP) >> 5); }
#define LDS_WAIT() asm volatile("s_waitcnt lgkmcnt(0)" ::: "memory")

using pg8::Unit;
struct EpiSwiglu {
    static constexpr bool PERM = true, AFTER_DRAIN = false;
    bf16* H;
    __device__ __forceinline__ void operator()(const f32x4 (&acc)[2][2][4][2], const Unit& u, int wr, int wc, int fr, int fq) const {
        const int row0 = u.pm * 256 + wr * 64 + fr, col0 = u.pn * 128 + wc * 32 + 8 * fq;
#pragma unroll
        for (int ai = 0; ai < 2; ++ai)
#pragma unroll
            for (int m = 0; m < 4; ++m) {
                const int row = row0 + ai * 128 + m * 16;
                u32x4 w; unsigned ww[4];
#pragma unroll
                for (int n = 0; n < 2; ++n) {
                    const f32x4 g = acc[ai][0][m][n], up = acc[ai][1][m][n];
                    const f32x4 t = g * (-LOG2E);
                    f32x4 d; d[0] = __builtin_amdgcn_exp2f(t[0]); d[1] = __builtin_amdgcn_exp2f(t[1]); d[2] = __builtin_amdgcn_exp2f(t[2]); d[3] = __builtin_amdgcn_exp2f(t[3]);
                    d = d + 1.0f;
                    f32x4 rc; rc[0] = __builtin_amdgcn_rcpf(d[0]); rc[1] = __builtin_amdgcn_rcpf(d[1]); rc[2] = __builtin_amdgcn_rcpf(d[2]); rc[3] = __builtin_amdgcn_rcpf(d[3]);
                    const f32x4 r = (g * up) * rc;
                    ww[2 * n] = pk2(r[0], r[1]); ww[2 * n + 1] = pk2(r[2], r[3]);
                }
                w.x = ww[0]; w.y = ww[1]; w.z = ww[2]; w.w = ww[3];
                *(u32x4*)(H + (size_t)row * FF + col0) = w;
            }
    }
};
struct EpiResid {
    static constexpr bool PERM = true, AFTER_DRAIN = false;
    const float* xp; const float* xs; float* out; const float* mod; int gi; float gscale;
    __device__ __forceinline__ void operator()(const f32x4 (&acc)[2][2][4][2], const Unit& u, int wr, int wc, int fr, int fq) const {
        const int row0 = u.pm * 256 + wr * 64 + fr, col0 = u.pn * 256 + wc * 32 + 8 * fq;
#pragma unroll
        for (int ai = 0; ai < 2; ++ai) {
            f32x4 xv[4][2][2];
#pragma unroll
            for (int m = 0; m < 4; ++m) {
                const int row = row0 + ai * 128 + m * 16;
                const float* xin = row < NP ? xp + (size_t)row * DM : xs + (size_t)(row - NP) * DM;
#pragma unroll
                for (int bj = 0; bj < 2; ++bj)
#pragma unroll
                    for (int n = 0; n < 2; ++n) xv[m][bj][n] = *(const f32x4*)(xin + col0 + bj * 128 + 4 * n);
            }
#pragma unroll
            for (int m = 0; m < 4; ++m) {
                const int row = row0 + ai * 128 + m * 16;
                const float* gate = mod + bidx(row) * NMOD + gi * DM;
                float* orow = out + (size_t)row * DM;
#pragma unroll
                for (int bj = 0; bj < 2; ++bj)
#pragma unroll
                    for (int n = 0; n < 2; ++n) {
                        const int col = col0 + bj * 128 + 4 * n;
                        const f32x4 g = *(const f32x4*)(gate + col);
                        *(f32x4*)(orow + col) = xv[m][bj][n] + (g + 1.0f) * gscale * acc[ai][bj][m][n];
                    }
            }
        }
    }
};
struct EpiIn {
    static constexpr bool PERM = true, AFTER_DRAIN = false;
    bf16 *U, *Q, *KB, *VB; float* out;
    __device__ __forceinline__ void operator()(const f32x4 (&acc)[2][2][4][2], const Unit& u, int wr, int wc, int fr, int fq) const {
        const int t = u.pn >> 1;
        const int row0 = u.pm * 256 + wr * 64 + fr, col0 = (u.pn & 1) * 256 + wc * 32 + 8 * fq;
        bf16* dst = t == 0 ? U : t == 1 ? Q : t == 2 ? KB : VB;
        const float sc = t == 1 ? QSCALE : 1.0f;
#pragma unroll
        for (int ai = 0; ai < 2; ++ai)
#pragma unroll
            for (int m = 0; m < 4; ++m) {
                const int row = row0 + ai * 128 + m * 16;
                float* fo = row < NP ? out + (t == 2 ? O_KP : O_VP) + (size_t)row * DH : out + (t == 2 ? O_KS : O_VS) + (size_t)(row - NP) * DH;
#pragma unroll
                for (int bj = 0; bj < 2; ++bj) {
                    const int col = col0 + bj * 128;
                    const f32x4 v0 = acc[ai][bj][m][0], v1 = acc[ai][bj][m][1];
                    u32x4 w; w.x = pk2(v0[0] * sc, v0[1] * sc); w.y = pk2(v0[2] * sc, v0[3] * sc); w.z = pk2(v1[0] * sc, v1[1] * sc); w.w = pk2(v1[2] * sc, v1[3] * sc);
                    *(u32x4*)(dst + (size_t)row * DH + col) = w;
                    if (t >= 2) { *(f32x4*)(fo + col) = v0; *(f32x4*)(fo + col + 4) = v1; }
                }
            }
    }
};
struct EpiGlu {
    static constexpr bool PERM = true, AFTER_DRAIN = false;
    const bf16* Z; bf16* Y; const float* bglu;
    __device__ __forceinline__ void operator()(const f32x4 (&acc)[2][2][4][2], const Unit& u, int wr, int wc, int fr, int fq) const {
        const int row0 = u.pm * 256 + wr * 64 + fr, col0 = u.pn * 256 + wc * 32 + 8 * fq;
#pragma unroll
        for (int bj = 0; bj < 2; ++bj) {
            const int col = col0 + bj * 128;
            const f32x4 b0 = *(const f32x4*)(bglu + col), b1 = *(const f32x4*)(bglu + col + 4);
            u32x4 zv[2][4];
#pragma unroll
            for (int ai = 0; ai < 2; ++ai)
#pragma unroll
                for (int m = 0; m < 4; ++m) zv[ai][m] = *(const u32x4*)(Z + (size_t)(row0 + ai * 128 + m * 16) * DH + col);
#pragma unroll
            for (int ai = 0; ai < 2; ++ai)
#pragma unroll
                for (int m = 0; m < 4; ++m) {
                    const int row = row0 + ai * 128 + m * 16;
                    const u32x4 z = zv[ai][m];
                    const f32x4 a0 = acc[ai][bj][m][0] + b0, a1 = acc[ai][bj][m][1] + b1;
                    u32x4 w;
                    w.x = pk2(bflo(z.x) * fsigmoid(a0[0]), bfhi(z.x) * fsigmoid(a0[1]));
                    w.y = pk2(bflo(z.y) * fsigmoid(a0[2]), bfhi(z.y) * fsigmoid(a0[3]));
                    w.z = pk2(bflo(z.z) * fsigmoid(a1[0]), bfhi(z.z) * fsigmoid(a1[1]));
                    w.w = pk2(bflo(z.w) * fsigmoid(a1[2]), bfhi(z.w) * fsigmoid(a1[3]));
                    *(u32x4*)(Y + (size_t)row * DH + col) = w;
                }
        }
    }
};

#define RLX_AGENT __ATOMIC_RELAXED, __HIP_MEMORY_SCOPE_AGENT
__device__ __forceinline__ void wait_count(unsigned* cnt, unsigned want) {
    const unsigned long long t0 = __builtin_amdgcn_s_memrealtime();
    for (;;) {
        if ((unsigned)__builtin_amdgcn_readfirstlane(__hip_atomic_load(cnt, RLX_AGENT)) >= want) break;
        if (__builtin_amdgcn_s_memrealtime() - t0 > 2000000ull) break;
        __builtin_amdgcn_s_sleep(2);
    }
    __builtin_amdgcn_fence(__ATOMIC_ACQUIRE, "agent");
}
struct PanelRms {
    float* xbuf;
    unsigned* cnt;
    __device__ __forceinline__ void run(const f32x4 (&v)[2][2][4][2], const Unit& u, int wr, int wc, int fr, int fq, LAS unsigned char* lds, int wid, int lane) const {
        LAS float* P = (LAS float*)lds; LAS float* S = (LAS float*)(lds + 4096);
#pragma unroll
        for (int ai = 0; ai < 2; ++ai)
#pragma unroll
            for (int m = 0; m < 4; ++m) {
                float s = 0.f;
#pragma unroll
                for (int bj = 0; bj < 2; ++bj)
#pragma unroll
                    for (int n = 0; n < 2; ++n) { const f32x4 x = v[ai][bj][m][n]; s += (x[0] * x[0] + x[1] * x[1]) + (x[2] * x[2] + x[3] * x[3]); }
                s += __shfl_xor(s, 16); s += __shfl_xor(s, 32);
                if (fq == 0) P[(ai * 128 + wr * 64 + m * 16 + fr) * 4 + wc] = s;
            }
        LDS_WAIT(); __builtin_amdgcn_s_barrier(); asm volatile("" ::: "memory");
        const int row = wid * 32 + (lane & 31);
        if (lane < 32) {
            const f32x4 a = *(const LAS f32x4*)(P + row * 4);
            __hip_atomic_store(xbuf + (size_t)(u.pm * 256 + row) * 4 + u.pn, (a[0] + a[1]) + (a[2] + a[3]), RLX_AGENT);
        }
        asm volatile("s_waitcnt vmcnt(0)" ::: "memory");
        if (lane == 0) __hip_atomic_fetch_add(cnt + 64 * u.pm, 1u, RLX_AGENT);
        if (wid == 0) wait_count(cnt + 64 * u.pm, 32u);
        asm volatile("s_waitcnt vmcnt(0) lgkmcnt(0)" ::: "memory"); __builtin_amdgcn_s_barrier(); asm volatile("" ::: "memory");
        if (lane < 32) {
            const float* slot = xbuf + (size_t)(u.pm * 256 + row) * 4; float q = 0.f;
#pragma unroll
            for (int t = 0; t < 4; ++t) q += __hip_atomic_load(slot + t, RLX_AGENT);
            S[row] = 1.0f / sqrtf(q * (1.0f / DM) + EPS);
        }
        LDS_WAIT(); __builtin_amdgcn_s_barrier(); asm volatile("" ::: "memory");
    }
};
struct EpiFinalNorm {
    static constexpr bool PERM = true, AFTER_DRAIN = true;
    const float* xin; float* out; const float* mod; int gi; float gscale; const float* gfin; PanelRms st;
    __device__ __forceinline__ void fused(f32x4 (&acc)[2][2][4][2], const Unit& u, int wr, int wc, int fr, int fq, LAS unsigned char* lds, int wid, int lane) const {
        const int row0 = u.pm * 256 + wr * 64 + fr, col0 = u.pn * 256 + wc * 32 + 8 * fq;
        const float* gate = mod + (u.pm >> 4) * NMOD + gi * DM;
#pragma unroll
        for (int ai = 0; ai < 2; ++ai)
#pragma unroll
            for (int m = 0; m < 4; ++m) {
                const float* xr = xin + (size_t)(row0 + ai * 128 + m * 16) * DM;
#pragma unroll
                for (int bj = 0; bj < 2; ++bj)
#pragma unroll
                    for (int n = 0; n < 2; ++n) { const int col = col0 + bj * 128 + 4 * n;
                        const f32x4 g = *(const f32x4*)(gate + col), x = *(const f32x4*)(xr + col);
                        acc[ai][bj][m][n] = x + (g + 1.0f) * gscale * acc[ai][bj][m][n]; }
                asm volatile("" : "+v"(acc[ai][0][m][0]), "+v"(acc[ai][0][m][1]), "+v"(acc[ai][1][m][0]), "+v"(acc[ai][1][m][1]));
                if (m & 1) asm volatile("" ::: "memory");
            }
        st.run(acc, u, wr, wc, fr, fq, lds, wid, lane);
        const LAS float* S = (const LAS float*)(lds + 4096);
#pragma unroll
        for (int ai = 0; ai < 2; ++ai)
#pragma unroll
            for (int m = 0; m < 4; ++m) {
                const float rs = S[ai * 128 + wr * 64 + m * 16 + fr];
                float* orow = out + (size_t)(row0 + ai * 128 + m * 16) * DM;
#pragma unroll
                for (int bj = 0; bj < 2; ++bj)
#pragma unroll
                    for (int n = 0; n < 2; ++n) { const int col = col0 + bj * 128 + 4 * n;
                        *(f32x4*)(orow + col) = acc[ai][bj][m][n] * rs * *(const f32x4*)(gfin + col); }
            }
    }
};

__device__ __forceinline__ void phase_ada(Frame& F) {
    LAS float* sm = (LAS float*)F.lds;
    LAS float* red = sm + 12288;
    const float* cp = F.in[2]; const float* cs = F.in[3]; const float* wada = F.in[9]; const float* bada = F.in[10];
    for (int i = F.tid; i < 12288; i += 512) { const int d = i / 12, bi = i % 12; const float c = bi < 4 ? cp[bi * DM + d] : cs[(bi - 4) * DM + d]; sm[i] = c * fsigmoid(c); }
    __syncthreads();
    for (int cb = blockIdx.x; cb < 256; cb += F.G) {
        const int ks = F.tid / 36, cl = F.tid % 36;
        float acc[12];
#pragma unroll
        for (int i = 0; i < 12; ++i) acc[i] = 0.f;
        if (F.tid < 504) {
            const float* wp = wada + (size_t)ks * NMOD + cb * 36 + cl;
            const int nd = (DM - ks + 13) / 14;
            for (int i0 = 0; i0 < nd; i0 += 16) {
                float w[16];
#pragma unroll
                for (int u = 0; u < 16; ++u) w[u] = (i0 + u < nd) ? __builtin_nontemporal_load(wp + (size_t)(i0 + u) * 14 * NMOD) : 0.f;
#pragma unroll
                for (int u = 0; u < 16; ++u) {
                    const int d = (i0 + u < nd) ? ks + 14 * (i0 + u) : 0;
                    const f32x4 s0 = *(const LAS f32x4*)(sm + d * 12), s1 = *(const LAS f32x4*)(sm + d * 12 + 4), s2 = *(const LAS f32x4*)(sm + d * 12 + 8);
                    acc[0] += w[u] * s0[0]; acc[1] += w[u] * s0[1]; acc[2] += w[u] * s0[2]; acc[3] += w[u] * s0[3];
                    acc[4] += w[u] * s1[0]; acc[5] += w[u] * s1[1]; acc[6] += w[u] * s1[2]; acc[7] += w[u] * s1[3];
                    acc[8] += w[u] * s2[0]; acc[9] += w[u] * s2[1]; acc[10] += w[u] * s2[2]; acc[11] += w[u] * s2[3];
                }
            }
#pragma unroll
            for (int i = 0; i < 12; ++i) red[(ks * 36 + cl) * 12 + i] = acc[i];
        }
        __syncthreads();
        if (F.tid < 432) {
            const int c2 = F.tid / 12, bi = F.tid % 12; float s = bada[cb * 36 + c2];
#pragma unroll
            for (int k = 0; k < 14; ++k) s += red[(k * 36 + c2) * 12 + bi];
            F.mod[bi * NMOD + cb * 36 + c2] = s;
        }
        __syncthreads();
    }
}
__device__ __forceinline__ void sincos_d(double x, double& s, double& c) {
    const double kf = __builtin_rint(x * 0.63661977236758134308);
    double r = __builtin_fma(-kf, 1.57079632679489655800e+00, x); r = __builtin_fma(-kf, 6.12323399573676603587e-17, r);
    const int k = ((int)kf) & 3; const double r2 = r * r;
    double sp = 1.0 / 6227020800.0; sp = __builtin_fma(sp, r2, -1.0 / 39916800.0); sp = __builtin_fma(sp, r2, 1.0 / 362880.0); sp = __builtin_fma(sp, r2, -1.0 / 5040.0);
    sp = __builtin_fma(sp, r2, 1.0 / 120.0); sp = __builtin_fma(sp, r2, -1.0 / 6.0); sp = __builtin_fma(sp, r2, 1.0); const double sr = sp * r;
    double cq = -1.0 / 87178291200.0; cq = __builtin_fma(cq, r2, 1.0 / 479001600.0); cq = __builtin_fma(cq, r2, -1.0 / 3628800.0); cq = __builtin_fma(cq, r2, 1.0 / 40320.0);
    cq = __builtin_fma(cq, r2, -1.0 / 720.0); cq = __builtin_fma(cq, r2, 1.0 / 24.0); cq = __builtin_fma(cq, r2, -0.5); const double cr = __builtin_fma(cq, r2, 1.0);
    s = (k == 0) ? sr : (k == 1) ? cr : (k == 2) ? -sr : -cr;
    c = (k == 0) ? cr : (k == 1) ? -sr : (k == 2) ? -cr : sr;
}
__device__ __forceinline__ double exp_d(double x) {
    const double n = __builtin_rint(x * 1.4426950408889634074);
    double r = __builtin_fma(-n, 6.93147180369123816490e-01, x); r = __builtin_fma(-n, 1.90821492927058770002e-10, r);
    double p = 1.0 / 6227020800.0;
    p = __builtin_fma(p, r, 1.0 / 479001600.0); p = __builtin_fma(p, r, 1.0 / 39916800.0); p = __builtin_fma(p, r, 1.0 / 3628800.0); p = __builtin_fma(p, r, 1.0 / 362880.0);
    p = __builtin_fma(p, r, 1.0 / 40320.0); p = __builtin_fma(p, r, 1.0 / 5040.0); p = __builtin_fma(p, r, 1.0 / 720.0); p = __builtin_fma(p, r, 1.0 / 120.0);
    p = __builtin_fma(p, r, 1.0 / 24.0); p = __builtin_fma(p, r, 1.0 / 6.0); p = __builtin_fma(p, r, 0.5); p = __builtin_fma(p, r, 1.0); p = __builtin_fma(p, r, 1.0);
    return __builtin_ldexp(p, (int)n);
}
__device__ __forceinline__ void phase_s5const(Frame& F) {
    if (F.tid >= 8) return;
    for (int id = blockIdx.x * 8 + F.tid; id < 2048; id += F.G * 8) {
    const int g = id >> 6, p = id & 63;
    const double lre = (double)F.in[17][id], lim = (double)F.in[18][id], dt = exp_d((double)F.in[19][g]);
    const double mag = exp_d(lre * dt); double sn, cs; sincos_d(lim * dt, sn, cs);
    const double are = mag * cs, aim = mag * sn;
    F.abar[id] = (f32x2){(float)are, (float)aim};
    double pr = are, pi = aim;
#pragma unroll
    for (int i = 0; i < 6; ++i) { const double nr = pr * pr - pi * pi, ni = 2.0 * pr * pi; pr = nr; pi = ni; }
    F.a64[id] = (f32x2){(float)pr, (float)pi};
    const double xr = are - 1.0, xi = aim, den = lre * lre + lim * lim;
    const double cr = (xr * lre + xi * lim) / den, ci = (xi * lre - xr * lim) / den;
    const float* bre = F.in[20] + (size_t)id * 16; const float* bim = F.in[21] + (size_t)id * 16;
    const int kre = 64 * (p >> 5) + (p & 31), kim = kre + 32;
#pragma unroll
    for (int c = 0; c < 16; ++c) { const double br = bre[c], bi = bim[c]; const float vr = (float)(cr * br - ci * bi), vi = (float)(cr * bi + ci * br);
        const unsigned hr = f2bf(vr), hi_ = f2bf(vi);
        F.bmh[(size_t)(g * 128 + kre) * 16 + c] = (bf16)hr; F.bmh[(size_t)(g * 128 + kim) * 16 + c] = (bf16)hi_; }
    const float* cre = F.in[22]; const float* cim = F.in[23];
#pragma unroll
    for (int c = 0; c < 16; ++c) {
        F.cmt[(g * 16 + c) * 128 + p] = (bf16)f2bf(cre[(g * 16 + c) * 64 + p]);
        F.cmt[(g * 16 + c) * 128 + 64 + p] = (bf16)f2bf(-cim[(g * 16 + c) * 64 + p]);
    }
    }
}
__device__ __forceinline__ void transpose_item(const float* W, int ldw, int k0, int n0, bf16* WT, int Kd, int drow0, LAS float* scr, int lane) {
    float wv[32];
#pragma unroll
    for (int i = 0; i < 32; ++i) wv[i] = __builtin_nontemporal_load(W + (size_t)(k0 + 2 * i + (lane >> 5)) * ldw + n0 + (lane & 31));
#pragma unroll
    for (int i = 0; i < 32; ++i) scr[(2 * i + (lane >> 5)) * 33 + (lane & 31)] = wv[i];
    LDS_WAIT();
    const int c = lane & 7;
#pragma unroll
    for (int j = 0; j < 4; ++j) { const int n = (lane >> 3) + 8 * j; const LAS float* s = scr + (8 * c) * 33 + n;
        u32x4 o; o.x = pk2(s[0 * 33], s[1 * 33]); o.y = pk2(s[2 * 33], s[3 * 33]); o.z = pk2(s[4 * 33], s[5 * 33]); o.w = pk2(s[6 * 33], s[7 * 33]);
        *(u32x4*)(WT + (size_t)(drow0 + n) * Kd + k0 + 8 * c) = o; }
    LDS_WAIT();
}
__device__ __forceinline__ int up_drow(int n0) { return n0 < FF ? 256 * (n0 >> 7) + (n0 & 127) : 256 * ((n0 - FF) >> 7) + 128 + ((n0 - FF) & 127); }
__device__ __forceinline__ void phase_weights(Frame& F) {
    LAS float* scr = (LAS float*)(F.lds + 81920 + F.wave * 8704);
    constexpr int I_UP = 16 * 176, I_DN = 44 * 32, I_IN = 16 * 64, I_GLU = 8 * 16, I_OUT = 16 * 32;
    constexpr int NITEMS = 2 * I_UP + 2 * I_DN + I_IN + I_GLU + I_OUT;
    for (int it = F.gw; it < NITEMS; it += F.NGW) {
        int r = it;
        if (r < I_UP) { const int kb = r / 176, nb = r % 176; transpose_item(F.in[12], NUP, 64 * kb, 32 * nb, F.WUP1, DM, up_drow(32 * nb), scr, F.lane); continue; } r -= I_UP;
        if (r < I_UP) { const int kb = r / 176, nb = r % 176; transpose_item(F.in[31], NUP, 64 * kb, 32 * nb, F.WUP2, DM, up_drow(32 * nb), scr, F.lane); continue; } r -= I_UP;
        if (r < I_DN) { const int kb = r / 32, nb = r % 32; transpose_item(F.in[13], DM, 64 * kb, 32 * nb, F.WDN1, FF, 32 * nb, scr, F.lane); continue; } r -= I_DN;
        if (r < I_DN) { const int kb = r / 32, nb = r % 32; transpose_item(F.in[32], DM, 64 * kb, 32 * nb, F.WDN2, FF, 32 * nb, scr, F.lane); continue; } r -= I_DN;
        if (r < I_IN) { const int kb = r / 64, nb = r % 64; transpose_item(F.in[15], DIN, 64 * kb, 32 * nb, F.WIN, DM, 32 * nb, scr, F.lane); continue; } r -= I_IN;
        if (r < I_GLU) { const int kb = r / 16, nb = r % 16; transpose_item(F.in[25], DH, 64 * kb, 32 * nb, F.WGLU, DH, 32 * nb, scr, F.lane); continue; } r -= I_GLU;
        { const int kb = r / 32, nb = r % 32; transpose_item(F.in[29], DM, 64 * kb, 32 * nb, F.WOUT, DM, 32 * nb, scr, F.lane); }
    }
}

__device__ __forceinline__ bool row_next(const Frame& F, int k, int& row) {
    if (F.NGW == 2048) { if (k < 8) { row = F.gw + 2048 * k; return true; } if (k == 8 && (F.gw & 7) == 0) { row = NP + (F.gw >> 3); return true; } return false; }
    row = F.gw + k * F.NGW; return row < MT;
}
template <bool FG>
__device__ __forceinline__ void phase_norm(Frame& F, const float* xp, const float* xs, const float* gN, int si, int ci) {
    LAS float* wf = (LAS float*)F.lds;
    if (FG) {
        const float* win = F.in[15];
        for (int i = F.tid; i < 8192; i += 512) wf[i] = win[(size_t)(i >> 3) * DIN + 2048 + (i & 7)];
        __syncthreads();
    }
    const int lane = F.lane;
    int row, nrow; f32x4 v[4], nv[4];
    bool have = row_next(F, 0, row);
    if (have) { const float* xr = row < NP ? xp + (size_t)row * DM : xs + (size_t)(row - NP) * DM;
#pragma unroll
        for (int j = 0; j < 4; ++j) v[j] = *(const f32x4*)(xr + 4 * lane + 256 * j); }
    for (int k_ = 0; have; ++k_) {
        const bool hn = row_next(F, k_ + 1, nrow);
        if (hn) { const float* xr = nrow < NP ? xp + (size_t)nrow * DM : xs + (size_t)(nrow - NP) * DM;
#pragma unroll
            for (int j = 0; j < 4; ++j) nv[j] = *(const f32x4*)(xr + 4 * lane + 256 * j); }
        float ss = 0.f;
#pragma unroll
        for (int j = 0; j < 4; ++j) ss += (v[j][0] * v[j][0] + v[j][1] * v[j][1]) + (v[j][2] * v[j][2] + v[j][3] * v[j][3]);
        const float rstd = 1.0f / sqrtf(wave_sum(ss) * (1.0f / DM) + EPS);
        const float* sh = F.mod + bidx(row) * NMOD + si * DM; const float* sc = F.mod + bidx(row) * NMOD + ci * DM;
        float f[8];
#pragma unroll
        for (int i = 0; i < 8; ++i) f[i] = 0.f;
#pragma unroll
        for (int j = 0; j < 4; ++j) {
            const int col = 4 * lane + 256 * j;
            const f32x4 g4 = *(const f32x4*)(gN + col), s4 = *(const f32x4*)(sc + col), h4 = *(const f32x4*)(sh + col);
            const f32x4 h = v[j] * rstd * g4 * (s4 + 1.0f) + h4;
            u32x2 w; w.x = pk2(h[0], h[1]); w.y = pk2(h[2], h[3]);
            *(u32x2*)(F.HA + (size_t)row * DM + col) = w;
            if (FG) {
#pragma unroll
                for (int e = 0; e < 4; ++e) {
                    const f32x4 w0 = *(const LAS f32x4*)(wf + (col + e) * 8), w1 = *(const LAS f32x4*)(wf + (col + e) * 8 + 4);
                    f[0] += h[e] * w0[0]; f[1] += h[e] * w0[1]; f[2] += h[e] * w0[2]; f[3] += h[e] * w0[3];
                    f[4] += h[e] * w1[0]; f[5] += h[e] * w1[1]; f[6] += h[e] * w1[2]; f[7] += h[e] * w1[3];
                }
            }
        }
        if (FG) {
#pragma unroll
            for (int i = 0; i < 8; ++i) f[i] = wave_sum(f[i]);
            float fv = f[0];
            fv = lane == 1 ? f[1] : fv; fv = lane == 2 ? f[2] : fv; fv = lane == 3 ? f[3] : fv; fv = lane == 4 ? f[4] : fv;
            fv = lane == 5 ? f[5] : fv; fv = lane == 6 ? f[6] : fv; fv = lane == 7 ? f[7] : fv;
            if (lane < 8) {
                const float x = fv + F.in[16][lane];
                const float lf = fminf(x, 0.f) - log1pf(expf(-fabsf(x)));
                float* o = row < NP ? F.out + O_LFP + (size_t)row * 8 : F.out + O_LFS + (size_t)(row - NP) * 8;
                o[lane] = lf;
            }
        }
#pragma unroll
        for (int j = 0; j < 4; ++j) v[j] = nv[j];
        row = nrow; have = hn;
    }
}
__device__ __forceinline__ void phase_mixnorm(Frame& F, int parts, int wq, int nwq) {
    const int lane = F.lane; const float* gs = F.in[27]; const float* gf = F.in[28];
    int row;
    for (int k_ = 0; nwq ? ((row = wq + k_ * nwq) < MT) : row_next(F, k_, row); ++k_) {
#pragma unroll
        for (int part = 0; part < 2; ++part) {
            if (!((parts >> part) & 1)) continue;
            const float* g = (part == 0 ? gs : gf) + 8 * lane;
            float v[8];
            if (part == 1 && row >= NP) {
                const int b = (row - NP) >> 5, q = (row - NP) & 31, h = lane >> 3, d0 = 8 * (lane & 7);
                const float* pb = F.PB + ((size_t)(((b * 8 + h) * 4) * 32 + q)) * 68;
                float Mi[4], M = -INFINITY;
#pragma unroll
                for (int i = 0; i < 4; ++i) { Mi[i] = pb[(size_t)i * 32 * 68 + 64]; M = fmaxf(M, Mi[i]); }
                float L = 0.f;
#pragma unroll
                for (int e = 0; e < 8; ++e) v[e] = 0.f;
#pragma unroll
                for (int i = 0; i < 4; ++i) {
                    const float wg = __builtin_amdgcn_exp2f(Mi[i] - M); L += pb[(size_t)i * 32 * 68 + 65] * wg;
                    const f32x4 o0 = *(const f32x4*)(pb + (size_t)i * 32 * 68 + d0), o1 = *(const f32x4*)(pb + (size_t)i * 32 * 68 + d0 + 4);
                    v[0] += o0[0] * wg; v[1] += o0[1] * wg; v[2] += o0[2] * wg; v[3] += o0[3] * wg; v[4] += o1[0] * wg; v[5] += o1[1] * wg; v[6] += o1[2] * wg; v[7] += o1[3] * wg;
                }
                const float rl = 1.0f / L;
#pragma unroll
                for (int e = 0; e < 8; ++e) v[e] *= rl;
            } else {
                const bf16* src = (part == 0 ? F.U : F.O) + (size_t)row * DH + 8 * lane;
                const u32x4 z = *(const u32x4*)src;
                v[0] = bflo(z.x); v[1] = bfhi(z.x); v[2] = bflo(z.y); v[3] = bfhi(z.y); v[4] = bflo(z.z); v[5] = bfhi(z.z); v[6] = bflo(z.w); v[7] = bfhi(z.w);
            }
            float ss = 0.f;
#pragma unroll
            for (int i = 0; i < 8; ++i) ss += v[i] * v[i];
            const float rstd = 1.0f / sqrtf(wave_sum(ss) * (1.0f / DH) + EPS);
            const f32x4 g0 = *(const f32x4*)g, g1 = *(const f32x4*)(g + 4);
            u32x4 w; w.x = pk2(v[0] * rstd * g0[0], v[1] * rstd * g0[1]); w.y = pk2(v[2] * rstd * g0[2], v[3] * rstd * g0[3]);
            w.z = pk2(v[4] * rstd * g1[0], v[5] * rstd * g1[1]); w.w = pk2(v[6] * rstd * g1[2], v[7] * rstd * g1[3]);
            *(u32x4*)(F.HA + (size_t)row * DM + part * DH + 8 * lane) = w;
        }
    }
}
__device__ __forceinline__ void phase_finalnorm(Frame& F) {
    const int lane = F.lane; const float* gN = F.in[33];
    int row, nrow; f32x4 v[4], nv[4];
    bool have = row_next(F, 0, row);
    if (have) {
#pragma unroll
        for (int j = 0; j < 4; ++j) v[j] = *(const f32x4*)(F.out + (size_t)row * DM + 4 * lane + 256 * j); }
    for (int k_ = 0; have; ++k_) {
        const bool hn = row_next(F, k_ + 1, nrow);
        if (hn) {
#pragma unroll
            for (int j = 0; j < 4; ++j) nv[j] = *(const f32x4*)(F.out + (size_t)nrow * DM + 4 * lane + 256 * j); }
        float* xr = F.out + (size_t)row * DM; float ss = 0.f;
#pragma unroll
        for (int j = 0; j < 4; ++j) ss += (v[j][0] * v[j][0] + v[j][1] * v[j][1]) + (v[j][2] * v[j][2] + v[j][3] * v[j][3]);
        const float rstd = 1.0f / sqrtf(wave_sum(ss) * (1.0f / DM) + EPS);
#pragma unroll
        for (int j = 0; j < 4; ++j) { const f32x4 g4 = *(const f32x4*)(gN + 4 * lane + 256 * j); *(f32x4*)(xr + 4 * lane + 256 * j) = v[j] * rstd * g4; }
#pragma unroll
        for (int j = 0; j < 4; ++j) v[j] = nv[j];
        row = nrow; have = hn;
    }
}
__device__ __forceinline__ void phase_fcum(Frame& F) {
    LAS float* wt = (LAS float*)F.lds;
    const int tid = F.tid, lane = F.lane, wave = F.wave;
    for (int job = blockIdx.x; job < 96; job += F.G) {
        const float* src; float* dst; int b, h;
        if (job < 32) { b = job >> 3; h = job & 7; src = F.out + O_LFP + (size_t)b * 4096 * 8 + h; dst = F.F2P + (size_t)job * 4096; }
        else { const int j2 = job - 32; b = j2 >> 3; h = j2 & 7; src = F.in[6] + (size_t)b * 4096 * 8 + h; dst = F.F2S + (size_t)j2 * 4128; }
        float v[8]; float tsum = 0.f;
#pragma unroll
        for (int i = 0; i < 8; ++i) { v[i] = src[(size_t)(8 * tid + i) * 8]; tsum += v[i]; }
        float inc = tsum;
#pragma unroll
        for (int o = 1; o < 64; o <<= 1) { const float t = __shfl_up(inc, o); if (lane >= o) inc += t; }
        if (lane == 63) wt[wave] = inc;
        __syncthreads();
        float woff = 0.f, total = 0.f;
#pragma unroll
        for (int w = 0; w < 8; ++w) { const float x = wt[w]; if (w < wave) woff += x; total += x; }
        float run = woff + inc - tsum;
#pragma unroll
        for (int i = 0; i < 8; ++i) { run += v[i]; dst[8 * tid + i] = run * LOG2E; }
        if (job >= 32 && wave == 0) {
            float x = lane < 32 ? F.out[O_LFS + (size_t)(b * 32 + lane) * 8 + h] : 0.f;
#pragma unroll
            for (int o = 1; o < 64; o <<= 1) { const float t = __shfl_up(x, o); if (lane >= o) x += t; }
            if (lane < 32) dst[4096 + lane] = (total + x) * LOG2E;
        }
        __syncthreads();
    }
}
#define XB_TMO      128
#define XB_XCNT(j)  (256  + 64 * (j))
#define XB_XSUB(j)  (1280 + 64 * (j))
#define XB_XGEN(j)  (2304 + 64 * (j))
#define XB_TOP      3328
#define XB_TOPGEN   3392
#define XCD_BAR_WORDS 3456
#define XB_SPIN_CAP (1u << 18)

__device__ __forceinline__ unsigned xb_ld(unsigned* p)              { return __hip_atomic_load(p, __ATOMIC_RELAXED, __HIP_MEMORY_SCOPE_AGENT); }
__device__ __forceinline__ unsigned xb_add(unsigned* p, unsigned v) { return __hip_atomic_fetch_add(p, v, __ATOMIC_RELAXED, __HIP_MEMORY_SCOPE_AGENT); }
__device__ __forceinline__ unsigned xb_xcc_id() { return (unsigned)__builtin_amdgcn_s_getreg((3 << 11) | 20) & 0xFu; }
#define XB_SPIN(cond, bar) do { unsigned _sp = 0; while (cond) { __builtin_amdgcn_s_sleep(1); \
    if ((++_sp & 255u) == 0u) { if (xb_ld(&(bar)[XB_TMO])) break; if (_sp > XB_SPIN_CAP) { atomicAdd(&(bar)[XB_TMO], 1u); break; } } } } while (0)

struct XcdBarrier {
    unsigned* bar; unsigned x;
    volatile LAS unsigned* st;
};

__device__ __forceinline__ XcdBarrier xcd_barrier_post(unsigned* bar, volatile LAS unsigned* st) {
    XcdBarrier b; b.bar = bar; b.x = xb_xcc_id(); b.st = st;
    if (threadIdx.x == 0) (void)xb_add(&bar[XB_XCNT(b.x)], 1u);
    return b;
}
__device__ __forceinline__ void xcd_barrier_complete(unsigned* bar, unsigned x, unsigned& nloc, unsigned& nx) {
    const unsigned G = gridDim.x * gridDim.y * gridDim.z;
    unsigned sum, cnt, mine, sp = 0u;
    for (;;) {
        sum = 0u; cnt = 0u; mine = 0u;
#pragma unroll
        for (unsigned j = 0; j < 16; ++j) { const unsigned c = xb_ld(&bar[XB_XCNT(j)]); sum += c; cnt += (c > 0u) ? 1u : 0u; mine = (j == x) ? c : mine; }
        if (sum == G) break;
        __builtin_amdgcn_s_sleep(1);
        if ((++sp & 255u) == 0u) { if (xb_ld(&bar[XB_TMO])) break; if (sp > XB_SPIN_CAP) { atomicAdd(&bar[XB_TMO], 1u); break; } }
    }
    nloc = mine > 0u ? mine : 1u; nx = cnt > 0u ? cnt : 1u;
}

__device__ __forceinline__ void xcd_barrier(const XcdBarrier& b) {
    asm volatile("s_waitcnt vmcnt(0)" ::: "memory");
    __syncthreads();
    if (threadIdx.x == 0) {
        unsigned* bar = b.bar;
        __builtin_amdgcn_s_waitcnt(0);
        unsigned nloc = b.st[0], nx = b.st[1];
        if (nloc == 0u) { xcd_barrier_complete(bar, b.x, nloc, nx); b.st[0] = nloc; b.st[1] = nx; }
        const unsigned old = xb_add(&bar[XB_XSUB(b.x)], 1u);
        const unsigned gen = old / nloc;
        if (old + 1u == (gen + 1u) * nloc) {
            __builtin_amdgcn_fence(__ATOMIC_RELEASE, "agent");
            asm volatile("s_waitcnt vmcnt(0)" ::: "memory");
            const unsigned og = xb_add(&bar[XB_TOP], 1u);
            const unsigned tg = og / nx;
            if (og + 1u == (tg + 1u) * nx) xb_add(&bar[XB_TOPGEN], 1u);
            else XB_SPIN(xb_ld(&bar[XB_TOPGEN]) == tg, bar);
            __builtin_amdgcn_fence(__ATOMIC_ACQUIRE, "agent");
            xb_add(&bar[XB_XGEN(b.x)], 1u);
            asm volatile("s_waitcnt vmcnt(0)" ::: "memory");
        } else {
            XB_SPIN(xb_ld(&bar[XB_XGEN(b.x)]) == gen, bar);
            __builtin_amdgcn_fence(__ATOMIC_ACQUIRE, "agent");
            asm volatile("s_waitcnt vmcnt(0)" ::: "memory");
        }
    }
    __syncthreads();
}

__device__ __forceinline__ void seam_arrive(unsigned* word) {
    asm volatile("s_waitcnt vmcnt(0)" ::: "memory");
    __syncthreads();
    if (threadIdx.x == 0) { __builtin_amdgcn_fence(__ATOMIC_RELEASE, "agent"); asm volatile("s_waitcnt vmcnt(0)" ::: "memory"); (void)xb_add(word, 1u); }
}
__device__ __forceinline__ void seam_wait(unsigned* word, unsigned want) {
    if (threadIdx.x == 0) {
        unsigned sp = 0u;
        while (xb_ld(word) < want) { __builtin_amdgcn_s_sleep(1); if (++sp > (1u << 22)) break; }
        __builtin_amdgcn_fence(__ATOMIC_ACQUIRE, "agent");
        asm volatile("s_waitcnt vmcnt(0)" ::: "memory");
    }
    __syncthreads();
}

constexpr int KP = 72, VP = 68;
typedef short v4i16_t __attribute__((ext_vector_type(4)));
__device__ __forceinline__ s16x4 vtr(const LAS bf16* p) { return __builtin_bit_cast(s16x4, __builtin_amdgcn_ds_read_tr16_b64_v4i16((LAS v4i16_t*)p)); }
template <int NK, int VPT, bool TR>
__device__ __forceinline__ void attn_tile(const LAS bf16* kL, const LAS bf16* vL, const LAS float* fL, LAS float* wsf, const bf16x8 (&qr)[4], f32x16 (&o)[2],
                                          float& m, float& l, bool domask, int lim, int r32, int hi) {
    f32x16 p[2 * NK];
#pragma unroll
    for (int t = 0; t < NK; ++t)
#pragma unroll
        for (int rg = 0; rg < 4; ++rg) {
            const f32x4 fa = *(const LAS f32x4*)(fL + 64 * t + 8 * rg + 4 * hi), fb = *(const LAS f32x4*)(fL + 64 * t + 32 + 8 * rg + 4 * hi);
#pragma unroll
            for (int i = 0; i < 4; ++i) { p[2 * t][4 * rg + i] = fa[i]; p[2 * t + 1][4 * rg + i] = fb[i]; }
        }
    __builtin_amdgcn_s_setprio(1);
#pragma unroll
    for (int t = 0; t < NK; ++t)
#pragma unroll
        for (int d0 = 0; d0 < 4; ++d0) {
            const bf16x8 a0 = *(const LAS bf16x8*)(kL + (64 * t + r32) * KP + d0 * 16 + hi * 8);
            const bf16x8 a1 = *(const LAS bf16x8*)(kL + (64 * t + 32 + r32) * KP + d0 * 16 + hi * 8);
            p[2 * t] = __builtin_amdgcn_mfma_f32_32x32x16_bf16(a0, qr[d0], p[2 * t], 0, 0, 0);
            p[2 * t + 1] = __builtin_amdgcn_mfma_f32_32x32x16_bf16(a1, qr[d0], p[2 * t + 1], 0, 0, 0);
            if (NK > 1 && (d0 & 1)) __builtin_amdgcn_sched_barrier(0);
        }
    __builtin_amdgcn_s_setprio(0);
    if (domask) {
#pragma unroll
        for (int t = 0; t < 2 * NK; ++t)
#pragma unroll
            for (int r = 0; r < 16; ++r) { const int kv = 32 * t + (r & 3) + 8 * (r >> 2) + 4 * hi; if (kv > lim) p[t][r] = -INFINITY; }
    }
    float mt = p[0][0];
#pragma unroll
    for (int t = 0; t < 2 * NK; ++t)
#pragma unroll
        for (int r = 0; r < 16; ++r) mt = fmaxf(mt, p[t][r]);
    { const auto rr = __builtin_amdgcn_permlane32_swap(__float_as_uint(mt), __float_as_uint(mt), false, false); mt = fmaxf(__uint_as_float(rr[0]), __uint_as_float(rr[1])); }
    if (__any(mt > m + 8.0f)) {
        const float mn = (mt > m + 8.0f) ? mt : m;
        const float alpha = __builtin_amdgcn_exp2f(m - mn);
        m = mn; l *= alpha;
        if (hi == 0) wsf[r32] = alpha;
        LDS_WAIT();
#pragma unroll
        for (int rg = 0; rg < 4; ++rg) {
            const f32x4 al = *(const LAS f32x4*)(wsf + 8 * rg + 4 * hi);
#pragma unroll
            for (int i = 0; i < 4; ++i) { o[0][4 * rg + i] *= al[i]; o[1][4 * rg + i] *= al[i]; }
        }
    }
    f32x2 rs2 = (f32x2){0.f, 0.f}; const f32x2 m2 = (f32x2){m, m};
#pragma unroll
    for (int t = 0; t < 2 * NK; ++t)
#pragma unroll
        for (int r = 0; r < 16; r += 2) {
            const f32x2 d = (f32x2){p[t][r], p[t][r + 1]} - m2;
            const f32x2 e = (f32x2){__builtin_amdgcn_exp2f(d.x), __builtin_amdgcn_exp2f(d.y)};
            p[t][r] = e.x; p[t][r + 1] = e.y; rs2 += e;
        }
    l += rs2.x + rs2.y;
    __builtin_amdgcn_s_setprio(1);
#pragma unroll
    for (int t = 0; t < 2 * NK; ++t) {
        if (NK > 1) __builtin_amdgcn_sched_barrier(0);
        u32x4 pw0 = (u32x4){pk2(p[t][0], p[t][1]), pk2(p[t][2], p[t][3]), pk2(p[t][4], p[t][5]), pk2(p[t][6], p[t][7])};
        u32x4 pw1 = (u32x4){pk2(p[t][8], p[t][9]), pk2(p[t][10], p[t][11]), pk2(p[t][12], p[t][13]), pk2(p[t][14], p[t][15])};
#pragma unroll
        for (int d0 = 0; d0 < 2; ++d0)
#pragma unroll
            for (int s = 0; s < 2; ++s) {
                s16x4 lo, h4;
                if (TR) {
                    const LAS bf16* vb = vL + (4 * hi + ((r32 & 15) >> 2)) * VPT + 16 * (r32 >> 4) + 4 * (r32 & 3);
                    lo = vtr(vb + (32 * t + 16 * s) * VPT + 32 * d0); h4 = vtr(vb + (32 * t + 16 * s + 8) * VPT + 32 * d0);
                } else {
                    lo = *(const LAS s16x4*)(vL + (r32 + 32 * d0) * VPT + 32 * t + 16 * s + 4 * hi);
                    h4 = *(const LAS s16x4*)(vL + (r32 + 32 * d0) * VPT + 32 * t + 16 * s + 8 + 4 * hi);
                }
                const bf16x8 bv = (bf16x8){lo[0], lo[1], lo[2], lo[3], h4[0], h4[1], h4[2], h4[3]};
                o[d0] = __builtin_amdgcn_mfma_f32_32x32x16_bf16(__builtin_bit_cast(bf16x8, s == 0 ? pw0 : pw1), bv, o[d0], 0, 0, 0);
            }
    }
    __builtin_amdgcn_s_setprio(0);
    LDS_WAIT();
}
__device__ __forceinline__ void st16(LAS bf16* p, unsigned v) { *(LAS unsigned short*)p = (unsigned short)v; }
__device__ __forceinline__ void attn_prompt_unit(Frame& F, int b, int h, int qb) {
    const int tid = F.tid, lane = F.lane, wave = F.wave, r32 = lane & 31, hi = lane >> 5;
    constexpr int VPR = 96;
    LAS bf16* kbuf = (LAS bf16*)F.lds; LAS bf16* vbuf = (LAS bf16*)(F.lds + 36864); LAS float* fbuf = (LAS float*)(F.lds + 86016);
    LAS float* wsf = (LAS float*)(F.lds + 87040) + wave * 64;
    const int rowbase = b * 4096, q0 = qb * 256;
    const bf16* Qw = F.Q + (size_t)(rowbase + q0 + wave * 32) * DH + h * 64;
    bf16* Ow = F.O + (size_t)(rowbase + q0 + wave * 32) * DH + h * 64;
    bf16x8 qr[4];
#pragma unroll
    for (int d0 = 0; d0 < 4; ++d0) qr[d0] = *(const bf16x8*)(Qw + (size_t)r32 * DH + d0 * 16 + hi * 8);
    const int NT = 4 * (qb + 1), kvs = tid >> 3, c8 = tid & 7;
    const bf16* kg = F.KB + (size_t)(rowbase + kvs) * DH + h * 64 + 8 * c8;
    const bf16* vg = F.VB + (size_t)(rowbase + kvs) * DH + h * 64 + 8 * c8;
    const float* fg = F.F2P + (size_t)(b * 8 + h) * 4096;
    u32x4 kr0 = *(const u32x4*)kg, vr0 = *(const u32x4*)vg, kr1 = *(const u32x4*)(kg + (size_t)64 * DH), vr1 = *(const u32x4*)(vg + (size_t)64 * DH);
    float fr_ = tid < 128 ? fg[tid] : 0.f;
    float m = -1e30f, l = 0.f; f32x16 o[2];
#pragma unroll
    for (int r = 0; r < 16; ++r) { o[0][r] = 0.f; o[1][r] = 0.f; }
    const int qmin = q0 + wave * 32, NS = NT / 2;
#define ATT_WRITE_STEP(t_) do { LAS bf16* kL_ = kbuf + ((t_) & 1) * (128 * KP); LAS bf16* vL_ = vbuf + ((t_) & 1) * (128 * VPR); LAS float* fL_ = fbuf + ((t_) & 1) * 128; \
        *(LAS u32x4*)(kL_ + kvs * KP + 8 * c8) = kr0; *(LAS u32x4*)(kL_ + (64 + kvs) * KP + 8 * c8) = kr1; \
        *(LAS u32x4*)(vL_ + kvs * VPR + 8 * c8) = vr0; *(LAS u32x4*)(vL_ + (64 + kvs) * VPR + 8 * c8) = vr1; \
        if (tid < 128) fL_[tid] = -fr_; } while (0)
    ATT_WRITE_STEP(0);
    __syncthreads();
    for (int t = 0; t < NS; ++t) {
        if (t + 1 < NS) { const size_t go = (size_t)(t + 1) * 128 * DH;
            kr0 = *(const u32x4*)(kg + go); vr0 = *(const u32x4*)(vg + go); kr1 = *(const u32x4*)(kg + go + (size_t)64 * DH); vr1 = *(const u32x4*)(vg + go + (size_t)64 * DH);
            fr_ = tid < 128 ? fg[(t + 1) * 128 + tid] : 0.f; }
        if (128 * t <= qmin + 31) {
            const bool domask = (128 * t + 127 > qmin);
            const LAS bf16* kS = kbuf + (t & 1) * (128 * KP); const LAS bf16* vS = vbuf + (t & 1) * (128 * VPR); const LAS float* fS = fbuf + (t & 1) * 128;
            attn_tile<1, VPR, true>(kS, vS, fS, wsf, qr, o, m, l, (128 * t + 63 > qmin), qmin + r32 - 128 * t, r32, hi);
            if (128 * t + 64 <= qmin + 31) attn_tile<1, VPR, true>(kS + 64 * KP, vS + 64 * VPR, fS + 64, wsf, qr, o, m, l, domask, qmin + r32 - 128 * t - 64, r32, hi);
        }
        if (t + 1 < NS) ATT_WRITE_STEP(t + 1);
        __syncthreads();
    }
#undef ATT_WRITE_STEP
    l += __shfl_xor(l, 32);
    if (hi == 0) wsf[r32] = 1.0f / l;
    LDS_WAIT();
#pragma unroll
    for (int rg = 0; rg < 4; ++rg) {
        const f32x4 rl = *(const LAS f32x4*)(wsf + 8 * rg + 4 * hi);
#pragma unroll
        for (int i = 0; i < 4; ++i) {
            const int q = 8 * rg + 4 * hi + i;
            Ow[(size_t)q * DH + r32] = (bf16)f2bf(o[0][4 * rg + i] * rl[i]);
            Ow[(size_t)q * DH + 32 + r32] = (bf16)f2bf(o[1][4 * rg + i] * rl[i]);
        }
    }
    LDS_WAIT();
    __syncthreads();
}
__device__ __forceinline__ void attn_sample_unit(Frame& F, int b, int h, int qd) {
    const int tid = F.tid, lane = F.lane, wave = F.wave, r32 = lane & 31, hi = lane >> 5;
    LAS unsigned char* wb = F.lds + wave * 18432;
    LAS bf16* kL = (LAS bf16*)wb; LAS bf16* vL = (LAS bf16*)(wb + 9216); LAS float* fL = (LAS float*)(wb + 17920); LAS float* wsf = (LAS float*)(wb + 18176);
    const int qrow0 = NP + b * 32;
    bf16x8 qr[4];
#pragma unroll
    for (int d0 = 0; d0 < 4; ++d0) qr[d0] = *(const bf16x8*)(F.Q + (size_t)(qrow0 + r32) * DH + h * 64 + d0 * 16 + hi * 8);
    float m = -1e30f, l = 0.f; f32x16 o[2];
#pragma unroll
    for (int r = 0; r < 16; ++r) { o[0][r] = 0.f; o[1][r] = 0.f; }
    const float* ck = F.in[4] + ((size_t)b * 4096 * 8 + h) * 64;
    const float* cv = F.in[5] + ((size_t)b * 4096 * 8 + h) * 64;
    const float* f2 = F.F2S + (size_t)(b * 8 + h) * 4128;
    const int c16 = lane & 15, kq = lane >> 4;
    for (int tt = 0; tt < 2; ++tt) {
        const int kv0 = qd * 1024 + wave * 128 + tt * 64;
        {
            f32x4 x[16];
#pragma unroll
            for (int i = 0; i < 16; ++i) x[i] = __builtin_nontemporal_load((const f32x4*)(ck + (size_t)(kv0 + kq + 4 * i) * 512 + 4 * c16));
#pragma unroll
            for (int i = 0; i < 16; ++i) { u32x2 w; w.x = pk2(x[i][0], x[i][1]); w.y = pk2(x[i][2], x[i][3]); *(LAS u32x2*)(kL + (kq + 4 * i) * KP + 4 * c16) = w; }
#pragma unroll
            for (int i = 0; i < 16; ++i) x[i] = __builtin_nontemporal_load((const f32x4*)(cv + (size_t)(kv0 + kq + 4 * i) * 512 + 4 * c16));
#pragma unroll
            for (int i = 0; i < 16; ++i) { const int kv = kq + 4 * i; const unsigned y0 = pk2(x[i][0], x[i][1]), y1 = pk2(x[i][2], x[i][3]);
                st16(vL + (4 * c16 + 0) * VP + kv, y0); st16(vL + (4 * c16 + 1) * VP + kv, y0 >> 16);
                st16(vL + (4 * c16 + 2) * VP + kv, y1); st16(vL + (4 * c16 + 3) * VP + kv, y1 >> 16); }
        }
        fL[lane] = -f2[kv0 + lane];
        LDS_WAIT();
        attn_tile<1, VP, false>(kL, vL, fL, wsf, qr, o, m, l, false, 0, r32, hi);
    }
    if (wave == 7 && qd == 3) {
        const int kv = lane >> 1, half = lane & 1;
        const bf16* kn = F.KB + (size_t)(qrow0 + kv) * DH + h * 64 + 32 * half;
        const bf16* vn = F.VB + (size_t)(qrow0 + kv) * DH + h * 64 + 32 * half;
#pragma unroll
        for (int i = 0; i < 4; ++i) {
            const u32x4 x = *(const u32x4*)(kn + 8 * i), y = *(const u32x4*)(vn + 8 * i);
            *(LAS u32x4*)(kL + kv * KP + 32 * half + 8 * i) = x;
            *(LAS u32x4*)(kL + (32 + kv) * KP + 32 * half + 8 * i) = (u32x4){0u, 0u, 0u, 0u};
            const int d = 32 * half + 8 * i;
            st16(vL + (d + 0) * VP + kv, y.x); st16(vL + (d + 1) * VP + kv, y.x >> 16); st16(vL + (d + 2) * VP + kv, y.y); st16(vL + (d + 3) * VP + kv, y.y >> 16);
            st16(vL + (d + 4) * VP + kv, y.z); st16(vL + (d + 5) * VP + kv, y.z >> 16); st16(vL + (d + 6) * VP + kv, y.w); st16(vL + (d + 7) * VP + kv, y.w >> 16);
#pragma unroll
            for (int e = 0; e < 8; ++e) st16(vL + (d + e) * VP + 32 + kv, 0u);
        }
        fL[lane] = lane < 32 ? -f2[4096 + lane] : 0.f;
        LDS_WAIT();
        attn_tile<1, VP, false>(kL, vL, fL, wsf, qr, o, m, l, true, r32, r32, hi);
    }
    l += __shfl_xor(l, 32);
    __syncthreads();
    LAS float* cm = (LAS float*)F.lds; LAS float* cl = cm + 256; LAS float* co = cl + 256;
    if (hi == 0) { cm[wave * 32 + r32] = m; cl[wave * 32 + r32] = l; }
#pragma unroll
    for (int r = 0; r < 16; ++r) {
        const int q = (r & 3) + 8 * (r >> 2) + 4 * hi;
        co[(wave * 32 + q) * 64 + r32] = o[0][r]; co[(wave * 32 + q) * 64 + 32 + r32] = o[1][r];
    }
    __syncthreads();
    {
        const int q = tid >> 4, dg = tid & 15;
        float M = cm[q];
#pragma unroll
        for (int w = 1; w < 8; ++w) M = fmaxf(M, cm[w * 32 + q]);
        float L = 0.f; f32x4 acc = (f32x4){0.f, 0.f, 0.f, 0.f};
#pragma unroll
        for (int w = 0; w < 8; ++w) {
            const float wg = __builtin_amdgcn_exp2f(cm[w * 32 + q] - M);
            L += cl[w * 32 + q] * wg;
            acc += *(const LAS f32x4*)(co + (w * 32 + q) * 64 + 4 * dg) * wg;
        }
        float* pb = F.PB + ((size_t)(((b * 8 + h) * 4 + qd) * 32 + q)) * 68;
        *(f32x4*)(pb + 4 * dg) = acc;
        if (dg == 0) { pb[64] = M; pb[65] = L; }
    }
    __syncthreads();
}

__device__ __forceinline__ bool s5_pair_next(const Frame& F, int k, bool with_sample, int& q) {
    if (F.NGW == 2048) {
        if (k < 2) { q = k * 2048 + ((F.gw + 531 * k) & 2047); return true; }
        if (k == 2 && with_sample && (F.gw & 15) == 0) { q = 4096 + (F.gw >> 4); return true; }
        return false;
    }
    q = F.gw + k * F.NGW; return q < (with_sample ? 4224 : 4096);
}
__device__ __forceinline__ void s5_pair_item(int q, int hs, int& g, int& item, int& row0) {
    if (q < 4096) { g = q >> 7; const int b = ((q >> 6) & 1) + 2 * hs, ch = q & 63; item = g * S5_ITEMS_PER_G + b * 64 + ch; row0 = b * 4096 + ch * 64; }
    else { const int s = q - 4096; g = s >> 2; const int sb = (s & 3) + 4 * hs; item = g * S5_ITEMS_PER_G + 256 + sb; row0 = NP + sb * 32; }
}
__device__ __forceinline__ void s5_bu(const bf16x8 ua, const bf16x8 (&bmf)[4], f32x16 (&D)[4]) {
#pragma unroll
    for (int kt = 0; kt < 4; ++kt) {
#pragma unroll
        for (int r = 0; r < 16; ++r) D[kt][r] = 0.f;
        D[kt] = __builtin_amdgcn_mfma_f32_32x32x16_bf16(ua, bmf[kt], D[kt], 0, 0, 0);
    }
}
__device__ __forceinline__ void s5_pair_a(Frame& F, int q) {
    const int lane = F.lane, kl = lane & 31, hs = lane >> 5;
    int g, itemA, rowA, itemB, rowB, itemM, rowM;
    s5_pair_item(q, 0, g, itemA, rowA); s5_pair_item(q, 1, g, itemB, rowB); s5_pair_item(q, hs, g, itemM, rowM);
    const f32x2 aA = F.abar[g * 64 + kl], aB = F.abar[g * 64 + 32 + kl];
    bf16x8 bmf[4];
#pragma unroll
    for (int kt = 0; kt < 4; ++kt) bmf[kt] = *(const bf16x8*)(F.bmh + (size_t)(g * 128 + 32 * kt + kl) * 16 + 8 * hs);
    const int ri = (kl & 3) + 4 * (kl >> 3), hsel = (kl >> 2) & 1;
    const bf16* up = F.U + (size_t)((hsel ? rowB : rowA) + ri) * DH + g * 16 + 8 * hs;
    bf16x8 ua[4];
#pragma unroll
    for (int sb = 0; sb < 4; ++sb) ua[sb] = *(const bf16x8*)(up + (size_t)16 * sb * DH);
    f32x2 sA = (f32x2){0.f, 0.f}, sB = (f32x2){0.f, 0.f};
#pragma unroll
    for (int sb = 0; sb < 4; ++sb) {
        f32x16 D[4]; s5_bu(ua[sb], bmf, D);
#pragma unroll
        for (int r = 0; r < 16; ++r) {
            f32x2 n; n.x = aA.x * sA.x - aA.y * sA.y + D[0][r]; n.y = aA.x * sA.y + aA.y * sA.x + D[1][r]; sA = n;
            f32x2 w; w.x = aB.x * sB.x - aB.y * sB.y + D[2][r]; w.y = aB.x * sB.y + aB.y * sB.x + D[3][r]; sB = w;
        }
    }
    F.E[(size_t)itemM * 64 + kl] = sA; F.E[(size_t)itemM * 64 + 32 + kl] = sB;
}
__device__ __forceinline__ void s5_pass_a(Frame& F) {
    int q;
    for (int k = 0; s5_pair_next(F, k, false, q); ++k) s5_pair_a(F, q);
}
__device__ __forceinline__ void s5_pair_c(Frame& F, int q, LAS bf16* Sb) {
    const int lane = F.lane, kl = lane & 31, hs = lane >> 5, fr = lane & 15, fq = lane >> 4;
    int g, itemA, rowA, itemB, rowB, itemM, rowM;
    s5_pair_item(q, 0, g, itemA, rowA); s5_pair_item(q, 1, g, itemB, rowB); s5_pair_item(q, hs, g, itemM, rowM);
    const bool prompt = q < 4096; const int nsb = prompt ? 4 : 2;
    const f32x2 aA = F.abar[g * 64 + kl], aB = F.abar[g * 64 + 32 + kl];
    bf16x8 bmf[4];
#pragma unroll
    for (int kt = 0; kt < 4; ++kt) bmf[kt] = *(const bf16x8*)(F.bmh + (size_t)(g * 128 + 32 * kt + kl) * 16 + 8 * hs);
    bf16x8 cmf[4];
#pragma unroll
    for (int ks = 0; ks < 4; ++ks) cmf[ks] = *(const bf16x8*)(F.cmt + (g * 16 + fr) * 128 + 32 * ks + 8 * fq);
    const f32x4 dv = *(const f32x4*)(F.in[24] + g * 16 + 4 * fq);
    const int ri = (kl & 3) + 4 * (kl >> 3), hsel = (kl >> 2) & 1;
    const bf16* up = F.U + (size_t)((hsel ? rowB : rowA) + ri) * DH + g * 16 + 8 * hs;
    bf16x8 ua[4];
#pragma unroll
    for (int sb = 0; sb < 4; ++sb) ua[sb] = (sb < nsb) ? *(const bf16x8*)(up + (size_t)16 * sb * DH) : (bf16x8){0, 0, 0, 0, 0, 0, 0, 0};
    f32x2 sA, sB;
    if (prompt) {
        sA = (f32x2){0.f, 0.f}; sB = (f32x2){0.f, 0.f};
        const f32x2 cA = F.a64[g * 64 + kl], cB = F.a64[g * 64 + 32 + kl];
        const int nprev = q & 63;
        const f32x2* ep = F.E + (size_t)(itemM - nprev) * 64 + kl;
        const int off = (8 - (nprev & 7)) & 7;
        for (int i0 = -off; i0 < nprev; i0 += 8) {
            f32x2 eA[8], eB[8];
#pragma unroll
            for (int u = 0; u < 8; ++u) { const bool ok = (i0 + u >= 0); eA[u] = ok ? ep[(size_t)(i0 + u) * 64] : (f32x2){0.f, 0.f}; eB[u] = ok ? ep[(size_t)(i0 + u) * 64 + 32] : (f32x2){0.f, 0.f}; }
#pragma unroll
            for (int u = 0; u < 8; ++u) {
                f32x2 n; n.x = cA.x * sA.x - cA.y * sA.y + eA[u].x; n.y = cA.x * sA.y + cA.y * sA.x + eA[u].y; sA = n;
                f32x2 w; w.x = cB.x * sB.x - cB.y * sB.y + eB[u].x; w.y = cB.x * sB.y + cB.y * sB.x + eB[u].y; sB = w;
            }
        }
    } else {
        const int sq = (q - 4096) & 3, sbi = sq + 4 * hs; const size_t si = (size_t)(sbi * 32 + g) * 64;
        sA = (f32x2){F.in[7][si + kl], F.in[8][si + kl]}; sB = (f32x2){F.in[7][si + 32 + kl], F.in[8][si + 32 + kl]};
    }
    for (int sb = 0; sb < nsb; ++sb) {
        f32x16 D[4];
        { const bf16x8 uas = sb == 0 ? ua[0] : sb == 1 ? ua[1] : sb == 2 ? ua[2] : ua[3]; s5_bu(uas, bmf, D); }
#pragma unroll
        for (int r = 0; r < 16; ++r) {
            f32x2 n; n.x = aA.x * sA.x - aA.y * sA.y + D[0][r]; n.y = aA.x * sA.y + aA.y * sA.x + D[1][r]; sA = n;
            f32x2 w; w.x = aB.x * sB.x - aB.y * sB.y + D[2][r]; w.y = aB.x * sB.y + aB.y * sB.x + D[3][r]; sB = w;
            LAS bf16* sp = Sb + (hs * 16 + r) * 136 + kl;
            st16(sp, f2bf(sA.x)); st16(sp + 64, f2bf(sA.y)); st16(sp + 32, f2bf(sB.x)); st16(sp + 96, f2bf(sB.y));
        }
        LDS_WAIT();
#pragma unroll
        for (int it = 0; it < 2; ++it) {
            f32x4 acc = (f32x4){0.f, 0.f, 0.f, 0.f};
#pragma unroll
            for (int ks = 0; ks < 4; ++ks) {
                const bf16x8 sf = *(const LAS bf16x8*)(Sb + (it * 16 + fr) * 136 + 32 * ks + 8 * fq);
                acc = __builtin_amdgcn_mfma_f32_16x16x32_bf16(cmf[ks], sf, acc, 0, 0, 0);
            }
            const size_t row = (size_t)(it ? rowB : rowA) + 16 * sb + fr;
            const u32x2 ub = *(const u32x2*)(F.U + row * DH + g * 16 + 4 * fq);
            const float u4[4] = {bflo(ub.x), bfhi(ub.x), bflo(ub.y), bfhi(ub.y)};
            float y[4];
#pragma unroll
            for (int i = 0; i < 4; ++i) { const float t = acc[i] + dv[i] * u4[i]; y[i] = t * fsigmoid(1.5957691216057308f * (t + 0.044715f * t * t * t)); }
            u32x2 w; w.x = pk2(y[0], y[1]); w.y = pk2(y[2], y[3]);
            *(u32x2*)(F.Z + row * DH + g * 16 + 4 * fq) = w;
        }
        LDS_WAIT();
    }
    if (!prompt) { const int sbi = ((q - 4096) & 3) + 4 * hs; const size_t si = (size_t)(sbi * 32 + g) * 64;
        F.out[O_SRS + si + kl] = sA.x; F.out[O_SIS + si + kl] = sA.y; F.out[O_SRS + si + 32 + kl] = sB.x; F.out[O_SIS + si + 32 + kl] = sB.y; }
    else if ((q & 63) == 63) { const int b = ((q >> 6) & 1) + 2 * hs; const size_t si = (size_t)(b * 32 + g) * 64;
        F.out[O_SRP + si + kl] = sA.x; F.out[O_SIP + si + kl] = sA.y; F.out[O_SRP + si + 32 + kl] = sB.x; F.out[O_SIP + si + 32 + kl] = sB.y; }
}
__device__ __forceinline__ void s5_pass_c(Frame& F) {
    LAS bf16* Sb = (LAS bf16*)(F.lds + F.wave * 12800);
    int q;
    for (int k = 0; s5_pair_next(F, k, true, q); ++k) s5_pair_c(F, q, Sb);
}

struct SkSwiglu { bf16* H;
    __device__ __forceinline__ int brow(int ct, int nb) const { return 256 * (ct >> 2) + 32 * (ct & 3) + 128 * nb; }
    __device__ __forceinline__ void pre(int, int, int, f32x4&) const {}
    __device__ __forceinline__ void operator()(int row, int ct, int j0, const float (&v)[2][2], const f32x4&) const {
        const float a = v[0][0] * fsigmoid(v[0][0]) * v[1][0], b = v[0][1] * fsigmoid(v[0][1]) * v[1][1];
        *(unsigned*)(H + (size_t)(NP + row) * FF + 32 * ct + j0) = pk2(a, b); } };
struct SkResid { const float* xin; float* out; const float* mod; int gi; float gscale;
    __device__ __forceinline__ int brow(int ct, int) const { return 32 * ct; }
    __device__ __forceinline__ void pre(int row, int ct, int j0, f32x4& pf) const {
        const int col = 32 * ct + j0; const float* gate = mod + (4 + (row >> 5)) * NMOD + gi * DM + col;
        const f32x2 x = *(const f32x2*)(xin + (size_t)row * DM + col), g = *(const f32x2*)gate; pf = (f32x4){x.x, x.y, g.x, g.y}; }
    __device__ __forceinline__ void operator()(int row, int ct, int j0, const float (&v)[1][2], const f32x4& pf) const {
        const int col = 32 * ct + j0;
        f32x2 o; o.x = pf[0] + gscale * (1.f + pf[2]) * v[0][0]; o.y = pf[1] + gscale * (1.f + pf[3]) * v[0][1];
        *(f32x2*)(out + (size_t)row * DM + col) = o; } };
struct SkIn { bf16 *U, *Q, *KB, *VB; float* out;
    __device__ __forceinline__ int brow(int ct, int) const { return 32 * ct; }
    __device__ __forceinline__ void pre(int, int, int, f32x4&) const {}
    __device__ __forceinline__ void operator()(int row, int ct, int j0, const float (&v)[1][2], const f32x4&) const {
        const int n = 32 * ct + j0, t = n >> 9, col = n & 511; const float sc = t == 1 ? QSCALE : 1.f;
        bf16* dst = U + (size_t)t * (17 * MiB / 2);
        *(unsigned*)(dst + (size_t)(NP + row) * DH + col) = pk2(v[0][0] * sc, v[0][1] * sc);
        if (t >= 2) *(f32x2*)(out + (t == 2 ? O_KS : O_VS) + (size_t)row * DH + col) = (f32x2){v[0][0], v[0][1]}; } };
struct SkGlu { const bf16* Z; bf16* Y; const float* bglu;
    __device__ __forceinline__ int brow(int ct, int) const { return 32 * ct; }
    __device__ __forceinline__ void pre(int, int, int, f32x4&) const {}
    __device__ __forceinline__ void operator()(int row, int ct, int j0, const float (&v)[1][2], const f32x4&) const {
        const int col = 32 * ct + j0; const unsigned z = *(const unsigned*)(Z + (size_t)(NP + row) * DH + col);
        *(unsigned*)(Y + (size_t)(NP + row) * DH + col) = pk2(bflo(z) * fsigmoid(v[0][0] + bglu[col]), bfhi(z) * fsigmoid(v[0][1] + bglu[col + 1])); } };

struct SkFinalNorm { const float* xin; float* out; const float* mod; int gi; float gscale; const float* gfin; float* xbuf; unsigned* cnt;
    __device__ __forceinline__ int brow(int ct, int) const { return 32 * ct; }
    __device__ __forceinline__ void operator()(int row, int ct, int j0, const float (&v)[1][2]) const {
        const int col = 32 * ct + j0, rt = row >> 5, lane = threadIdx.x & 63; const float* gate = mod + (4 + (row >> 5)) * NMOD + gi * DM + col;
        const f32x2 x = *(const f32x2*)(xin + (size_t)row * DM + col), g = *(const f32x2*)gate;
        f32x2 o; o.x = x.x + gscale * (1.f + g.x) * v[0][0]; o.y = x.y + gscale * (1.f + g.y) * v[0][1];
        float ss = o.x * o.x + o.y * o.y;
        ss += __shfl_xor(ss, 1); ss += __shfl_xor(ss, 2); ss += __shfl_xor(ss, 4); ss += __shfl_xor(ss, 8);
        if ((lane & 15) == 0) __hip_atomic_store(xbuf + (size_t)row * 32 + ct, ss, RLX_AGENT);
        asm volatile("s_waitcnt vmcnt(0)" ::: "memory");
        if (lane == 0) __hip_atomic_fetch_add(cnt + 64 * rt, 1u, RLX_AGENT);
        wait_count(cnt + 64 * rt, 256u);
        const float a = __hip_atomic_load(xbuf + (size_t)row * 32 + 2 * (lane & 15), RLX_AGENT), b = __hip_atomic_load(xbuf + (size_t)row * 32 + 2 * (lane & 15) + 1, RLX_AGENT);
        float q = a + b;
        q += __shfl_xor(q, 1); q += __shfl_xor(q, 2); q += __shfl_xor(q, 4); q += __shfl_xor(q, 8);
        const float rs = 1.0f / sqrtf(q * (1.0f / DM) + EPS);
        *(f32x2*)(out + (size_t)row * DM + col) = (f32x2){o.x * rs * gfin[col], o.y * rs * gfin[col + 1]}; } };
template <int NB, int KS, class Epi>
__device__ __forceinline__ void skinny_gemm(Frame& F, const bf16* A, const bf16* Bt, int ntc, const Epi& E, int first_cu = 0) {
    constexpr int K = KS * 128;
    const int lane = F.lane, wave = F.wave, r32 = lane & 31, hi = lane >> 5, tid = F.tid;
    LAS float* red = (LAS float*)F.lds;
    if ((int)blockIdx.x < first_cu) return;
    for (int tile = blockIdx.x - first_cu; tile < 8 * ntc; tile += F.G - first_cu) {
        const int rt = tile / ntc, ct = tile % ntc;
        f32x4 pf = (f32x4){0.f, 0.f, 0.f, 0.f}; E.pre(32 * rt + (tid >> 4), ct, 2 * (tid & 15), pf);
        const bf16* ap = A + (size_t)(32 * rt + r32) * K + wave * (K / 8) + 8 * hi;
        f32x16 acc[NB];
#pragma unroll
        for (int nb = 0; nb < NB; ++nb)
#pragma unroll
            for (int r = 0; r < 16; ++r) acc[nb][r] = 0.f;
        const bf16* bp0 = Bt + (size_t)(E.brow(ct, 0) + r32) * K + wave * (K / 8) + 8 * hi;
        const bf16* bp1 = Bt + (size_t)(E.brow(ct, NB - 1) + r32) * K + wave * (K / 8) + 8 * hi;
        constexpr int SB = (KS % 11 == 0) ? 11 : KS;
#pragma unroll 1
        for (int s0 = 0; s0 < KS; s0 += SB) {
            bf16x8 af[SB], b0[SB], b1[SB];
#pragma unroll
            for (int s = 0; s < SB; ++s) { af[s] = *(const bf16x8*)(ap + 16 * (s0 + s)); b0[s] = *(const bf16x8*)(bp0 + 16 * (s0 + s)); if (NB == 2) b1[s] = *(const bf16x8*)(bp1 + 16 * (s0 + s)); }
#pragma unroll
            for (int s = 0; s < SB; ++s) {
                acc[0] = __builtin_amdgcn_mfma_f32_32x32x16_bf16(af[s], b0[s], acc[0], 0, 0, 0);
                if (NB == 2) acc[NB - 1] = __builtin_amdgcn_mfma_f32_32x32x16_bf16(af[s], b1[s], acc[NB - 1], 0, 0, 0);
            }
        }
#pragma unroll
        for (int nb = 0; nb < NB; ++nb)
#pragma unroll
            for (int r = 0; r < 16; ++r) red[((wave * NB + nb) * 32 + (r & 3) + 8 * (r >> 2) + 4 * hi) * 32 + r32] = acc[nb][r];
        __syncthreads();
        {
            const int i = tid >> 4, j0 = 2 * (tid & 15);
            float v[NB][2];
#pragma unroll
            for (int nb = 0; nb < NB; ++nb) { v[nb][0] = 0.f; v[nb][1] = 0.f;
#pragma unroll
                for (int w = 0; w < 8; ++w) { const f32x2 x = *(const LAS f32x2*)(red + ((w * NB + nb) * 32 + i) * 32 + j0); v[nb][0] += x.x; v[nb][1] += x.y; } }
            E(32 * rt + i, ct, j0, v, pf);
        }
        __syncthreads();
    }
}

constexpr int N_PHASES_K = 15;

__global__ void __launch_bounds__(512, 2) mk_fwd(Args args) {
    extern __shared__ __attribute__((aligned(16))) unsigned char lds_raw[];
    cg::grid_group grid = cg::this_grid();
    Frame F;
    F.lds = (LAS unsigned char*)lds_raw;
    F.tid = threadIdx.x; F.lane = F.tid & 63; F.wave = __builtin_amdgcn_readfirstlane(F.tid >> 6);
    F.G = gridDim.x; { const int bx = blockIdx.x; F.vcu = (F.G % 8 == 0) ? (bx % 8) * (F.G / 8) + bx / 8 : bx; }
    F.gw = blockIdx.x * NWAVES + F.wave; F.NGW = F.G * NWAVES;
#pragma unroll
    for (int i = 0; i < 34; ++i) F.in[i] = args.in[i];
    F.out = args.out;
    unsigned char* ws = args.ws;
    F.mod = (float*)(ws + WS_MOD);
    F.abar = (f32x2*)(ws + WS_S5C); F.a64 = (f32x2*)(ws + WS_S5C + 16384); F.bbar = (f32x2*)(ws + WS_S5C + 32768); F.cmt = (bf16*)(ws + WS_S5C + 294912); F.bmh = (bf16*)(ws + WS_S5C + 425984);
    F.F2P = (float*)(ws + WS_F2P); F.F2S = (float*)(ws + WS_F2S); F.E = (f32x2*)(ws + WS_E);
    F.WUP1 = (bf16*)(ws + WS_WUP1); F.WDN1 = (bf16*)(ws + WS_WDN1); F.WIN = (bf16*)(ws + WS_WIN); F.WGLU = (bf16*)(ws + WS_WGLU); F.WOUT = (bf16*)(ws + WS_WOUT);
    F.WUP2 = (bf16*)(ws + WS_WUP2); F.WDN2 = (bf16*)(ws + WS_WDN2); F.HA = (bf16*)(ws + WS_HA); F.HID = (bf16*)(ws + WS_HID);
    F.U = (bf16*)(ws + WS_U); F.Q = (bf16*)(ws + WS_Q); F.KB = (bf16*)(ws + WS_KB); F.VB = (bf16*)(ws + WS_VB); F.Z = (bf16*)(ws + WS_Z); F.O = (bf16*)(ws + WS_O); F.PB = (float*)(ws + WS_PB);
    const int lo = args.ph_lo, hi = args.ph_hi;
    volatile LAS unsigned* misc = (volatile LAS unsigned*)(F.lds + LDS_BYTES - 256);
    if (F.tid < 2) misc[F.tid] = 0u;
    __syncthreads();
    XcdBarrier xbar; xbar.bar = (unsigned*)(ws + WS_BAR); xbar.x = 0; xbar.st = nullptr;
    if (hi - lo > 1) xbar = xcd_barrier_post((unsigned*)(ws + WS_BAR), misc);
#define IN(k) (lo <= (k) && (k) < hi)
#define REPS(k) _Pragma("nounroll") for (int rep_ = 0; rep_ < 1 + ((MK_REP_MASK >> (k)) & 1); ++rep_)
#define SEAM(k) do { if (IN(k) && IN((k) + 1)) { if ((k) == 100) grid.sync(); else xcd_barrier(xbar); } } while (0)
    typedef pg8::StaticOrder SO;
    float* xs_out = F.out + (size_t)NP * DM;

    if (hi > 1000) grid.sync();
    unsigned* sw = (unsigned*)(ws + WS_BAR) + 3840;
    const bool one_launch = false;
    const bool one_s5 = false;
    if (IN(0)) { phase_ada(F); if (one_launch) seam_arrive(sw); phase_s5const(F); phase_weights(F); }
    if (!one_launch) SEAM(0);
    if (IN(1)) { if (one_launch) seam_wait(sw, (unsigned)F.G); phase_norm<false>(F, F.in[0], F.in[1], F.in[11], 0, 1); }
    SEAM(1);
    if (IN(2)) REPS(2) { pg8::Gemm g{F.HA, F.WUP1, MT, NUP, DM}; SO S; S.init(MT, NUP, F.G, (int)blockIdx.x); EpiSwiglu E{F.HID};
        pg8::gemm_phase<EpiSwiglu, SO, PG8_ALIGN, PG8_SP2>(F.lds, g, S, E);
    }
    SEAM(2);
    if (IN(3)) REPS(3) { pg8::Gemm g{F.HID, F.WDN1, NP, DM, FF}; SO S; S.init(NP, DM, F.G, (int)blockIdx.x); EpiResid E{F.in[0], F.in[1], F.out, F.mod, 2, 0.5f};
        pg8::gemm_phase<EpiResid, SO, PG8_ALIGN, PG8_SP2>(F.lds, g, S, E);
        skinny_gemm<1, 22>(F, F.HID + (size_t)NP * FF, F.WDN1, 32, SkResid{F.in[1], xs_out, F.mod, 2, 0.5f});
    }
    SEAM(3);
    if (IN(4)) REPS(4) phase_norm<true>(F, F.out, xs_out, F.in[14], 3, 4);
    SEAM(4);
    if (IN(5)) REPS(5) { phase_fcum(F);
        pg8::Gemm g{F.HA, F.WIN, NP, 2048, DM}; SO S; S.init(NP, 2048, F.G, (int)blockIdx.x); EpiIn E{F.U, F.Q, F.KB, F.VB, F.out};
        pg8::gemm_phase<EpiIn, SO, PG8_ALIGN, PG8_SP2>(F.lds, g, S, E);
        skinny_gemm<1, 8>(F, F.HA + (size_t)NP * DM, F.WIN, 64, SkIn{F.U, F.Q, F.KB, F.VB, F.out});
    }
    SEAM(5);
    if (IN(6)) {
        if (one_s5) { s5_pass_a(F); seam_arrive(sw + 64); }
        for (int j = F.vcu; j < 256; j += F.G) attn_sample_unit(F, j >> 5, (j >> 2) & 7, j & 3);
        for (int uix_ = F.vcu; uix_ < 256 * (1 + ((MK_REP_MASK >> 6) & 1)); uix_ += F.G) {
            const int uix = uix_ & 255, bh = uix >> 3, s = uix & 7;
            attn_prompt_unit(F, bh >> 3, bh & 7, 15 - s);
            attn_prompt_unit(F, bh >> 3, bh & 7, s);
        }
        if (!one_s5) s5_pass_a(F);
        __syncthreads();
    }
    if (!one_s5) SEAM(6);
    if (IN(7)) { if (one_s5) seam_wait(sw + 64, (unsigned)F.G); s5_pass_c(F); }
    SEAM(7);
    if (IN(8)) REPS(8) { pg8::Gemm g{F.Z, F.WGLU, MT, DH, DH}; SO S; S.init(MT, DH, F.G, (int)blockIdx.x); EpiGlu E{F.Z, F.U, F.in[26]};
        pg8::gemm_phase<EpiGlu, SO, PG8_ALIGN, PG8_SP2>(F.lds, g, S, E);
        const bool half_idle = (F.G == 256);
        if (half_idle && blockIdx.x >= 130) { phase_mixnorm(F, 2, ((int)blockIdx.x - 130) * NWAVES + F.wave, 126 * NWAVES); }
    }
    SEAM(8);
    if (IN(9)) phase_mixnorm(F, F.G == 256 ? 1 : 3, 0, 0);
    SEAM(9);
    if (IN(10)) REPS(10) { pg8::Gemm g{F.HA, F.WOUT, NP, DM, DM}; SO S; S.init(NP, DM, F.G, (int)blockIdx.x); EpiResid E{F.out, xs_out, F.out, F.mod, 5, 1.0f};
        pg8::gemm_phase<EpiResid, SO, PG8_ALIGN, PG8_SP2>(F.lds, g, S, E);
        skinny_gemm<1, 8>(F, F.HA + (size_t)NP * DM, F.WOUT, 32, SkResid{xs_out, xs_out, F.mod, 5, 1.0f}); }
    SEAM(10);
    if (IN(11)) REPS(11) phase_norm<false>(F, F.out, xs_out, F.in[30], 6, 7);
    SEAM(11);
    if (IN(12)) REPS(12) { pg8::Gemm g{F.HA, F.WUP2, MT, NUP, DM}; SO S; S.init(MT, NUP, F.G, (int)blockIdx.x); EpiSwiglu E{F.HID};
        pg8::gemm_phase<EpiSwiglu, SO, PG8_ALIGN, PG8_SP2>(F.lds, g, S, E);
    }
    SEAM(12);
    if (IN(13)) { pg8::Gemm g{F.HID, F.WDN2, NP, DM, FF}; SO S; S.init(NP, DM, F.G, (int)blockIdx.x); EpiResid E{F.out, xs_out, F.out, F.mod, 8, 0.5f};
        pg8::gemm_phase<EpiResid, SO, PG8_ALIGN, PG8_SP2>(F.lds, g, S, E);
        skinny_gemm<1, 22>(F, F.HID + (size_t)NP * FF, F.WDN2, 32, SkResid{xs_out, xs_out, F.mod, 8, 0.5f}); }
    SEAM(13);
    if (IN(14)) phase_finalnorm(F);
#undef IN
#undef SEAM
}
constexpr int N_PHASES = 15;
static_assert(N_PHASES == N_PHASES_K, "phase count");

#ifndef MK_MULTI
#define MK_MULTI 0
#endif
extern "C" void kernel_launch(void* const* d_in, const int* in_sizes, int n_in, void* d_out, int out_size, void* d_ws, size_t ws_size, hipStream_t stream) {
    static int grid = 0;
    if (grid == 0) {
        int dev = 0, cus = 0, per_cu = 0;
        if (hipGetDevice(&dev) != hipSuccess || hipDeviceGetAttribute(&cus, hipDeviceAttributeMultiprocessorCount, dev) != hipSuccess) { fprintf(stderr, "kernel_launch: device query failed\n"); grid = -1; return; }
        if (hipFuncSetAttribute((const void*)mk_fwd, hipFuncAttributeMaxDynamicSharedMemorySize, LDS_BYTES) != hipSuccess) { fprintf(stderr, "kernel_launch: hipFuncSetAttribute failed\n"); grid = -1; return; }
        if (hipOccupancyMaxActiveBlocksPerMultiprocessor(&per_cu, (const void*)mk_fwd, NWAVES * 64, LDS_BYTES) != hipSuccess || per_cu < 1) per_cu = 1;
        (void)hipGetLastError();
        grid = cus;
        if (n_in != 34 || ws_size < 176 * MiB) fprintf(stderr, "kernel_launch: unexpected n_in %d / ws %zu\n", n_in, ws_size);
    }
    if (grid < 0) return;
    if (hipMemsetAsync((char*)d_ws + WS_BAR, 0, CTL_BYTES, stream) != hipSuccess) { fprintf(stderr, "kernel_launch: memset failed\n"); return; }
    Args a{};
    for (int i = 0; i < 34; ++i) a.in[i] = (const float*)d_in[i];
    a.out = (float*)d_out; a.ws = (unsigned char*)d_ws;
#if MK_MULTI
    for (int p = 0; p < N_PHASES; ++p) { a.ph_lo = p; a.ph_hi = p + 1; hipLaunchKernelGGL(mk_fwd, dim3(grid), dim3(NWAVES * 64), LDS_BYTES, stream, a); }
#else
    a.ph_lo = 0; a.ph_hi = N_PHASES;
    void* kargs[] = {&a};
    const hipError_t e = hipLaunchCooperativeKernel((const void*)mk_fwd, dim3(grid), dim3(NWAVES * 64), kargs, LDS_BYTES, stream);
    if (e != hipSuccess) fprintf(stderr, "kernel_launch: cooperative launch failed: %s (grid %d)\n", hipGetErrorString(e), grid);
#endif
}
```
